# Optimizing an MI355X kernel written in HIP

```python
import math
import jax, jax.numpy as jnp
from jax import lax
import numpy as np

D_MODEL = 2048
BATCH = 16
SEQ = 256
DEPTH = 4
DEC_BATCH = 2
DEC_SEQ = 1024
PAST_LEN = 256

GRID_W = 64
CONV_WIDTH = 1024
CONV_HEADS = 16
SSM_WIDTH = 1024
SSM_GROUP = 16
SSM_GROUPS = SSM_WIDTH // SSM_GROUP
SSM_STATE = 64
MIX_WIDTH = CONV_WIDTH + SSM_WIDTH
IN_COLS = 3 * CONV_WIDTH + SSM_WIDTH
D_FF = 5632
EPS = 1e-6
DT_MIN = 1e-3
DT_MAX = 1e-1

kernel_name = 'hybrid_conv_s5_diffusion_step'


def _rms(x, g):
    xf = x.astype(jnp.float32)
    y = xf * lax.rsqrt(jnp.mean(xf * xf, axis=-1, keepdims=True) + EPS)
    return (y * g.astype(jnp.float32)).astype(x.dtype)


def _head_rms(x, g):
    hd = CONV_WIDTH // CONV_HEADS
    xh = x.reshape(x.shape[:-1] + (CONV_HEADS, hd))
    return _rms(xh, g.reshape(CONV_HEADS, hd)).reshape(x.shape)


def _dwconv3(x, w, axis):
    n = x.shape[axis]
    pad = [(0, 0)] * x.ndim
    pad[axis] = (1, 1)
    xp = jnp.pad(x, pad)
    return (lax.slice_in_dim(xp, 0, n, axis=axis) * w[0]
            + lax.slice_in_dim(xp, 1, n + 1, axis=axis) * w[1]
            + lax.slice_in_dim(xp, 2, n + 2, axis=axis) * w[2])


def _diag_scan(bu, a_bar, h0):
    bu = bu.at[:, 0].add(a_bar * h0)
    a = jnp.broadcast_to(a_bar, bu.shape)

    def combine(left, right):
        al, bl = left
        ar, br = right
        return ar * al, ar * bl + br

    _, s = lax.associative_scan(combine, (a, bu), axis=1)
    return s


def _s5(u, p, h0_re, h0_im):
    f32 = jnp.float32
    bsz, L, _ = u.shape
    uc = u.astype(f32).reshape(bsz, L, SSM_GROUPS, SSM_GROUP).astype(jnp.complex64)
    h0 = lax.complex(h0_re.astype(f32), h0_im.astype(f32))
    y = jnp.zeros((bsz, L, SSM_GROUPS, SSM_GROUP), f32)
    fin = []
    for d in range(2):
        a = lax.complex(p['a_re'][d].astype(f32), p['a_im'][d].astype(f32))
        dt = jnp.exp(p['log_dt'][d].astype(f32))[:, None]
        a_bar = jnp.exp(a * dt)
        b_bar = ((a_bar - 1.0) / a)[..., None] * lax.complex(
            p['b_re'][d].astype(f32), p['b_im'][d].astype(f32))
        c_mat = lax.complex(p['c_re'][d].astype(f32), p['c_im'][d].astype(f32))
        ud = uc if d == 0 else jnp.flip(uc, 1)
        bu = jnp.einsum('blgh,gnh->blgn', ud, b_bar)
        s = _diag_scan(bu, a_bar, h0[:, d])
        fin.append(s[:, -1])
        yd = jnp.einsum('blgn,ghn->blgh', s, c_mat).real
        y = y + (yd if d == 0 else jnp.flip(yd, 1))
    y = y.reshape(bsz, L, SSM_WIDTH) + p['d'].astype(f32) * u.astype(f32)
    z = jax.nn.gelu(y).astype(u.dtype)
    out = z * jax.nn.sigmoid(z @ p['w_glu'] + p['b_glu'])
    fin = jnp.stack(fin, axis=1)
    return out, fin.real, fin.imag


def _modulation(cvec, w, b):
    m = jax.nn.silu(cvec) @ w + b
    return jnp.split(m[:, None, :], 6, axis=-1)


def _layer(x, mod, p, rows, h0_re, h0_im):
    sh1, sc1, gt1, sh2, sc2, gt2 = mod
    bsz, L, _ = x.shape
    h = _rms(x, p['g_pre1']) * (1 + sc1) + sh1
    proj = h @ p['w_in']
    gb, gc, hv, u = jnp.split(proj, [CONV_WIDTH, 2 * CONV_WIDTH, 3 * CONV_WIDTH], axis=-1)
    v = gc * hv
    if rows is None:
        v = _dwconv3(v, p['conv_w'], 1)
    else:
        v = _dwconv3(v.reshape(bsz, rows, GRID_W, CONV_WIDTH), p['conv_w'], 2).reshape(bsz, L, CONV_WIDTH)
    conv_out = gb * v
    ssm_out, fin_re, fin_im = _s5(u, p, h0_re, h0_im)
    mixed = jnp.concatenate([_head_rms(conv_out, p['g_conv_out']),
                             _rms(ssm_out, p['g_ssm_out'])], axis=-1) @ p['w_out']
    x = x + gt1 * _rms(mixed, p['g_post1'])
    h = _rms(x, p['g_pre2']) * (1 + sc2) + sh2
    up = h @ p['w_up']
    if rows is None:
        up = _dwconv3(up, p['ffn_conv_w'], 1)
    else:
        up = _dwconv3(up.reshape(bsz, rows, GRID_W, 2 * D_FF), p['ffn_conv_w'], 1).reshape(bsz, L, 2 * D_FF)
    a, g = jnp.split(up, 2, axis=-1)
    ff = (jax.nn.silu(g) * a) @ p['w_down']
    x = x + gt2 * _rms(ff, p['g_post2'])
    return x, fin_re, fin_im


def setup_inputs(seed: int = 0) -> dict:
    key = jax.random.key(seed)
    ks = iter(jax.random.split(key, 40))
    f32 = jnp.float32
    nrm = lambda shape, s: jax.random.normal(next(ks), shape, f32) * s
    gain = lambda shape: 1.0 + 0.02 * jax.random.normal(next(ks), shape, f32)
    n_idx = jnp.arange(SSM_STATE, dtype=f32)
    a_re = -0.5 + nrm((DEPTH, 2, SSM_GROUPS, SSM_STATE), 0.01)
    a_im = math.pi * n_idx + nrm((DEPTH, 2, SSM_GROUPS, SSM_STATE), 0.01)
    log_dt = jax.random.uniform(next(ks), (DEPTH, 2, SSM_GROUPS), f32,
                                math.log(DT_MIN), math.log(DT_MAX))
    return {
        'x_prompt': nrm((BATCH, SEQ, D_MODEL), 1.0),
        'x_sample': nrm((DEC_BATCH, DEC_SEQ, D_MODEL), 1.0),
        'state_ssm_re': nrm((DEC_BATCH, DEPTH, 2, SSM_GROUPS, SSM_STATE), 0.5),
        'state_ssm_im': nrm((DEC_BATCH, DEPTH, 2, SSM_GROUPS, SSM_STATE), 0.5),
        'c': nrm((DEC_BATCH, D_MODEL), 1.0),
        'c_ctx': nrm((D_MODEL,), 1.0),
        'w_ada': nrm((DEPTH, D_MODEL, 6 * D_MODEL), 0.5 * D_MODEL ** -0.5),
        'b_ada': nrm((DEPTH, 6 * D_MODEL), 0.01),
        'g_pre1': gain((DEPTH, D_MODEL)),
        'w_in': nrm((DEPTH, D_MODEL, IN_COLS), D_MODEL ** -0.5),
        'conv_w': nrm((DEPTH, 3, CONV_WIDTH), 3 ** -0.5),
        'ssm_a_re': a_re,
        'ssm_a_im': a_im,
        'ssm_log_dt': log_dt,
        'ssm_b_re': nrm((DEPTH, 2, SSM_GROUPS, SSM_STATE, SSM_GROUP), (2 * SSM_GROUP) ** -0.5),
        'ssm_b_im': nrm((DEPTH, 2, SSM_GROUPS, SSM_STATE, SSM_GROUP), (2 * SSM_GROUP) ** -0.5),
        'ssm_c_re': nrm((DEPTH, 2, SSM_GROUPS, SSM_GROUP, SSM_STATE), (2 * SSM_STATE) ** -0.5),
        'ssm_c_im': nrm((DEPTH, 2, SSM_GROUPS, SSM_GROUP, SSM_STATE), (2 * SSM_STATE) ** -0.5),
        'ssm_d': nrm((DEPTH, SSM_WIDTH), 1.0),
        'w_glu': nrm((DEPTH, SSM_WIDTH, SSM_WIDTH), SSM_WIDTH ** -0.5),
        'b_glu': nrm((DEPTH, SSM_WIDTH), 0.01),
        'g_conv_out': gain((DEPTH, CONV_WIDTH)),
        'g_ssm_out': gain((DEPTH, SSM_WIDTH)),
        'w_out': nrm((DEPTH, MIX_WIDTH, D_MODEL), MIX_WIDTH ** -0.5),
        'g_post1': gain((DEPTH, D_MODEL)),
        'g_pre2': gain((DEPTH, D_MODEL)),
        'w_up': nrm((DEPTH, D_MODEL, 2 * D_FF), D_MODEL ** -0.5),
        'ffn_conv_w': nrm((DEPTH, 3, 2 * D_FF), 3 ** -0.5),
        'w_down': nrm((DEPTH, D_FF, D_MODEL), D_FF ** -0.5),
        'g_post2': gain((DEPTH, D_MODEL)),
    }


def reference(x_prompt, x_sample, state_ssm_re, state_ssm_im, c, c_ctx, w_ada, b_ada,
              g_pre1, w_in, conv_w, ssm_a_re, ssm_a_im, ssm_log_dt, ssm_b_re, ssm_b_im,
              ssm_c_re, ssm_c_im, ssm_d, w_glu, b_glu, g_conv_out, g_ssm_out, w_out,
              g_post1, g_pre2, w_up, ffn_conv_w, w_down, g_post2):
    dec_rows = x_sample.shape[1] // GRID_W
    zero_state = jnp.zeros((x_prompt.shape[0], 2, SSM_GROUPS, SSM_STATE), jnp.float32)
    yp = x_prompt
    ys = x_sample
    new_re = []
    new_im = []
    for l in range(DEPTH):
        p = {
            'g_pre1': g_pre1[l], 'w_in': w_in[l], 'conv_w': conv_w[l],
            'a_re': ssm_a_re[l], 'a_im': ssm_a_im[l], 'log_dt': ssm_log_dt[l],
            'b_re': ssm_b_re[l], 'b_im': ssm_b_im[l], 'c_re': ssm_c_re[l], 'c_im': ssm_c_im[l],
            'd': ssm_d[l], 'w_glu': w_glu[l], 'b_glu': b_glu[l],
            'g_conv_out': g_conv_out[l], 'g_ssm_out': g_ssm_out[l], 'w_out': w_out[l],
            'g_post1': g_post1[l], 'g_pre2': g_pre2[l], 'w_up': w_up[l],
            'ffn_conv_w': ffn_conv_w[l], 'w_down': w_down[l], 'g_post2': g_post2[l],
        }
        mod_ctx = _modulation(c_ctx[None, :], w_ada[l], b_ada[l])
        yp, fin_re, fin_im = _layer(yp, mod_ctx, p, None, zero_state, zero_state)
        new_re.append(fin_re)
        new_im.append(fin_im)
        mod_lat = _modulation(c, w_ada[l], b_ada[l])
        ys, _, _ = _layer(ys, mod_lat, p, dec_rows, state_ssm_re[:, l], state_ssm_im[:, l])
    new_state_re = jnp.stack(new_re, axis=1)
    new_state_im = jnp.stack(new_im, axis=1)
    return (yp, ys, new_state_re, new_state_im)
```

```cpp
#include <hip/hip_runtime.h>
#include <cstdio>
#include <cstdint>
namespace pg8 {
#define PG8_LAS __attribute__((address_space(3)))
typedef unsigned short bf16_t;
typedef short bf16x8 __attribute__((ext_vector_type(8)));
typedef float f32x4 __attribute__((ext_vector_type(4)));
typedef unsigned u32x4 __attribute__((ext_vector_type(4)));
constexpr int BM = 256, BK = 64, HALF = 128, HTB = HALF * BK * 2  , STAGE_BYTES = 8 * HTB, NXCD = 8, WGM = 8;

__host__ __device__ __forceinline__ int lds_byte(int r, int c) { const int st = (r >> 4) * 2 + (c >> 5), rr = r & 15, cc = c & 31, ob = rr * 64 + cc * 2; return st * 1024 + (ob ^ (((ob >> 9) & 1) << 5)); }
__host__ __device__ __forceinline__ void stage_rc(int b, int& R, int& C) { const int st = b / 1024, sb = b % 1024, swz = sb ^ (((sb >> 9) & 1) << 5); R = (st >> 1) * 16 + swz / 64; C = (st & 1) * 32 + (swz % 64) / 2; }
__host__ __device__ __forceinline__ int perm32(int rho) { const int n = rho >> 4, i = rho & 15; return 8 * (i >> 2) + 4 * n + (i & 3); }

struct Unit { int pm, pn; };
struct Gemm { const bf16_t* A; const bf16_t* Bt; int M, N, K; int ld = 0; int nsp = 1; };

struct StaticOrder {
    int nM, nN, nwg, G, c;
    __host__ __device__ void init(int M, int N, int G_, int c_) { nM = M / BM; nN = N / BM; nwg = nM * nN; G = G_; c = c_; }
    __host__ __device__ bool next(int i, Unit& u) const {
        const long L = (long)i * G + c; if (L >= nwg) return false;
        int wgid = (int)L; { const int q = nwg / NXCD, r = nwg % NXCD, xcd = wgid % NXCD, off = wgid / NXCD; wgid = (xcd < r ? xcd * (q + 1) : r * (q + 1) + (xcd - r) * q) + off; }
        const int nig = WGM * nN, gid = wgid / nig, fm = gid * WGM, gsz = (nM - fm) < WGM ? (nM - fm) : WGM;
        u.pm = fm + ((wgid % nig) % gsz); u.pn = (wgid % nig) / gsz; return true;
    }
    __device__ __forceinline__ void a_ready(const Unit&) const {}
    __device__ __forceinline__ void done(const Unit&) const {}
};

__device__ __forceinline__ unsigned cvt_pk_bf16(float lo, float hi) { unsigned r; asm volatile("v_cvt_pk_bf16_f32 %0, %1, %2" : "=v"(r) : "v"(lo), "v"(hi)); return r; }
typedef float f32x2 __attribute__((ext_vector_type(2)));
__device__ __forceinline__ f32x2 gelu_pk(f32x2 v) {
    const f32x2 av = __builtin_elementwise_abs(v), d = av * 0.2316418882f + 1.0f;
    f32x2 t; t.x = __builtin_amdgcn_rcpf(d.x); t.y = __builtin_amdgcn_rcpf(d.y);
    f32x2 q = t * 0.5307027145f + (-0.7265760135f); q = q * t + 0.7107068705f; q = q * t + (-0.142248368f); q = q * t + 0.127414796f; q = q * t;
    const f32x2 s = (v * v) * (-0.72134752044f);
    f32x2 e; e.x = __builtin_amdgcn_exp2f(s.x); e.y = __builtin_amdgcn_exp2f(s.y);
    const f32x2 m = v * (q * e), r = v - m;
    f32x2 o; o.x = v.x < 0.f ? m.x : r.x; o.y = v.y < 0.f ? m.y : r.y; return o;
}

template <int ACT  > struct EpiBf16 {
    static constexpr bool PERM = true, AFTER_DRAIN = false; static_assert(ACT == 0 || ACT == 1, "EpiBf16: ACT is 0 (none) or 1 (gelu_pk)");
    bf16_t* O; int ldc; const float* bias; int split_cols; size_t split_stride; float scale0;
    __device__ __forceinline__ void operator()(const f32x4 (&acc)[2][2][4][2], const Unit& u, int wr, int wc, int fr, int fq) const {
        const int row0 = u.pm * BM + wr * 64 + fr; int colt = u.pn * BM; bf16_t* base = O;
        float sc = 1.f; if (split_cols) { const int t = colt / split_cols; base += (size_t)t * split_stride; colt -= t * split_cols; if (t == 0) sc = scale0; }
        const int col0 = colt + wc * 32 + 8 * fq, bcol0 = u.pn * BM + wc * 32 + 8 * fq;
        f32x4 bv[2][2];
#pragma unroll
        for (int bj = 0; bj < 2; ++bj)
#pragma unroll
            for (int n = 0; n < 2; ++n) bv[bj][n] = bias ? *(const f32x4*)(bias + bcol0 + bj * HALF + 4 * n) : (f32x4){0.f, 0.f, 0.f, 0.f};
#pragma unroll
        for (int ai = 0; ai < 2; ++ai)
#pragma unroll
            for (int m = 0; m < 4; ++m) { bf16_t* rowp = base + (size_t)(row0 + ai * HALF + m * 16) * ldc + col0;
#pragma unroll
                for (int bj = 0; bj < 2; ++bj) { f32x4 v0 = acc[ai][bj][m][0] + bv[bj][0], v1 = acc[ai][bj][m][1] + bv[bj][1];
                    if (ACT == 1) { f32x2 a = gelu_pk((f32x2){v0[0], v0[1]}), b = gelu_pk((f32x2){v0[2], v0[3]}), c = gelu_pk((f32x2){v1[0], v1[1]}), d = gelu_pk((f32x2){v1[2], v1[3]});
                        v0 = (f32x4){a.x, a.y, b.x, b.y}; v1 = (f32x4){c.x, c.y, d.x, d.y}; }
                    v0 = v0 * sc; v1 = v1 * sc; u32x4 w; w.x = cvt_pk_bf16(v0[0], v0[1]); w.y = cvt_pk_bf16(v0[2], v0[3]); w.z = cvt_pk_bf16(v1[0], v1[1]); w.w = cvt_pk_bf16(v1[2], v1[3]);
                    *(u32x4*)(rowp + bj * HALF) = w; } }
    }
};
template <class Epi, class Sched, bool ALIGN_EPI = false, bool SP2 = false>
__device__ __forceinline__ void gemm_phase(PG8_LAS unsigned char* lds, const Gemm g, const Sched& S, const Epi& E) {
    int tid_ = threadIdx.x; asm volatile("" : "+v"(tid_));
    const int tid = tid_, wid = __builtin_amdgcn_readfirstlane(tid >> 6), lane = tid & 63, wr = wid >> 2, wc = wid & 3, fr = lane & 15, fq = lane >> 4;
    const int K = g.K, nt = K / BK, ld = g.ld ? g.ld : g.K, nNr = g.N / BM / g.nsp;
    unsigned voffA[2], voffB[2];
#pragma unroll
    for (int i = 0; i < 2; ++i) { int R, C; stage_rc(tid * 16 + i * 8192, R, C); const int Rb = Epi::PERM ? ((R & ~31) + perm32(R & 31)) : R;
        voffA[i] = (unsigned)(R * ld + C) * 2u; voffB[i] = (unsigned)(Rb * ld + C) * 2u; }
    const size_t kstep = (size_t)(BK * 2);
    const size_t hstep = (size_t)HALF * ld * 2;
    const size_t tstep = 2 * hstep;
    const unsigned ldsw = (unsigned)wid * 1024u;
    const int aoff = lds_byte(wr * 64 + fr, fq * 8), boff = lds_byte(wc * 32 + fr, fq * 8);
#define PG8_SA(b, h) (((b) * 2 + (h)) * HTB)
#define PG8_SB(b, h) ((4 + (b) * 2 + (h)) * HTB)
#define PG8_STAGE(bufoff, gbase, voff) do { _Pragma("unroll") for (int _i = 0; _i < 2; ++_i) \
        __builtin_amdgcn_global_load_lds((const unsigned*)((const char*)(gbase) + (voff)[_i]), (PG8_LAS unsigned*)(lds + (bufoff) + ldsw + _i * 8192), 16, 0, 0); } while (0)
#define PG8_LDA(dst, b, h) do { _Pragma("unroll") for (int m = 0; m < 4; ++m) _Pragma("unroll") for (int k = 0; k < 2; ++k) dst[m][k] = *(const PG8_LAS bf16x8*)(lds + PG8_SA(b, h) + aoff + m * 2048 + k * 1024); } while (0)
#define PG8_LDB(dst, b, h) do { _Pragma("unroll") for (int n = 0; n < 2; ++n) _Pragma("unroll") for (int k = 0; k < 2; ++k) dst[n][k] = *(const PG8_LAS bf16x8*)(lds + PG8_SB(b, h) + boff + n * 2048 + k * 1024); } while (0)
#define PG8_MMA(ai, bj, At, Bt) do { __builtin_amdgcn_s_setprio(1); _Pragma("unroll") for (int m = 0; m < 4; ++m) _Pragma("unroll") for (int n = 0; n < 2; ++n) _Pragma("unroll") for (int k = 0; k < 2; ++k) \
        acc[ai][bj][m][n] = __builtin_amdgcn_mfma_f32_16x16x32_bf16(Bt[n][k], At[m][k], acc[ai][bj][m][n], 0, 0, 0); __builtin_amdgcn_s_setprio(0); } while (0)
#define PG8_WAIT_V(n) asm volatile("s_waitcnt vmcnt(" #n ")" ::: "memory")
#define PG8_WAIT_L(n) asm volatile("s_waitcnt lgkmcnt(" #n ")" ::: "memory")
#define PG8_BAR __builtin_amdgcn_s_barrier()
#define PG8_SCHED __builtin_amdgcn_sched_barrier(0)
    Unit cur, nxt; int ui = 0;
    if (!S.next(0, cur)) return;
    f32x4 acc[2][2][4][2];
#pragma unroll
    for (int a = 0; a < 2; ++a)
#pragma unroll
        for (int b = 0; b < 2; ++b)
#pragma unroll
            for (int m = 0; m < 4; ++m)
#pragma unroll
                for (int n = 0; n < 2; ++n) acc[a][b][m][n] = (f32x4){0.f, 0.f, 0.f, 0.f};
    bf16x8 At[4][2], B0[2][2], B1[2][2];
#define PG8_APTR(u) ((const char*)g.A + (size_t)(u).pm * tstep + (size_t)((u).pn / nNr) * K * 2)
#define PG8_BPTR(u) ((const char*)g.Bt + (size_t)((u).pn % nNr) * tstep + (size_t)((u).pn / nNr) * K * 2)
    const char* cA = PG8_APTR(cur); const char* cB = PG8_BPTR(cur);
    S.a_ready(cur);
    if constexpr (SP2) {
        PG8_STAGE(PG8_SB(0, 0), cB, voffB); PG8_STAGE(PG8_SB(0, 1), cB + hstep, voffB); PG8_STAGE(PG8_SA(0, 0), cA, voffA); PG8_STAGE(PG8_SA(0, 1), cA + hstep, voffA);
        if (wr == 1) PG8_BAR;
        PG8_WAIT_V(2); PG8_BAR;
        PG8_STAGE(PG8_SB(1, 0), cB + kstep, voffB); PG8_STAGE(PG8_SA(1, 0), cA + kstep, voffA); PG8_STAGE(PG8_SB(1, 1), cB + hstep + kstep, voffB);
        PG8_WAIT_V(6); PG8_BAR;
    } else {
        PG8_STAGE(PG8_SB(0, 0), cB, voffB); PG8_STAGE(PG8_SA(0, 0), cA, voffA); PG8_STAGE(PG8_SB(0, 1), cB + hstep, voffB); PG8_STAGE(PG8_SA(0, 1), cA + hstep, voffA);
        if (wr == 1) PG8_BAR;
        PG8_WAIT_V(4); PG8_BAR;
        PG8_STAGE(PG8_SB(1, 0), cB + kstep, voffB); PG8_STAGE(PG8_SA(1, 0), cA + kstep, voffA); PG8_STAGE(PG8_SB(1, 1), cB + hstep + kstep, voffB);
        PG8_WAIT_V(6); PG8_BAR;
    }
    for (;;) {
        const bool has_next = S.next(ui + 1, nxt);
        const char* nA = has_next ? PG8_APTR(nxt) : cA; const char* nB = has_next ? PG8_BPTR(nxt) : cB;
        for (int t = 0; t < nt; t += 2) {
            const bool last = (t == nt - 2);
            const char* a1 = cA + (size_t)(t + 1) * kstep;
            const char* a2 = last ? nA : cA + (size_t)(t + 2) * kstep; const char* b2 = last ? nB : cB + (size_t)(t + 2) * kstep;
            const char* a3 = a2 + kstep; const char* b3 = b2 + kstep;
            if (last && has_next) S.a_ready(nxt);
            if constexpr (SP2) {
            PG8_LDB(B0, 0, 0); PG8_LDB(B1, 0, 1); PG8_SCHED; PG8_LDA(At, 0, 0); PG8_STAGE(PG8_SA(1, 1), a1 + hstep, voffA);
            PG8_WAIT_V(8); PG8_WAIT_L(0); PG8_BAR; PG8_MMA(0, 0, At, B0); PG8_MMA(0, 1, At, B1); PG8_BAR; PG8_SCHED;
            PG8_LDA(At, 0, 1); PG8_STAGE(PG8_SB(0, 0), b2, voffB); PG8_STAGE(PG8_SB(0, 1), b2 + hstep, voffB); PG8_STAGE(PG8_SA(0, 0), a2, voffA);
            PG8_WAIT_V(8); PG8_WAIT_L(0); PG8_BAR; PG8_MMA(1, 0, At, B0); PG8_MMA(1, 1, At, B1); PG8_BAR; PG8_SCHED;
            PG8_LDB(B0, 1, 0); PG8_LDB(B1, 1, 1); PG8_SCHED; PG8_LDA(At, 1, 0); PG8_STAGE(PG8_SA(0, 1), a2 + hstep, voffA);
            PG8_WAIT_V(8); PG8_WAIT_L(0); PG8_BAR; PG8_MMA(0, 0, At, B0); PG8_MMA(0, 1, At, B1); PG8_BAR; PG8_SCHED;
            PG8_LDA(At, 1, 1); PG8_STAGE(PG8_SB(1, 0), b3, voffB); PG8_STAGE(PG8_SB(1, 1), b3 + hstep, voffB); PG8_STAGE(PG8_SA(1, 0), a3, voffA);
            PG8_WAIT_V(8); PG8_WAIT_L(0); PG8_BAR; PG8_MMA(1, 0, At, B0); PG8_MMA(1, 1, At, B1); PG8_BAR; PG8_SCHED;
            } else {
            PG8_LDB(B0, 0, 0); PG8_SCHED; PG8_LDA(At, 0, 0); PG8_STAGE(PG8_SA(1, 1), a1 + hstep, voffA);
            PG8_WAIT_L(8); PG8_BAR; PG8_WAIT_L(0); PG8_MMA(0, 0, At, B0); PG8_BAR; PG8_SCHED;
            PG8_LDB(B1, 0, 1); PG8_STAGE(PG8_SB(0, 0), b2, voffB);
            PG8_BAR; PG8_WAIT_L(0); PG8_MMA(0, 1, At, B1); PG8_BAR;
            PG8_LDA(At, 0, 1); PG8_STAGE(PG8_SA(0, 0), a2, voffA);
            PG8_BAR; PG8_WAIT_L(0); PG8_MMA(1, 0, At, B0); PG8_BAR; PG8_SCHED;
            PG8_STAGE(PG8_SB(0, 1), b2 + hstep, voffB);
            PG8_WAIT_V(6); PG8_BAR; PG8_MMA(1, 1, At, B1); PG8_BAR;
            PG8_LDB(B0, 1, 0); PG8_SCHED; PG8_LDA(At, 1, 0); PG8_STAGE(PG8_SA(0, 1), a2 + hstep, voffA);
            PG8_WAIT_L(8); PG8_BAR; PG8_WAIT_L(0); PG8_MMA(0, 0, At, B0); PG8_BAR; PG8_SCHED;
            PG8_LDB(B1, 1, 1); PG8_STAGE(PG8_SB(1, 0), b3, voffB);
            PG8_BAR; PG8_WAIT_L(0); PG8_MMA(0, 1, At, B1); PG8_BAR;
            PG8_LDA(At, 1, 1); PG8_STAGE(PG8_SA(1, 0), a3, voffA);
            PG8_BAR; PG8_WAIT_L(0); PG8_MMA(1, 0, At, B0); PG8_BAR; PG8_SCHED;
            PG8_STAGE(PG8_SB(1, 1), b3 + hstep, voffB);
            PG8_WAIT_V(6); PG8_BAR; PG8_MMA(1, 1, At, B1); PG8_BAR;
            }
        }
        if constexpr (ALIGN_EPI) { if (wr == 0) PG8_BAR; }
        if constexpr (!Epi::AFTER_DRAIN) { E(acc, cur, wr, wc, fr, fq); S.done(cur); }
        if (!has_next) break;
#pragma unroll
        for (int a = 0; a < 2; ++a)
#pragma unroll
            for (int b = 0; b < 2; ++b)
#pragma unroll
                for (int m = 0; m < 4; ++m)
#pragma unroll
                    for (int n = 0; n < 2; ++n) acc[a][b][m][n] = (f32x4){0.f, 0.f, 0.f, 0.f};
        cur = nxt; cA = nA; cB = nB; ++ui;
        if constexpr (ALIGN_EPI) { if (wr == 1) PG8_BAR; }
    }
    PG8_WAIT_V(0);
    if constexpr (!ALIGN_EPI) { if (wr == 0) PG8_BAR; }
    PG8_BAR;
    if constexpr (Epi::AFTER_DRAIN) { E.fused(acc, cur, wr, wc, fr, fq, lds, wid, lane); S.done(cur); }
#undef PG8_APTR
#undef PG8_BPTR
#undef PG8_SA
#undef PG8_SB
#undef PG8_STAGE
#undef PG8_LDA
#undef PG8_LDB
#undef PG8_MMA
#undef PG8_WAIT_V
#undef PG8_WAIT_L
#undef PG8_BAR
#undef PG8_SCHED
}
}

constexpr int DM = 2048, NTOK = 6144, NCTX = 4096, DEPTH = 4;
constexpr int CW = 1024, SW = 1024, INC = 4096, DFF = 5632, UPN = 2 * DFF;
constexpr float EPS = 1e-6f;
constexpr int NWAVES = 8;

constexpr size_t MiB = 1u << 20;
constexpr size_t WS_CTL = 0, CTL_ZERO_BYTES = 1 * MiB;
constexpr size_t WS_MOD = 1 * MiB;
constexpr size_t WS_WIN = 2 * MiB, WS_WGLU = 66 * MiB, WS_WOUT = 74 * MiB, WS_WUP = 106 * MiB, WS_WDN = 282 * MiB;
constexpr size_t WS_H = 370 * MiB;
constexpr size_t WS_GB = 394 * MiB, WS_V = 406 * MiB, WS_U = 418 * MiB;
constexpr size_t WS_Z = 430 * MiB, WS_O = 442 * MiB;
constexpr size_t WS_MIXIN = 454 * MiB, WS_MIXED = 478 * MiB;
constexpr size_t WS_UP = 502 * MiB;
constexpr size_t WS_ACT = 634 * MiB;
constexpr size_t WS_FF = 700 * MiB;
constexpr size_t WS_END = 724 * MiB;
constexpr int CW_SUB = 12288;
constexpr size_t WS_FFP = WS_UP;
constexpr int CW_BAR = 4096;

constexpr int RING_BYTES = 131072;
constexpr int LDS_BYTES = 147456;
constexpr int LDSCTL_OFF = LDS_BYTES - 512, MISC_OFF = LDSCTL_OFF;

#define GAS __attribute__((address_space(1)))
#define LAS __attribute__((address_space(3)))
typedef unsigned short bf16;
typedef unsigned v4u __attribute__((ext_vector_type(4)));
typedef unsigned v2u __attribute__((ext_vector_type(2)));
typedef float f32x4 __attribute__((ext_vector_type(4)));
typedef float f32x2 __attribute__((ext_vector_type(2)));
typedef float f32x16 __attribute__((ext_vector_type(16)));
typedef short bf16x8 __attribute__((ext_vector_type(8)));
typedef GAS unsigned gu32;
#define LDS_WAIT() asm volatile("s_waitcnt lgkmcnt(0)" ::: "memory")

__device__ __forceinline__ unsigned f2bf(float f) { unsigned u = __builtin_bit_cast(unsigned, f); return (u + 0x7fffu + ((u >> 16) & 1u)) >> 16; }
__device__ __forceinline__ unsigned pk2(float lo, float hi) { unsigned r; asm("v_cvt_pk_bf16_f32 %0, %1, %2" : "=v"(r) : "v"(lo), "v"(hi)); return r; }
__device__ __forceinline__ float bflo(unsigned w) { return __uint_as_float(w << 16); }
__device__ __forceinline__ float bfhi(unsigned w) { return __uint_as_float(w & 0xffff0000u); }
__device__ __forceinline__ void unpack8(const v4u w, float (&f)[8]) { f[0] = bflo(w.x); f[1] = bfhi(w.x); f[2] = bflo(w.y); f[3] = bfhi(w.y); f[4] = bflo(w.z); f[5] = bfhi(w.z); f[6] = bflo(w.w); f[7] = bfhi(w.w); }
__device__ __forceinline__ v4u pack8(const float (&f)[8]) { v4u w; w.x = pk2(f[0], f[1]); w.y = pk2(f[2], f[3]); w.z = pk2(f[4], f[5]); w.w = pk2(f[6], f[7]); return w; }
__device__ __forceinline__ float wave_sum(float v) {
#pragma unroll
    for (int o = 1; o < 64; o <<= 1) v += __shfl_xor(v, o);
    return v;
}
__device__ __forceinline__ float sigmoidf_(float x) { return 1.0f / (1.0f + __expf(-x)); }
__device__ __forceinline__ float gelu_tanh(float y) { const float v = 0.7978845608028654f * (y + 0.044715f * y * y * y); const float t = 1.0f - 2.0f / (__expf(2.0f * v) + 1.0f); return 0.5f * y * (1.0f + t); }
__device__ __forceinline__ void sincos_cw(float x, float& s, float& c) {
    const float k = rintf(x * 0.6366197723675814f);
    float r = fmaf(k, -1.5707963705062866f, x);
    r = fmaf(k, 4.371138828673793e-08f, r);
    r = fmaf(k, 1.7763568394002505e-15f, r);
    const float r2 = r * r;
    const float sp = r + r * r2 * fmaf(r2, fmaf(r2, -1.9515295891e-4f, 8.3321608736e-3f), -1.6666654611e-1f);
    const float cp = fmaf(r2 * r2, fmaf(r2, fmaf(r2, 2.443315711809948e-5f, -1.388731625493765e-3f), 4.166664568298827e-2f), fmaf(r2, -0.5f, 1.0f));
    const int q = ((int)k) & 3;
    const float ss = (q & 1) ? cp : sp, cc = (q & 1) ? sp : cp;
    s = (q & 2) ? -ss : ss;
    c = ((q + 1) & 2) ? -cc : cc;
}

__device__ __forceinline__ int fresh_v(int x) { asm volatile("" : "+v"(x)); return x; }
__device__ __forceinline__ int fresh_s(int x) { asm volatile("" : "+s"(x)); return x; }
struct Args { const float* in[30]; float* out; unsigned char* ws; };
struct KImg { unsigned long long in[30]; unsigned long long out; unsigned long long ws; };
struct DArgs { const float* in[30]; float* out; unsigned char* ws; };
__device__ __forceinline__ DArgs load_args() {
    const __attribute__((address_space(4))) KImg* p = (const __attribute__((address_space(4))) KImg*)__builtin_amdgcn_kernarg_segment_ptr();
    asm volatile("" : "+s"(p));
    DArgs a;
#pragma unroll
    for (int i = 0; i < 30; ++i) a.in[i] = (const float*)(GAS const float*)p->in[i];
    a.out = (float*)(GAS float*)p->out; a.ws = (unsigned char*)(GAS unsigned char*)p->ws;
    return a;
}
enum { I_XP = 0, I_XS, I_SRE, I_SIM, I_C, I_CCTX, I_WADA, I_BADA, I_GPRE1, I_WIN, I_CONVW, I_ARE, I_AIM, I_LOGDT, I_BRE, I_BIM, I_CRE, I_CIM, I_SSMD, I_WGLU, I_BGLU,
       I_GCONV, I_GSSM, I_WOUT, I_GPOST1, I_GPRE2, I_WUP, I_FFNW, I_WDOWN, I_GPOST2 };

namespace pg8 {
struct EpiIn {
    static constexpr bool PERM = true, AFTER_DRAIN = false;
    bf16_t *GB, *V, *U;
    __device__ __forceinline__ void operator()(const f32x4 (&acc)[2][2][4][2], const Unit& u, int wr, int wc, int fr, int fq) const {
        const int row0 = u.pm * BM + wr * 64 + fr;
        if (u.pn < 8) {
            const int col0 = u.pn * 128 + wc * 32 + 8 * fq;
#pragma unroll
            for (int ai = 0; ai < 2; ++ai)
#pragma unroll
                for (int m = 0; m < 4; ++m) { bf16_t* rowp = V + (size_t)(row0 + ai * HALF + m * 16) * 1024 + col0;
                    const f32x4 v0 = acc[ai][0][m][0] * acc[ai][1][m][0], v1 = acc[ai][0][m][1] * acc[ai][1][m][1];
                    u32x4 w; w.x = cvt_pk_bf16(v0[0], v0[1]); w.y = cvt_pk_bf16(v0[2], v0[3]); w.z = cvt_pk_bf16(v1[0], v1[1]); w.w = cvt_pk_bf16(v1[2], v1[3]);
                    *(u32x4*)rowp = w; }
        } else {
            const int col0 = (u.pn - 8) * 128 + wc * 32 + 8 * fq;
#pragma unroll
            for (int ai = 0; ai < 2; ++ai)
#pragma unroll
                for (int m = 0; m < 4; ++m) { const size_t off = (size_t)(row0 + ai * HALF + m * 16) * 1024 + col0;
#pragma unroll
                    for (int bj = 0; bj < 2; ++bj) { const f32x4 v0 = acc[ai][bj][m][0], v1 = acc[ai][bj][m][1];
                        u32x4 w; w.x = cvt_pk_bf16(v0[0], v0[1]); w.y = cvt_pk_bf16(v0[2], v0[3]); w.z = cvt_pk_bf16(v1[0], v1[1]); w.w = cvt_pk_bf16(v1[2], v1[3]);
                        *(u32x4*)((bj ? U : GB) + off) = w; } }
        }
    }
};
struct EpiGlu {
    static constexpr bool PERM = true, AFTER_DRAIN = false;
    const bf16_t* Z; bf16_t* O; const float* bias;
    __device__ __forceinline__ void operator()(const f32x4 (&acc)[2][2][4][2], const Unit& u, int wr, int wc, int fr, int fq) const {
        const int row0 = u.pm * BM + wr * 64 + fr, col0 = u.pn * BM + wc * 32 + 8 * fq;
        f32x4 bv[2][2];
#pragma unroll
        for (int bj = 0; bj < 2; ++bj)
#pragma unroll
            for (int n = 0; n < 2; ++n) bv[bj][n] = *(const f32x4*)(bias + col0 + bj * HALF + 4 * n);
#pragma unroll
        for (int ai = 0; ai < 2; ++ai)
#pragma unroll
            for (int m = 0; m < 4; ++m) { const size_t off = (size_t)(row0 + ai * HALF + m * 16) * 1024 + col0;
#pragma unroll
                for (int bj = 0; bj < 2; ++bj) { const u32x4 zw = *(const u32x4*)(Z + off + bj * HALF);
                    const f32x4 g0 = acc[ai][bj][m][0] + bv[bj][0], g1 = acc[ai][bj][m][1] + bv[bj][1];
                    float z[8]; z[0] = __uint_as_float(zw.x << 16); z[1] = __uint_as_float(zw.x & 0xffff0000u); z[2] = __uint_as_float(zw.y << 16); z[3] = __uint_as_float(zw.y & 0xffff0000u);
                    z[4] = __uint_as_float(zw.z << 16); z[5] = __uint_as_float(zw.z & 0xffff0000u); z[6] = __uint_as_float(zw.w << 16); z[7] = __uint_as_float(zw.w & 0xffff0000u);
                    float o[8];
#pragma unroll
                    for (int j = 0; j < 4; ++j) { o[j] = z[j] / (1.0f + __expf(-g0[j])); o[4 + j] = z[4 + j] / (1.0f + __expf(-g1[j])); }
                    u32x4 w; w.x = cvt_pk_bf16(o[0], o[1]); w.y = cvt_pk_bf16(o[2], o[3]); w.z = cvt_pk_bf16(o[4], o[5]); w.w = cvt_pk_bf16(o[6], o[7]);
                    *(u32x4*)(O + off + bj * HALF) = w; } }
    }
};
typedef unsigned u32x2 __attribute__((ext_vector_type(2)));
struct EpiFfn {
    static constexpr bool PERM = true, AFTER_DRAIN = false;
    bf16_t* ACT; const float* fw; PG8_LAS float* xch;
    static __device__ __forceinline__ float ror8(float v) { return __builtin_bit_cast(float, __builtin_amdgcn_mov_dpp(__builtin_bit_cast(int, v), 0x128  , 0xf, 0xf, true)); }
    static __device__ __forceinline__ f32x4 shx8(const f32x4 v) { f32x4 r; r[0] = ror8(v[0]); r[1] = ror8(v[1]); r[2] = ror8(v[2]); r[3] = ror8(v[3]); return r; }
    static __device__ __forceinline__ f32x4 shl(const f32x4 v, int src) { f32x4 r; r[0] = __shfl(v[0], src); r[1] = __shfl(v[1], src); r[2] = __shfl(v[2], src); r[3] = __shfl(v[3], src); return r; }
    static __device__ __forceinline__ f32x4 sel(bool c, const f32x4 a, const f32x4 b) { f32x4 r; r[0] = c ? a[0] : b[0]; r[1] = c ? a[1] : b[1]; r[2] = c ? a[2] : b[2]; r[3] = c ? a[3] : b[3]; return r; }
    __device__ __forceinline__ void operator()(const f32x4 (&acc)[2][2][4][2], const Unit& u, int wr, int wc, int fr, int fq) const {
        const bool ctx = u.pm < 16, h = (fr >> 3) != 0;
        const int c7 = fr & 7, lane = fq * 16 + fr, ch0 = u.pn * 128 + wc * 32 + 8 * fq;
        const f32x4 zero = {0.f, 0.f, 0.f, 0.f};
        f32x4 wa[2][3], wg[2][3];
#pragma unroll
        for (int k = 0; k < 3; ++k) { wa[0][k] = *(const f32x4*)(fw + k * (2 * 5632) + ch0); wg[0][k] = *(const f32x4*)(fw + k * (2 * 5632) + 5632 + ch0); }
        if (ctx) {
            if (wr == 0 && fr == 15) { PG8_LAS f32x4* p = (PG8_LAS f32x4*)(xch + ((wc * 2 + 0) * 4 + fq) * 16); p[0] = acc[1][0][3][0]; p[1] = acc[1][0][3][1]; p[2] = acc[1][1][3][0]; p[3] = acc[1][1][3][1]; }
            if (wr == 1 && fr == 0)  { PG8_LAS f32x4* p = (PG8_LAS f32x4*)(xch + ((wc * 2 + 1) * 4 + fq) * 16); p[0] = acc[0][0][0][0]; p[1] = acc[0][0][0][1]; p[2] = acc[0][1][0][0]; p[3] = acc[0][1][0][1]; }
            asm volatile("s_waitcnt lgkmcnt(0)" ::: "memory"); __builtin_amdgcn_s_barrier(); asm volatile("" ::: "memory");
        }
        const int srcp = (lane + 7) & 63, srcn = (lane - 7) & 63;
        u32x2 keep[8];
#pragma unroll
        for (int n = 0; n < 2; ++n) {
            f32x4 bpa = shl(acc[1][0][3][n], srcp), bpg = shl(acc[1][1][3][n], srcp), bna = shl(acc[0][0][0][n], srcn), bng = shl(acc[0][1][0][n], srcn);
            if (ctx) {
                const PG8_LAS f32x4* p0 = (const PG8_LAS f32x4*)(xch + ((wc * 2 + 0) * 4 + fq) * 16); const PG8_LAS f32x4* p1 = (const PG8_LAS f32x4*)(xch + ((wc * 2 + 1) * 4 + fq) * 16);
                const f32x4 xpa = p0[n], xpg = p0[2 + n], xna = p1[n], xng = p1[2 + n];
                bpa = sel(c7 >= 1, bpa, sel(wr == 1, xpa, zero)); bpg = sel(c7 >= 1, bpg, sel(wr == 1, xpg, zero));
                bna = sel(c7 <= 6, bna, sel(wr == 0, xna, zero)); bng = sel(c7 <= 6, bng, sel(wr == 0, xng, zero));
            } else { bpa = zero; bpg = zero; bna = zero; bng = zero; }
            if (n == 0) {
#pragma unroll
                for (int k = 0; k < 3; ++k) { wa[1][k] = *(const f32x4*)(fw + k * (2 * 5632) + ch0 + 4); wg[1][k] = *(const f32x4*)(fw + k * (2 * 5632) + 5632 + ch0 + 4); }
            }
            f32x4 ea0 = shx8(acc[0][0][0][n]), eg0 = shx8(acc[0][1][0][n]);
            f32x4 pa = sel(h, ea0, bpa), pg = sel(h, eg0, bpg);
#pragma unroll
            for (int s = 0; s < 8; ++s) { const int ai = s >> 2, m = s & 3;
                const f32x4 eap = s < 7 ? shx8(acc[(s + 1) >> 2][0][(s + 1) & 3][n]) : bna, egp = s < 7 ? shx8(acc[(s + 1) >> 2][1][(s + 1) & 3][n]) : bng;
                const f32x4 xa = acc[ai][0][m][n], xg = acc[ai][1][m][n];
                const f32x4 na = sel(h, eap, ea0), ng = sel(h, egp, eg0);
                const f32x4 ca = wa[n][0] * pa + wa[n][1] * xa + wa[n][2] * na, cg = wg[n][0] * pg + wg[n][1] * xg + wg[n][2] * ng;
                const f32x4 t = cg * ca, ex = cg * (-1.442695041f);
                f32x4 den; den[0] = __builtin_amdgcn_exp2f(ex[0]); den[1] = __builtin_amdgcn_exp2f(ex[1]); den[2] = __builtin_amdgcn_exp2f(ex[2]); den[3] = __builtin_amdgcn_exp2f(ex[3]);
                den = den + 1.0f;
                f32x4 rc; rc[0] = __builtin_amdgcn_rcpf(den[0]); rc[1] = __builtin_amdgcn_rcpf(den[1]); rc[2] = __builtin_amdgcn_rcpf(den[2]); rc[3] = __builtin_amdgcn_rcpf(den[3]);
                const f32x4 o = t * rc;
                u32x2 w; w.x = cvt_pk_bf16(o[0], o[1]); w.y = cvt_pk_bf16(o[2], o[3]);
                if (n == 0) keep[s] = w;
                else { u32x4 w4; w4.x = keep[s].x; w4.y = keep[s].y; w4.z = w.x; w4.w = w.y; *(u32x4*)(ACT + (size_t)(u.pm * BM + ai * HALF + wr * 64 + m * 16 + fr) * 5632 + ch0) = w4; }
                pa = na; pg = ng; ea0 = eap; eg0 = egp;
            }
        }
    }
};
struct G4Order {
    int lo, hi, G, c; bool plain;
    __device__ __forceinline__ bool next(int i, Unit& u) const {
        const int L = lo + i * G + c; if (L >= hi) return false;
        StaticOrder so; so.init(24 * BM, 44 * BM, 1, 0);
        if (plain) return so.next(L, u);
        if (L >= 1024) { u.pm = 23; u.pn = 12 + (L - 1024); return true; }
        so.next(L, u); if (u.pm == 23 && u.pn >= 12) so.next(1024 + u.pn - 12, u);
        return true;
    }
    __device__ __forceinline__ void a_ready(const Unit&) const {}
    __device__ __forceinline__ void done(const Unit&) const {}
};
struct G5Order {
    bool st; StaticOrder so; Unit u0;
    __device__ __forceinline__ bool next(int i, Unit& u) const { if (st) return so.next(i, u); if (i != 0 || u0.pm < 0) return false; u = u0; return true; }
    __device__ __forceinline__ void a_ready(const Unit&) const {}
    __device__ __forceinline__ void done(const Unit&) const {}
};
}

__device__ __forceinline__ void cvt_load(const float* __restrict__ W, int N, int k0, int n0, int tid, f32x4 (&r0)[4], f32x4 (&r1)[4]) {
    const int n4 = tid & 31, kp = tid >> 5;
#pragma unroll
    for (int i = 0; i < 4; ++i) { const float* p = W + (size_t)(k0 + 2 * kp + 32 * i) * N + n0 + 4 * n4; r0[i] = *(const f32x4*)p; r1[i] = *(const f32x4*)(p + N); }
}
__device__ __forceinline__ void cvt_put(LAS unsigned* T, int tid, const f32x4 (&r0)[4], const f32x4 (&r1)[4]) {
    const int n4 = tid & 31, kp = tid >> 5;
#pragma unroll
    for (int i = 0; i < 4; ++i)
#pragma unroll
        for (int e = 0; e < 4; ++e) T[(4 * n4 + e) * 65 + kp + 16 * i] = pk2(r0[i][e], r1[i][e]);
}
__device__ __forceinline__ void cvt_store(const LAS unsigned* T, bf16* __restrict__ Bt, int K, int k0, int j0, int tid) {
    const int n = tid >> 2, kc = tid & 3;
    unsigned w[16];
#pragma unroll
    for (int i = 0; i < 16; ++i) w[i] = T[n * 65 + 16 * kc + i];
    v4u* dst = (v4u*)(Bt + (size_t)(j0 + n) * K + k0 + 32 * kc);
#pragma unroll
    for (int q = 0; q < 4; ++q) { v4u o; o.x = w[4 * q]; o.y = w[4 * q + 1]; o.z = w[4 * q + 2]; o.w = w[4 * q + 3]; dst[q] = o; }
}
constexpr int CVT_PER_LAYER = 512 + 64 + 256 + 1408 + 704;
struct CvtD { const float* W; bf16* Bt; int N, K, k0, n0, j0; };
__device__ __forceinline__ CvtD cvt_desc(const DArgs& a, int it) {
    const int l = it / CVT_PER_LAYER; int r = it % CVT_PER_LAYER;
    const float* W; bf16* Bt; int N, K, jb, kb, n0;
    if (r < 512) { N = INC; K = DM; W = a.in[I_WIN] + (size_t)l * K * N; Bt = (bf16*)(a.ws + WS_WIN) + (size_t)l * N * K; kb = r >> 5; jb = r & 31;
        const int pn = jb >> 1, bj = jb & 1; n0 = pn < 8 ? ((bj ? 2048 : 1024) + 128 * pn) : ((bj ? 3072 : 0) + 128 * (pn - 8)); }
    else if (r < 576) { r -= 512; N = SW; K = SW; W = a.in[I_WGLU] + (size_t)l * K * N; Bt = (bf16*)(a.ws + WS_WGLU) + (size_t)l * N * K; kb = r >> 3; jb = r & 7; n0 = 128 * jb; }
    else if (r < 832) { r -= 576; N = DM; K = DM; W = a.in[I_WOUT] + (size_t)l * K * N; Bt = (bf16*)(a.ws + WS_WOUT) + (size_t)l * N * K; kb = r >> 4; jb = r & 15; n0 = 128 * jb; }
    else if (r < 2240) { r -= 832; N = UPN; K = DM; W = a.in[I_WUP] + (size_t)l * K * N; Bt = (bf16*)(a.ws + WS_WUP) + (size_t)l * N * K; kb = r / 88; jb = r % 88; n0 = ((jb & 1) ? DFF : 0) + 128 * (jb >> 1); }
    else { r -= 2240; N = DM; K = DFF; W = a.in[I_WDOWN] + (size_t)l * K * N; Bt = (bf16*)(a.ws + WS_WDN) + (size_t)l * N * K; kb = r >> 4; jb = r & 15; n0 = 128 * jb; }
    CvtD d; d.W = W; d.Bt = Bt; d.N = N; d.K = K; d.k0 = 128 * kb; d.n0 = n0; d.j0 = 128 * jb; return d;
}

constexpr int CW_CVT = 8192;
#define CVT_LDS_BAR() asm volatile("s_waitcnt lgkmcnt(0)\n\ts_barrier" ::: "memory")
__device__ __forceinline__ void cvt_fill(LAS unsigned char* lds, int tid_, int ln, int budget  ) {
    const int tid = fresh_v(tid_);
    volatile LAS unsigned* tk = (volatile LAS unsigned*)(lds + MISC_OFF) + 16;
    LAS unsigned* T0 = (LAS unsigned*)lds; LAS unsigned* T1 = T0 + 128 * 65;
    const int npairs = budget < 0 ? 0x7fffffff : (budget + 1) / 2;
    if (npairs <= 0) return;
    if (tid == 0) { const DArgs a = load_args(); tk[0] = __hip_atomic_fetch_add((unsigned*)(a.ws + WS_CTL) + CW_CVT + 64 * ln, 1u, __ATOMIC_RELAXED, __HIP_MEMORY_SCOPE_AGENT); }
    __syncthreads();
    for (int n = 0; n < npairs; ++n) {
        const unsigned t = tk[n & 1];
        if (2u * t >= (unsigned)CVT_PER_LAYER) break;
        const DArgs a = load_args();
        unsigned nx = 0xffffffffu;
        if (tid == 0 && n + 1 < npairs) nx = __hip_atomic_fetch_add((unsigned*)(a.ws + WS_CTL) + CW_CVT + 64 * ln, 1u, __ATOMIC_RELAXED, __HIP_MEMORY_SCOPE_AGENT);
        const CvtD d0 = cvt_desc(a, ln * CVT_PER_LAYER + 2 * (int)t), d1 = cvt_desc(a, ln * CVT_PER_LAYER + 2 * (int)t + 1);
        f32x4 a0[4], a1[4], b0[4], b1[4];
        cvt_load(d0.W, d0.N, d0.k0, d0.n0, tid, a0, a1); cvt_load(d1.W, d1.N, d1.k0, d1.n0, tid, b0, b1);
        cvt_put(T0, tid, a0, a1); cvt_put(T1, tid, b0, b1);
        if (tid == 0) tk[(n + 1) & 1] = nx;
        CVT_LDS_BAR();
        cvt_store(T0, d0.Bt, d0.K, d0.k0, d0.j0, tid); cvt_store(T1, d1.Bt, d1.K, d1.k0, d1.j0, tid);
        CVT_LDS_BAR();
    }
    __syncthreads();
}
__device__ __forceinline__ void mod_task(LAS unsigned char* lds, int tid_, int lane_, int wave_, int task) {
    const DArgs a = load_args(); const int tid = fresh_v(tid_), lane = fresh_v(lane_), wave = fresh_s(wave_);
    LAS float* SC = (LAS float*)(lds + 36864);
    LAS float* RED = (LAS float*)(lds + 36864 + 24576);
    const int l = task / 48, j0 = (task % 48) * 256;
    for (int i = tid; i < 3 * DM; i += 512) { const int v = i >> 11, k = i & 2047; const float x = v == 0 ? a.in[I_CCTX][k] : a.in[I_C][(v - 1) * DM + k]; SC[i] = x / (1.0f + __expf(-x)); }
    __syncthreads();
    const float* W = a.in[I_WADA] + (size_t)l * DM * 12288 + j0 + 4 * lane;
    f32x4 a0 = {0.f, 0.f, 0.f, 0.f}, a1 = a0, a2 = a0;
    const int kbeg = wave * 256;
    for (int k = kbeg; k < kbeg + 256; k += 8) {
        f32x4 w[8];
#pragma unroll
        for (int u = 0; u < 8; ++u) w[u] = *(const f32x4*)(W + (size_t)(k + u) * 12288);
#pragma unroll
        for (int u = 0; u < 8; ++u) { const float s0 = SC[k + u], s1 = SC[2048 + k + u], s2 = SC[4096 + k + u]; a0 += w[u] * s0; a1 += w[u] * s1; a2 += w[u] * s2; }
    }
    *(LAS f32x4*)(RED + (wave * 3 + 0) * 256 + 4 * lane) = a0;
    *(LAS f32x4*)(RED + (wave * 3 + 1) * 256 + 4 * lane) = a1;
    *(LAS f32x4*)(RED + (wave * 3 + 2) * 256 + 4 * lane) = a2;
    __syncthreads();
    float* MOD = (float*)(a.ws + WS_MOD);
    for (int i = tid; i < 768; i += 512) { const int v = i >> 8, jj = i & 255; float s = a.in[I_BADA][l * 12288 + j0 + jj];
#pragma unroll
        for (int w8 = 0; w8 < 8; ++w8) s += RED[(w8 * 3 + v) * 256 + jj];
        const int ch = (j0 + jj) >> 11, e = (j0 + jj) & 2047;
        if (ch == 1) s = (1.0f + s) * a.in[I_GPRE1][l * DM + e]; else if (ch == 2) s *= a.in[I_GPOST1][l * DM + e];
        else if (ch == 4) s = (1.0f + s) * a.in[I_GPRE2][l * DM + e]; else if (ch == 5) s *= a.in[I_GPOST2][l * DM + e];
        MOD[(size_t)(l * 3 + v) * 12288 + j0 + jj] = s; }
    __syncthreads();
}

__device__ __forceinline__ int mod_vec(int row) { return row < NCTX ? 0 : 1 + ((row - NCTX) >> 10); }
__device__ __forceinline__ int perm_row(int row) {
    int gr, cc, base;
    if (row < NCTX) { const int t = row & 255; gr = t & 15; cc = t >> 4; base = row & ~255; }
    else { const int q = row - NCTX, p = q & 1023; gr = p >> 6; cc = p & 15; base = NCTX + ((q >> 10) * 4 + ((p >> 4) & 3)) * 256; }
    return base + 128 * (gr >> 3) + 64 * (cc >> 3) + 16 * ((gr >> 1) & 3) + 8 * (gr & 1) + (cc & 7);
}
constexpr size_t WS_XH = WS_UP + 8 * MiB, WS_XL = WS_UP + 40 * MiB;
__device__ __forceinline__ void x24_load(const unsigned char* ws, int row, int e0, float (&o)[8]) {
    const v4u h = *(const v4u*)((const unsigned short*)(ws + WS_XH) + (size_t)row * DM + e0); const v2u lo = *(const v2u*)(ws + WS_XL + (size_t)row * DM + e0);
    const unsigned hw[4] = {h.x, h.y, h.z, h.w}, lw[2] = {lo.x, lo.y};
#pragma unroll
    for (int i = 0; i < 8; ++i) { const unsigned hi = (i & 1) ? (hw[i >> 1] & 0xffff0000u) : (hw[i >> 1] << 16); const unsigned l8 = (lw[i >> 2] >> (8 * (i & 3))) & 0xffu; o[i] = __uint_as_float(hi | (l8 << 8)); }
}
__device__ __forceinline__ void x24_store(unsigned char* ws, int row, int e0, const float (&x)[8]) {
    unsigned b[8];
#pragma unroll
    for (int i = 0; i < 8; ++i) b[i] = __float_as_uint(x[i]) + 0x80u;
    v4u h; h.x = (b[0] >> 16) | (b[1] & 0xffff0000u); h.y = (b[2] >> 16) | (b[3] & 0xffff0000u); h.z = (b[4] >> 16) | (b[5] & 0xffff0000u); h.w = (b[6] >> 16) | (b[7] & 0xffff0000u);
    v2u lo; lo.x = ((b[0] >> 8) & 0xffu) | (b[1] & 0xff00u) | ((b[2] << 8) & 0xff0000u) | ((b[3] << 16) & 0xff000000u); lo.y = ((b[4] >> 8) & 0xffu) | (b[5] & 0xff00u) | ((b[6] << 8) & 0xff0000u) | ((b[7] << 16) & 0xff000000u);
    *(v4u*)((unsigned short*)(ws + WS_XH) + (size_t)row * DM + e0) = h; *(v2u*)(ws + WS_XL + (size_t)row * DM + e0) = lo;
}
struct RowVec { f32x4 gv[8], cv[8], hv[8]; int v; };
template <int MODE>
__device__ __forceinline__ void row_vec_load(const DArgs& a, int l, int v, int lane, RowVec& rv) {
    constexpr bool FIRST = (MODE == 0), HAS_NEXT = (MODE != 3);
    const float* modl = (const float*)(a.ws + WS_MOD) + (size_t)l * 3 * 12288;
    const float* modg = modl + (MODE == 1 ? 2 : 5) * DM;
    const float* modn = MODE == 2 ? modl + 3 * 12288 : modl;
    const int sc_off = (MODE == 1 ? 4 : 1) * DM, sh_off = (MODE == 1 ? 3 : 0) * DM;
    rv.v = v;
#pragma unroll
    for (int j = 0; j < 4; ++j) { const int e0 = 8 * lane + 512 * j;
        if (!FIRST) { const float* gate = modg + (size_t)v * 12288; rv.gv[2 * j] = *(const f32x4*)(gate + e0); rv.gv[2 * j + 1] = *(const f32x4*)(gate + e0 + 4); }
        if (HAS_NEXT) { const float* sc = modn + (size_t)v * 12288 + sc_off; const float* sh = modn + (size_t)v * 12288 + sh_off;
            rv.cv[2 * j] = *(const f32x4*)(sc + e0); rv.cv[2 * j + 1] = *(const f32x4*)(sc + e0 + 4); rv.hv[2 * j] = *(const f32x4*)(sh + e0); rv.hv[2 * j + 1] = *(const f32x4*)(sh + e0 + 4); } }
}
template <int MODE>
__device__ __forceinline__ void row_prefetch(int l, int bx_, int G_, int wave_, int lane_, RowVec& rv) {
    const int bx = fresh_s(bx_), G = fresh_s(G_), wave = fresh_s(wave_), lane = fresh_v(lane_);
    const DArgs a = load_args();
    const int rpw = (NTOK + G * NWAVES - 1) / (G * NWAVES), rbeg = (bx * NWAVES + wave) * rpw;
#pragma unroll
    for (int j = 0; j < 8; ++j) { rv.gv[j] = (f32x4){0.f, 0.f, 0.f, 0.f}; rv.cv[j] = rv.gv[j]; rv.hv[j] = rv.gv[j]; }
    rv.v = -1;
    if (rbeg < NTOK) row_vec_load<MODE>(a, l, mod_vec(rbeg), lane, rv);
}
template <int MODE>
__device__ __forceinline__ void row_pass(int l, int bx_, int G_, int wave_, int lane_, RowVec& rv, bool split23 = false) {
    const int bx = fresh_s(bx_), G = fresh_s(G_), wave = fresh_s(wave_), lane = fresh_v(lane_);
    constexpr bool FIRST = (MODE == 0), HAS_NEXT = (MODE != 3);
    const DArgs a = load_args();
    const float* MOD = (const float*)(a.ws + WS_MOD);
    const float* modl = MOD + (size_t)l * 3 * 12288;
    const bf16* Y = (const bf16*)(a.ws + (MODE == 1 ? WS_MIXED : WS_FF));
    const float* modg = modl + (MODE == 1 ? 2 : 5) * DM;
    const float* modn = MODE == 2 ? modl + 3 * 12288 : modl;
    const int sc_off = (MODE == 1 ? 4 : 1) * DM, sh_off = (MODE == 1 ? 3 : 0) * DM;
    bf16* Hdst = (bf16*)(a.ws + WS_H);
    const int rpw = (NTOK + G * NWAVES - 1) / (G * NWAVES), rbeg = (bx * NWAVES + wave) * rpw, rend = rbeg + rpw < NTOK ? rbeg + rpw : NTOK;
    for (int row = rbeg; row < rend; ++row) {
        const int v = mod_vec(row);
        if (v != rv.v) row_vec_load<MODE>(a, l, v, lane, rv);
        const f32x4 (&gv)[8] = rv.gv; const f32x4 (&cv)[8] = rv.cv; const f32x4 (&hv)[8] = rv.hv;
        float* xr = a.out + (size_t)row * DM;
        float x[32];
        if (FIRST) {
            const float* src = row < NCTX ? a.in[I_XP] + (size_t)row * DM : a.in[I_XS] + (size_t)(row - NCTX) * DM;
#pragma unroll
            for (int j = 0; j < 4; ++j) { const f32x4 p = *(const f32x4*)(src + 8 * lane + 512 * j), q = *(const f32x4*)(src + 8 * lane + 512 * j + 4);
                x[8 * j] = p[0]; x[8 * j + 1] = p[1]; x[8 * j + 2] = p[2]; x[8 * j + 3] = p[3]; x[8 * j + 4] = q[0]; x[8 * j + 5] = q[1]; x[8 * j + 6] = q[2]; x[8 * j + 7] = q[3];
                const float t8[8] = {p[0], p[1], p[2], p[3], q[0], q[1], q[2], q[3]}; x24_store(a.ws, row, 8 * lane + 512 * j, t8); }
        } else {
            float y[32]; float ssq = 0.f;
            const int pr = MODE == 1 ? row : perm_row(row);
            const bool sp23 = MODE != 1 && split23 && pr >= 23 * 256;
            const bf16* yr = sp23 ? (const bf16*)(a.ws + WS_FFP) + (size_t)(pr - 23 * 256) * DM : Y + (size_t)pr * DM;
#pragma unroll
            for (int j = 0; j < 4; ++j) { const v4u w = *(const v4u*)(yr + 8 * lane + 512 * j); float t[8]; unpack8(w, t);
                if (sp23) {
#pragma unroll
                    for (int sp = 1; sp < 4; ++sp) { float t2[8]; unpack8(*(const v4u*)(yr + (size_t)sp * 256 * DM + 8 * lane + 512 * j), t2);
#pragma unroll
                        for (int i = 0; i < 8; ++i) t[i] += t2[i]; } }
#pragma unroll
                for (int i = 0; i < 8; ++i) { y[8 * j + i] = t[i]; ssq += t[i] * t[i]; } }
            ssq = wave_sum(ssq);
            const float rs = 1.0f / sqrtf(ssq * (1.0f / DM) + EPS);
#pragma unroll
            for (int j = 0; j < 4; ++j) { const int e0 = 8 * lane + 512 * j;
                float xo[8]; x24_load(a.ws, row, e0, xo);
                const f32x4 g0 = gv[2 * j], g1 = gv[2 * j + 1];
                f32x4 np, nq;
#pragma unroll
                for (int i = 0; i < 4; ++i) { np[i] = xo[i] + g0[i] * (y[8 * j + i] * rs); nq[i] = xo[4 + i] + g1[i] * (y[8 * j + 4 + i] * rs); x[8 * j + i] = np[i]; x[8 * j + 4 + i] = nq[i]; }
                if (MODE == 3) { *(f32x4*)(xr + e0) = np; *(f32x4*)(xr + e0 + 4) = nq; }
                else { const float t8[8] = {np[0], np[1], np[2], np[3], nq[0], nq[1], nq[2], nq[3]}; x24_store(a.ws, row, e0, t8); } }
        }
        if (HAS_NEXT) {
            float ssq = 0.f;
#pragma unroll
            for (int i = 0; i < 32; ++i) ssq += x[i] * x[i];
            ssq = wave_sum(ssq);
            const float rs = 1.0f / sqrtf(ssq * (1.0f / DM) + EPS);
            bf16* hr = Hdst + (size_t)(MODE == 1 ? perm_row(row) : row) * DM;
#pragma unroll
            for (int j = 0; j < 4; ++j) { const int e0 = 8 * lane + 512 * j;
                const f32x4 c0 = cv[2 * j], c1 = cv[2 * j + 1], h0 = hv[2 * j], h1 = hv[2 * j + 1];
                float o[8];
#pragma unroll
                for (int i = 0; i < 4; ++i) { o[i] = x[8 * j + i] * rs * c0[i] + h0[i]; o[4 + i] = x[8 * j + 4 + i] * rs * c1[i] + h1[i]; }
                *(v4u*)(hr + e0) = pack8(o); }
        }
    }
}

struct MixVec { float w0r[16], w1r[16], w2r[16], gcr[16], gsr[16]; };
__device__ __forceinline__ void mix_prefetch(int lane_, int l, MixVec& mv) {
    const DArgs a = load_args(); const int lane = fresh_v(lane_);
    const float* cw = a.in[I_CONVW] + (size_t)l * 3 * CW; const float* gc = a.in[I_GCONV] + (size_t)l * CW; const float* gs = a.in[I_GSSM] + (size_t)l * SW;
#pragma unroll
    for (int j = 0; j < 2; ++j) { const int c0 = 8 * lane + 512 * j;
#pragma unroll
        for (int hq = 0; hq < 2; ++hq) { const f32x4 t0 = *(const f32x4*)(cw + c0 + 4 * hq), t1 = *(const f32x4*)(cw + CW + c0 + 4 * hq), t2 = *(const f32x4*)(cw + 2 * CW + c0 + 4 * hq),
                                               t3 = *(const f32x4*)(gc + c0 + 4 * hq), t4 = *(const f32x4*)(gs + c0 + 4 * hq);
#pragma unroll
            for (int i = 0; i < 4; ++i) { mv.w0r[8 * j + 4 * hq + i] = t0[i]; mv.w1r[8 * j + 4 * hq + i] = t1[i]; mv.w2r[8 * j + 4 * hq + i] = t2[i]; mv.gcr[8 * j + 4 * hq + i] = t3[i]; mv.gsr[8 * j + 4 * hq + i] = t4[i]; } } }
}
__device__ __forceinline__ void mix_pass(int bx_, int G_, int wave_, int lane_, int l, const MixVec& mv) {
    const DArgs a = load_args(); const int bx = fresh_s(bx_), G = fresh_s(G_), wave = fresh_s(wave_), lane = fresh_v(lane_);
    const bf16* GB = (const bf16*)(a.ws + WS_GB); const bf16* V = (const bf16*)(a.ws + WS_V); const bf16* O = (const bf16*)(a.ws + WS_O); bf16* MX = (bf16*)(a.ws + WS_MIXIN);
    const float* cw = a.in[I_CONVW] + (size_t)l * 3 * CW; const float* gc = a.in[I_GCONV] + (size_t)l * CW; const float* gs = a.in[I_GSSM] + (size_t)l * SW;
    const float (&w0r)[16] = mv.w0r; const float (&w1r)[16] = mv.w1r; const float (&w2r)[16] = mv.w2r; const float (&gcr)[16] = mv.gcr; const float (&gsr)[16] = mv.gsr;
    const int rpw = (NTOK + G * NWAVES - 1) / (G * NWAVES), rbeg = (bx * NWAVES + wave) * rpw, rend = rbeg + rpw < NTOK ? rbeg + rpw : NTOK;
    for (int row = rbeg; row < rend; ++row) {
        bool hp, hn;
        if (row < NCTX) { const int t = row & 255; hp = t > 0; hn = t < 255; } else { const int c = (row - NCTX) & 63; hp = c > 0; hn = c < 63; }
#pragma unroll
        for (int j = 0; j < 2; ++j) { const int c0 = 8 * lane + 512 * j; const size_t off = (size_t)row * CW + c0;
            float vc[8], vp[8], vn[8], gb[8];
            unpack8(*(const v4u*)(V + off), vc); unpack8(*(const v4u*)(GB + off), gb);
            if (hp) unpack8(*(const v4u*)(V + off - CW), vp); else {
#pragma unroll
                for (int i = 0; i < 8; ++i) vp[i] = 0.f; }
            if (hn) unpack8(*(const v4u*)(V + off + CW), vn); else {
#pragma unroll
                for (int i = 0; i < 8; ++i) vn[i] = 0.f; }
            float o[8]; float ssq = 0.f;
#pragma unroll
            for (int i = 0; i < 8; ++i) { o[i] = gb[i] * (w0r[8 * j + i] * vp[i] + w1r[8 * j + i] * vc[i] + w2r[8 * j + i] * vn[i]); ssq += o[i] * o[i]; }
            ssq += __shfl_xor(ssq, 1); ssq += __shfl_xor(ssq, 2); ssq += __shfl_xor(ssq, 4);
            const float rs = 1.0f / sqrtf(ssq * (1.0f / 64.0f) + EPS);
#pragma unroll
            for (int i = 0; i < 8; ++i) o[i] = o[i] * rs * gcr[8 * j + i];
            *(v4u*)(MX + (size_t)row * DM + c0) = pack8(o); }
        float s[16]; float ssq = 0.f;
#pragma unroll
        for (int j = 0; j < 2; ++j) { float t[8]; unpack8(*(const v4u*)(O + (size_t)row * SW + 8 * lane + 512 * j), t);
#pragma unroll
            for (int i = 0; i < 8; ++i) { s[8 * j + i] = t[i]; ssq += t[i] * t[i]; } }
        ssq = wave_sum(ssq);
        const float rs = 1.0f / sqrtf(ssq * (1.0f / SW) + EPS);
#pragma unroll
        for (int j = 0; j < 2; ++j) { const int c0 = 8 * lane + 512 * j; float o[8];
#pragma unroll
            for (int i = 0; i < 8; ++i) o[i] = s[8 * j + i] * rs * gsr[8 * j + i];
            *(v4u*)(MX + (size_t)row * DM + CW + c0) = pack8(o); }
    }
}

struct S5C { bf16x8 Bf[2][4]; float ar[2][2], ai[2][2]; };
__device__ __forceinline__ void s5_setup(const DArgs& a, LAS unsigned char* lds, int lane, int wave, int l, int g, S5C& c) {
    const int n = lane & 31, hf = lane >> 5, tq = lane & 15, q = lane >> 4;
    LAS unsigned char* CFB = lds + 135168;
    LAS float* A16 = (LAS float*)(lds + 143360);
#pragma unroll
    for (int d = 0; d < 2; ++d) {
        const int pg = (l * 2 + d) * 64 + g;
        const float dt = expf(a.in[I_LOGDT][pg]);
#pragma unroll
        for (int s = 0; s < 2; ++s) { const int nn = n + 32 * s;
            const float are = a.in[I_ARE][pg * 64 + nn], aim = a.in[I_AIM][pg * 64 + nn];
            const float er = expf(are * dt); float sn, cs; sincos_cw(aim * dt, sn, cs);
            const float abr = er * cs, abi = er * sn; c.ar[d][s] = abr; c.ai[d][s] = abi;
            if (wave == 0 && hf == 0) { const float e16 = expf(16.0f * are * dt); float s16, c16; sincos_cw(16.0f * aim * dt, s16, c16); *(LAS f32x2*)(A16 + (d * 64 + nn) * 2) = (f32x2){e16 * c16, e16 * s16}; }
            const float inv = 1.0f / (are * are + aim * aim);
            const float cr = ((abr - 1.0f) * are + abi * aim) * inv, ci = (abi * are - (abr - 1.0f) * aim) * inv;
            const float* brp = a.in[I_BRE] + (unsigned)((pg * 64 + nn) * 16 + 8 * hf); const float* bip = a.in[I_BIM] + (unsigned)((pg * 64 + nn) * 16 + 8 * hf);
            const f32x4 br0 = *(const f32x4*)brp, br1 = *(const f32x4*)(brp + 4), bi0 = *(const f32x4*)bip, bi1 = *(const f32x4*)(bip + 4);
            v4u wr_, wi_;
            wr_.x = pk2(cr * br0[0] - ci * bi0[0], cr * br0[1] - ci * bi0[1]); wr_.y = pk2(cr * br0[2] - ci * bi0[2], cr * br0[3] - ci * bi0[3]);
            wr_.z = pk2(cr * br1[0] - ci * bi1[0], cr * br1[1] - ci * bi1[1]); wr_.w = pk2(cr * br1[2] - ci * bi1[2], cr * br1[3] - ci * bi1[3]);
            wi_.x = pk2(cr * bi0[0] + ci * br0[0], cr * bi0[1] + ci * br0[1]); wi_.y = pk2(cr * bi0[2] + ci * br0[2], cr * bi0[3] + ci * br0[3]);
            wi_.z = pk2(cr * bi1[0] + ci * br1[0], cr * bi1[1] + ci * br1[1]); wi_.w = pk2(cr * bi1[2] + ci * br1[2], cr * bi1[3] + ci * br1[3]);
            c.Bf[d][2 * s] = __builtin_bit_cast(bf16x8, wr_); c.Bf[d][2 * s + 1] = __builtin_bit_cast(bf16x8, wi_); }
        if (wave == 0) {
            const float* crp = a.in[I_CRE] + (unsigned)((pg * 16 + tq) * 64); const float* cip = a.in[I_CIM] + (unsigned)((pg * 16 + tq) * 64);
#pragma unroll
            for (int ks = 0; ks < 4; ++ks) { const int n0 = 8 * ks + 2 * q;
                const f32x2 cr0 = *(const f32x2*)(crp + n0), cr1 = *(const f32x2*)(crp + n0 + 32), ci0 = *(const f32x2*)(cip + n0), ci1 = *(const f32x2*)(cip + n0 + 32);
                v4u w; w.x = pk2(cr0[0], -ci0[0]); w.y = pk2(cr1[0], -ci1[0]); w.z = pk2(cr0[1], -ci0[1]); w.w = pk2(cr1[1], -ci1[1]);
                *(LAS v4u*)(CFB + ((d * 4 + ks) * 64 + lane) * 16) = w; }
        }
    }
}
__device__ __forceinline__ void s5_task(const DArgs& a, LAS unsigned char* lds, int tid, int lane, int wave, int l, int row0, int NC, int g, int bidx, bool latent, const S5C& cst, bf16x8& Afpre, int next_row0) {
#define S5_BAR() do { asm volatile("s_waitcnt lgkmcnt(0)" ::: "memory"); __builtin_amdgcn_s_barrier(); asm volatile("" ::: "memory"); } while (0)
    const int n = lane & 31, hf = lane >> 5, tq = lane & 15, q = lane >> 4;
    LAS float* EB = (LAS float*)lds;
    LAS unsigned char* SB = lds + 65536 + wave * 8704;
    const bf16* U = (const bf16*)(a.ws + WS_U); bf16* Z = (bf16*)(a.ws + WS_Z);
    LAS unsigned char* CFB = lds + 135168;
    const LAS float* A16 = (const LAS float*)(lds + 143360);
    bf16x8 Bf[2][4]; float ar[2][2], ai[2][2];
#pragma unroll
    for (int d = 0; d < 2; ++d) {
#pragma unroll
        for (int cb = 0; cb < 4; ++cb) Bf[d][cb] = cst.Bf[d][cb];
#pragma unroll
        for (int s2 = 0; s2 < 2; ++s2) { ar[d][s2] = cst.ar[d][s2]; ai[d][s2] = cst.ai[d][s2]; } }
    const f32x16 zero16 = {0.f, 0.f, 0.f, 0.f, 0.f, 0.f, 0.f, 0.f, 0.f, 0.f, 0.f, 0.f, 0.f, 0.f, 0.f, 0.f};
    const int cbit = (n >> 2) & 1, tA = (n >> 3) * 4 + (n & 3);
#define S5_PIN_BU() asm volatile("s_nop 15\n\ts_nop 15\n\ts_nop 15\n\ts_nop 15\n\ts_nop 15\n\ts_nop 15\n\ts_nop 15\n\ts_nop 15\n\ts_nop 15\n\ts_nop 15\n\ts_nop 15\n\ts_nop 15\n\ts_nop 15\n\ts_nop 15\n\ts_nop 15\n\ts_nop 15\n\ts_nop 15\n\ts_nop 15\n\ts_nop 15\n\ts_nop 15" : "+v"(acc[0]), "+v"(acc[1]), "+v"(acc[2]), "+v"(acc[3]) : "v"(Afd), "v"(Bf[d][0]), "v"(Bf[d][1]), "v"(Bf[d][2]), "v"(Bf[d][3]))
    bf16x8 Afk = {0, 0, 0, 0, 0, 0, 0, 0};
    bf16x8 Afn = Afpre;
    for (int item = wave; item < NC / 2; item += NWAVES) { const int c0 = 2 * item;
        const bf16x8 Af = Afn;
        if (item + NWAVES < NC / 2) Afn = *(const bf16x8*)(U + (unsigned)((row0 + (c0 + 2 * NWAVES + cbit) * 16 + tA) * SW + g * 16 + 8 * hf));
        Afk = Af;
#pragma unroll
        for (int d = 0; d < 2; ++d) {
            bf16x8 Afd = Af; asm volatile("" : "+v"(Afd) :: "memory");
            f32x16 acc[4];
#pragma unroll
            for (int cb = 0; cb < 4; ++cb) acc[cb] = __builtin_amdgcn_mfma_f32_32x32x16_bf16(Afd, Bf[d][cb], zero16, 0, 0, 0);
            S5_PIN_BU();
            float s0r = 0.f, s0i = 0.f, s1r = 0.f, s1i = 0.f;
#pragma unroll
            for (int ii = 0; ii < 16; ++ii) { const int i = d == 0 ? ii : 15 - ii;
                const float n0r = fmaf(ar[d][0], s0r, fmaf(-ai[d][0], s0i, acc[0][i])), n0i = fmaf(ar[d][0], s0i, fmaf(ai[d][0], s0r, acc[1][i]));
                const float n1r = fmaf(ar[d][1], s1r, fmaf(-ai[d][1], s1i, acc[2][i])), n1i = fmaf(ar[d][1], s1i, fmaf(ai[d][1], s1r, acc[3][i]));
                s0r = n0r; s0i = n0i; s1r = n1r; s1i = n1i; }
            *(LAS f32x4*)(EB + (d * 64 + c0 + hf) * 128 + 4 * n) = (f32x4){s0r, s0i, s1r, s1i};
            asm volatile("s_waitcnt lgkmcnt(0)" :: "v"(s0r), "v"(s0i), "v"(s1r), "v"(s1i) : "memory");
        }
    }
    S5_BAR();
    if (tid < 128) { const int d = tid >> 6, nn = tid & 63, pos = nn < 32 ? 4 * nn : 4 * (nn - 32) + 2;
        const f32x2 p16 = *(const LAS f32x2*)(A16 + (d * 64 + nn) * 2); const float pr = p16[0], pi = p16[1];
        const unsigned sidx = ((((unsigned)bidx * DEPTH + l) * 2 + d) * 64 + g) * 64 + nn;
        float sr = 0.f, si = 0.f;
        if (latent) { sr = a.in[I_SRE][sidx]; si = a.in[I_SIM][sidx]; }
        for (int cb8 = 0; cb8 < NC; cb8 += 8) {
            f32x2 e[8];
#pragma unroll
            for (int j = 0; j < 8; ++j) { const int c = d == 0 ? cb8 + j : NC - 1 - cb8 - j; e[j] = *(const LAS f32x2*)(EB + (d * 64 + c) * 128 + pos); }
#pragma unroll
            for (int j = 0; j < 8; ++j) { const int c = d == 0 ? cb8 + j : NC - 1 - cb8 - j; const f32x2 sv = {sr, si};
                const float nr = fmaf(pr, sr, fmaf(-pi, si, e[j][0])), ni = fmaf(pr, si, fmaf(pi, sr, e[j][1])); sr = nr; si = ni;
                *(LAS f32x2*)(EB + (d * 64 + c) * 128 + pos) = sv; }
        }
        if (!latent) { float* ns = a.out + (size_t)NTOK * DM; ns[sidx] = sr; ns[524288u + sidx] = si; }
    }
    S5_BAR();
    if (next_row0 >= 0) Afpre = *(const bf16x8*)(U + (unsigned)((next_row0 + (2 * wave + cbit) * 16 + tA) * SW + g * 16 + 8 * hf));
    if (latent) Afn = *(const bf16x8*)(U + (unsigned)((row0 + (2 * wave + cbit) * 16 + tA) * SW + g * 16 + 8 * hf));
    const f32x4 dd = *(const f32x4*)(a.in[I_SSMD] + (unsigned)(l * SW + g * 16 + 4 * q));
    for (int item = wave; item < NC / 2; item += NWAVES) { const int c0 = 2 * item;
        bf16x8 Af = Afk;
        if (latent) { Af = Afn; if (item + NWAVES < NC / 2) Afn = *(const bf16x8*)(U + (unsigned)((row0 + (c0 + 2 * NWAVES + cbit) * 16 + tA) * SW + g * 16 + 8 * hf)); }
        v2u uwv[2];
#pragma unroll
        for (int cc = 0; cc < 2; ++cc) uwv[cc] = *(const v2u*)(U + (unsigned)((row0 + (c0 + cc) * 16 + tq) * SW + g * 16 + 4 * q));
        f32x4 yacc[2] = {{0.f, 0.f, 0.f, 0.f}, {0.f, 0.f, 0.f, 0.f}};
#pragma unroll
        for (int d = 0; d < 2; ++d) {
            bf16x8 Afd = Af; asm volatile("" : "+v"(Afd) :: "memory");
            f32x16 acc[4];
#pragma unroll
            for (int cb = 0; cb < 4; ++cb) acc[cb] = __builtin_amdgcn_mfma_f32_32x32x16_bf16(Afd, Bf[d][cb], zero16, 0, 0, 0);
            S5_PIN_BU();
            const f32x4 s_in = *(const LAS f32x4*)(EB + (d * 64 + c0 + hf) * 128 + 4 * n);
            float s0r = s_in[0], s0i = s_in[1], s1r = s_in[2], s1i = s_in[3];
            v2u w[16];
#pragma unroll
            for (int ii = 0; ii < 16; ++ii) { const int i = d == 0 ? ii : 15 - ii;
                const float n0r = fmaf(ar[d][0], s0r, fmaf(-ai[d][0], s0i, acc[0][i])), n0i = fmaf(ar[d][0], s0i, fmaf(ai[d][0], s0r, acc[1][i]));
                const float n1r = fmaf(ar[d][1], s1r, fmaf(-ai[d][1], s1i, acc[2][i])), n1i = fmaf(ar[d][1], s1i, fmaf(ai[d][1], s1r, acc[3][i]));
                s0r = n0r; s0i = n0i; s1r = n1r; s1i = n1i;
                w[i].x = pk2(s0r, s0i); w[i].y = pk2(s1r, s1i); }
#pragma unroll
            for (int i = 0; i < 16; ++i) *(LAS v2u*)(SB + (hf * 16 + i) * 272 + 8 * n) = w[i];
            asm volatile("s_waitcnt lgkmcnt(0)" :: "v"(w[0]), "v"(w[1]), "v"(w[2]), "v"(w[3]), "v"(w[4]), "v"(w[5]), "v"(w[6]), "v"(w[7]), "v"(w[8]), "v"(w[9]), "v"(w[10]), "v"(w[11]), "v"(w[12]), "v"(w[13]), "v"(w[14]), "v"(w[15]) : "memory");
            {
                bf16x8 sf[2][4], cf[4];
#pragma unroll
                for (int ks = 0; ks < 4; ++ks) { cf[ks] = *(const LAS bf16x8*)(CFB + ((d * 4 + ks) * 64 + lane) * 16);
#pragma unroll
                    for (int cc = 0; cc < 2; ++cc) sf[cc][ks] = *(const LAS bf16x8*)(SB + (cc * 16 + tq) * 272 + ks * 64 + q * 16); }
                asm volatile("s_waitcnt lgkmcnt(0)" : "+v"(sf[0][0]), "+v"(sf[0][1]), "+v"(sf[0][2]), "+v"(sf[0][3]), "+v"(sf[1][0]), "+v"(sf[1][1]), "+v"(sf[1][2]), "+v"(sf[1][3]), "+v"(cf[0]), "+v"(cf[1]), "+v"(cf[2]), "+v"(cf[3]) :: "memory");
#pragma unroll
                for (int cc = 0; cc < 2; ++cc)
#pragma unroll
                    for (int ks = 0; ks < 4; ++ks) yacc[cc] = __builtin_amdgcn_mfma_f32_16x16x32_bf16(cf[ks], sf[cc][ks], yacc[cc], 0, 0, 0);
                asm volatile("s_nop 15\n\ts_nop 15\n\ts_nop 15\n\ts_nop 15\n\ts_nop 15\n\ts_nop 15\n\ts_nop 15\n\ts_nop 15\n\ts_nop 15\n\ts_nop 15\n\ts_nop 15\n\ts_nop 15\n\ts_nop 15\n\ts_nop 15\n\ts_nop 15\n\ts_nop 15" : "+v"(yacc[0]), "+v"(yacc[1]) : "v"(sf[0][0]), "v"(sf[0][1]), "v"(sf[0][2]), "v"(sf[0][3]), "v"(sf[1][0]), "v"(sf[1][1]), "v"(sf[1][2]), "v"(sf[1][3]), "v"(cf[0]), "v"(cf[1]), "v"(cf[2]), "v"(cf[3]) : "memory");
            }
        }
#pragma unroll
        for (int cc = 0; cc < 2; ++cc) { const unsigned off = (unsigned)((row0 + (c0 + cc) * 16 + tq) * SW + g * 16 + 4 * q);
            const v2u uw = uwv[cc];
            const float u0 = bflo(uw.x), u1 = bfhi(uw.x), u2 = bflo(uw.y), u3 = bfhi(uw.y);
            const float z0 = gelu_tanh(yacc[cc][0] + dd[0] * u0), z1 = gelu_tanh(yacc[cc][1] + dd[1] * u1), z2 = gelu_tanh(yacc[cc][2] + dd[2] * u2), z3 = gelu_tanh(yacc[cc][3] + dd[3] * u3);
            v2u zw; zw.x = pk2(z0, z1); zw.y = pk2(z2, z3);
            *(v2u*)(Z + off) = zw; }
    }
    S5_BAR();
}
__device__ __forceinline__ void s5_phase(LAS unsigned char* lds, int tid_, int lane_, int wave_, int bx_, int G_, int l) {
    const DArgs a = load_args(); const int tid = fresh_v(tid_), lane = fresh_v(lane_), wave = fresh_s(wave_), bx = fresh_s(bx_), G = fresh_s(G_);
    const bool bal = (G == 256);
    const int nt = bal ? (bx < 128 ? 3 : 6) : (128 + 1024 - bx + G - 1) / G;
    S5C cst; int gprev = -1; bf16x8 Afpre = {0, 0, 0, 0, 0, 0, 0, 0};
    const int lane_n = lane & 31, cbit = (lane_n >> 2) & 1, tA = (lane_n >> 3) * 4 + (lane_n & 3), hf = lane >> 5;
    const bf16* U = (const bf16*)(a.ws + WS_U);
    for (int i = 0; i < nt; ++i) {
        bool latent, latn = false; int b, g, bn = 0, gn = -1;
#define S5_TASK(ii, LAT, B, GG) do { if (bal) { if (bx < 128) { LAT = ((ii) == 0); GG = bx & 63; B = LAT ? (bx >> 6) : 2 * (bx >> 6) + ((ii) - 1); } else { const int w = bx - 128; LAT = false; GG = w >> 1; B = 4 + 6 * (w & 1) + (ii); } } \
        else { const int t = bx + (ii) * G; LAT = t < 128; const int tc = LAT ? t : t - 128; B = tc >> 6; GG = tc & 63; } } while (0)
        S5_TASK(i, latent, b, g);
        if (i + 1 < nt) S5_TASK(i + 1, latn, bn, gn);
        const int row0 = latent ? NCTX + b * 1024 : b * 256;
        const int rown = (i + 1 < nt && gn == g) ? (latn ? NCTX + bn * 1024 : bn * 256) : -1;
        if (g != gprev) { s5_setup(a, lds, lane, wave, l, g, cst); gprev = g;
            Afpre = *(const bf16x8*)(U + (unsigned)((row0 + (2 * wave + cbit) * 16 + tA) * SW + g * 16 + 8 * hf)); }
        s5_task(a, lds, tid, lane, wave, l, row0, latent ? 64 : 16, g, b, latent, cst, Afpre, rown);
#undef S5_TASK
    }
}
#define XB_TMO      128
#define XB_XCNT(j)  (256  + 64 * (j))
#define XB_XSUB(j)  (1280 + 64 * (j))
#define XB_XGEN(j)  (2304 + 64 * (j))
#define XB_TOP      3328
#define XB_TOPGEN   3392
#define XCD_BAR_WORDS 3456
#define XB_SPIN_CAP (1u << 18)

__device__ __forceinline__ unsigned xb_ld(unsigned* p)              { return __hip_atomic_load(p, __ATOMIC_RELAXED, __HIP_MEMORY_SCOPE_AGENT); }
__device__ __forceinline__ unsigned xb_add(unsigned* p, unsigned v) { return __hip_atomic_fetch_add(p, v, __ATOMIC_RELAXED, __HIP_MEMORY_SCOPE_AGENT); }
__device__ __forceinline__ unsigned xb_xcc_id() { return (unsigned)__builtin_amdgcn_s_getreg((3 << 11) | 20) & 0xFu; }
#define XB_SPIN(cond, bar) do { unsigned _sp = 0; while (cond) { __builtin_amdgcn_s_sleep(1); \
    if ((++_sp & 255u) == 0u) { if (xb_ld(&(bar)[XB_TMO])) break; if (_sp > XB_SPIN_CAP) { atomicAdd(&(bar)[XB_TMO], 1u); break; } } } } while (0)

struct XcdBarrier {
    unsigned* bar; unsigned x;
    volatile LAS unsigned* st;
};

__device__ __forceinline__ XcdBarrier xcd_barrier_post(unsigned* bar, volatile LAS unsigned* st) {
    XcdBarrier b; b.bar = bar; b.x = xb_xcc_id(); b.st = st;
    if (threadIdx.x == 0) (void)xb_add(&bar[XB_XCNT(b.x)], 1u);
    return b;
}
__device__ __forceinline__ void xcd_barrier_complete(unsigned* bar, unsigned x, unsigned& nloc, unsigned& nx) {
    const unsigned G = gridDim.x * gridDim.y * gridDim.z;
    unsigned sum, cnt, mine, sp = 0u;
    for (;;) {
        sum = 0u; cnt = 0u; mine = 0u;
#pragma unroll
        for (unsigned j = 0; j < 16; ++j) { const unsigned c = xb_ld(&bar[XB_XCNT(j)]); sum += c; cnt += (c > 0u) ? 1u : 0u; mine = (j == x) ? c : mine; }
        if (sum == G) break;
        __builtin_amdgcn_s_sleep(1);
        if ((++sp & 255u) == 0u) { if (xb_ld(&bar[XB_TMO])) break; if (sp > XB_SPIN_CAP) { atomicAdd(&bar[XB_TMO], 1u); break; } }
    }
    nloc = mine > 0u ? mine : 1u; nx = cnt > 0u ? cnt : 1u;
}

__device__ __forceinline__ void xcd_barrier(const XcdBarrier& b) {
    asm volatile("s_waitcnt vmcnt(0)" ::: "memory");
    __syncthreads();
    if (threadIdx.x == 0) {
        unsigned* bar = b.bar;
        __builtin_amdgcn_s_waitcnt(0);
        unsigned nloc = b.st[0], nx = b.st[1];
        if (nloc == 0u) { xcd_barrier_complete(bar, b.x, nloc, nx); b.st[0] = nloc; b.st[1] = nx; }
        const unsigned old = xb_add(&bar[XB_XSUB(b.x)], 1u);
        const unsigned gen = old / nloc;
        if (old + 1u == (gen + 1u) * nloc) {
            __builtin_amdgcn_fence(__ATOMIC_RELEASE, "agent");
            asm volatile("s_waitcnt vmcnt(0)" ::: "memory");
            const unsigned og = xb_add(&bar[XB_TOP], 1u);
            const unsigned tg = og / nx;
            if (og + 1u == (tg + 1u) * nx) xb_add(&bar[XB_TOPGEN], 1u);
            else XB_SPIN(xb_ld(&bar[XB_TOPGEN]) == tg, bar);
            __builtin_amdgcn_fence(__ATOMIC_ACQUIRE, "agent");
            xb_add(&bar[XB_XGEN(b.x)], 1u);
            asm volatile("s_waitcnt vmcnt(0)" ::: "memory");
        } else {
            XB_SPIN(xb_ld(&bar[XB_XGEN(b.x)]) == gen, bar);
            __builtin_amdgcn_fence(__ATOMIC_ACQUIRE, "agent");
            asm volatile("s_waitcnt vmcnt(0)" ::: "memory");
        }
    }
    __syncthreads();
}


__device__ __forceinline__ void sub_barrier(unsigned* word, unsigned n, unsigned* bar) {
    asm volatile("s_waitcnt vmcnt(0)" ::: "memory");
    __syncthreads();
    if (threadIdx.x == 0) {
        __builtin_amdgcn_s_waitcnt(0);
        __builtin_amdgcn_fence(__ATOMIC_RELEASE, "agent");
        asm volatile("s_waitcnt vmcnt(0)" ::: "memory");
        (void)xb_add(word, 1u);
        XB_SPIN(xb_ld(word) < n, bar);
        __builtin_amdgcn_fence(__ATOMIC_ACQUIRE, "agent");
        asm volatile("s_waitcnt vmcnt(0)" ::: "memory");
    }
    __syncthreads();
}

__global__ void __launch_bounds__(NWAVES * 64, 2) fwd_kernel(Args  ) {
    extern __shared__ __attribute__((aligned(16))) unsigned char lds_raw[];
    LAS unsigned char* lds = (LAS unsigned char*)lds_raw;
    const int tid = threadIdx.x, lane = tid & 63, wave = __builtin_amdgcn_readfirstlane(tid >> 6), G = gridDim.x, bx = blockIdx.x;
    volatile LAS unsigned* MISC = (volatile LAS unsigned*)(lds + MISC_OFF);
    for (int u = tid; u < (LDS_BYTES - LDSCTL_OFF) / 4; u += NWAVES * 64) ((LAS unsigned*)(lds + LDSCTL_OFF))[u] = 0u;
    __syncthreads();
    XcdBarrier bar;
    { const DArgs a = load_args(); gu32* ctl = (gu32*)(a.ws + WS_CTL); bar = xcd_barrier_post((unsigned*)(ctl + CW_BAR), MISC + 8); }
#define GRID_BAR() do { XcdBarrier b_ = bar; asm volatile("" : "+s"(b_.bar), "+s"(b_.x)); xcd_barrier(b_); } while (0)


    for (int t = bx; t < 192; t += G) mod_task(lds, tid, lane, wave, t);
    cvt_fill(lds, tid, 0, (G == 256 && bx < 192) ? 6 : -1);
    cvt_fill(lds, tid, 0, -1);
    GRID_BAR();
    { RowVec rv; row_prefetch<0>(0, bx, G, wave, lane, rv); row_pass<0>(0, bx, G, wave, lane, rv); }
    GRID_BAR();

    const int nl = fresh_s(DEPTH);
    for (int li = 0; li < nl; ++li) {
        const int l = li;
        const bool dfl = fresh_s(G) == 256;
        { const int x = bx & 7, r = bx >> 3;
          pg8::G5Order S; S.st = !dfl; S.so.init(NTOK, INC, fresh_s(G), fresh_s(bx));
          if (r < 24) { S.u0.pm = 3 * x + r % 3; S.u0.pn = 8 + r / 3; } else if (r < 28) { S.u0.pm = 3 * x + (r - 24) % 3; S.u0.pn = (r - 24) / 3; } else { S.u0.pm = -1; S.u0.pn = 0; }
          if (S.st || S.u0.pm >= 0) {
              const DArgs a = load_args(); pg8::Gemm g{(const bf16*)(a.ws + WS_H), (const bf16*)(a.ws + WS_WIN) + (size_t)l * INC * DM, NTOK, INC, DM};
              pg8::EpiIn E{(bf16*)(a.ws + WS_GB), (bf16*)(a.ws + WS_V), (bf16*)(a.ws + WS_U)};
              pg8::gemm_phase<pg8::EpiIn, pg8::G5Order, true, true>(lds, g, S, E);
          } else if (li + 1 < nl) cvt_fill(lds, tid, l + 1, 12);
        }
        GRID_BAR();
        s5_phase(lds, tid, lane, wave, bx, G, l);
        GRID_BAR();
        { const int x = bx & 7, r = bx >> 3;
          if (dfl && r < 20) {
              pg8::G5Order S; S.st = false; S.u0.pm = 3 * x + (r + 4) % 3; S.u0.pn = (r + 4) / 3;
              const DArgs a = load_args(); pg8::Gemm g{(const bf16*)(a.ws + WS_H), (const bf16*)(a.ws + WS_WIN) + (size_t)l * INC * DM, NTOK, INC, DM};
              pg8::EpiIn E{(bf16*)(a.ws + WS_GB), (bf16*)(a.ws + WS_V), (bf16*)(a.ws + WS_U)};
              pg8::gemm_phase<pg8::EpiIn, pg8::G5Order, true, true>(lds, g, S, E);
          } else {
              pg8::G5Order S; S.st = !dfl; S.so.init(NTOK, SW, fresh_s(G), fresh_s(bx)); S.u0.pm = 3 * x + (r - 20) % 3; S.u0.pn = (r - 20) / 3;
              const DArgs a = load_args(); pg8::Gemm g{(const bf16*)(a.ws + WS_Z), (const bf16*)(a.ws + WS_WGLU) + (size_t)l * SW * SW, NTOK, SW, SW};
              pg8::EpiGlu E{(const bf16*)(a.ws + WS_Z), (bf16*)(a.ws + WS_O), a.in[I_BGLU] + (size_t)l * SW};
              pg8::gemm_phase<pg8::EpiGlu, pg8::G5Order, true, true>(lds, g, S, E);
              if (li + 1 < nl) cvt_fill(lds, tid, l + 1, 4);
          }
        }
        MixVec mv; mix_prefetch(lane, l, mv);
        GRID_BAR();
        mix_pass(bx, G, wave, lane, l, mv);
        GRID_BAR();
        { const DArgs a = load_args(); pg8::Gemm g{(const bf16*)(a.ws + WS_MIXIN), (const bf16*)(a.ws + WS_WOUT) + (size_t)l * DM * DM, NTOK, DM, DM}; pg8::G5Order S; S.st = !dfl; S.so.init(NTOK, DM, fresh_s(G), fresh_s(bx)); { const int x = bx & 7, r = bx >> 3; S.u0.pm = r < 24 ? 3 * x + r % 3 : -1; S.u0.pn = r / 3; }
          pg8::EpiBf16<0> E{(bf16*)(a.ws + WS_MIXED), DM, nullptr, 0, 0, 1.f};
          pg8::gemm_phase<pg8::EpiBf16<0>, pg8::G5Order, true, true>(lds, g, S, E); }
        if (li + 1 < nl && bx >= 192) cvt_fill(lds, tid, l + 1, 12);
        RowVec rv1; row_prefetch<1>(l, bx, G, wave, lane, rv1);
        GRID_BAR();
        row_pass<1>(l, bx, G, wave, lane, rv1);
        GRID_BAR();
        { const DArgs a = load_args(); pg8::Gemm g{(const bf16*)(a.ws + WS_H), (const bf16*)(a.ws + WS_WUP) + (size_t)l * UPN * DM, NTOK, UPN, DM}; pg8::G4Order S{0, dfl ? 1024 : 1056, fresh_s(G), fresh_s(bx), !dfl};
          pg8::EpiFfn E{(bf16*)(a.ws + WS_ACT), a.in[I_FFNW] + (size_t)l * 3 * UPN, (LAS float*)(lds + RING_BYTES)};
          pg8::gemm_phase<pg8::EpiFfn, pg8::G4Order, true, true>(lds, g, S, E); }
        GRID_BAR();
        if (dfl && bx < 32) {
            { const DArgs a = load_args(); pg8::Gemm g{(const bf16*)(a.ws + WS_H), (const bf16*)(a.ws + WS_WUP) + (size_t)l * UPN * DM, NTOK, UPN, DM}; pg8::G4Order S{1024, 1056, fresh_s(G), fresh_s(bx), false};
              pg8::EpiFfn E{(bf16*)(a.ws + WS_ACT), a.in[I_FFNW] + (size_t)l * 3 * UPN, (LAS float*)(lds + RING_BYTES)};
              pg8::gemm_phase<pg8::EpiFfn, pg8::G4Order, true, true>(lds, g, S, E); }
            { const DArgs a = load_args(); sub_barrier((unsigned*)(a.ws + WS_CTL) + CW_SUB + 64 * l, 32u, (unsigned*)(a.ws + WS_CTL) + CW_BAR); }
            { const DArgs a = load_args(); pg8::Gemm g{(const bf16*)(a.ws + WS_ACT) + (size_t)23 * 256 * DFF, (const bf16*)(a.ws + WS_WDN) + (size_t)l * DM * DFF, 256, 4 * DM, DFF / 4, DFF, 4};
              pg8::G5Order S; S.st = false; S.u0.pm = 0; S.u0.pn = fresh_s(bx);
              pg8::EpiBf16<0> E{(bf16*)(a.ws + WS_FFP), DM, nullptr, DM, (size_t)256 * DM, 1.f};
              pg8::gemm_phase<pg8::EpiBf16<0>, pg8::G5Order, true, true>(lds, g, S, E); }
            if (li + 1 < nl) cvt_fill(lds, tid, l + 1, 8);
        } else {
            const int x = bx & 7, r = (bx >> 3) - 4;
            pg8::G5Order S; S.st = !dfl; S.so.init(NTOK, DM, fresh_s(G), fresh_s(bx));
            if (bx < 224 && !(x == 7 && r >= 16)) { S.u0.pm = x < 7 ? 3 * x + r % 3 : 21 + (r & 1); S.u0.pn = x < 7 ? r / 3 : r >> 1; } else { S.u0.pm = -1; S.u0.pn = 0; }
            if (S.st || S.u0.pm >= 0) {
                const DArgs a = load_args(); pg8::Gemm g{(const bf16*)(a.ws + WS_ACT), (const bf16*)(a.ws + WS_WDN) + (size_t)l * DM * DFF, NTOK, DM, DFF};
                pg8::EpiBf16<0> E{(bf16*)(a.ws + WS_FF), DM, nullptr, 0, 0, 1.f};
                pg8::gemm_phase<pg8::EpiBf16<0>, pg8::G5Order, true, true>(lds, g, S, E);
            } else if (li + 1 < nl) cvt_fill(lds, tid, l + 1, 48);
        }
        RowVec rv2; if (li < nl - 1) row_prefetch<2>(l, bx, G, wave, lane, rv2); else row_prefetch<3>(l, bx, G, wave, lane, rv2);
        GRID_BAR();
        if (li < nl - 1) {
            row_pass<2>(l, bx, G, wave, lane, rv2, fresh_s(G) == 256);
            cvt_fill(lds, tid, l + 1, -1);
            GRID_BAR();
        } else {
            row_pass<3>(l, bx, G, wave, lane, rv2, fresh_s(G) == 256);
        }
    }

#undef GRID_BAR
}

extern "C" void kernel_launch(void* const* d_in, const int* in_sizes, int n_in, void* d_out, int out_size, void* d_ws, size_t ws_size, hipStream_t stream) {
    static int grid = 0;
    if (grid == 0) {
        if (n_in != 30 || out_size != NTOK * DM + 2 * 524288 || ws_size < WS_END) { fprintf(stderr, "kernel_launch: unexpected shapes (n_in %d, out %d, ws %zu); nothing launched\n", n_in, out_size, ws_size); grid = -1; return; }
        int dev = 0, cus = 0, per_cu = 0;
        if (hipGetDevice(&dev) != hipSuccess || hipDeviceGetAttribute(&cus, hipDeviceAttributeMultiprocessorCount, dev) != hipSuccess) { grid = -1; return; }
        if (hipFuncSetAttribute((const void*)fwd_kernel, hipFuncAttributeMaxDynamicSharedMemorySize, LDS_BYTES) != hipSuccess) { fprintf(stderr, "kernel_launch: hipFuncSetAttribute failed\n"); grid = -1; return; }
        if (hipOccupancyMaxActiveBlocksPerMultiprocessor(&per_cu, (const void*)fwd_kernel, NWAVES * 64, LDS_BYTES) != hipSuccess || per_cu < 1)
            fprintf(stderr, "kernel_launch: note: occupancy query reports %d workgroups per CU\n", per_cu);
        (void)hipGetLastError();
        grid = cus;
    }
    if (grid < 0) return;
    if (hipMemsetAsync((char*)d_ws + WS_CTL, 0, CTL_ZERO_BYTES, stream) != hipSuccess) return;
    Args a{};
    for (int i = 0; i < 30; ++i) a.in[i] = (const float*)d_in[i];
    a.out = (float*)d_out; a.ws = (unsigned char*)d_ws;
    hipLaunchKernelGGL(fwd_kernel, dim3(grid), dim3(NWAVES * 64), LDS_BYTES, stream, a);
}
```

```cpp
#include <hip/hip_runtime.h>
#include <cstdio>
#include <cstdint>
namespace pg8 {
#define PG8_LAS __attribute__((address_space(3)))
typedef unsigned short bf16_t;
typedef short bf16x8 __attribute__((ext_vector_type(8)));
typedef float f32x4 __attribute__((ext_vector_type(4)));
typedef unsigned u32x4 __attribute__((ext_vector_type(4)));
constexpr int BM = 256, BK = 64, HALF = 128, HTB = HALF * BK * 2  , STAGE_BYTES = 8 * HTB, NXCD = 8, WGM = 8;

__host__ __device__ __forceinline__ int lds_byte(int r, int c) { const int st = (r >> 4) * 2 + (c >> 5), rr = r & 15, cc = c & 31, ob = rr * 64 + cc * 2; return st * 1024 + (ob ^ (((ob >> 9) & 1) << 5)); }
__host__ __device__ __forceinline__ void stage_rc(int b, int& R, int& C) { const int st = b / 1024, sb = b % 1024, swz = sb ^ (((sb >> 9) & 1) << 5); R = (st >> 1) * 16 + swz / 64; C = (st & 1) * 32 + (swz % 64) / 2; }
__host__ __device__ __forceinline__ int perm32(int rho) { const int n = rho >> 4, i = rho & 15; return 8 * (i >> 2) + 4 * n + (i & 3); }

struct Unit { int pm, pn; };
struct Gemm { const bf16_t* A; const bf16_t* Bt; int M, N, K; int ld = 0; int nsp = 1; };

struct StaticOrder {
    int nM, nN, nwg, G, c;
    __host__ __device__ void init(int M, int N, int G_, int c_) { nM = M / BM; nN = N / BM; nwg = nM * nN; G = G_; c = c_; }
    __host__ __device__ bool next(int i, Unit& u) const {
        const long L = (long)i * G + c; if (L >= nwg) return false;
        int wgid = (int)L; { const int q = nwg / NXCD, r = nwg % NXCD, xcd = wgid % NXCD, off = wgid / NXCD; wgid = (xcd < r ? xcd * (q + 1) : r * (q + 1) + (xcd - r) * q) + off; }
        const int nig = WGM * nN, gid = wgid / nig, fm = gid * WGM, gsz = (nM - fm) < WGM ? (nM - fm) : WGM;
        u.pm = fm + ((wgid % nig) % gsz); u.pn = (wgid % nig) / gsz; return true;
    }
    __device__ __forceinline__ void a_ready(const Unit&) const {}
    __device__ __forceinline__ void done(const Unit&) const {}
};

__device__ __forceinline__ unsigned cvt_pk_bf16(float lo, float hi) { unsigned r; asm volatile("v_cvt_pk_bf16_f32 %0, %1, %2" : "=v"(r) : "v"(lo), "v"(hi)); return r; }
typedef float f32x2 __attribute__((ext_vector_type(2)));
__device__ __forceinline__ f32x2 gelu_pk(f32x2 v) {
    const f32x2 av = __builtin_elementwise_abs(v), d = av * 0.2316418882f + 1.0f;
    f32x2 t; t.x = __builtin_amdgcn_rcpf(d.x); t.y = __builtin_amdgcn_rcpf(d.y);
    f32x2 q = t * 0.5307027145f + (-0.7265760135f); q = q * t + 0.7107068705f; q = q * t + (-0.142248368f); q = q * t + 0.127414796f; q = q * t;
    const f32x2 s = (v * v) * (-0.72134752044f);
    f32x2 e; e.x = __builtin_amdgcn_exp2f(s.x); e.y = __builtin_amdgcn_exp2f(s.y);
    const f32x2 m = v * (q * e), r = v - m;
    f32x2 o; o.x = v.x < 0.f ? m.x : r.x; o.y = v.y < 0.f ? m.y : r.y; return o;
}

template <int ACT  > struct EpiBf16 {
    static constexpr bool PERM = true, AFTER_DRAIN = false; static_assert(ACT == 0 || ACT == 1, "EpiBf16: ACT is 0 (none) or 1 (gelu_pk)");
    bf16_t* O; int ldc; const float* bias; int split_cols; size_t split_stride; float scale0;
    __device__ __forceinline__ void operator()(const f32x4 (&acc)[2][2][4][2], const Unit& u, int wr, int wc, int fr, int fq) const {
        const int row0 = u.pm * BM + wr * 64 + fr; int colt = u.pn * BM; bf16_t* base = O;
        float sc = 1.f; if (split_cols) { const int t = colt / split_cols; base += (size_t)t * split_stride; colt -= t * split_cols; if (t == 0) sc = scale0; }
        const int col0 = colt + wc * 32 + 8 * fq, bcol0 = u.pn * BM + wc * 32 + 8 * fq;
        f32x4 bv[2][2];
#pragma unroll
        for (int bj = 0; bj < 2; ++bj)
#pragma unroll
            for (int n = 0; n < 2; ++n) bv[bj][n] = bias ? *(const f32x4*)(bias + bcol0 + bj * HALF + 4 * n) : (f32x4){0.f, 0.f, 0.f, 0.f};
#pragma unroll
        for (int ai = 0; ai < 2; ++ai)
#pragma unroll
            for (int m = 0; m < 4; ++m) { bf16_t* rowp = base + (size_t)(row0 + ai * HALF + m * 16) * ldc + col0;
#pragma unroll
                for (int bj = 0; bj < 2; ++bj) { f32x4 v0 = acc[ai][bj][m][0] + bv[bj][0], v1 = acc[ai][bj][m][1] + bv[bj][1];
                    if (ACT == 1) { f32x2 a = gelu_pk((f32x2){v0[0], v0[1]}), b = gelu_pk((f32x2){v0[2], v0[3]}), c = gelu_pk((f32x2){v1[0], v1[1]}), d = gelu_pk((f32x2){v1[2], v1[3]});
                        v0 = (f32x4){a.x, a.y, b.x, b.y}; v1 = (f32x4){c.x, c.y, d.x, d.y}; }
                    v0 = v0 * sc; v1 = v1 * sc; u32x4 w; w.x = cvt_pk_bf16(v0[0], v0[1]); w.y = cvt_pk_bf16(v0[2], v0[3]); w.z = cvt_pk_bf16(v1[0], v1[1]); w.w = cvt_pk_bf16(v1[2], v1[3]);
                    *(u32x4*)(rowp + bj * HALF) = w; } }
    }
};
template <class Epi, class Sched, bool ALIGN_EPI = false, bool SP2 = false>
__device__ __forceinline__ void gemm_phase(PG8_LAS unsigned char* lds, const Gemm g, const Sched& S, const Epi& E) {
    int tid_ = threadIdx.x; asm volatile("" : "+v"(tid_));
    const int tid = tid_, wid = __builtin_amdgcn_readfirstlane(tid >> 6), lane = tid & 63, wr = wid >> 2, wc = wid & 3, fr = lane & 15, fq = lane >> 4;
    const int K = g.K, nt = K / BK, ld = g.ld ? g.ld : g.K, nNr = g.N / BM / g.nsp;
    unsigned voffA[2], voffB[2];
#pragma unroll
    for (int i = 0; i < 2; ++i) { int R, C; stage_rc(tid * 16 + i * 8192, R, C); const int Rb = Epi::PERM ? ((R & ~31) + perm32(R & 31)) : R;
        voffA[i] = (unsigned)(R * ld + C) * 2u; voffB[i] = (unsigned)(Rb * ld + C) * 2u; }
    const size_t kstep = (size_t)(BK * 2);
    const size_t hstep = (size_t)HALF * ld * 2;
    const size_t tstep = 2 * hstep;
    const unsigned ldsw = (unsigned)wid * 1024u;
    const int aoff = lds_byte(wr * 64 + fr, fq * 8), boff = lds_byte(wc * 32 + fr, fq * 8);
#define PG8_SA(b, h) (((b) * 2 + (h)) * HTB)
#define PG8_SB(b, h) ((4 + (b) * 2 + (h)) * HTB)
#define PG8_STAGE(bufoff, gbase, voff) do { _Pragma("unroll") for (int _i = 0; _i < 2; ++_i) \
        __builtin_amdgcn_global_load_lds((const unsigned*)((const char*)(gbase) + (voff)[_i]), (PG8_LAS unsigned*)(lds + (bufoff) + ldsw + _i * 8192), 16, 0, 0); } while (0)
#define PG8_LDA(dst, b, h) do { _Pragma("unroll") for (int m = 0; m < 4; ++m) _Pragma("unroll") for (int k = 0; k < 2; ++k) dst[m][k] = *(const PG8_LAS bf16x8*)(lds + PG8_SA(b, h) + aoff + m * 2048 + k * 1024); } while (0)
#define PG8_LDB(dst, b, h) do { _Pragma("unroll") for (int n = 0; n < 2; ++n) _Pragma("unroll") for (int k = 0; k < 2; ++k) dst[n][k] = *(const PG8_LAS bf16x8*)(lds + PG8_SB(b, h) + boff + n * 2048 + k * 1024); } while (0)
#define PG8_MMA(ai, bj, At, Bt) do { __builtin_amdgcn_s_setprio(1); _Pragma("unroll") for (int m = 0; m < 4; ++m) _Pragma("unroll") for (int n = 0; n < 2; ++n) _Pragma("unroll") for (int k = 0; k < 2; ++k) \
        acc[ai][bj][m][n] = __builtin_amdgcn_mfma_f32_16x16x32_bf16(Bt[n][k], At[m][k], acc[ai][bj][m][n], 0, 0, 0); __builtin_amdgcn_s_setprio(0); } while (0)
#define PG8_WAIT_V(n) asm volatile("s_waitcnt vmcnt(" #n ")" ::: "memory")
#define PG8_WAIT_L(n) asm volatile("s_waitcnt lgkmcnt(" #n ")" ::: "memory")
#define PG8_BAR __builtin_amdgcn_s_barrier()
#define PG8_SCHED __builtin_amdgcn_sched_barrier(0)
    Unit cur, nxt; int ui = 0;
    if (!S.next(0, cur)) return;
    f32x4 acc[2][2][4][2];
#pragma unroll
    for (int a = 0; a < 2; ++a)
#pragma unroll
        for (int b = 0; b < 2; ++b)
#pragma unroll
            for (int m = 0; m < 4; ++m)
#pragma unroll
                for (int n = 0; n < 2; ++n) acc[a][b][m][n] = (f32x4){0.f, 0.f, 0.f, 0.f};
    bf16x8 At[4][2], B0[2][2], B1[2][2];
#define PG8_APTR(u) ((const char*)g.A + (size_t)(u).pm * tstep + (size_t)((u).pn / nNr) * K * 2)
#define PG8_BPTR(u) ((const char*)g.Bt + (size_t)((u).pn % nNr) * tstep + (size_t)((u).pn / nNr) * K * 2)
    const char* cA = PG8_APTR(cur); const char* cB = PG8_BPTR(cur);
    S.a_ready(cur);
    if constexpr (SP2) {
        PG8_STAGE(PG8_SB(0, 0), cB, voffB); PG8_STAGE(PG8_SB(0, 1), cB + hstep, voffB); PG8_STAGE(PG8_SA(0, 0), cA, voffA); PG8_STAGE(PG8_SA(0, 1), cA + hstep, voffA);
        if (wr == 1) PG8_BAR;
        PG8_WAIT_V(2); PG8_BAR;
        PG8_STAGE(PG8_SB(1, 0), cB + kstep, voffB); PG8_STAGE(PG8_SA(1, 0), cA + kstep, voffA); PG8_STAGE(PG8_SB(1, 1), cB + hstep + kstep, voffB);
        PG8_WAIT_V(6); PG8_BAR;
    } else {
        PG8_STAGE(PG8_SB(0, 0), cB, voffB); PG8_STAGE(PG8_SA(0, 0), cA, voffA); PG8_STAGE(PG8_SB(0, 1), cB + hstep, voffB); PG8_STAGE(PG8_SA(0, 1), cA + hstep, voffA);
        if (wr == 1) PG8_BAR;
        PG8_WAIT_V(4); PG8_BAR;
        PG8_STAGE(PG8_SB(1, 0), cB + kstep, voffB); PG8_STAGE(PG8_SA(1, 0), cA + kstep, voffA); PG8_STAGE(PG8_SB(1, 1), cB + hstep + kstep, voffB);
        PG8_WAIT_V(6); PG8_BAR;
    }
    for (;;) {
        const bool has_next = S.next(ui + 1, nxt);
        const char* nA = has_next ? PG8_APTR(nxt) : cA; const char* nB = has_next ? PG8_BPTR(nxt) : cB;
        for (int t = 0; t < nt; t += 2) {
            const bool last = (t == nt - 2);
            const char* a1 = cA + (size_t)(t + 1) * kstep;
            const char* a2 = last ? nA : cA + (size_t)(t + 2) * kstep; const char* b2 = last ? nB : cB + (size_t)(t + 2) * kstep;
            const char* a3 = a2 + kstep; const char* b3 = b2 + kstep;
            if (last && has_next) S.a_ready(nxt);
            if constexpr (SP2) {
            PG8_LDB(B0, 0, 0); PG8_LDB(B1, 0, 1); PG8_SCHED; PG8_LDA(At, 0, 0); PG8_STAGE(PG8_SA(1, 1), a1 + hstep, voffA);
            PG8_WAIT_V(8); PG8_WAIT_L(0); PG8_BAR; PG8_MMA(0, 0, At, B0); PG8_MMA(0, 1, At, B1); PG8_BAR; PG8_SCHED;
            PG8_LDA(At, 0, 1); PG8_STAGE(PG8_SB(0, 0), b2, voffB); PG8_STAGE(PG8_SB(0, 1), b2 + hstep, voffB); PG8_STAGE(PG8_SA(0, 0), a2, voffA);
            PG8_WAIT_V(8); PG8_WAIT_L(0); PG8_BAR; PG8_MMA(1, 0, At, B0); PG8_MMA(1, 1, At, B1); PG8_BAR; PG8_SCHED;
            PG8_LDB(B0, 1, 0); PG8_LDB(B1, 1, 1); PG8_SCHED; PG8_LDA(At, 1, 0); PG8_STAGE(PG8_SA(0, 1), a2 + hstep, voffA);
            PG8_WAIT_V(8); PG8_WAIT_L(0); PG8_BAR; PG8_MMA(0, 0, At, B0); PG8_MMA(0, 1, At, B1); PG8_BAR; PG8_SCHED;
            PG8_LDA(At, 1, 1); PG8_STAGE(PG8_SB(1, 0), b3, voffB); PG8_STAGE(PG8_SB(1, 1), b3 + hstep, voffB); PG8_STAGE(PG8_SA(1, 0), a3, voffA);
            PG8_WAIT_V(8); PG8_WAIT_L(0); PG8_BAR; PG8_MMA(1, 0, At, B0); PG8_MMA(1, 1, At, B1); PG8_BAR; PG8_SCHED;
            } else {
            PG8_LDB(B0, 0, 0); PG8_SCHED; PG8_LDA(At, 0, 0); PG8_STAGE(PG8_SA(1, 1), a1 + hstep, voffA);
            PG8_WAIT_L(8); PG8_BAR; PG8_WAIT_L(0); PG8_MMA(0, 0, At, B0); PG8_BAR; PG8_SCHED;
            PG8_LDB(B1, 0, 1); PG8_STAGE(PG8_SB(0, 0), b2, voffB);
            PG8_BAR; PG8_WAIT_L(0); PG8_MMA(0, 1, At, B1); PG8_BAR;
            PG8_LDA(At, 0, 1); PG8_STAGE(PG8_SA(0, 0), a2, voffA);
            PG8_BAR; PG8_WAIT_L(0); PG8_MMA(1, 0, At, B0); PG8_BAR; PG8_SCHED;
            PG8_STAGE(PG8_SB(0, 1), b2 + hstep, voffB);
            PG8_WAIT_V(6); PG8_BAR; PG8_MMA(1, 1, At, B1); PG8_BAR;
            PG8_LDB(B0, 1, 0); PG8_SCHED; PG8_LDA(At, 1, 0); PG8_STAGE(PG8_SA(0, 1), a2 + hstep, voffA);
            PG8_WAIT_L(8); PG8_BAR; PG8_WAIT_L(0); PG8_MMA(0, 0, At, B0); PG8_BAR; PG8_SCHED;
            PG8_LDB(B1, 1, 1); PG8_STAGE(PG8_SB(1, 0), b3, voffB);
            PG8_BAR; PG8_WAIT_L(0); PG8_MMA(0, 1, At, B1); PG8_BAR;
            PG8_LDA(At, 1, 1); PG8_STAGE(PG8_SA(1, 0), a3, voffA);
            PG8_BAR; PG8_WAIT_L(0); PG8_MMA(1, 0, At, B0); PG8_BAR; PG8_SCHED;
            PG8_STAGE(PG8_SB(1, 1), b3 + hstep, voffB);
            PG8_WAIT_V(6); PG8_BAR; PG8_MMA(1, 1, At, B1); PG8_BAR;
            }
        }
        if constexpr (ALIGN_EPI) { if (wr == 0) PG8_BAR; }
        if constexpr (!Epi::AFTER_DRAIN) { E(acc, cur, wr, wc, fr, fq); S.done(cur); }
        if (!has_next) break;
#pragma unroll
        for (int a = 0; a < 2; ++a)
#pragma unroll
            for (int b = 0; b < 2; ++b)
#pragma unroll
                for (int m = 0; m < 4; ++m)
#pragma unroll
                    for (int n = 0; n < 2; ++n) acc[a][b][m][n] = (f32x4){0.f, 0.f, 0.f, 0.f};
        cur = nxt; cA = nA; cB = nB; ++ui;
        if constexpr (ALIGN_EPI) { if (wr == 1) PG8_BAR; }
    }
    PG8_WAIT_V(0);
    if constexpr (!ALIGN_EPI) { if (wr == 0) PG8_BAR; }
    PG8_BAR;
    if constexpr (Epi::AFTER_DRAIN) { E.fused(acc, cur, wr, wc, fr, fq, lds, wid, lane); S.done(cur); }
#undef PG8_APTR
#undef PG8_BPTR
#undef PG8_SA
#undef PG8_SB
#undef PG8_STAGE
#undef PG8_LDA
#undef PG8_LDB
#undef PG8_MMA
#undef PG8_WAIT_V
#undef PG8_WAIT_L
#undef PG8_BAR
#undef PG8_SCHED
}
}

constexpr int DM = 2048, NTOK = 6144, NCTX = 4096, DEPTH = 4;
constexpr int CW = 1024, SW = 1024, INC = 4096, DFF = 5632, UPN = 2 * DFF;
constexpr float EPS = 1e-6f;
constexpr int NWAVES = 8;

constexpr size_t MiB = 1u << 20;
constexpr size_t WS_CTL = 0, CTL_ZERO_BYTES = 1 * MiB;
constexpr size_t WS_MOD = 1 * MiB;
constexpr size_t WS_WIN = 2 * MiB, WS_WGLU = 66 * MiB, WS_WOUT = 74 * MiB, WS_WUP = 106 * MiB, WS_WDN = 282 * MiB;
constexpr size_t WS_H = 370 * MiB;
constexpr size_t WS_GB = 394 * MiB, WS_V = 406 * MiB, WS_U = 418 * MiB;
constexpr size_t WS_Z = 430 * MiB, WS_O = 442 * MiB;
constexpr size_t WS_MIXIN = 454 * MiB, WS_MIXED = 478 * MiB;
constexpr size_t WS_UP = 502 * MiB;
constexpr size_t WS_ACT = 634 * MiB;
constexpr size_t WS_FF = 700 * MiB;
constexpr size_t WS_END = 724 * MiB;
constexpr int CW_SUB = 12288;
constexpr size_t WS_FFP = WS_UP;
constexpr int CW_BAR = 4096;

constexpr int RING_BYTES = 131072;
constexpr int LDS_BYTES = 147456;
constexpr int LDSCTL_OFF = LDS_BYTES - 512, MISC_OFF = LDSCTL_OFF;

#define GAS __attribute__((address_space(1)))
#define LAS __attribute__((address_space(3)))
typedef unsigned short bf16;
typedef unsigned v4u __attribute__((ext_vector_type(4)));
typedef unsigned v2u __attribute__((ext_vector_type(2)));
typedef float f32x4 __attribute__((ext_vector_type(4)));
typedef float f32x2 __attribute__((ext_vector_type(2)));
typedef float f32x16 __attribute__((ext_vector_type(16)));
typedef short bf16x8 __attribute__((ext_vector_type(8)));
typedef GAS unsigned gu32;
#define LDS_WAIT() asm volatile("s_waitcnt lgkmcnt(0)" ::: "memory")

__device__ __forceinline__ unsigned f2bf(float f) { unsigned u = __builtin_bit_cast(unsigned, f); return (u + 0x7fffu + ((u >> 16) & 1u)) >> 16; }
__device__ __forceinline__ unsigned pk2(float lo, float hi) { unsigned r; asm("v_cvt_pk_bf16_f32 %0, %1, %2" : "=v"(r) : "v"(lo), "v"(hi)); return r; }
__device__ __forceinline__ float bflo(unsigned w) { return __uint_as_float(w << 16); }
__device__ __forceinline__ float bfhi(unsigned w) { return __uint_as_float(w & 0xffff0000u); }
__device__ __forceinline__ void unpack8(const v4u w, float (&f)[8]) { f[0] = bflo(w.x); f[1] = bfhi(w.x); f[2] = bflo(w.y); f[3] = bfhi(w.y); f[4] = bflo(w.z); f[5] = bfhi(w.z); f[6] = bflo(w.w); f[7] = bfhi(w.w); }
__device__ __forceinline__ v4u pack8(const float (&f)[8]) { v4u w; w.x = pk2(f[0], f[1]); w.y = pk2(f[2], f[3]); w.z = pk2(f[4], f[5]); w.w = pk2(f[6], f[7]); return w; }
__device__ __forceinline__ float wave_sum(float v) {
#pragma unroll
    for (int o = 1; o < 64; o <<= 1) v += __shfl_xor(v, o);
    return v;
}
__device__ __forceinline__ float sigmoidf_(float x) { return 1.0f / (1.0f + __expf(-x)); }
__device__ __forceinline__ float gelu_tanh(float y) { const float v = 0.7978845608028654f * (y + 0.044715f * y * y * y); const float t = 1.0f - 2.0f / (__expf(2.0f * v) + 1.0f); return 0.5f * y * (1.0f + t); }
__device__ __forceinline__ void sincos_cw(float x, float& s, float& c) {
    const float k = rintf(x * 0.6366197723675814f);
    float r = fmaf(k, -1.5707963705062866f, x);
    r = fmaf(k, 4.371138828673793e-08f, r);
    r = fmaf(k, 1.7763568394002505e-15f, r);
    const float r2 = r * r;
    const float sp = r + r * r2 * fmaf(r2, fmaf(r2, -1.9515295891e-4f, 8.3321608736e-3f), -1.6666654611e-1f);
    const float cp = fmaf(r2 * r2, fmaf(r2, fmaf(r2, 2.443315711809948e-5f, -1.388731625493765e-3f), 4.166664568298827e-2f), fmaf(r2, -0.5f, 1.0f));
    const int q = ((int)k) & 3;
    const float ss = (q & 1) ? cp : sp, cc = (q & 1) ? sp : cp;
    s = (q & 2) ? -ss : ss;
    c = ((q + 1) & 2) ? -cc : cc;
}

__device__ __forceinline__ int fresh_v(int x) { asm volatile("" : "+v"(x)); return x; }
__device__ __forceinline__ int fresh_s(int x) { asm volatile("" : "+s"(x)); return x; }
struct Args { const float* in[30]; float* out; unsigned char* ws; };
struct KImg { unsigned long long in[30]; unsigned long long out; unsigned long long ws; };
struct DArgs { const float* in[30]; float* out; unsigned char* ws; };
__device__ __forceinline__ DArgs load_args() {
    const __attribute__((address_space(4))) KImg* p = (const __attribute__((address_space(4))) KImg*)__builtin_amdgcn_kernarg_segment_ptr();
    asm volatile("" : "+s"(p));
    DArgs a;
#pragma unroll
    for (int i = 0; i < 30; ++i) a.in[i] = (const float*)(GAS const float*)p->in[i];
    a.out = (float*)(GAS float*)p->out; a.ws = (unsigned char*)(GAS unsigned char*)p->ws;
    return a;
}
enum { I_XP = 0, I_XS, I_SRE, I_SIM, I_C, I_CCTX, I_WADA, I_BADA, I_GPRE1, I_WIN, I_CONVW, I_ARE, I_AIM, I_LOGDT, I_BRE, I_BIM, I_CRE, I_CIM, I_SSMD, I_WGLU, I_BGLU,
       I_GCONV, I_GSSM, I_WOUT, I_GPOST1, I_GPRE2, I_WUP, I_FFNW, I_WDOWN, I_GPOST2 };

namespace pg8 {
struct EpiIn {
    static constexpr bool PERM = true, AFTER_DRAIN = false;
    bf16_t *GB, *V, *U;
    __device__ __forceinline__ void operator()(const f32x4 (&acc)[2][2][4][2], const Unit& u, int wr, int wc, int fr, int fq) const {
        const int row0 = u.pm * BM + wr * 64 + fr;
        if (u.pn < 8) {
            const int col0 = u.pn * 128 + wc * 32 + 8 * fq;
#pragma unroll
            for (int ai = 0; ai < 2; ++ai)
#pragma unroll
                for (int m = 0; m < 4; ++m) { bf16_t* rowp = V + (size_t)(row0 + ai * HALF + m * 16) * 1024 + col0;
                    const f32x4 v0 = acc[ai][0][m][0] * acc[ai][1][m][0], v1 = acc[ai][0][m][1] * acc[ai][1][m][1];
                    u32x4 w; w.x = cvt_pk_bf16(v0[0], v0[1]); w.y = cvt_pk_bf16(v0[2], v0[3]); w.z = cvt_pk_bf16(v1[0], v1[1]); w.w = cvt_pk_bf16(v1[2], v1[3]);
                    *(u32x4*)rowp = w; }
        } else {
            const int col0 = (u.pn - 8) * 128 + wc * 32 + 8 * fq;
#pragma unroll
            for (int ai = 0; ai < 2; ++ai)
#pragma unroll
                for (int m = 0; m < 4; ++m) { const size_t off = (size_t)(row0 + ai * HALF + m * 16) * 1024 + col0;
#pragma unroll
                    for (int bj = 0; bj < 2; ++bj) { const f32x4 v0 = acc[ai][bj][m][0], v1 = acc[ai][bj][m][1];
                        u32x4 w; w.x = cvt_pk_bf16(v0[0], v0[1]); w.y = cvt_pk_bf16(v0[2], v0[3]); w.z = cvt_pk_bf16(v1[0], v1[1]); w.w = cvt_pk_bf16(v1[2], v1[3]);
                        *(u32x4*)((bj ? U : GB) + off) = w; } }
        }
    }
};
struct EpiGlu {
    static constexpr bool PERM = true, AFTER_DRAIN = false;
    const bf16_t* Z; bf16_t* O; const float* bias;
    __device__ __forceinline__ void operator()(const f32x4 (&acc)[2][2][4][2], const Unit& u, int wr, int wc, int fr, int fq) const {
        const int row0 = u.pm * BM + wr * 64 + fr, col0 = u.pn * BM + wc * 32 + 8 * fq;
        f32x4 bv[2][2];
#pragma unroll
        for (int bj = 0; bj < 2; ++bj)
#pragma unroll
            for (int n = 0; n < 2; ++n) bv[bj][n] = *(const f32x4*)(bias + col0 + bj * HALF + 4 * n);
#pragma unroll
        for (int ai = 0; ai < 2; ++ai)
#pragma unroll
            for (int m = 0; m < 4; ++m) { const size_t off = (size_t)(row0 + ai * HALF + m * 16) * 1024 + col0;
#pragma unroll
                for (int bj = 0; bj < 2; ++bj) { const u32x4 zw = *(const u32x4*)(Z + off + bj * HALF);
                    const f32x4 g0 = acc[ai][bj][m][0] + bv[bj][0], g1 = acc[ai][bj][m][1] + bv[bj][1];
                    float z[8]; z[0] = __uint_as_float(zw.x << 16); z[1] = __uint_as_float(zw.x & 0xffff0000u); z[2] = __uint_as_float(zw.y << 16); z[3] = __uint_as_float(zw.y & 0xffff0000u);
                    z[4] = __uint_as_float(zw.z << 16); z[5] = __uint_as_float(zw.z & 0xffff0000u); z[6] = __uint_as_float(zw.w << 16); z[7] = __uint_as_float(zw.w & 0xffff0000u);
                    float o[8];
#pragma unroll
                    for (int j = 0; j < 4; ++j) { o[j] = z[j] / (1.0f + __expf(-g0[j])); o[4 + j] = z[4 + j] / (1.0f + __expf(-g1[j])); }
                    u32x4 w; w.x = cvt_pk_bf16(o[0], o[1]); w.y = cvt_pk_bf16(o[2], o[3]); w.z = cvt_pk_bf16(o[4], o[5]); w.w = cvt_pk_bf16(o[6], o[7]);
                    *(u32x4*)(O + off + bj * HALF) = w; } }
    }
};
typedef unsigned u32x2 __attribute__((ext_vector_type(2)));
struct EpiFfn {
    static constexpr bool PERM = true, AFTER_DRAIN = false;
    bf16_t* ACT; const float* fw; PG8_LAS float* xch;
    static __device__ __forceinline__ float ror8(float v) { return __builtin_bit_cast(float, __builtin_amdgcn_mov_dpp(__builtin_bit_cast(int, v), 0x128  , 0xf, 0xf, true)); }
    static __device__ __forceinline__ f32x4 shx8(const f32x4 v) { f32x4 r; r[0] = ror8(v[0]); r[1] = ror8(v[1]); r[2] = ror8(v[2]); r[3] = ror8(v[3]); return r; }
    static __device__ __forceinline__ f32x4 shl(const f32x4 v, int src) { f32x4 r; r[0] = __shfl(v[0], src); r[1] = __shfl(v[1], src); r[2] = __shfl(v[2], src); r[3] = __shfl(v[3], src); return r; }
    static __device__ __forceinline__ f32x4 sel(bool c, const f32x4 a, const f32x4 b) { f32x4 r; r[0] = c ? a[0] : b[0]; r[1] = c ? a[1] : b[1]; r[2] = c ? a[2] : b[2]; r[3] = c ? a[3] : b[3]; return r; }
    __device__ __forceinline__ void operator()(const f32x4 (&acc)[2][2][4][2], const Unit& u, int wr, int wc, int fr, int fq) const {
        const bool ctx = u.pm < 16, h = (fr >> 3) != 0;
        const int c7 = fr & 7, lane = fq * 16 + fr, ch0 = u.pn * 128 + wc * 32 + 8 * fq;
        const f32x4 zero = {0.f, 0.f, 0.f, 0.f};
        f32x4 wa[2][3], wg[2][3];
#pragma unroll
        for (int k = 0; k < 3; ++k) { wa[0][k] = *(const f32x4*)(fw + k * (2 * 5632) + ch0); wg[0][k] = *(const f32x4*)(fw + k * (2 * 5632) + 5632 + ch0); }
        if (ctx) {
            if (wr == 0 && fr == 15) { PG8_LAS f32x4* p = (PG8_LAS f32x4*)(xch + ((wc * 2 + 0) * 4 + fq) * 16); p[0] = acc[1][0][3][0]; p[1] = acc[1][0][3][1]; p[2] = acc[1][1][3][0]; p[3] = acc[1][1][3][1]; }
            if (wr == 1 && fr == 0)  { PG8_LAS f32x4* p = (PG8_LAS f32x4*)(xch + ((wc * 2 + 1) * 4 + fq) * 16); p[0] = acc[0][0][0][0]; p[1] = acc[0][0][0][1]; p[2] = acc[0][1][0][0]; p[3] = acc[0][1][0][1]; }
            asm volatile("s_waitcnt lgkmcnt(0)" ::: "memory"); __builtin_amdgcn_s_barrier(); asm volatile("" ::: "memory");
        }
        const int srcp = (lane + 7) & 63, srcn = (lane - 7) & 63;
        u32x2 keep[8];
#pragma unroll
        for (int n = 0; n < 2; ++n) {
            f32x4 bpa = shl(acc[1][0][3][n], srcp), bpg = shl(acc[1][1][3][n], srcp), bna = shl(acc[0][0][0][n], srcn), bng = shl(acc[0][1][0][n], srcn);
            if (ctx) {
                const PG8_LAS f32x4* p0 = (const PG8_LAS f32x4*)(xch + ((wc * 2 + 0) * 4 + fq) * 16); const PG8_LAS f32x4* p1 = (const PG8_LAS f32x4*)(xch + ((wc * 2 + 1) * 4 + fq) * 16);
                const f32x4 xpa = p0[n], xpg = p0[2 + n], xna = p1[n], xng = p1[2 + n];
                bpa = sel(c7 >= 1, bpa, sel(wr == 1, xpa, zero)); bpg = sel(c7 >= 1, bpg, sel(wr == 1, xpg, zero));
                bna = sel(c7 <= 6, bna, sel(wr == 0, xna, zero)); bng = sel(c7 <= 6, bng, sel(wr == 0, xng, zero));
            } else { bpa = zero; bpg = zero; bna = zero; bng = zero; }
            if (n == 0) {
#pragma unroll
                for (int k = 0; k < 3; ++k) { wa[1][k] = *(const f32x4*)(fw + k * (2 * 5632) + ch0 + 4); wg[1][k] = *(const f32x4*)(fw + k * (2 * 5632) + 5632 + ch0 + 4); }
            }
            f32x4 ea0 = shx8(acc[0][0][0][n]), eg0 = shx8(acc[0][1][0][n]);
            f32x4 pa = sel(h, ea0, bpa), pg = sel(h, eg0, bpg);
#pragma unroll
            for (int s = 0; s < 8; ++s) { const int ai = s >> 2, m = s & 3;
                const f32x4 eap = s < 7 ? shx8(acc[(s + 1) >> 2][0][(s + 1) & 3][n]) : bna, egp = s < 7 ? shx8(acc[(s + 1) >> 2][1][(s + 1) & 3][n]) : bng;
                const f32x4 xa = acc[ai][0][m][n], xg = acc[ai][1][m][n];
                const f32x4 na = sel(h, eap, ea0), ng = sel(h, egp, eg0);
                const f32x4 ca = wa[n][0] * pa + wa[n][1] * xa + wa[n][2] * na, cg = wg[n][0] * pg + wg[n][1] * xg + wg[n][2] * ng;
                const f32x4 t = cg * ca, ex = cg * (-1.442695041f);
                f32x4 den; den[0] = __builtin_amdgcn_exp2f(ex[0]); den[1] = __builtin_amdgcn_exp2f(ex[1]); den[2] = __builtin_amdgcn_exp2f(ex[2]); den[3] = __builtin_amdgcn_exp2f(ex[3]);
                den = den + 1.0f;
                f32x4 rc; rc[0] = __builtin_amdgcn_rcpf(den[0]); rc[1] = __builtin_amdgcn_rcpf(den[1]); rc[2] = __builtin_amdgcn_rcpf(den[2]); rc[3] = __builtin_amdgcn_rcpf(den[3]);
                const f32x4 o = t * rc;
                u32x2 w; w.x = cvt_pk_bf16(o[0], o[1]); w.y = cvt_pk_bf16(o[2], o[3]);
                if (n == 0) keep[s] = w;
                else { u32x4 w4; w4.x = keep[s].x; w4.y = keep[s].y; w4.z = w.x; w4.w = w.y; *(u32x4*)(ACT + (size_t)(u.pm * BM + ai * HALF + wr * 64 + m * 16 + fr) * 5632 + ch0) = w4; }
                pa = na; pg = ng; ea0 = eap; eg0 = egp;
            }
        }
    }
};
struct G4Order {
    int lo, hi, G, c; bool plain;
    __device__ __forceinline__ bool next(int i, Unit& u) const {
        const int L = lo + i * G + c; if (L >= hi) return false;
        StaticOrder so; so.init(24 * BM, 44 * BM, 1, 0);
        if (plain) return so.next(L, u);
        if (L >= 1024) { u.pm = 23; u.pn = 12 + (L - 1024); return true; }
        so.next(L, u); if (u.pm == 23 && u.pn >= 12) so.next(1024 + u.pn - 12, u);
        return true;
    }
    __device__ __forceinline__ void a_ready(const Unit&) const {}
    __device__ __forceinline__ void done(const Unit&) const {}
};
struct G5Order {
    bool st; StaticOrder so; Unit u0;
    __device__ __forceinline__ bool next(int i, Unit& u) const { if (st) return so.next(i, u); if (i != 0 || u0.pm < 0) return false; u = u0; return true; }
    __device__ __forceinline__ void a_ready(const Unit&) const {}
    __device__ __forceinline__ void done(const Unit&) const {}
};
}

__device__ __forceinline__ void cvt_load(const float* __restrict__ W, int N, int k0, int n0, int tid, f32x4 (&r0)[4], f32x4 (&r1)[4]) {
    const int n4 = tid & 31, kp = tid >> 5;
#pragma unroll
    for (int i = 0; i < 4; ++i) { const float* p = W + (size_t)(k0 + 2 * kp + 32 * i) * N + n0 + 4 * n4; r0[i] = *(const f32x4*)p; r1[i] = *(const f32x4*)(p + N); }
}
__device__ __forceinline__ void cvt_put(LAS unsigned* T, int tid, const f32x4 (&r0)[4], const f32x4 (&r1)[4]) {
    const int n4 = tid & 31, kp = tid >> 5;
#pragma unroll
    for (int i = 0; i < 4; ++i)
#pragma unroll
        for (int e = 0; e < 4; ++e) T[(4 * n4 + e) * 65 + kp + 16 * i] = pk2(r0[i][e], r1[i][e]);
}
__device__ __forceinline__ void cvt_store(const LAS unsigned* T, bf16* __restrict__ Bt, int K, int k0, int j0, int tid) {
    const int n = tid >> 2, kc = tid & 3;
    unsigned w[16];
#pragma unroll
    for (int i = 0; i < 16; ++i) w[i] = T[n * 65 + 16 * kc + i];
    v4u* dst = (v4u*)(Bt + (size_t)(j0 + n) * K + k0 + 32 * kc);
#pragma unroll
    for (int q = 0; q < 4; ++q) { v4u o; o.x = w[4 * q]; o.y = w[4 * q + 1]; o.z = w[4 * q + 2]; o.w = w[4 * q + 3]; dst[q] = o; }
}
constexpr int CVT_PER_LAYER = 512 + 64 + 256 + 1408 + 704;
struct CvtD { const float* W; bf16* Bt; int N, K, k0, n0, j0; };
__device__ __forceinline__ CvtD cvt_desc(const DArgs& a, int it) {
    const int l = it / CVT_PER_LAYER; int r = it % CVT_PER_LAYER;
    const float* W; bf16* Bt; int N, K, jb, kb, n0;
    if (r < 512) { N = INC; K = DM; W = a.in[I_WIN] + (size_t)l * K * N; Bt = (bf16*)(a.ws + WS_WIN) + (size_t)l * N * K; kb = r >> 5; jb = r & 31;
        const int pn = jb >> 1, bj = jb & 1; n0 = pn < 8 ? ((bj ? 2048 : 1024) + 128 * pn) : ((bj ? 3072 : 0) + 128 * (pn - 8)); }
    else if (r < 576) { r -= 512; N = SW; K = SW; W = a.in[I_WGLU] + (size_t)l * K * N; Bt = (bf16*)(a.ws + WS_WGLU) + (size_t)l * N * K; kb = r >> 3; jb = r & 7; n0 = 128 * jb; }
    else if (r < 832) { r -= 576; N = DM; K = DM; W = a.in[I_WOUT] + (size_t)l * K * N; Bt = (bf16*)(a.ws + WS_WOUT) + (size_t)l * N * K; kb = r >> 4; jb = r & 15; n0 = 128 * jb; }
    else if (r < 2240) { r -= 832; N = UPN; K = DM; W = a.in[I_WUP] + (size_t)l * K * N; Bt = (bf16*)(a.ws + WS_WUP) + (size_t)l * N * K; kb = r / 88; jb = r % 88; n0 = ((jb & 1) ? DFF : 0) + 128 * (jb >> 1); }
    else { r -= 2240; N = DM; K = DFF; W = a.in[I_WDOWN] + (size_t)l * K * N; Bt = (bf16*)(a.ws + WS_WDN) + (size_t)l * N * K; kb = r >> 4; jb = r & 15; n0 = 128 * jb; }
    CvtD d; d.W = W; d.Bt = Bt; d.N = N; d.K = K; d.k0 = 128 * kb; d.n0 = n0; d.j0 = 128 * jb; return d;
}

constexpr int CW_CVT = 8192;
#define CVT_LDS_BAR() asm volatile("s_waitcnt lgkmcnt(0)\n\ts_barrier" ::: "memory")
__device__ __forceinline__ void cvt_fill(LAS unsigned char* lds, int tid_, int ln, int budget  ) {
    const int tid = fresh_v(tid_);
    volatile LAS unsigned* tk = (volatile LAS unsigned*)(lds + MISC_OFF) + 16;
    LAS unsigned* T0 = (LAS unsigned*)lds; LAS unsigned* T1 = T0 + 128 * 65;
    const int npairs = budget < 0 ? 0x7fffffff : (budget + 1) / 2;
    if (npairs <= 0) return;
    if (tid == 0) { const DArgs a = load_args(); tk[0] = __hip_atomic_fetch_add((unsigned*)(a.ws + WS_CTL) + CW_CVT + 64 * ln, 1u, __ATOMIC_RELAXED, __HIP_MEMORY_SCOPE_AGENT); }
    __syncthreads();
    for (int n = 0; n < npairs; ++n) {
        const unsigned t = tk[n & 1];
        if (2u * t >= (unsigned)CVT_PER_LAYER) break;
        const DArgs a = load_args();
        unsigned nx = 0xffffffffu;
        if (tid == 0 && n + 1 < npairs) nx = __hip_atomic_fetch_add((unsigned*)(a.ws + WS_CTL) + CW_CVT + 64 * ln, 1u, __ATOMIC_RELAXED, __HIP_MEMORY_SCOPE_AGENT);
        const CvtD d0 = cvt_desc(a, ln * CVT_PER_LAYER + 2 * (int)t), d1 = cvt_desc(a, ln * CVT_PER_LAYER + 2 * (int)t + 1);
        f32x4 a0[4], a1[4], b0[4], b1[4];
        cvt_load(d0.W, d0.N, d0.k0, d0.n0, tid, a0, a1); cvt_load(d1.W, d1.N, d1.k0, d1.n0, tid, b0, b1);
        cvt_put(T0, tid, a0, a1); cvt_put(T1, tid, b0, b1);
        if (tid == 0) tk[(n + 1) & 1] = nx;
        CVT_LDS_BAR();
        cvt_store(T0, d0.Bt, d0.K, d0.k0, d0.j0, tid); cvt_store(T1, d1.Bt, d1.K, d1.k0, d1.j0, tid);
        CVT_LDS_BAR();
    }
    __syncthreads();
}
__device__ __forceinline__ void mod_task(LAS unsigned char* lds, int tid_, int lane_, int wave_, int task) {
    const DArgs a = load_args(); const int tid = fresh_v(tid_), lane = fresh_v(lane_), wave = fresh_s(wave_);
    LAS float* SC = (LAS float*)(lds + 36864);
    LAS float* RED = (LAS float*)(lds + 36864 + 24576);
    const int l = task / 48, j0 = (task % 48) * 256;
    for (int i = tid; i < 3 * DM; i += 512) { const int v = i >> 11, k = i & 2047; const float x = v == 0 ? a.in[I_CCTX][k] : a.in[I_C][(v - 1) * DM + k]; SC[i] = x / (1.0f + __expf(-x)); }
    __syncthreads();
    const float* W = a.in[I_WADA] + (size_t)l * DM * 12288 + j0 + 4 * lane;
    f32x4 a0 = {0.f, 0.f, 0.f, 0.f}, a1 = a0, a2 = a0;
    const int kbeg = wave * 256;
    for (int k = kbeg; k < kbeg + 256; k += 8) {
        f32x4 w[8];
#pragma unroll
        for (int u = 0; u < 8; ++u) w[u] = *(const f32x4*)(W + (size_t)(k + u) * 12288);
#pragma unroll
        for (int u = 0; u < 8; ++u) { const float s0 = SC[k + u], s1 = SC[2048 + k + u], s2 = SC[4096 + k + u]; a0 += w[u] * s0; a1 += w[u] * s1; a2 += w[u] * s2; }
    }
    *(LAS f32x4*)(RED + (wave * 3 + 0) * 256 + 4 * lane) = a0;
    *(LAS f32x4*)(RED + (wave * 3 + 1) * 256 + 4 * lane) = a1;
    *(LAS f32x4*)(RED + (wave * 3 + 2) * 256 + 4 * lane) = a2;
    __syncthreads();
    float* MOD = (float*)(a.ws + WS_MOD);
    for (int i = tid; i < 768; i += 512) { const int v = i >> 8, jj = i & 255; float s = a.in[I_BADA][l * 12288 + j0 + jj];
#pragma unroll
        for (int w8 = 0; w8 < 8; ++w8) s += RED[(w8 * 3 + v) * 256 + jj];
        const int ch = (j0 + jj) >> 11, e = (j0 + jj) & 2047;
        if (ch == 1) s = (1.0f + s) * a.in[I_GPRE1][l * DM + e]; else if (ch == 2) s *= a.in[I_GPOST1][l * DM + e];
        else if (ch == 4) s = (1.0f + s) * a.in[I_GPRE2][l * DM + e]; else if (ch == 5) s *= a.in[I_GPOST2][l * DM + e];
        MOD[(size_t)(l * 3 + v) * 12288 + j0 + jj] = s; }
    __syncthreads();
}

__device__ __forceinline__ int mod_vec(int row) { return row < NCTX ? 0 : 1 + ((row - NCTX) >> 10); }
__device__ __forceinline__ int perm_row(int row) {
    int gr, cc, base;
    if (row < NCTX) { const int t = row & 255; gr = t & 15; cc = t >> 4; base = row & ~255; }
    else { const int q = row - NCTX, p = q & 1023; gr = p >> 6; cc = p & 15; base = NCTX + ((q >> 10) * 4 + ((p >> 4) & 3)) * 256; }
    return base + 128 * (gr >> 3) + 64 * (cc >> 3) + 16 * ((gr >> 1) & 3) + 8 * (gr & 1) + (cc & 7);
}
constexpr size_t WS_XH = WS_UP + 8 * MiB, WS_XL = WS_UP + 40 * MiB;
__device__ __forceinline__ void x24_load(const unsigned char* ws, int row, int e0, float (&o)[8]) {
    const v4u h = *(const v4u*)((const unsigned short*)(ws + WS_XH) + (size_t)row * DM + e0); const v2u lo = *(const v2u*)(ws + WS_XL + (size_t)row * DM + e0);
    const unsigned hw[4] = {h.x, h.y, h.z, h.w}, lw[2] = {lo.x, lo.y};
#pragma unroll
    for (int i = 0; i < 8; ++i) { const unsigned hi = (i & 1) ? (hw[i >> 1] & 0xffff0000u) : (hw[i >> 1] << 16); const unsigned l8 = (lw[i >> 2] >> (8 * (i & 3))) & 0xffu; o[i] = __uint_as_float(hi | (l8 << 8)); }
}
__device__ __forceinline__ void x24_store(unsigned char* ws, int row, int e0, const float (&x)[8]) {
    unsigned b[8];
#pragma unroll
    for (int i = 0; i < 8; ++i) b[i] = __float_as_uint(x[i]) + 0x80u;
    v4u h; h.x = (b[0] >> 16) | (b[1] & 0xffff0000u); h.y = (b[2] >> 16) | (b[3] & 0xffff0000u); h.z = (b[4] >> 16) | (b[5] & 0xffff0000u); h.w = (b[6] >> 16) | (b[7] & 0xffff0000u);
    v2u lo; lo.x = ((b[0] >> 8) & 0xffu) | (b[1] & 0xff00u) | ((b[2] << 8) & 0xff0000u) | ((b[3] << 16) & 0xff000000u); lo.y = ((b[4] >> 8) & 0xffu) | (b[5] & 0xff00u) | ((b[6] << 8) & 0xff0000u) | ((b[7] << 16) & 0xff000000u);
    *(v4u*)((unsigned short*)(ws + WS_XH) + (size_t)row * DM + e0) = h; *(v2u*)(ws + WS_XL + (size_t)row * DM + e0) = lo;
}
template <int MODE>
__device__ __forceinline__ void row_pass(int l, int bx_, int G_, int wave_, int lane_, bool split23 = false) {
    const int bx = fresh_s(bx_), G = fresh_s(G_), wave = fresh_s(wave_), lane = fresh_v(lane_);
    constexpr bool FIRST = (MODE == 0), HAS_NEXT = (MODE != 3);
    const DArgs a = load_args();
    const float* MOD = (const float*)(a.ws + WS_MOD);
    const float* modl = MOD + (size_t)l * 3 * 12288;
    const bf16* Y = (const bf16*)(a.ws + (MODE == 1 ? WS_MIXED : WS_FF));
    const float* modg = modl + (MODE == 1 ? 2 : 5) * DM;
    const float* modn = MODE == 2 ? modl + 3 * 12288 : modl;
    const int sc_off = (MODE == 1 ? 4 : 1) * DM, sh_off = (MODE == 1 ? 3 : 0) * DM;
    bf16* Hdst = (bf16*)(a.ws + WS_H);
    const int rpw = (NTOK + G * NWAVES - 1) / (G * NWAVES), rbeg = (bx * NWAVES + wave) * rpw, rend = rbeg + rpw < NTOK ? rbeg + rpw : NTOK;
    int vprev = -1;
    f32x4 gv[8], cv[8], hv[8];
#pragma unroll
    for (int j = 0; j < 8; ++j) { gv[j] = (f32x4){0.f, 0.f, 0.f, 0.f}; cv[j] = gv[j]; hv[j] = gv[j]; }
    for (int row = rbeg; row < rend; ++row) {
        const int v = mod_vec(row);
        if (v != vprev) { vprev = v;
#pragma unroll
            for (int j = 0; j < 4; ++j) { const int e0 = 8 * lane + 512 * j;
                if (!FIRST) { const float* gate = modg + (size_t)v * 12288; gv[2 * j] = *(const f32x4*)(gate + e0); gv[2 * j + 1] = *(const f32x4*)(gate + e0 + 4); }
                if (HAS_NEXT) { const float* sc = modn + (size_t)v * 12288 + sc_off; const float* sh = modn + (size_t)v * 12288 + sh_off;
                    cv[2 * j] = *(const f32x4*)(sc + e0); cv[2 * j + 1] = *(const f32x4*)(sc + e0 + 4); hv[2 * j] = *(const f32x4*)(sh + e0); hv[2 * j + 1] = *(const f32x4*)(sh + e0 + 4); } } }
        float* xr = a.out + (size_t)row * DM;
        float x[32];
        if (FIRST) {
            const float* src = row < NCTX ? a.in[I_XP] + (size_t)row * DM : a.in[I_XS] + (size_t)(row - NCTX) * DM;
#pragma unroll
            for (int j = 0; j < 4; ++j) { const f32x4 p = *(const f32x4*)(src + 8 * lane + 512 * j), q = *(const f32x4*)(src + 8 * lane + 512 * j + 4);
                x[8 * j] = p[0]; x[8 * j + 1] = p[1]; x[8 * j + 2] = p[2]; x[8 * j + 3] = p[3]; x[8 * j + 4] = q[0]; x[8 * j + 5] = q[1]; x[8 * j + 6] = q[2]; x[8 * j + 7] = q[3];
                const float t8[8] = {p[0], p[1], p[2], p[3], q[0], q[1], q[2], q[3]}; x24_store(a.ws, row, 8 * lane + 512 * j, t8); }
        } else {
            float y[32]; float ssq = 0.f;
            const int pr = MODE == 1 ? row : perm_row(row);
            const bool sp23 = MODE != 1 && split23 && pr >= 23 * 256;
            const bf16* yr = sp23 ? (const bf16*)(a.ws + WS_FFP) + (size_t)(pr - 23 * 256) * DM : Y + (size_t)pr * DM;
#pragma unroll
            for (int j = 0; j < 4; ++j) { const v4u w = *(const v4u*)(yr + 8 * lane + 512 * j); float t[8]; unpack8(w, t);
                if (sp23) {
#pragma unroll
                    for (int sp = 1; sp < 4; ++sp) { float t2[8]; unpack8(*(const v4u*)(yr + (size_t)sp * 256 * DM + 8 * lane + 512 * j), t2);
#pragma unroll
                        for (int i = 0; i < 8; ++i) t[i] += t2[i]; } }
#pragma unroll
                for (int i = 0; i < 8; ++i) { y[8 * j + i] = t[i]; ssq += t[i] * t[i]; } }
            ssq = wave_sum(ssq);
            const float rs = 1.0f / sqrtf(ssq * (1.0f / DM) + EPS);
#pragma unroll
            for (int j = 0; j < 4; ++j) { const int e0 = 8 * lane + 512 * j;
                float xo[8]; x24_load(a.ws, row, e0, xo);
                const f32x4 g0 = gv[2 * j], g1 = gv[2 * j + 1];
                f32x4 np, nq;
#pragma unroll
                for (int i = 0; i < 4; ++i) { np[i] = xo[i] + g0[i] * (y[8 * j + i] * rs); nq[i] = xo[4 + i] + g1[i] * (y[8 * j + 4 + i] * rs); x[8 * j + i] = np[i]; x[8 * j + 4 + i] = nq[i]; }
                if (MODE == 3) { *(f32x4*)(xr + e0) = np; *(f32x4*)(xr + e0 + 4) = nq; }
                else { const float t8[8] = {np[0], np[1], np[2], np[3], nq[0], nq[1], nq[2], nq[3]}; x24_store(a.ws, row, e0, t8); } }
        }
        if (HAS_NEXT) {
            float ssq = 0.f;
#pragma unroll
            for (int i = 0; i < 32; ++i) ssq += x[i] * x[i];
            ssq = wave_sum(ssq);
            const float rs = 1.0f / sqrtf(ssq * (1.0f / DM) + EPS);
            bf16* hr = Hdst + (size_t)(MODE == 1 ? perm_row(row) : row) * DM;
#pragma unroll
            for (int j = 0; j < 4; ++j) { const int e0 = 8 * lane + 512 * j;
                const f32x4 c0 = cv[2 * j], c1 = cv[2 * j + 1], h0 = hv[2 * j], h1 = hv[2 * j + 1];
                float o[8];
#pragma unroll
                for (int i = 0; i < 4; ++i) { o[i] = x[8 * j + i] * rs * c0[i] + h0[i]; o[4 + i] = x[8 * j + 4 + i] * rs * c1[i] + h1[i]; }
                *(v4u*)(hr + e0) = pack8(o); }
        }
    }
}

__device__ __forceinline__ void mix_pass(int bx_, int G_, int wave_, int lane_, int l) {
    const DArgs a = load_args(); const int bx = fresh_s(bx_), G = fresh_s(G_), wave = fresh_s(wave_), lane = fresh_v(lane_);
    const bf16* GB = (const bf16*)(a.ws + WS_GB); const bf16* V = (const bf16*)(a.ws + WS_V); const bf16* O = (const bf16*)(a.ws + WS_O); bf16* MX = (bf16*)(a.ws + WS_MIXIN);
    const float* cw = a.in[I_CONVW] + (size_t)l * 3 * CW; const float* gc = a.in[I_GCONV] + (size_t)l * CW; const float* gs = a.in[I_GSSM] + (size_t)l * SW;
    float w0r[16], w1r[16], w2r[16], gcr[16], gsr[16];
#pragma unroll
    for (int j = 0; j < 2; ++j) { const int c0 = 8 * lane + 512 * j;
#pragma unroll
        for (int hq = 0; hq < 2; ++hq) { const f32x4 t0 = *(const f32x4*)(cw + c0 + 4 * hq), t1 = *(const f32x4*)(cw + CW + c0 + 4 * hq), t2 = *(const f32x4*)(cw + 2 * CW + c0 + 4 * hq),
                                               t3 = *(const f32x4*)(gc + c0 + 4 * hq), t4 = *(const f32x4*)(gs + c0 + 4 * hq);
#pragma unroll
            for (int i = 0; i < 4; ++i) { w0r[8 * j + 4 * hq + i] = t0[i]; w1r[8 * j + 4 * hq + i] = t1[i]; w2r[8 * j + 4 * hq + i] = t2[i]; gcr[8 * j + 4 * hq + i] = t3[i]; gsr[8 * j + 4 * hq + i] = t4[i]; } } }
    const int rpw = (NTOK + G * NWAVES - 1) / (G * NWAVES), rbeg = (bx * NWAVES + wave) * rpw, rend = rbeg + rpw < NTOK ? rbeg + rpw : NTOK;
    for (int row = rbeg; row < rend; ++row) {
        bool hp, hn;
        if (row < NCTX) { const int t = row & 255; hp = t > 0; hn = t < 255; } else { const int c = (row - NCTX) & 63; hp = c > 0; hn = c < 63; }
#pragma unroll
        for (int j = 0; j < 2; ++j) { const int c0 = 8 * lane + 512 * j; const size_t off = (size_t)row * CW + c0;
            float vc[8], vp[8], vn[8], gb[8];
            unpack8(*(const v4u*)(V + off), vc); unpack8(*(const v4u*)(GB + off), gb);
            if (hp) unpack8(*(const v4u*)(V + off - CW), vp); else {
#pragma unroll
                for (int i = 0; i < 8; ++i) vp[i] = 0.f; }
            if (hn) unpack8(*(const v4u*)(V + off + CW), vn); else {
#pragma unroll
                for (int i = 0; i < 8; ++i) vn[i] = 0.f; }
            float o[8]; float ssq = 0.f;
#pragma unroll
            for (int i = 0; i < 8; ++i) { o[i] = gb[i] * (w0r[8 * j + i] * vp[i] + w1r[8 * j + i] * vc[i] + w2r[8 * j + i] * vn[i]); ssq += o[i] * o[i]; }
            ssq += __shfl_xor(ssq, 1); ssq += __shfl_xor(ssq, 2); ssq += __shfl_xor(ssq, 4);
            const float rs = 1.0f / sqrtf(ssq * (1.0f / 64.0f) + EPS);
#pragma unroll
            for (int i = 0; i < 8; ++i) o[i] = o[i] * rs * gcr[8 * j + i];
            *(v4u*)(MX + (size_t)row * DM + c0) = pack8(o); }
        float s[16]; float ssq = 0.f;
#pragma unroll
        for (int j = 0; j < 2; ++j) { float t[8]; unpack8(*(const v4u*)(O + (size_t)row * SW + 8 * lane + 512 * j), t);
#pragma unroll
            for (int i = 0; i < 8; ++i) { s[8 * j + i] = t[i]; ssq += t[i] * t[i]; } }
        ssq = wave_sum(ssq);
        const float rs = 1.0f / sqrtf(ssq * (1.0f / SW) + EPS);
#pragma unroll
        for (int j = 0; j < 2; ++j) { const int c0 = 8 * lane + 512 * j; float o[8];
#pragma unroll
            for (int i = 0; i < 8; ++i) o[i] = s[8 * j + i] * rs * gsr[8 * j + i];
            *(v4u*)(MX + (size_t)row * DM + CW + c0) = pack8(o); }
    }
}

struct S5C { bf16x8 Bf[2][4]; float ar[2][2], ai[2][2]; };
__device__ __forceinline__ void s5_setup(const DArgs& a, LAS unsigned char* lds, int lane, int wave, int l, int g, S5C& c) {
    const int n = lane & 31, hf = lane >> 5, tq = lane & 15, q = lane >> 4;
    LAS unsigned char* CFB = lds + 135168;
    LAS float* A16 = (LAS float*)(lds + 143360);
#pragma unroll
    for (int d = 0; d < 2; ++d) {
        const int pg = (l * 2 + d) * 64 + g;
        const float dt = expf(a.in[I_LOGDT][pg]);
#pragma unroll
        for (int s = 0; s < 2; ++s) { const int nn = n + 32 * s;
            const float are = a.in[I_ARE][pg * 64 + nn], aim = a.in[I_AIM][pg * 64 + nn];
            const float er = expf(are * dt); float sn, cs; sincos_cw(aim * dt, sn, cs);
            const float abr = er * cs, abi = er * sn; c.ar[d][s] = abr; c.ai[d][s] = abi;
            if (wave == 0 && hf == 0) { const float e16 = expf(16.0f * are * dt); float s16, c16; sincos_cw(16.0f * aim * dt, s16, c16); *(LAS f32x2*)(A16 + (d * 64 + nn) * 2) = (f32x2){e16 * c16, e16 * s16}; }
            const float inv = 1.0f / (are * are + aim * aim);
            const float cr = ((abr - 1.0f) * are + abi * aim) * inv, ci = (abi * are - (abr - 1.0f) * aim) * inv;
            const float* brp = a.in[I_BRE] + (unsigned)((pg * 64 + nn) * 16 + 8 * hf); const float* bip = a.in[I_BIM] + (unsigned)((pg * 64 + nn) * 16 + 8 * hf);
            const f32x4 br0 = *(const f32x4*)brp, br1 = *(const f32x4*)(brp + 4), bi0 = *(const f32x4*)bip, bi1 = *(const f32x4*)(bip + 4);
            v4u wr_, wi_;
            wr_.x = pk2(cr * br0[0] - ci * bi0[0], cr * br0[1] - ci * bi0[1]); wr_.y = pk2(cr * br0[2] - ci * bi0[2], cr * br0[3] - ci * bi0[3]);
            wr_.z = pk2(cr * br1[0] - ci * bi1[0], cr * br1[1] - ci * bi1[1]); wr_.w = pk2(cr * br1[2] - ci * bi1[2], cr * br1[3] - ci * bi1[3]);
            wi_.x = pk2(cr * bi0[0] + ci * br0[0], cr * bi0[1] + ci * br0[1]); wi_.y = pk2(cr * bi0[2] + ci * br0[2], cr * bi0[3] + ci * br0[3]);
            wi_.z = pk2(cr * bi1[0] + ci * br1[0], cr * bi1[1] + ci * br1[1]); wi_.w = pk2(cr * bi1[2] + ci * br1[2], cr * bi1[3] + ci * br1[3]);
            c.Bf[d][2 * s] = __builtin_bit_cast(bf16x8, wr_); c.Bf[d][2 * s + 1] = __builtin_bit_cast(bf16x8, wi_); }
        if (wave == 0) {
            const float* crp = a.in[I_CRE] + (unsigned)((pg * 16 + tq) * 64); const float* cip = a.in[I_CIM] + (unsigned)((pg * 16 + tq) * 64);
#pragma unroll
            for (int ks = 0; ks < 4; ++ks) { const int n0 = 8 * ks + 2 * q;
                const f32x2 cr0 = *(const f32x2*)(crp + n0), cr1 = *(const f32x2*)(crp + n0 + 32), ci0 = *(const f32x2*)(cip + n0), ci1 = *(const f32x2*)(cip + n0 + 32);
                v4u w; w.x = pk2(cr0[0], -ci0[0]); w.y = pk2(cr1[0], -ci1[0]); w.z = pk2(cr0[1], -ci0[1]); w.w = pk2(cr1[1], -ci1[1]);
                *(LAS v4u*)(CFB + ((d * 4 + ks) * 64 + lane) * 16) = w; }
        }
    }
}
__device__ __forceinline__ void s5_task(const DArgs& a, LAS unsigned char* lds, int tid, int lane, int wave, int l, int row0, int NC, int g, int bidx, bool latent, const S5C& cst, bf16x8& Afpre, int next_row0) {
#define S5_BAR() do { asm volatile("s_waitcnt lgkmcnt(0)" ::: "memory"); __builtin_amdgcn_s_barrier(); asm volatile("" ::: "memory"); } while (0)
    const int n = lane & 31, hf = lane >> 5, tq = lane & 15, q = lane >> 4;
    LAS float* EB = (LAS float*)lds;
    LAS unsigned char* SB = lds + 65536 + wave * 8704;
    const bf16* U = (const bf16*)(a.ws + WS_U); bf16* Z = (bf16*)(a.ws + WS_Z);
    LAS unsigned char* CFB = lds + 135168;
    const LAS float* A16 = (const LAS float*)(lds + 143360);
    bf16x8 Bf[2][4]; float ar[2][2], ai[2][2];
#pragma unroll
    for (int d = 0; d < 2; ++d) {
#pragma unroll
        for (int cb = 0; cb < 4; ++cb) Bf[d][cb] = cst.Bf[d][cb];
#pragma unroll
        for (int s2 = 0; s2 < 2; ++s2) { ar[d][s2] = cst.ar[d][s2]; ai[d][s2] = cst.ai[d][s2]; } }
    const f32x16 zero16 = {0.f, 0.f, 0.f, 0.f, 0.f, 0.f, 0.f, 0.f, 0.f, 0.f, 0.f, 0.f, 0.f, 0.f, 0.f, 0.f};
    const int cbit = (n >> 2) & 1, tA = (n >> 3) * 4 + (n & 3);
#define S5_PIN_BU() asm volatile("s_nop 15\n\ts_nop 15\n\ts_nop 15\n\ts_nop 15\n\ts_nop 15\n\ts_nop 15\n\ts_nop 15\n\ts_nop 15\n\ts_nop 15\n\ts_nop 15\n\ts_nop 15\n\ts_nop 15\n\ts_nop 15\n\ts_nop 15\n\ts_nop 15\n\ts_nop 15\n\ts_nop 15\n\ts_nop 15\n\ts_nop 15\n\ts_nop 15" : "+v"(acc[0]), "+v"(acc[1]), "+v"(acc[2]), "+v"(acc[3]) : "v"(Afd), "v"(Bf[d][0]), "v"(Bf[d][1]), "v"(Bf[d][2]), "v"(Bf[d][3]))
    bf16x8 Afk = {0, 0, 0, 0, 0, 0, 0, 0};
    bf16x8 Afn = Afpre;
    for (int item = wave; item < NC / 2; item += NWAVES) { const int c0 = 2 * item;
        const bf16x8 Af = Afn;
        if (item + NWAVES < NC / 2) Afn = *(const bf16x8*)(U + (unsigned)((row0 + (c0 + 2 * NWAVES + cbit) * 16 + tA) * SW + g * 16 + 8 * hf));
        Afk = Af;
#pragma unroll
        for (int d = 0; d < 2; ++d) {
            bf16x8 Afd = Af; asm volatile("" : "+v"(Afd) :: "memory");
            f32x16 acc[4];
#pragma unroll
            for (int cb = 0; cb < 4; ++cb) acc[cb] = __builtin_amdgcn_mfma_f32_32x32x16_bf16(Afd, Bf[d][cb], zero16, 0, 0, 0);
            S5_PIN_BU();
            float s0r = 0.f, s0i = 0.f, s1r = 0.f, s1i = 0.f;
#pragma unroll
            for (int ii = 0; ii < 16; ++ii) { const int i = d == 0 ? ii : 15 - ii;
                const float n0r = fmaf(ar[d][0], s0r, fmaf(-ai[d][0], s0i, acc[0][i])), n0i = fmaf(ar[d][0], s0i, fmaf(ai[d][0], s0r, acc[1][i]));
                const float n1r = fmaf(ar[d][1], s1r, fmaf(-ai[d][1], s1i, acc[2][i])), n1i = fmaf(ar[d][1], s1i, fmaf(ai[d][1], s1r, acc[3][i]));
                s0r = n0r; s0i = n0i; s1r = n1r; s1i = n1i; }
            *(LAS f32x4*)(EB + (d * 64 + c0 + hf) * 128 + 4 * n) = (f32x4){s0r, s0i, s1r, s1i};
            asm volatile("s_waitcnt lgkmcnt(0)" :: "v"(s0r), "v"(s0i), "v"(s1r), "v"(s1i) : "memory");
        }
    }
    S5_BAR();
    if (tid < 128) { const int d = tid >> 6, nn = tid & 63, pos = nn < 32 ? 4 * nn : 4 * (nn - 32) + 2;
        const f32x2 p16 = *(const LAS f32x2*)(A16 + (d * 64 + nn) * 2); const float pr = p16[0], pi = p16[1];
        const unsigned sidx = ((((unsigned)bidx * DEPTH + l) * 2 + d) * 64 + g) * 64 + nn;
        float sr = 0.f, si = 0.f;
        if (latent) { sr = a.in[I_SRE][sidx]; si = a.in[I_SIM][sidx]; }
        for (int cb8 = 0; cb8 < NC; cb8 += 8) {
            f32x2 e[8];
#pragma unroll
            for (int j = 0; j < 8; ++j) { const int c = d == 0 ? cb8 + j : NC - 1 - cb8 - j; e[j] = *(const LAS f32x2*)(EB + (d * 64 + c) * 128 + pos); }
#pragma unroll
            for (int j = 0; j < 8; ++j) { const int c = d == 0 ? cb8 + j : NC - 1 - cb8 - j; const f32x2 sv = {sr, si};
                const float nr = fmaf(pr, sr, fmaf(-pi, si, e[j][0])), ni = fmaf(pr, si, fmaf(pi, sr, e[j][1])); sr = nr; si = ni;
                *(LAS f32x2*)(EB + (d * 64 + c) * 128 + pos) = sv; }
        }
        if (!latent) { float* ns = a.out + (size_t)NTOK * DM; ns[sidx] = sr; ns[524288u + sidx] = si; }
    }
    S5_BAR();
    if (next_row0 >= 0) Afpre = *(const bf16x8*)(U + (unsigned)((next_row0 + (2 * wave + cbit) * 16 + tA) * SW + g * 16 + 8 * hf));
    if (latent) Afn = *(const bf16x8*)(U + (unsigned)((row0 + (2 * wave + cbit) * 16 + tA) * SW + g * 16 + 8 * hf));
    const f32x4 dd = *(const f32x4*)(a.in[I_SSMD] + (unsigned)(l * SW + g * 16 + 4 * q));
    for (int item = wave; item < NC / 2; item += NWAVES) { const int c0 = 2 * item;
        bf16x8 Af = Afk;
        if (latent) { Af = Afn; if (item + NWAVES < NC / 2) Afn = *(const bf16x8*)(U + (unsigned)((row0 + (c0 + 2 * NWAVES + cbit) * 16 + tA) * SW + g * 16 + 8 * hf)); }
        v2u uwv[2];
#pragma unroll
        for (int cc = 0; cc < 2; ++cc) uwv[cc] = *(const v2u*)(U + (unsigned)((row0 + (c0 + cc) * 16 + tq) * SW + g * 16 + 4 * q));
        f32x4 yacc[2] = {{0.f, 0.f, 0.f, 0.f}, {0.f, 0.f, 0.f, 0.f}};
#pragma unroll
        for (int d = 0; d < 2; ++d) {
            bf16x8 Afd = Af; asm volatile("" : "+v"(Afd) :: "memory");
            f32x16 acc[4];
#pragma unroll
            for (int cb = 0; cb < 4; ++cb) acc[cb] = __builtin_amdgcn_mfma_f32_32x32x16_bf16(Afd, Bf[d][cb], zero16, 0, 0, 0);
            S5_PIN_BU();
            const f32x4 s_in = *(const LAS f32x4*)(EB + (d * 64 + c0 + hf) * 128 + 4 * n);
            float s0r = s_in[0], s0i = s_in[1], s1r = s_in[2], s1i = s_in[3];
            v2u w[16];
#pragma unroll
            for (int ii = 0; ii < 16; ++ii) { const int i = d == 0 ? ii : 15 - ii;
                const float n0r = fmaf(ar[d][0], s0r, fmaf(-ai[d][0], s0i, acc[0][i])), n0i = fmaf(ar[d][0], s0i, fmaf(ai[d][0], s0r, acc[1][i]));
                const float n1r = fmaf(ar[d][1], s1r, fmaf(-ai[d][1], s1i, acc[2][i])), n1i = fmaf(ar[d][1], s1i, fmaf(ai[d][1], s1r, acc[3][i]));
                s0r = n0r; s0i = n0i; s1r = n1r; s1i = n1i;
                w[i].x = pk2(s0r, s0i); w[i].y = pk2(s1r, s1i); }
#pragma unroll
            for (int i = 0; i < 16; ++i) *(LAS v2u*)(SB + (hf * 16 + i) * 272 + 8 * n) = w[i];
            asm volatile("s_waitcnt lgkmcnt(0)" :: "v"(w[0]), "v"(w[1]), "v"(w[2]), "v"(w[3]), "v"(w[4]), "v"(w[5]), "v"(w[6]), "v"(w[7]), "v"(w[8]), "v"(w[9]), "v"(w[10]), "v"(w[11]), "v"(w[12]), "v"(w[13]), "v"(w[14]), "v"(w[15]) : "memory");
            {
                bf16x8 sf[2][4], cf[4];
#pragma unroll
                for (int ks = 0; ks < 4; ++ks) { cf[ks] = *(const LAS bf16x8*)(CFB + ((d * 4 + ks) * 64 + lane) * 16);
#pragma unroll
                    for (int cc = 0; cc < 2; ++cc) sf[cc][ks] = *(const LAS bf16x8*)(SB + (cc * 16 + tq) * 272 + ks * 64 + q * 16); }
                asm volatile("s_waitcnt lgkmcnt(0)" : "+v"(sf[0][0]), "+v"(sf[0][1]), "+v"(sf[0][2]), "+v"(sf[0][3]), "+v"(sf[1][0]), "+v"(sf[1][1]), "+v"(sf[1][2]), "+v"(sf[1][3]), "+v"(cf[0]), "+v"(cf[1]), "+v"(cf[2]), "+v"(cf[3]) :: "memory");
#pragma unroll
                for (int cc = 0; cc < 2; ++cc)
#pragma unroll
                    for (int ks = 0; ks < 4; ++ks) yacc[cc] = __builtin_amdgcn_mfma_f32_16x16x32_bf16(cf[ks], sf[cc][ks], yacc[cc], 0, 0, 0);
                asm volatile("s_nop 15\n\ts_nop 15\n\ts_nop 15\n\ts_nop 15\n\ts_nop 15\n\ts_nop 15\n\ts_nop 15\n\ts_nop 15\n\ts_nop 15\n\ts_nop 15\n\ts_nop 15\n\ts_nop 15\n\ts_nop 15\n\ts_nop 15\n\ts_nop 15\n\ts_nop 15" : "+v"(yacc[0]), "+v"(yacc[1]) : "v"(sf[0][0]), "v"(sf[0][1]), "v"(sf[0][2]), "v"(sf[0][3]), "v"(sf[1][0]), "v"(sf[1][1]), "v"(sf[1][2]), "v"(sf[1][3]), "v"(cf[0]), "v"(cf[1]), "v"(cf[2]), "v"(cf[3]) : "memory");
            }
        }
#pragma unroll
        for (int cc = 0; cc < 2; ++cc) { const unsigned off = (unsigned)((row0 + (c0 + cc) * 16 + tq) * SW + g * 16 + 4 * q);
            const v2u uw = uwv[cc];
            const float u0 = bflo(uw.x), u1 = bfhi(uw.x), u2 = bflo(uw.y), u3 = bfhi(uw.y);
            const float z0 = gelu_tanh(yacc[cc][0] + dd[0] * u0), z1 = gelu_tanh(yacc[cc][1] + dd[1] * u1), z2 = gelu_tanh(yacc[cc][2] + dd[2] * u2), z3 = gelu_tanh(yacc[cc][3] + dd[3] * u3);
            v2u zw; zw.x = pk2(z0, z1); zw.y = pk2(z2, z3);
            *(v2u*)(Z + off) = zw; }
    }
    S5_BAR();
}
__device__ __forceinline__ void s5_phase(LAS unsigned char* lds, int tid_, int lane_, int wave_, int bx_, int G_, int l) {
    const DArgs a = load_args(); const int tid = fresh_v(tid_), lane = fresh_v(lane_), wave = fresh_s(wave_), bx = fresh_s(bx_), G = fresh_s(G_);
    const bool bal = (G == 256);
    const int nt = bal ? (bx < 128 ? 3 : 6) : (128 + 1024 - bx + G - 1) / G;
    S5C cst; int gprev = -1; bf16x8 Afpre = {0, 0, 0, 0, 0, 0, 0, 0};
    const int lane_n = lane & 31, cbit = (lane_n >> 2) & 1, tA = (lane_n >> 3) * 4 + (lane_n & 3), hf = lane >> 5;
    const bf16* U = (const bf16*)(a.ws + WS_U);
    for (int i = 0; i < nt; ++i) {
        bool latent, latn = false; int b, g, bn = 0, gn = -1;
#define S5_TASK(ii, LAT, B, GG) do { if (bal) { if (bx < 128) { LAT = ((ii) == 0); GG = bx & 63; B = LAT ? (bx >> 6) : 2 * (bx >> 6) + ((ii) - 1); } else { const int w = bx - 128; LAT = false; GG = w >> 1; B = 4 + 6 * (w & 1) + (ii); } } \
        else { const int t = bx + (ii) * G; LAT = t < 128; const int tc = LAT ? t : t - 128; B = tc >> 6; GG = tc & 63; } } while (0)
        S5_TASK(i, latent, b, g);
        if (i + 1 < nt) S5_TASK(i + 1, latn, bn, gn);
        const int row0 = latent ? NCTX + b * 1024 : b * 256;
        const int rown = (i + 1 < nt && gn == g) ? (latn ? NCTX + bn * 1024 : bn * 256) : -1;
        if (g != gprev) { s5_setup(a, lds, lane, wave, l, g, cst); gprev = g;
            Afpre = *(const bf16x8*)(U + (unsigned)((row0 + (2 * wave + cbit) * 16 + tA) * SW + g * 16 + 8 * hf)); }
        s5_task(a, lds, tid, lane, wave, l, row0, latent ? 64 : 16, g, b, latent, cst, Afpre, rown);
#undef S5_TASK
    }
}
#define XB_TMO      128
#define XB_XCNT(j)  (256  + 64 * (j))
#define XB_XSUB(j)  (1280 + 64 * (j))
#define XB_XGEN(j)  (2304 + 64 * (j))
#define XB_TOP      3328
#define XB_TOPGEN   3392
#define XCD_BAR_WORDS 3456
#define XB_SPIN_CAP (1u << 18)

__device__ __forceinline__ unsigned xb_ld(unsigned* p)              { return __hip_atomic_load(p, __ATOMIC_RELAXED, __HIP_MEMORY_SCOPE_AGENT); }
__device__ __forceinline__ unsigned xb_add(unsigned* p, unsigned v) { return __hip_atomic_fetch_add(p, v, __ATOMIC_RELAXED, __HIP_MEMORY_SCOPE_AGENT); }
__device__ __forceinline__ unsigned xb_xcc_id() { return (unsigned)__builtin_amdgcn_s_getreg((3 << 11) | 20) & 0xFu; }
#define XB_SPIN(cond, bar) do { unsigned _sp = 0; while (cond) { __builtin_amdgcn_s_sleep(1); \
    if ((++_sp & 255u) == 0u) { if (xb_ld(&(bar)[XB_TMO])) break; if (_sp > XB_SPIN_CAP) { atomicAdd(&(bar)[XB_TMO], 1u); break; } } } } while (0)

struct XcdBarrier {
    unsigned* bar; unsigned x;
    volatile LAS unsigned* st;
};

__device__ __forceinline__ XcdBarrier xcd_barrier_post(unsigned* bar, volatile LAS unsigned* st) {
    XcdBarrier b; b.bar = bar; b.x = xb_xcc_id(); b.st = st;
    if (threadIdx.x == 0) (void)xb_add(&bar[XB_XCNT(b.x)], 1u);
    return b;
}
__device__ __forceinline__ void xcd_barrier_complete(unsigned* bar, unsigned x, unsigned& nloc, unsigned& nx) {
    const unsigned G = gridDim.x * gridDim.y * gridDim.z;
    unsigned sum, cnt, mine, sp = 0u;
    for (;;) {
        sum = 0u; cnt = 0u; mine = 0u;
#pragma unroll
        for (unsigned j = 0; j < 16; ++j) { const unsigned c = xb_ld(&bar[XB_XCNT(j)]); sum += c; cnt += (c > 0u) ? 1u : 0u; mine = (j == x) ? c : mine; }
        if (sum == G) break;
        __builtin_amdgcn_s_sleep(1);
        if ((++sp & 255u) == 0u) { if (xb_ld(&bar[XB_TMO])) break; if (sp > XB_SPIN_CAP) { atomicAdd(&bar[XB_TMO], 1u); break; } }
    }
    nloc = mine > 0u ? mine : 1u; nx = cnt > 0u ? cnt : 1u;
}

__device__ __forceinline__ void xcd_barrier(const XcdBarrier& b) {
    asm volatile("s_waitcnt vmcnt(0)" ::: "memory");
    __syncthreads();
    if (threadIdx.x == 0) {
        unsigned* bar = b.bar;
        __builtin_amdgcn_s_waitcnt(0);
        unsigned nloc = b.st[0], nx = b.st[1];
        if (nloc == 0u) { xcd_barrier_complete(bar, b.x, nloc, nx); b.st[0] = nloc; b.st[1] = nx; }
        const unsigned old = xb_add(&bar[XB_XSUB(b.x)], 1u);
        const unsigned gen = old / nloc;
        if (old + 1u == (gen + 1u) * nloc) {
            __builtin_amdgcn_fence(__ATOMIC_RELEASE, "agent");
            asm volatile("s_waitcnt vmcnt(0)" ::: "memory");
            const unsigned og = xb_add(&bar[XB_TOP], 1u);
            const unsigned tg = og / nx;
            if (og + 1u == (tg + 1u) * nx) xb_add(&bar[XB_TOPGEN], 1u);
            else XB_SPIN(xb_ld(&bar[XB_TOPGEN]) == tg, bar);
            __builtin_amdgcn_fence(__ATOMIC_ACQUIRE, "agent");
            xb_add(&bar[XB_XGEN(b.x)], 1u);
            asm volatile("s_waitcnt vmcnt(0)" ::: "memory");
        } else {
            XB_SPIN(xb_ld(&bar[XB_XGEN(b.x)]) == gen, bar);
            __builtin_amdgcn_fence(__ATOMIC_ACQUIRE, "agent");
            asm volatile("s_waitcnt vmcnt(0)" ::: "memory");
        }
    }
    __syncthreads();
}


__device__ __forceinline__ void sub_barrier(unsigned* word, unsigned n, unsigned* bar) {
    asm volatile("s_waitcnt vmcnt(0)" ::: "memory");
    __syncthreads();
    if (threadIdx.x == 0) {
        __builtin_amdgcn_s_waitcnt(0);
        __builtin_amdgcn_fence(__ATOMIC_RELEASE, "agent");
        asm volatile("s_waitcnt vmcnt(0)" ::: "memory");
        (void)xb_add(word, 1u);
        XB_SPIN(xb_ld(word) < n, bar);
        __builtin_amdgcn_fence(__ATOMIC_ACQUIRE, "agent");
        asm volatile("s_waitcnt vmcnt(0)" ::: "memory");
    }
    __syncthreads();
}

__global__ void __launch_bounds__(NWAVES * 64, 2) fwd_kernel(Args  ) {
    extern __shared__ __attribute__((aligned(16))) unsigned char lds_raw[];
    LAS unsigned char* lds = (LAS unsigned char*)lds_raw;
    const int tid = threadIdx.x, lane = tid & 63, wave = __builtin_amdgcn_readfirstlane(tid >> 6), G = gridDim.x, bx = blockIdx.x;
    volatile LAS unsigned* MISC = (volatile LAS unsigned*)(lds + MISC_OFF);
    for (int u = tid; u < (LDS_BYTES - LDSCTL_OFF) / 4; u += NWAVES * 64) ((LAS unsigned*)(lds + LDSCTL_OFF))[u] = 0u;
    __syncthreads();
    XcdBarrier bar;
    { const DArgs a = load_args(); gu32* ctl = (gu32*)(a.ws + WS_CTL); bar = xcd_barrier_post((unsigned*)(ctl + CW_BAR), MISC + 8); }
#define GRID_BAR() do { XcdBarrier b_ = bar; asm volatile("" : "+s"(b_.bar), "+s"(b_.x)); xcd_barrier(b_); } while (0)


    for (int t = bx; t < 192; t += G) mod_task(lds, tid, lane, wave, t);
    cvt_fill(lds, tid, 0, (G == 256 && bx < 192) ? 6 : -1);
    cvt_fill(lds, tid, 0, -1);
    GRID_BAR();
    row_pass<0>(0, bx, G, wave, lane);
    GRID_BAR();

    const int nl = fresh_s(DEPTH);
    for (int li = 0; li < nl; ++li) {
        const int l = li;
        const bool dfl = fresh_s(G) == 256;
        { const int x = bx & 7, r = bx >> 3;
          pg8::G5Order S; S.st = !dfl; S.so.init(NTOK, INC, fresh_s(G), fresh_s(bx));
          if (r < 24) { S.u0.pm = 3 * x + r % 3; S.u0.pn = 8 + r / 3; } else if (r < 28) { S.u0.pm = 3 * x + (r - 24) % 3; S.u0.pn = (r - 24) / 3; } else { S.u0.pm = -1; S.u0.pn = 0; }
          if (S.st || S.u0.pm >= 0) {
              const DArgs a = load_args(); pg8::Gemm g{(const bf16*)(a.ws + WS_H), (const bf16*)(a.ws + WS_WIN) + (size_t)l * INC * DM, NTOK, INC, DM};
              pg8::EpiIn E{(bf16*)(a.ws + WS_GB), (bf16*)(a.ws + WS_V), (bf16*)(a.ws + WS_U)};
              pg8::gemm_phase<pg8::EpiIn, pg8::G5Order, true, true>(lds, g, S, E);
          } else if (li + 1 < nl) cvt_fill(lds, tid, l + 1, 12);
        }
        GRID_BAR();
        s5_phase(lds, tid, lane, wave, bx, G, l);
        GRID_BAR();
        { const int x = bx & 7, r = bx >> 3;
          if (dfl && r < 20) {
              pg8::G5Order S; S.st = false; S.u0.pm = 3 * x + (r + 4) % 3; S.u0.pn = (r + 4) / 3;
              const DArgs a = load_args(); pg8::Gemm g{(const bf16*)(a.ws + WS_H), (const bf16*)(a.ws + WS_WIN) + (size_t)l * INC * DM, NTOK, INC, DM};
              pg8::EpiIn E{(bf16*)(a.ws + WS_GB), (bf16*)(a.ws + WS_V), (bf16*)(a.ws + WS_U)};
              pg8::gemm_phase<pg8::EpiIn, pg8::G5Order, true, true>(lds, g, S, E);
          } else {
              pg8::G5Order S; S.st = !dfl; S.so.init(NTOK, SW, fresh_s(G), fresh_s(bx)); S.u0.pm = 3 * x + (r - 20) % 3; S.u0.pn = (r - 20) / 3;
              const DArgs a = load_args(); pg8::Gemm g{(const bf16*)(a.ws + WS_Z), (const bf16*)(a.ws + WS_WGLU) + (size_t)l * SW * SW, NTOK, SW, SW};
              pg8::EpiGlu E{(const bf16*)(a.ws + WS_Z), (bf16*)(a.ws + WS_O), a.in[I_BGLU] + (size_t)l * SW};
              pg8::gemm_phase<pg8::EpiGlu, pg8::G5Order, true, true>(lds, g, S, E);
              if (li + 1 < nl) cvt_fill(lds, tid, l + 1, 4);
          }
        }
        GRID_BAR();
        mix_pass(bx, G, wave, lane, l);
        GRID_BAR();
        { const DArgs a = load_args(); pg8::Gemm g{(const bf16*)(a.ws + WS_MIXIN), (const bf16*)(a.ws + WS_WOUT) + (size_t)l * DM * DM, NTOK, DM, DM}; pg8::G5Order S; S.st = !dfl; S.so.init(NTOK, DM, fresh_s(G), fresh_s(bx)); { const int x = bx & 7, r = bx >> 3; S.u0.pm = r < 24 ? 3 * x + r % 3 : -1; S.u0.pn = r / 3; }
          pg8::EpiBf16<0> E{(bf16*)(a.ws + WS_MIXED), DM, nullptr, 0, 0, 1.f};
          pg8::gemm_phase<pg8::EpiBf16<0>, pg8::G5Order, true, true>(lds, g, S, E); }
        if (li + 1 < nl && bx >= 192) cvt_fill(lds, tid, l + 1, 12);
        GRID_BAR();
        row_pass<1>(l, bx, G, wave, lane);
        GRID_BAR();
        { const DArgs a = load_args(); pg8::Gemm g{(const bf16*)(a.ws + WS_H), (const bf16*)(a.ws + WS_WUP) + (size_t)l * UPN * DM, NTOK, UPN, DM}; pg8::G4Order S{0, dfl ? 1024 : 1056, fresh_s(G), fresh_s(bx), !dfl};
          pg8::EpiFfn E{(bf16*)(a.ws + WS_ACT), a.in[I_FFNW] + (size_t)l * 3 * UPN, (LAS float*)(lds + RING_BYTES)};
          pg8::gemm_phase<pg8::EpiFfn, pg8::G4Order, true, true>(lds, g, S, E); }
        GRID_BAR();
        if (dfl && bx < 32) {
            { const DArgs a = load_args(); pg8::Gemm g{(const bf16*)(a.ws + WS_H), (const bf16*)(a.ws + WS_WUP) + (size_t)l * UPN * DM, NTOK, UPN, DM}; pg8::G4Order S{1024, 1056, fresh_s(G), fresh_s(bx), false};
              pg8::EpiFfn E{(bf16*)(a.ws + WS_ACT), a.in[I_FFNW] + (size_t)l * 3 * UPN, (LAS float*)(lds + RING_BYTES)};
              pg8::gemm_phase<pg8::EpiFfn, pg8::G4Order, true, true>(lds, g, S, E); }
            { const DArgs a = load_args(); sub_barrier((unsigned*)(a.ws + WS_CTL) + CW_SUB + 64 * l, 32u, (unsigned*)(a.ws + WS_CTL) + CW_BAR); }
            { const DArgs a = load_args(); pg8::Gemm g{(const bf16*)(a.ws + WS_ACT) + (size_t)23 * 256 * DFF, (const bf16*)(a.ws + WS_WDN) + (size_t)l * DM * DFF, 256, 4 * DM, DFF / 4, DFF, 4};
              pg8::G5Order S; S.st = false; S.u0.pm = 0; S.u0.pn = fresh_s(bx);
              pg8::EpiBf16<0> E{(bf16*)(a.ws + WS_FFP), DM, nullptr, DM, (size_t)256 * DM, 1.f};
              pg8::gemm_phase<pg8::EpiBf16<0>, pg8::G5Order, true, true>(lds, g, S, E); }
            if (li + 1 < nl) cvt_fill(lds, tid, l + 1, 8);
        } else {
            const int x = bx & 7, r = (bx >> 3) - 4;
            pg8::G5Order S; S.st = !dfl; S.so.init(NTOK, DM, fresh_s(G), fresh_s(bx));
            if (bx < 224 && r < 23) { const int w = 23 * x + r, grp = w < 128 ? w >> 6 : 2, ww = w < 128 ? w & 63 : w - 128, gsz = grp < 2 ? 8 : 7; S.u0.pm = 8 * grp + ww % gsz; S.u0.pn = ww / gsz; }
            else { S.u0.pm = -1; S.u0.pn = 0; }
            if (S.st || S.u0.pm >= 0) {
                const DArgs a = load_args(); pg8::Gemm g{(const bf16*)(a.ws + WS_ACT), (const bf16*)(a.ws + WS_WDN) + (size_t)l * DM * DFF, NTOK, DM, DFF};
                pg8::EpiBf16<0> E{(bf16*)(a.ws + WS_FF), DM, nullptr, 0, 0, 1.f};
                pg8::gemm_phase<pg8::EpiBf16<0>, pg8::G5Order, true, true>(lds, g, S, E);
            } else if (li + 1 < nl) cvt_fill(lds, tid, l + 1, 48);
        }
        GRID_BAR();
        if (li < nl - 1) {
            row_pass<2>(l, bx, G, wave, lane, fresh_s(G) == 256);
            cvt_fill(lds, tid, l + 1, -1);
            GRID_BAR();
        } else {
            row_pass<3>(l, bx, G, wave, lane, fresh_s(G) == 256);
        }
    }

#undef GRID_BAR
}

extern "C" void kernel_launch(void* const* d_in, const int* in_sizes, int n_in, void* d_out, int out_size, void* d_ws, size_t ws_size, hipStream_t stream) {
    static int grid = 0;
    if (grid == 0) {
        if (n_in != 30 || out_size != NTOK * DM + 2 * 524288 || ws_size < WS_END) { fprintf(stderr, "kernel_launch: unexpected shapes (n_in %d, out %d, ws %zu); nothing launched\n", n_in, out_size, ws_size); grid = -1; return; }
        int dev = 0, cus = 0, per_cu = 0;
        if (hipGetDevice(&dev) != hipSuccess || hipDeviceGetAttribute(&cus, hipDeviceAttributeMultiprocessorCount, dev) != hipSuccess) { grid = -1; return; }
        if (hipFuncSetAttribute((const void*)fwd_kernel, hipFuncAttributeMaxDynamicSharedMemorySize, LDS_BYTES) != hipSuccess) { fprintf(stderr, "kernel_launch: hipFuncSetAttribute failed\n"); grid = -1; return; }
        if (hipOccupancyMaxActiveBlocksPerMultiprocessor(&per_cu, (const void*)fwd_kernel, NWAVES * 64, LDS_BYTES) != hipSuccess || per_cu < 1)
            fprintf(stderr, "kernel_launch: note: occupancy query reports %d workgroups per CU\n", per_cu);
        (void)hipGetLastError();
        grid = cus;
    }
    if (grid < 0) return;
    if (hipMemsetAsync((char*)d_ws + WS_CTL, 0, CTL_ZERO_BYTES, stream) != hipSuccess) return;
    Args a{};
    for (int i = 0; i < 30; ++i) a.in[i] = (const float*)d_in[i];
    a.out = (float*)d_out; a.ws = (unsigned char*)d_ws;
    hipLaunchKernelGGL(fwd_kernel, dim3(grid), dim3(NWAVES * 64), LDS_BYTES, stream, a);
}
```

```cpp
#include <hip/hip_runtime.h>
#include <cstdio>
#include <cstdint>
namespace pg8 {
#define PG8_LAS __attribute__((address_space(3)))
typedef unsigned short bf16_t;
typedef short bf16x8 __attribute__((ext_vector_type(8)));
typedef float f32x4 __attribute__((ext_vector_type(4)));
typedef unsigned u32x4 __attribute__((ext_vector_type(4)));
constexpr int BM = 256, BK = 64, HALF = 128, HTB = HALF * BK * 2  , STAGE_BYTES = 8 * HTB, NXCD = 8, WGM = 8;

__host__ __device__ __forceinline__ int lds_byte(int r, int c) { const int st = (r >> 4) * 2 + (c >> 5), rr = r & 15, cc = c & 31, ob = rr * 64 + cc * 2; return st * 1024 + (ob ^ (((ob >> 9) & 1) << 5)); }
__host__ __device__ __forceinline__ void stage_rc(int b, int& R, int& C) { const int st = b / 1024, sb = b % 1024, swz = sb ^ (((sb >> 9) & 1) << 5); R = (st >> 1) * 16 + swz / 64; C = (st & 1) * 32 + (swz % 64) / 2; }
__host__ __device__ __forceinline__ int perm32(int rho) { const int n = rho >> 4, i = rho & 15; return 8 * (i >> 2) + 4 * n + (i & 3); }

struct Unit { int pm, pn; };
struct Gemm { const bf16_t* A; const bf16_t* Bt; int M, N, K; int ld = 0; int nsp = 1; };

struct StaticOrder {
    int nM, nN, nwg, G, c;
    __host__ __device__ void init(int M, int N, int G_, int c_) { nM = M / BM; nN = N / BM; nwg = nM * nN; G = G_; c = c_; }
    __host__ __device__ bool next(int i, Unit& u) const {
        const long L = (long)i * G + c; if (L >= nwg) return false;
        int wgid = (int)L; { const int q = nwg / NXCD, r = nwg % NXCD, xcd = wgid % NXCD, off = wgid / NXCD; wgid = (xcd < r ? xcd * (q + 1) : r * (q + 1) + (xcd - r) * q) + off; }
        const int nig = WGM * nN, gid = wgid / nig, fm = gid * WGM, gsz = (nM - fm) < WGM ? (nM - fm) : WGM;
        u.pm = fm + ((wgid % nig) % gsz); u.pn = (wgid % nig) / gsz; return true;
    }
    __device__ __forceinline__ void a_ready(const Unit&) const {}
    __device__ __forceinline__ void done(const Unit&) const {}
};

__device__ __forceinline__ unsigned cvt_pk_bf16(float lo, float hi) { unsigned r; asm volatile("v_cvt_pk_bf16_f32 %0, %1, %2" : "=v"(r) : "v"(lo), "v"(hi)); return r; }
typedef float f32x2 __attribute__((ext_vector_type(2)));
__device__ __forceinline__ f32x2 gelu_pk(f32x2 v) {
    const f32x2 av = __builtin_elementwise_abs(v), d = av * 0.2316418882f + 1.0f;
    f32x2 t; t.x = __builtin_amdgcn_rcpf(d.x); t.y = __builtin_amdgcn_rcpf(d.y);
    f32x2 q = t * 0.5307027145f + (-0.7265760135f); q = q * t + 0.7107068705f; q = q * t + (-0.142248368f); q = q * t + 0.127414796f; q = q * t;
    const f32x2 s = (v * v) * (-0.72134752044f);
    f32x2 e; e.x = __builtin_amdgcn_exp2f(s.x); e.y = __builtin_amdgcn_exp2f(s.y);
    const f32x2 m = v * (q * e), r = v - m;
    f32x2 o; o.x = v.x < 0.f ? m.x : r.x; o.y = v.y < 0.f ? m.y : r.y; return o;
}

template <int ACT  > struct EpiBf16 {
    static constexpr bool PERM = true, AFTER_DRAIN = false; static_assert(ACT == 0 || ACT == 1, "EpiBf16: ACT is 0 (none) or 1 (gelu_pk)");
    bf16_t* O; int ldc; const float* bias; int split_cols; size_t split_stride; float scale0;
    __device__ __forceinline__ void operator()(const f32x4 (&acc)[2][2][4][2], const Unit& u, int wr, int wc, int fr, int fq) const {
        const int row0 = u.pm * BM + wr * 64 + fr; int colt = u.pn * BM; bf16_t* base = O;
        float sc = 1.f; if (split_cols) { const int t = colt / split_cols; base += (size_t)t * split_stride; colt -= t * split_cols; if (t == 0) sc = scale0; }
        const int col0 = colt + wc * 32 + 8 * fq, bcol0 = u.pn * BM + wc * 32 + 8 * fq;
        f32x4 bv[2][2];
#pragma unroll
        for (int bj = 0; bj < 2; ++bj)
#pragma unroll
            for (int n = 0; n < 2; ++n) bv[bj][n] = bias ? *(const f32x4*)(bias + bcol0 + bj * HALF + 4 * n) : (f32x4){0.f, 0.f, 0.f, 0.f};
#pragma unroll
        for (int ai = 0; ai < 2; ++ai)
#pragma unroll
            for (int m = 0; m < 4; ++m) { bf16_t* rowp = base + (size_t)(row0 + ai * HALF + m * 16) * ldc + col0;
#pragma unroll
                for (int bj = 0; bj < 2; ++bj) { f32x4 v0 = acc[ai][bj][m][0] + bv[bj][0], v1 = acc[ai][bj][m][1] + bv[bj][1];
                    if (ACT == 1) { f32x2 a = gelu_pk((f32x2){v0[0], v0[1]}), b = gelu_pk((f32x2){v0[2], v0[3]}), c = gelu_pk((f32x2){v1[0], v1[1]}), d = gelu_pk((f32x2){v1[2], v1[3]});
                        v0 = (f32x4){a.x, a.y, b.x, b.y}; v1 = (f32x4){c.x, c.y, d.x, d.y}; }
                    v0 = v0 * sc; v1 = v1 * sc; u32x4 w; w.x = cvt_pk_bf16(v0[0], v0[1]); w.y = cvt_pk_bf16(v0[2], v0[3]); w.z = cvt_pk_bf16(v1[0], v1[1]); w.w = cvt_pk_bf16(v1[2], v1[3]);
                    *(u32x4*)(rowp + bj * HALF) = w; } }
    }
};
template <class Epi, class Sched, bool ALIGN_EPI = false, bool SP2 = false>
__device__ __forceinline__ void gemm_phase(PG8_LAS unsigned char* lds, const Gemm g, const Sched& S, const Epi& E) {
    int tid_ = threadIdx.x; asm volatile("" : "+v"(tid_));
    const int tid = tid_, wid = __builtin_amdgcn_readfirstlane(tid >> 6), lane = tid & 63, wr = wid >> 2, wc = wid & 3, fr = lane & 15, fq = lane >> 4;
    const int K = g.K, nt = K / BK, ld = g.ld ? g.ld : g.K, nNr = g.N / BM / g.nsp;
    unsigned voffA[2], voffB[2];
#pragma unroll
    for (int i = 0; i < 2; ++i) { int R, C; stage_rc(tid * 16 + i * 8192, R, C); const int Rb = Epi::PERM ? ((R & ~31) + perm32(R & 31)) : R;
        voffA[i] = (unsigned)(R * ld + C) * 2u; voffB[i] = (unsigned)(Rb * ld + C) * 2u; }
    const size_t kstep = (size_t)(BK * 2);
    const size_t hstep = (size_t)HALF * ld * 2;
    const size_t tstep = 2 * hstep;
    const unsigned ldsw = (unsigned)wid * 1024u;
    const int aoff = lds_byte(wr * 64 + fr, fq * 8), boff = lds_byte(wc * 32 + fr, fq * 8);
#define PG8_SA(b, h) (((b) * 2 + (h)) * HTB)
#define PG8_SB(b, h) ((4 + (b) * 2 + (h)) * HTB)
#define PG8_STAGE(bufoff, gbase, voff) do { _Pragma("unroll") for (int _i = 0; _i < 2; ++_i) \
        __builtin_amdgcn_global_load_lds((const unsigned*)((const char*)(gbase) + (voff)[_i]), (PG8_LAS unsigned*)(lds + (bufoff) + ldsw + _i * 8192), 16, 0, 0); } while (0)
#define PG8_LDA(dst, b, h) do { _Pragma("unroll") for (int m = 0; m < 4; ++m) _Pragma("unroll") for (int k = 0; k < 2; ++k) dst[m][k] = *(const PG8_LAS bf16x8*)(lds + PG8_SA(b, h) + aoff + m * 2048 + k * 1024); } while (0)
#define PG8_LDB(dst, b, h) do { _Pragma("unroll") for (int n = 0; n < 2; ++n) _Pragma("unroll") for (int k = 0; k < 2; ++k) dst[n][k] = *(const PG8_LAS bf16x8*)(lds + PG8_SB(b, h) + boff + n * 2048 + k * 1024); } while (0)
#define PG8_MMA(ai, bj, At, Bt) do { __builtin_amdgcn_s_setprio(1); _Pragma("unroll") for (int m = 0; m < 4; ++m) _Pragma("unroll") for (int n = 0; n < 2; ++n) _Pragma("unroll") for (int k = 0; k < 2; ++k) \
        acc[ai][bj][m][n] = __builtin_amdgcn_mfma_f32_16x16x32_bf16(Bt[n][k], At[m][k], acc[ai][bj][m][n], 0, 0, 0); __builtin_amdgcn_s_setprio(0); } while (0)
#define PG8_WAIT_V(n) asm volatile("s_waitcnt vmcnt(" #n ")" ::: "memory")
#define PG8_WAIT_L(n) asm volatile("s_waitcnt lgkmcnt(" #n ")" ::: "memory")
#define PG8_BAR __builtin_amdgcn_s_barrier()
#define PG8_SCHED __builtin_amdgcn_sched_barrier(0)
    Unit cur, nxt; int ui = 0;
    if (!S.next(0, cur)) return;
    f32x4 acc[2][2][4][2];
#pragma unroll
    for (int a = 0; a < 2; ++a)
#pragma unroll
        for (int b = 0; b < 2; ++b)
#pragma unroll
            for (int m = 0; m < 4; ++m)
#pragma unroll
                for (int n = 0; n < 2; ++n) acc[a][b][m][n] = (f32x4){0.f, 0.f, 0.f, 0.f};
    bf16x8 At[4][2], B0[2][2], B1[2][2];
#define PG8_APTR(u) ((const char*)g.A + (size_t)(u).pm * tstep + (size_t)((u).pn / nNr) * K * 2)
#define PG8_BPTR(u) ((const char*)g.Bt + (size_t)((u).pn % nNr) * tstep + (size_t)((u).pn / nNr) * K * 2)
    const char* cA = PG8_APTR(cur); const char* cB = PG8_BPTR(cur);
    S.a_ready(cur);
    if constexpr (SP2) {
        PG8_STAGE(PG8_SB(0, 0), cB, voffB); PG8_STAGE(PG8_SB(0, 1), cB + hstep, voffB); PG8_STAGE(PG8_SA(0, 0), cA, voffA); PG8_STAGE(PG8_SA(0, 1), cA + hstep, voffA);
        if (wr == 1) PG8_BAR;
        PG8_WAIT_V(2); PG8_BAR;
        PG8_STAGE(PG8_SB(1, 0), cB + kstep, voffB); PG8_STAGE(PG8_SA(1, 0), cA + kstep, voffA); PG8_STAGE(PG8_SB(1, 1), cB + hstep + kstep, voffB);
        PG8_WAIT_V(6); PG8_BAR;
    } else {
        PG8_STAGE(PG8_SB(0, 0), cB, voffB); PG8_STAGE(PG8_SA(0, 0), cA, voffA); PG8_STAGE(PG8_SB(0, 1), cB + hstep, voffB); PG8_STAGE(PG8_SA(0, 1), cA + hstep, voffA);
        if (wr == 1) PG8_BAR;
        PG8_WAIT_V(4); PG8_BAR;
        PG8_STAGE(PG8_SB(1, 0), cB + kstep, voffB); PG8_STAGE(PG8_SA(1, 0), cA + kstep, voffA); PG8_STAGE(PG8_SB(1, 1), cB + hstep + kstep, voffB);
        PG8_WAIT_V(6); PG8_BAR;
    }
    for (;;) {
        const bool has_next = S.next(ui + 1, nxt);
        const char* nA = has_next ? PG8_APTR(nxt) : cA; const char* nB = has_next ? PG8_BPTR(nxt) : cB;
        for (int t = 0; t < nt; t += 2) {
            const bool last = (t == nt - 2);
            const char* a1 = cA + (size_t)(t + 1) * kstep;
            const char* a2 = last ? nA : cA + (size_t)(t + 2) * kstep; const char* b2 = last ? nB : cB + (size_t)(t + 2) * kstep;
            const char* a3 = a2 + kstep; const char* b3 = b2 + kstep;
            if (last && has_next) S.a_ready(nxt);
            if constexpr (SP2) {
            PG8_LDB(B0, 0, 0); PG8_LDB(B1, 0, 1); PG8_SCHED; PG8_LDA(At, 0, 0); PG8_STAGE(PG8_SA(1, 1), a1 + hstep, voffA);
            PG8_WAIT_V(8); PG8_WAIT_L(0); PG8_BAR; PG8_MMA(0, 0, At, B0); PG8_MMA(0, 1, At, B1); PG8_BAR; PG8_SCHED;
            PG8_LDA(At, 0, 1); PG8_STAGE(PG8_SB(0, 0), b2, voffB); PG8_STAGE(PG8_SB(0, 1), b2 + hstep, voffB); PG8_STAGE(PG8_SA(0, 0), a2, voffA);
            PG8_WAIT_V(8); PG8_WAIT_L(0); PG8_BAR; PG8_MMA(1, 0, At, B0); PG8_MMA(1, 1, At, B1); PG8_BAR; PG8_SCHED;
            PG8_LDB(B0, 1, 0); PG8_LDB(B1, 1, 1); PG8_SCHED; PG8_LDA(At, 1, 0); PG8_STAGE(PG8_SA(0, 1), a2 + hstep, voffA);
            PG8_WAIT_V(8); PG8_WAIT_L(0); PG8_BAR; PG8_MMA(0, 0, At, B0); PG8_MMA(0, 1, At, B1); PG8_BAR; PG8_SCHED;
            PG8_LDA(At, 1, 1); PG8_STAGE(PG8_SB(1, 0), b3, voffB); PG8_STAGE(PG8_SB(1, 1), b3 + hstep, voffB); PG8_STAGE(PG8_SA(1, 0), a3, voffA);
            PG8_WAIT_V(8); PG8_WAIT_L(0); PG8_BAR; PG8_MMA(1, 0, At, B0); PG8_MMA(1, 1, At, B1); PG8_BAR; PG8_SCHED;
            } else {
            PG8_LDB(B0, 0, 0); PG8_SCHED; PG8_LDA(At, 0, 0); PG8_STAGE(PG8_SA(1, 1), a1 + hstep, voffA);
            PG8_WAIT_L(8); PG8_BAR; PG8_WAIT_L(0); PG8_MMA(0, 0, At, B0); PG8_BAR; PG8_SCHED;
            PG8_LDB(B1, 0, 1); PG8_STAGE(PG8_SB(0, 0), b2, voffB);
            PG8_BAR; PG8_WAIT_L(0); PG8_MMA(0, 1, At, B1); PG8_BAR;
            PG8_LDA(At, 0, 1); PG8_STAGE(PG8_SA(0, 0), a2, voffA);
            PG8_BAR; PG8_WAIT_L(0); PG8_MMA(1, 0, At, B0); PG8_BAR; PG8_SCHED;
            PG8_STAGE(PG8_SB(0, 1), b2 + hstep, voffB);
            PG8_WAIT_V(6); PG8_BAR; PG8_MMA(1, 1, At, B1); PG8_BAR;
            PG8_LDB(B0, 1, 0); PG8_SCHED; PG8_LDA(At, 1, 0); PG8_STAGE(PG8_SA(0, 1), a2 + hstep, voffA);
            PG8_WAIT_L(8); PG8_BAR; PG8_WAIT_L(0); PG8_MMA(0, 0, At, B0); PG8_BAR; PG8_SCHED;
            PG8_LDB(B1, 1, 1); PG8_STAGE(PG8_SB(1, 0), b3, voffB);
            PG8_BAR; PG8_WAIT_L(0); PG8_MMA(0, 1, At, B1); PG8_BAR;
            PG8_LDA(At, 1, 1); PG8_STAGE(PG8_SA(1, 0), a3, voffA);
            PG8_BAR; PG8_WAIT_L(0); PG8_MMA(1, 0, At, B0); PG8_BAR; PG8_SCHED;
            PG8_STAGE(PG8_SB(1, 1), b3 + hstep, voffB);
            PG8_WAIT_V(6); PG8_BAR; PG8_MMA(1, 1, At, B1); PG8_BAR;
            }
        }
        if constexpr (ALIGN_EPI) { if (wr == 0) PG8_BAR; }
        if constexpr (!Epi::AFTER_DRAIN) { E(acc, cur, wr, wc, fr, fq); S.done(cur); }
        if (!has_next) break;
#pragma unroll
        for (int a = 0; a < 2; ++a)
#pragma unroll
            for (int b = 0; b < 2; ++b)
#pragma unroll
                for (int m = 0; m < 4; ++m)
#pragma unroll
                    for (int n = 0; n < 2; ++n) acc[a][b][m][n] = (f32x4){0.f, 0.f, 0.f, 0.f};
        cur = nxt; cA = nA; cB = nB; ++ui;
        if constexpr (ALIGN_EPI) { if (wr == 1) PG8_BAR; }
    }
    PG8_WAIT_V(0);
    if constexpr (!ALIGN_EPI) { if (wr == 0) PG8_BAR; }
    PG8_BAR;
    if constexpr (Epi::AFTER_DRAIN) { E.fused(acc, cur, wr, wc, fr, fq, lds, wid, lane); S.done(cur); }
#undef PG8_APTR
#undef PG8_BPTR
#undef PG8_SA
#undef PG8_SB
#undef PG8_STAGE
#undef PG8_LDA
#undef PG8_LDB
#undef PG8_MMA
#undef PG8_WAIT_V
#undef PG8_WAIT_L
#undef PG8_BAR
#undef PG8_SCHED
}
}

constexpr int DM = 2048, NTOK = 6144, NCTX = 4096, DEPTH = 4;
constexpr int CW = 1024, SW = 1024, INC = 4096, DFF = 5632, UPN = 2 * DFF;
constexpr float EPS = 1e-6f;
constexpr int NWAVES = 8;

constexpr size_t MiB = 1u << 20;
constexpr size_t WS_CTL = 0, CTL_ZERO_BYTES = 1 * MiB;
constexpr size_t WS_MOD = 1 * MiB;
constexpr size_t WS_WIN = 2 * MiB, WS_WGLU = 66 * MiB, WS_WOUT = 74 * MiB, WS_WUP = 106 * MiB, WS_WDN = 282 * MiB;
constexpr size_t WS_H = 370 * MiB;
constexpr size_t WS_GB = 394 * MiB, WS_V = 406 * MiB, WS_U = 418 * MiB;
constexpr size_t WS_Z = 430 * MiB, WS_O = 442 * MiB;
constexpr size_t WS_MIXIN = 454 * MiB, WS_MIXED = 478 * MiB;
constexpr size_t WS_UP = 502 * MiB;
constexpr size_t WS_ACT = 634 * MiB;
constexpr size_t WS_FF = 700 * MiB;
constexpr size_t WS_END = 724 * MiB;
constexpr int CW_SUB = 12288;
constexpr size_t WS_FFP = WS_UP;
constexpr int CW_BAR = 4096;

constexpr int RING_BYTES = 131072;
constexpr int LDS_BYTES = 147456;
constexpr int LDSCTL_OFF = LDS_BYTES - 512, MISC_OFF = LDSCTL_OFF;

#define GAS __attribute__((address_space(1)))
#define LAS __attribute__((address_space(3)))
typedef unsigned short bf16;
typedef unsigned v4u __attribute__((ext_vector_type(4)));
typedef unsigned v2u __attribute__((ext_vector_type(2)));
typedef float f32x4 __attribute__((ext_vector_type(4)));
typedef float f32x2 __attribute__((ext_vector_type(2)));
typedef float f32x16 __attribute__((ext_vector_type(16)));
typedef short bf16x8 __attribute__((ext_vector_type(8)));
typedef GAS unsigned gu32;
#define LDS_WAIT() asm volatile("s_waitcnt lgkmcnt(0)" ::: "memory")

__device__ __forceinline__ unsigned f2bf(float f) { unsigned u = __builtin_bit_cast(unsigned, f); return (u + 0x7fffu + ((u >> 16) & 1u)) >> 16; }
__device__ __forceinline__ unsigned pk2(float lo, float hi) { unsigned r; asm("v_cvt_pk_bf16_f32 %0, %1, %2" : "=v"(r) : "v"(lo), "v"(hi)); return r; }
__device__ __forceinline__ float bflo(unsigned w) { return __uint_as_float(w << 16); }
__device__ __forceinline__ float bfhi(unsigned w) { return __uint_as_float(w & 0xffff0000u); }
__device__ __forceinline__ void unpack8(const v4u w, float (&f)[8]) { f[0] = bflo(w.x); f[1] = bfhi(w.x); f[2] = bflo(w.y); f[3] = bfhi(w.y); f[4] = bflo(w.z); f[5] = bfhi(w.z); f[6] = bflo(w.w); f[7] = bfhi(w.w); }
__device__ __forceinline__ v4u pack8(const float (&f)[8]) { v4u w; w.x = pk2(f[0], f[1]); w.y = pk2(f[2], f[3]); w.z = pk2(f[4], f[5]); w.w = pk2(f[6], f[7]); return w; }
__device__ __forceinline__ float wave_sum(float v) {
#pragma unroll
    for (int o = 1; o < 64; o <<= 1) v += __shfl_xor(v, o);
    return v;
}
__device__ __forceinline__ float sigmoidf_(float x) { return 1.0f / (1.0f + __expf(-x)); }
__device__ __forceinline__ float gelu_tanh(float y) { const float v = 0.7978845608028654f * (y + 0.044715f * y * y * y); const float t = 1.0f - 2.0f / (__expf(2.0f * v) + 1.0f); return 0.5f * y * (1.0f + t); }
__device__ __forceinline__ void sincos_cw(float x, float& s, float& c) {
    const float k = rintf(x * 0.6366197723675814f);
    float r = fmaf(k, -1.5707963705062866f, x);
    r = fmaf(k, 4.371138828673793e-08f, r);
    r = fmaf(k, 1.7763568394002505e-15f, r);
    const float r2 = r * r;
    const float sp = r + r * r2 * fmaf(r2, fmaf(r2, -1.9515295891e-4f, 8.3321608736e-3f), -1.6666654611e-1f);
    const float cp = fmaf(r2 * r2, fmaf(r2, fmaf(r2, 2.443315711809948e-5f, -1.388731625493765e-3f), 4.166664568298827e-2f), fmaf(r2, -0.5f, 1.0f));
    const int q = ((int)k) & 3;
    const float ss = (q & 1) ? cp : sp, cc = (q & 1) ? sp : cp;
    s = (q & 2) ? -ss : ss;
    c = ((q + 1) & 2) ? -cc : cc;
}

__device__ __forceinline__ int fresh_v(int x) { asm volatile("" : "+v"(x)); return x; }
__device__ __forceinline__ int fresh_s(int x) { asm volatile("" : "+s"(x)); return x; }
struct Args { const float* in[30]; float* out; unsigned char* ws; };
struct KImg { unsigned long long in[30]; unsigned long long out; unsigned long long ws; };
struct DArgs { const float* in[30]; float* out; unsigned char* ws; };
__device__ __forceinline__ DArgs load_args() {
    const __attribute__((address_space(4))) KImg* p = (const __attribute__((address_space(4))) KImg*)__builtin_amdgcn_kernarg_segment_ptr();
    asm volatile("" : "+s"(p));
    DArgs a;
#pragma unroll
    for (int i = 0; i < 30; ++i) a.in[i] = (const float*)(GAS const float*)p->in[i];
    a.out = (float*)(GAS float*)p->out; a.ws = (unsigned char*)(GAS unsigned char*)p->ws;
    return a;
}
enum { I_XP = 0, I_XS, I_SRE, I_SIM, I_C, I_CCTX, I_WADA, I_BADA, I_GPRE1, I_WIN, I_CONVW, I_ARE, I_AIM, I_LOGDT, I_BRE, I_BIM, I_CRE, I_CIM, I_SSMD, I_WGLU, I_BGLU,
       I_GCONV, I_GSSM, I_WOUT, I_GPOST1, I_GPRE2, I_WUP, I_FFNW, I_WDOWN, I_GPOST2 };

namespace pg8 {
struct EpiIn {
    static constexpr bool PERM = true, AFTER_DRAIN = false;
    bf16_t *GB, *V, *U;
    __device__ __forceinline__ void operator()(const f32x4 (&acc)[2][2][4][2], const Unit& u, int wr, int wc, int fr, int fq) const {
        const int row0 = u.pm * BM + wr * 64 + fr;
        if (u.pn < 8) {
            const int col0 = u.pn * 128 + wc * 32 + 8 * fq;
#pragma unroll
            for (int ai = 0; ai < 2; ++ai)
#pragma unroll
                for (int m = 0; m < 4; ++m) { bf16_t* rowp = V + (size_t)(row0 + ai * HALF + m * 16) * 1024 + col0;
                    const f32x4 v0 = acc[ai][0][m][0] * acc[ai][1][m][0], v1 = acc[ai][0][m][1] * acc[ai][1][m][1];
                    u32x4 w; w.x = cvt_pk_bf16(v0[0], v0[1]); w.y = cvt_pk_bf16(v0[2], v0[3]); w.z = cvt_pk_bf16(v1[0], v1[1]); w.w = cvt_pk_bf16(v1[2], v1[3]);
                    *(u32x4*)rowp = w; }
        } else {
            const int col0 = (u.pn - 8) * 128 + wc * 32 + 8 * fq;
#pragma unroll
            for (int ai = 0; ai < 2; ++ai)
#pragma unroll
                for (int m = 0; m < 4; ++m) { const size_t off = (size_t)(row0 + ai * HALF + m * 16) * 1024 + col0;
#pragma unroll
                    for (int bj = 0; bj < 2; ++bj) { const f32x4 v0 = acc[ai][bj][m][0], v1 = acc[ai][bj][m][1];
                        u32x4 w; w.x = cvt_pk_bf16(v0[0], v0[1]); w.y = cvt_pk_bf16(v0[2], v0[3]); w.z = cvt_pk_bf16(v1[0], v1[1]); w.w = cvt_pk_bf16(v1[2], v1[3]);
                        *(u32x4*)((bj ? U : GB) + off) = w; } }
        }
    }
};
struct EpiGlu {
    static constexpr bool PERM = true, AFTER_DRAIN = false;
    const bf16_t* Z; bf16_t* O; const float* bias;
    __device__ __forceinline__ void operator()(const f32x4 (&acc)[2][2][4][2], const Unit& u, int wr, int wc, int fr, int fq) const {
        const int row0 = u.pm * BM + wr * 64 + fr, col0 = u.pn * BM + wc * 32 + 8 * fq;
        f32x4 bv[2][2];
#pragma unroll
        for (int bj = 0; bj < 2; ++bj)
#pragma unroll
            for (int n = 0; n < 2; ++n) bv[bj][n] = *(const f32x4*)(bias + col0 + bj * HALF + 4 * n);
#pragma unroll
        for (int ai = 0; ai < 2; ++ai)
#pragma unroll
            for (int m = 0; m < 4; ++m) { const size_t off = (size_t)(row0 + ai * HALF + m * 16) * 1024 + col0;
#pragma unroll
                for (int bj = 0; bj < 2; ++bj) { const u32x4 zw = *(const u32x4*)(Z + off + bj * HALF);
                    const f32x4 g0 = acc[ai][bj][m][0] + bv[bj][0], g1 = acc[ai][bj][m][1] + bv[bj][1];
                    float z[8]; z[0] = __uint_as_float(zw.x << 16); z[1] = __uint_as_float(zw.x & 0xffff0000u); z[2] = __uint_as_float(zw.y << 16); z[3] = __uint_as_float(zw.y & 0xffff0000u);
                    z[4] = __uint_as_float(zw.z << 16); z[5] = __uint_as_float(zw.z & 0xffff0000u); z[6] = __uint_as_float(zw.w << 16); z[7] = __uint_as_float(zw.w & 0xffff0000u);
                    float o[8];
#pragma unroll
                    for (int j = 0; j < 4; ++j) { o[j] = z[j] / (1.0f + __expf(-g0[j])); o[4 + j] = z[4 + j] / (1.0f + __expf(-g1[j])); }
                    u32x4 w; w.x = cvt_pk_bf16(o[0], o[1]); w.y = cvt_pk_bf16(o[2], o[3]); w.z = cvt_pk_bf16(o[4], o[5]); w.w = cvt_pk_bf16(o[6], o[7]);
                    *(u32x4*)(O + off + bj * HALF) = w; } }
    }
};
typedef unsigned u32x2 __attribute__((ext_vector_type(2)));
struct EpiFfn {
    static constexpr bool PERM = true, AFTER_DRAIN = false;
    bf16_t* ACT; const float* fw; PG8_LAS float* xch;
    static __device__ __forceinline__ float ror8(float v) { return __builtin_bit_cast(float, __builtin_amdgcn_mov_dpp(__builtin_bit_cast(int, v), 0x128  , 0xf, 0xf, true)); }
    static __device__ __forceinline__ f32x4 shx8(const f32x4 v) { f32x4 r; r[0] = ror8(v[0]); r[1] = ror8(v[1]); r[2] = ror8(v[2]); r[3] = ror8(v[3]); return r; }
    static __device__ __forceinline__ f32x4 shl(const f32x4 v, int src) { f32x4 r; r[0] = __shfl(v[0], src); r[1] = __shfl(v[1], src); r[2] = __shfl(v[2], src); r[3] = __shfl(v[3], src); return r; }
    static __device__ __forceinline__ f32x4 sel(bool c, const f32x4 a, const f32x4 b) { f32x4 r; r[0] = c ? a[0] : b[0]; r[1] = c ? a[1] : b[1]; r[2] = c ? a[2] : b[2]; r[3] = c ? a[3] : b[3]; return r; }
    __device__ __forceinline__ void operator()(const f32x4 (&acc)[2][2][4][2], const Unit& u, int wr, int wc, int fr, int fq) const {
        const bool ctx = u.pm < 16, h = (fr >> 3) != 0;
        const int c7 = fr & 7, lane = fq * 16 + fr, ch0 = u.pn * 128 + wc * 32 + 8 * fq;
        const f32x4 zero = {0.f, 0.f, 0.f, 0.f};
        f32x4 wa[2][3], wg[2][3];
#pragma unroll
        for (int k = 0; k < 3; ++k) { wa[0][k] = *(const f32x4*)(fw + k * (2 * 5632) + ch0); wg[0][k] = *(const f32x4*)(fw + k * (2 * 5632) + 5632 + ch0); }
        if (ctx) {
            if (wr == 0 && fr == 15) { PG8_LAS f32x4* p = (PG8_LAS f32x4*)(xch + ((wc * 2 + 0) * 4 + fq) * 16); p[0] = acc[1][0][3][0]; p[1] = acc[1][0][3][1]; p[2] = acc[1][1][3][0]; p[3] = acc[1][1][3][1]; }
            if (wr == 1 && fr == 0)  { PG8_LAS f32x4* p = (PG8_LAS f32x4*)(xch + ((wc * 2 + 1) * 4 + fq) * 16); p[0] = acc[0][0][0][0]; p[1] = acc[0][0][0][1]; p[2] = acc[0][1][0][0]; p[3] = acc[0][1][0][1]; }
            asm volatile("s_waitcnt lgkmcnt(0)" ::: "memory"); __builtin_amdgcn_s_barrier(); asm volatile("" ::: "memory");
        }
        const int srcp = (lane + 7) & 63, srcn = (lane - 7) & 63;
        u32x2 keep[8];
#pragma unroll
        for (int n = 0; n < 2; ++n) {
            f32x4 bpa = shl(acc[1][0][3][n], srcp), bpg = shl(acc[1][1][3][n], srcp), bna = shl(acc[0][0][0][n], srcn), bng = shl(acc[0][1][0][n], srcn);
            if (ctx) {
                const PG8_LAS f32x4* p0 = (const PG8_LAS f32x4*)(xch + ((wc * 2 + 0) * 4 + fq) * 16); const PG8_LAS f32x4* p1 = (const PG8_LAS f32x4*)(xch + ((wc * 2 + 1) * 4 + fq) * 16);
                const f32x4 xpa = p0[n], xpg = p0[2 + n], xna = p1[n], xng = p1[2 + n];
                bpa = sel(c7 >= 1, bpa, sel(wr == 1, xpa, zero)); bpg = sel(c7 >= 1, bpg, sel(wr == 1, xpg, zero));
                bna = sel(c7 <= 6, bna, sel(wr == 0, xna, zero)); bng = sel(c7 <= 6, bng, sel(wr == 0, xng, zero));
            } else { bpa = zero; bpg = zero; bna = zero; bng = zero; }
            if (n == 0) {
#pragma unroll
                for (int k = 0; k < 3; ++k) { wa[1][k] = *(const f32x4*)(fw + k * (2 * 5632) + ch0 + 4); wg[1][k] = *(const f32x4*)(fw + k * (2 * 5632) + 5632 + ch0 + 4); }
            }
            f32x4 ea0 = shx8(acc[0][0][0][n]), eg0 = shx8(acc[0][1][0][n]);
            f32x4 pa = sel(h, ea0, bpa), pg = sel(h, eg0, bpg);
#pragma unroll
            for (int s = 0; s < 8; ++s) { const int ai = s >> 2, m = s & 3;
                const f32x4 eap = s < 7 ? shx8(acc[(s + 1) >> 2][0][(s + 1) & 3][n]) : bna, egp = s < 7 ? shx8(acc[(s + 1) >> 2][1][(s + 1) & 3][n]) : bng;
                const f32x4 xa = acc[ai][0][m][n], xg = acc[ai][1][m][n];
                const f32x4 na = sel(h, eap, ea0), ng = sel(h, egp, eg0);
                const f32x4 ca = wa[n][0] * pa + wa[n][1] * xa + wa[n][2] * na, cg = wg[n][0] * pg + wg[n][1] * xg + wg[n][2] * ng;
                const f32x4 t = cg * ca, ex = cg * (-1.442695041f);
                f32x4 den; den[0] = __builtin_amdgcn_exp2f(ex[0]); den[1] = __builtin_amdgcn_exp2f(ex[1]); den[2] = __builtin_amdgcn_exp2f(ex[2]); den[3] = __builtin_amdgcn_exp2f(ex[3]);
                den = den + 1.0f;
                f32x4 rc; rc[0] = __builtin_amdgcn_rcpf(den[0]); rc[1] = __builtin_amdgcn_rcpf(den[1]); rc[2] = __builtin_amdgcn_rcpf(den[2]); rc[3] = __builtin_amdgcn_rcpf(den[3]);
                const f32x4 o = t * rc;
                u32x2 w; w.x = cvt_pk_bf16(o[0], o[1]); w.y = cvt_pk_bf16(o[2], o[3]);
                if (n == 0) keep[s] = w;
                else { u32x4 w4; w4.x = keep[s].x; w4.y = keep[s].y; w4.z = w.x; w4.w = w.y; *(u32x4*)(ACT + (size_t)(u.pm * BM + ai * HALF + wr * 64 + m * 16 + fr) * 5632 + ch0) = w4; }
                pa = na; pg = ng; ea0 = eap; eg0 = egp;
            }
        }
    }
};
struct G4Order {
    int lo, hi, G, c; bool plain;
    __device__ __forceinline__ bool next(int i, Unit& u) const {
        const int L = lo + i * G + c; if (L >= hi) return false;
        StaticOrder so; so.init(24 * BM, 44 * BM, 1, 0);
        if (plain) return so.next(L, u);
        if (L >= 1024) { u.pm = 23; u.pn = 12 + (L - 1024); return true; }
        so.next(L, u); if (u.pm == 23 && u.pn >= 12) so.next(1024 + u.pn - 12, u);
        return true;
    }
    __device__ __forceinline__ void a_ready(const Unit&) const {}
    __device__ __forceinline__ void done(const Unit&) const {}
};
struct G5Order {
    bool st; StaticOrder so; Unit u0;
    __device__ __forceinline__ bool next(int i, Unit& u) const { if (st) return so.next(i, u); if (i != 0 || u0.pm < 0) return false; u = u0; return true; }
    __device__ __forceinline__ void a_ready(const Unit&) const {}
    __device__ __forceinline__ void done(const Unit&) const {}
};
}

__device__ __forceinline__ void cvt_load(const float* __restrict__ W, int N, int k0, int n0, int tid, f32x4 (&r0)[4], f32x4 (&r1)[4]) {
    const int n4 = tid & 31, kp = tid >> 5;
#pragma unroll
    for (int i = 0; i < 4; ++i) { const float* p = W + (size_t)(k0 + 2 * kp + 32 * i) * N + n0 + 4 * n4; r0[i] = __builtin_nontemporal_load((const f32x4*)p); r1[i] = __builtin_nontemporal_load((const f32x4*)(p + N)); }
}
__device__ __forceinline__ void cvt_put(LAS unsigned* T, int tid, const f32x4 (&r0)[4], const f32x4 (&r1)[4]) {
    const int n4 = tid & 31, kp = tid >> 5;
#pragma unroll
    for (int i = 0; i < 4; ++i)
#pragma unroll
        for (int e = 0; e < 4; ++e) T[(4 * n4 + e) * 65 + kp + 16 * i] = pk2(r0[i][e], r1[i][e]);
}
__device__ __forceinline__ void cvt_store(const LAS unsigned* T, bf16* __restrict__ Bt, int K, int k0, int j0, int tid) {
    const int n = tid >> 2, kc = tid & 3;
    unsigned w[16];
#pragma unroll
    for (int i = 0; i < 16; ++i) w[i] = T[n * 65 + 16 * kc + i];
    v4u* dst = (v4u*)(Bt + (size_t)(j0 + n) * K + k0 + 32 * kc);
#pragma unroll
    for (int q = 0; q < 4; ++q) { v4u o; o.x = w[4 * q]; o.y = w[4 * q + 1]; o.z = w[4 * q + 2]; o.w = w[4 * q + 3]; dst[q] = o; }
}
constexpr int CVT_PER_LAYER = 512 + 64 + 256 + 1408 + 704;
struct CvtD { const float* W; bf16* Bt; int N, K, k0, n0, j0; };
__device__ __forceinline__ CvtD cvt_desc(const DArgs& a, int it) {
    const int l = it / CVT_PER_LAYER; int r = it % CVT_PER_LAYER;
    const float* W; bf16* Bt; int N, K, jb, kb, n0;
    if (r < 512) { N = INC; K = DM; W = a.in[I_WIN] + (size_t)l * K * N; Bt = (bf16*)(a.ws + WS_WIN) + (size_t)l * N * K; kb = r >> 5; jb = r & 31;
        const int pn = jb >> 1, bj = jb & 1; n0 = pn < 8 ? ((bj ? 2048 : 1024) + 128 * pn) : ((bj ? 3072 : 0) + 128 * (pn - 8)); }
    else if (r < 576) { r -= 512; N = SW; K = SW; W = a.in[I_WGLU] + (size_t)l * K * N; Bt = (bf16*)(a.ws + WS_WGLU) + (size_t)l * N * K; kb = r >> 3; jb = r & 7; n0 = 128 * jb; }
    else if (r < 832) { r -= 576; N = DM; K = DM; W = a.in[I_WOUT] + (size_t)l * K * N; Bt = (bf16*)(a.ws + WS_WOUT) + (size_t)l * N * K; kb = r >> 4; jb = r & 15; n0 = 128 * jb; }
    else if (r < 2240) { r -= 832; N = UPN; K = DM; W = a.in[I_WUP] + (size_t)l * K * N; Bt = (bf16*)(a.ws + WS_WUP) + (size_t)l * N * K; kb = r / 88; jb = r % 88; n0 = ((jb & 1) ? DFF : 0) + 128 * (jb >> 1); }
    else { r -= 2240; N = DM; K = DFF; W = a.in[I_WDOWN] + (size_t)l * K * N; Bt = (bf16*)(a.ws + WS_WDN) + (size_t)l * N * K; kb = r >> 4; jb = r & 15; n0 = 128 * jb; }
    CvtD d; d.W = W; d.Bt = Bt; d.N = N; d.K = K; d.k0 = 128 * kb; d.n0 = n0; d.j0 = 128 * jb; return d;
}

constexpr int CW_CVT = 8192;
#define CVT_LDS_BAR() asm volatile("s_waitcnt lgkmcnt(0)\n\ts_barrier" ::: "memory")
__device__ __forceinline__ void cvt_fill(LAS unsigned char* lds, int tid_, int ln, int budget  ) {
    const int tid = fresh_v(tid_);
    volatile LAS unsigned* tk = (volatile LAS unsigned*)(lds + MISC_OFF) + 16;
    LAS unsigned* T0 = (LAS unsigned*)lds; LAS unsigned* T1 = T0 + 128 * 65;
    const int npairs = budget < 0 ? 0x7fffffff : (budget + 1) / 2;
    if (npairs <= 0) return;
    if (tid == 0) { const DArgs a = load_args(); tk[0] = __hip_atomic_fetch_add((unsigned*)(a.ws + WS_CTL) + CW_CVT + 64 * ln, 1u, __ATOMIC_RELAXED, __HIP_MEMORY_SCOPE_AGENT); }
    __syncthreads();
    for (int n = 0; n < npairs; ++n) {
        const unsigned t = tk[n & 1];
        if (2u * t >= (unsigned)CVT_PER_LAYER) break;
        const DArgs a = load_args();
        unsigned nx = 0xffffffffu;
        if (tid == 0 && n + 1 < npairs) nx = __hip_atomic_fetch_add((unsigned*)(a.ws + WS_CTL) + CW_CVT + 64 * ln, 1u, __ATOMIC_RELAXED, __HIP_MEMORY_SCOPE_AGENT);
        const CvtD d0 = cvt_desc(a, ln * CVT_PER_LAYER + 2 * (int)t), d1 = cvt_desc(a, ln * CVT_PER_LAYER + 2 * (int)t + 1);
        f32x4 a0[4], a1[4], b0[4], b1[4];
        cvt_load(d0.W, d0.N, d0.k0, d0.n0, tid, a0, a1); cvt_load(d1.W, d1.N, d1.k0, d1.n0, tid, b0, b1);
        cvt_put(T0, tid, a0, a1); cvt_put(T1, tid, b0, b1);
        if (tid == 0) tk[(n + 1) & 1] = nx;
        CVT_LDS_BAR();
        cvt_store(T0, d0.Bt, d0.K, d0.k0, d0.j0, tid); cvt_store(T1, d1.Bt, d1.K, d1.k0, d1.j0, tid);
        CVT_LDS_BAR();
    }
    __syncthreads();
}
__device__ __forceinline__ void mod_task(LAS unsigned char* lds, int tid_, int lane_, int wave_, int task) {
    const DArgs a = load_args(); const int tid = fresh_v(tid_), lane = fresh_v(lane_), wave = fresh_s(wave_);
    LAS float* SC = (LAS float*)(lds + 36864);
    LAS float* RED = (LAS float*)(lds + 36864 + 24576);
    const int l = task / 48, j0 = (task % 48) * 256;
    for (int i = tid; i < 3 * DM; i += 512) { const int v = i >> 11, k = i & 2047; const float x = v == 0 ? a.in[I_CCTX][k] : a.in[I_C][(v - 1) * DM + k]; SC[i] = x / (1.0f + __expf(-x)); }
    __syncthreads();
    const float* W = a.in[I_WADA] + (size_t)l * DM * 12288 + j0 + 4 * lane;
    f32x4 a0 = {0.f, 0.f, 0.f, 0.f}, a1 = a0, a2 = a0;
    const int kbeg = wave * 256;
    for (int k = kbeg; k < kbeg + 256; k += 8) {
        f32x4 w[8];
#pragma unroll
        for (int u = 0; u < 8; ++u) w[u] = __builtin_nontemporal_load((const f32x4*)(W + (size_t)(k + u) * 12288));
#pragma unroll
        for (int u = 0; u < 8; ++u) { const float s0 = SC[k + u], s1 = SC[2048 + k + u], s2 = SC[4096 + k + u]; a0 += w[u] * s0; a1 += w[u] * s1; a2 += w[u] * s2; }
    }
    *(LAS f32x4*)(RED + (wave * 3 + 0) * 256 + 4 * lane) = a0;
    *(LAS f32x4*)(RED + (wave * 3 + 1) * 256 + 4 * lane) = a1;
    *(LAS f32x4*)(RED + (wave * 3 + 2) * 256 + 4 * lane) = a2;
    __syncthreads();
    float* MOD = (float*)(a.ws + WS_MOD);
    for (int i = tid; i < 768; i += 512) { const int v = i >> 8, jj = i & 255; float s = a.in[I_BADA][l * 12288 + j0 + jj];
#pragma unroll
        for (int w8 = 0; w8 < 8; ++w8) s += RED[(w8 * 3 + v) * 256 + jj];
        const int ch = (j0 + jj) >> 11, e = (j0 + jj) & 2047;
        if (ch == 1) s = (1.0f + s) * a.in[I_GPRE1][l * DM + e]; else if (ch == 2) s *= a.in[I_GPOST1][l * DM + e];
        else if (ch == 4) s = (1.0f + s) * a.in[I_GPRE2][l * DM + e]; else if (ch == 5) s *= a.in[I_GPOST2][l * DM + e];
        MOD[(size_t)(l * 3 + v) * 12288 + j0 + jj] = s; }
    __syncthreads();
}

__device__ __forceinline__ int mod_vec(int row) { return row < NCTX ? 0 : 1 + ((row - NCTX) >> 10); }
__device__ __forceinline__ int perm_row(int row) {
    int gr, cc, base;
    if (row < NCTX) { const int t = row & 255; gr = t & 15; cc = t >> 4; base = row & ~255; }
    else { const int q = row - NCTX, p = q & 1023; gr = p >> 6; cc = p & 15; base = NCTX + ((q >> 10) * 4 + ((p >> 4) & 3)) * 256; }
    return base + 128 * (gr >> 3) + 64 * (cc >> 3) + 16 * ((gr >> 1) & 3) + 8 * (gr & 1) + (cc & 7);
}
constexpr size_t WS_XH = WS_UP + 8 * MiB, WS_XL = WS_UP + 40 * MiB;
__device__ __forceinline__ void x24_load(const unsigned char* ws, int row, int e0, float (&o)[8]) {
    const v4u h = *(const v4u*)((const unsigned short*)(ws + WS_XH) + (size_t)row * DM + e0); const v2u lo = *(const v2u*)(ws + WS_XL + (size_t)row * DM + e0);
    const unsigned hw[4] = {h.x, h.y, h.z, h.w}, lw[2] = {lo.x, lo.y};
#pragma unroll
    for (int i = 0; i < 8; ++i) { const unsigned hi = (i & 1) ? (hw[i >> 1] & 0xffff0000u) : (hw[i >> 1] << 16); const unsigned l8 = (lw[i >> 2] >> (8 * (i & 3))) & 0xffu; o[i] = __uint_as_float(hi | (l8 << 8)); }
}
__device__ __forceinline__ void x24_store(unsigned char* ws, int row, int e0, const float (&x)[8]) {
    unsigned b[8];
#pragma unroll
    for (int i = 0; i < 8; ++i) b[i] = __float_as_uint(x[i]) + 0x80u;
    v4u h; h.x = (b[0] >> 16) | (b[1] & 0xffff0000u); h.y = (b[2] >> 16) | (b[3] & 0xffff0000u); h.z = (b[4] >> 16) | (b[5] & 0xffff0000u); h.w = (b[6] >> 16) | (b[7] & 0xffff0000u);
    v2u lo; lo.x = ((b[0] >> 8) & 0xffu) | (b[1] & 0xff00u) | ((b[2] << 8) & 0xff0000u) | ((b[3] << 16) & 0xff000000u); lo.y = ((b[4] >> 8) & 0xffu) | (b[5] & 0xff00u) | ((b[6] << 8) & 0xff0000u) | ((b[7] << 16) & 0xff000000u);
    *(v4u*)((unsigned short*)(ws + WS_XH) + (size_t)row * DM + e0) = h; *(v2u*)(ws + WS_XL + (size_t)row * DM + e0) = lo;
}
template <int MODE>
__device__ __forceinline__ void row_pass(int l, int bx_, int G_, int wave_, int lane_, bool split23 = false) {
    const int bx = fresh_s(bx_), G = fresh_s(G_), wave = fresh_s(wave_), lane = fresh_v(lane_);
    constexpr bool FIRST = (MODE == 0), HAS_NEXT = (MODE != 3);
    const DArgs a = load_args();
    const float* MOD = (const float*)(a.ws + WS_MOD);
    const float* modl = MOD + (size_t)l * 3 * 12288;
    const bf16* Y = (const bf16*)(a.ws + (MODE == 1 ? WS_MIXED : WS_FF));
    const float* modg = modl + (MODE == 1 ? 2 : 5) * DM;
    const float* modn = MODE == 2 ? modl + 3 * 12288 : modl;
    const int sc_off = (MODE == 1 ? 4 : 1) * DM, sh_off = (MODE == 1 ? 3 : 0) * DM;
    bf16* Hdst = (bf16*)(a.ws + WS_H);
    const int rpw = (NTOK + G * NWAVES - 1) / (G * NWAVES), rbeg = (bx * NWAVES + wave) * rpw, rend = rbeg + rpw < NTOK ? rbeg + rpw : NTOK;
    int vprev = -1;
    f32x4 gv[8], cv[8], hv[8];
#pragma unroll
    for (int j = 0; j < 8; ++j) { gv[j] = (f32x4){0.f, 0.f, 0.f, 0.f}; cv[j] = gv[j]; hv[j] = gv[j]; }
    for (int row = rbeg; row < rend; ++row) {
        const int v = mod_vec(row);
        if (v != vprev) { vprev = v;
#pragma unroll
            for (int j = 0; j < 4; ++j) { const int e0 = 8 * lane + 512 * j;
                if (!FIRST) { const float* gate = modg + (size_t)v * 12288; gv[2 * j] = *(const f32x4*)(gate + e0); gv[2 * j + 1] = *(const f32x4*)(gate + e0 + 4); }
                if (HAS_NEXT) { const float* sc = modn + (size_t)v * 12288 + sc_off; const float* sh = modn + (size_t)v * 12288 + sh_off;
                    cv[2 * j] = *(const f32x4*)(sc + e0); cv[2 * j + 1] = *(const f32x4*)(sc + e0 + 4); hv[2 * j] = *(const f32x4*)(sh + e0); hv[2 * j + 1] = *(const f32x4*)(sh + e0 + 4); } } }
        float* xr = a.out + (size_t)row * DM;
        float x[32];
        if (FIRST) {
            const float* src = row < NCTX ? a.in[I_XP] + (size_t)row * DM : a.in[I_XS] + (size_t)(row - NCTX) * DM;
#pragma unroll
            for (int j = 0; j < 4; ++j) { const f32x4 p = *(const f32x4*)(src + 8 * lane + 512 * j), q = *(const f32x4*)(src + 8 * lane + 512 * j + 4);
                x[8 * j] = p[0]; x[8 * j + 1] = p[1]; x[8 * j + 2] = p[2]; x[8 * j + 3] = p[3]; x[8 * j + 4] = q[0]; x[8 * j + 5] = q[1]; x[8 * j + 6] = q[2]; x[8 * j + 7] = q[3];
                const float t8[8] = {p[0], p[1], p[2], p[3], q[0], q[1], q[2], q[3]}; x24_store(a.ws, row, 8 * lane + 512 * j, t8); }
        } else {
            float y[32]; float ssq = 0.f;
            const int pr = MODE == 1 ? row : perm_row(row);
            const bool sp23 = MODE != 1 && split23 && pr >= 23 * 256;
            const bf16* yr = sp23 ? (const bf16*)(a.ws + WS_FFP) + (size_t)(pr - 23 * 256) * DM : Y + (size_t)pr * DM;
#pragma unroll
            for (int j = 0; j < 4; ++j) { const v4u w = *(const v4u*)(yr + 8 * lane + 512 * j); float t[8]; unpack8(w, t);
                if (sp23) {
#pragma unroll
                    for (int sp = 1; sp < 4; ++sp) { float t2[8]; unpack8(*(const v4u*)(yr + (size_t)sp * 256 * DM + 8 * lane + 512 * j), t2);
#pragma unroll
                        for (int i = 0; i < 8; ++i) t[i] += t2[i]; } }
#pragma unroll
                for (int i = 0; i < 8; ++i) { y[8 * j + i] = t[i]; ssq += t[i] * t[i]; } }
            ssq = wave_sum(ssq);
            const float rs = 1.0f / sqrtf(ssq * (1.0f / DM) + EPS);
#pragma unroll
            for (int j = 0; j < 4; ++j) { const int e0 = 8 * lane + 512 * j;
                float xo[8]; x24_load(a.ws, row, e0, xo);
                const f32x4 g0 = gv[2 * j], g1 = gv[2 * j + 1];
                f32x4 np, nq;
#pragma unroll
                for (int i = 0; i < 4; ++i) { np[i] = xo[i] + g0[i] * (y[8 * j + i] * rs); nq[i] = xo[4 + i] + g1[i] * (y[8 * j + 4 + i] * rs); x[8 * j + i] = np[i]; x[8 * j + 4 + i] = nq[i]; }
                if (MODE == 3) { *(f32x4*)(xr + e0) = np; *(f32x4*)(xr + e0 + 4) = nq; }
                else { const float t8[8] = {np[0], np[1], np[2], np[3], nq[0], nq[1], nq[2], nq[3]}; x24_store(a.ws, row, e0, t8); } }
        }
        if (HAS_NEXT) {
            float ssq = 0.f;
#pragma unroll
            for (int i = 0; i < 32; ++i) ssq += x[i] * x[i];
            ssq = wave_sum(ssq);
            const float rs = 1.0f / sqrtf(ssq * (1.0f / DM) + EPS);
            bf16* hr = Hdst + (size_t)(MODE == 1 ? perm_row(row) : row) * DM;
#pragma unroll
            for (int j = 0; j < 4; ++j) { const int e0 = 8 * lane + 512 * j;
                const f32x4 c0 = cv[2 * j], c1 = cv[2 * j + 1], h0 = hv[2 * j], h1 = hv[2 * j + 1];
                float o[8];
#pragma unroll
                for (int i = 0; i < 4; ++i) { o[i] = x[8 * j + i] * rs * c0[i] + h0[i]; o[4 + i] = x[8 * j + 4 + i] * rs * c1[i] + h1[i]; }
                *(v4u*)(hr + e0) = pack8(o); }
        }
    }
}

__device__ __forceinline__ void mix_pass(int bx_, int G_, int wave_, int lane_, int l) {
    const DArgs a = load_args(); const int bx = fresh_s(bx_), G = fresh_s(G_), wave = fresh_s(wave_), lane = fresh_v(lane_);
    const bf16* GB = (const bf16*)(a.ws + WS_GB); const bf16* V = (const bf16*)(a.ws + WS_V); const bf16* O = (const bf16*)(a.ws + WS_O); bf16* MX = (bf16*)(a.ws + WS_MIXIN);
    const float* cw = a.in[I_CONVW] + (size_t)l * 3 * CW; const float* gc = a.in[I_GCONV] + (size_t)l * CW; const float* gs = a.in[I_GSSM] + (size_t)l * SW;
    float w0r[16], w1r[16], w2r[16], gcr[16], gsr[16];
#pragma unroll
    for (int j = 0; j < 2; ++j) { const int c0 = 8 * lane + 512 * j;
#pragma unroll
        for (int hq = 0; hq < 2; ++hq) { const f32x4 t0 = *(const f32x4*)(cw + c0 + 4 * hq), t1 = *(const f32x4*)(cw + CW + c0 + 4 * hq), t2 = *(const f32x4*)(cw + 2 * CW + c0 + 4 * hq),
                                               t3 = *(const f32x4*)(gc + c0 + 4 * hq), t4 = *(const f32x4*)(gs + c0 + 4 * hq);
#pragma unroll
            for (int i = 0; i < 4; ++i) { w0r[8 * j + 4 * hq + i] = t0[i]; w1r[8 * j + 4 * hq + i] = t1[i]; w2r[8 * j + 4 * hq + i] = t2[i]; gcr[8 * j + 4 * hq + i] = t3[i]; gsr[8 * j + 4 * hq + i] = t4[i]; } } }
    const int rpw = (NTOK + G * NWAVES - 1) / (G * NWAVES), rbeg = (bx * NWAVES + wave) * rpw, rend = rbeg + rpw < NTOK ? rbeg + rpw : NTOK;
    for (int row = rbeg; row < rend; ++row) {
        bool hp, hn;
        if (row < NCTX) { const int t = row & 255; hp = t > 0; hn = t < 255; } else { const int c = (row - NCTX) & 63; hp = c > 0; hn = c < 63; }
#pragma unroll
        for (int j = 0; j < 2; ++j) { const int c0 = 8 * lane + 512 * j; const size_t off = (size_t)row * CW + c0;
            float vc[8], vp[8], vn[8], gb[8];
            unpack8(*(const v4u*)(V + off), vc); unpack8(*(const v4u*)(GB + off), gb);
            if (hp) unpack8(*(const v4u*)(V + off - CW), vp); else {
#pragma unroll
                for (int i = 0; i < 8; ++i) vp[i] = 0.f; }
            if (hn) unpack8(*(const v4u*)(V + off + CW), vn); else {
#pragma unroll
                for (int i = 0; i < 8; ++i) vn[i] = 0.f; }
            float o[8]; float ssq = 0.f;
#pragma unroll
            for (int i = 0; i < 8; ++i) { o[i] = gb[i] * (w0r[8 * j + i] * vp[i] + w1r[8 * j + i] * vc[i] + w2r[8 * j + i] * vn[i]); ssq += o[i] * o[i]; }
            ssq += __shfl_xor(ssq, 1); ssq += __shfl_xor(ssq, 2); ssq += __shfl_xor(ssq, 4);
            const float rs = 1.0f / sqrtf(ssq * (1.0f / 64.0f) + EPS);
#pragma unroll
            for (int i = 0; i < 8; ++i) o[i] = o[i] * rs * gcr[8 * j + i];
            *(v4u*)(MX + (size_t)row * DM + c0) = pack8(o); }
        float s[16]; float ssq = 0.f;
#pragma unroll
        for (int j = 0; j < 2; ++j) { float t[8]; unpack8(*(const v4u*)(O + (size_t)row * SW + 8 * lane + 512 * j), t);
#pragma unroll
            for (int i = 0; i < 8; ++i) { s[8 * j + i] = t[i]; ssq += t[i] * t[i]; } }
        ssq = wave_sum(ssq);
        const float rs = 1.0f / sqrtf(ssq * (1.0f / SW) + EPS);
#pragma unroll
        for (int j = 0; j < 2; ++j) { const int c0 = 8 * lane + 512 * j; float o[8];
#pragma unroll
            for (int i = 0; i < 8; ++i) o[i] = s[8 * j + i] * rs * gsr[8 * j + i];
            *(v4u*)(MX + (size_t)row * DM + CW + c0) = pack8(o); }
    }
}

struct S5C { bf16x8 Bf[2][4]; float ar[2][2], ai[2][2]; };
__device__ __forceinline__ void s5_setup(const DArgs& a, LAS unsigned char* lds, int lane, int wave, int l, int g, S5C& c) {
    const int n = lane & 31, hf = lane >> 5, tq = lane & 15, q = lane >> 4;
    LAS unsigned char* CFB = lds + 135168;
    LAS float* A16 = (LAS float*)(lds + 143360);
#pragma unroll
    for (int d = 0; d < 2; ++d) {
        const int pg = (l * 2 + d) * 64 + g;
        const float dt = expf(a.in[I_LOGDT][pg]);
#pragma unroll
        for (int s = 0; s < 2; ++s) { const int nn = n + 32 * s;
            const float are = a.in[I_ARE][pg * 64 + nn], aim = a.in[I_AIM][pg * 64 + nn];
            const float er = expf(are * dt); float sn, cs; sincos_cw(aim * dt, sn, cs);
            const float abr = er * cs, abi = er * sn; c.ar[d][s] = abr; c.ai[d][s] = abi;
            if (wave == 0 && hf == 0) { const float e16 = expf(16.0f * are * dt); float s16, c16; sincos_cw(16.0f * aim * dt, s16, c16); *(LAS f32x2*)(A16 + (d * 64 + nn) * 2) = (f32x2){e16 * c16, e16 * s16}; }
            const float inv = 1.0f / (are * are + aim * aim);
            const float cr = ((abr - 1.0f) * are + abi * aim) * inv, ci = (abi * are - (abr - 1.0f) * aim) * inv;
            const float* brp = a.in[I_BRE] + (unsigned)((pg * 64 + nn) * 16 + 8 * hf); const float* bip = a.in[I_BIM] + (unsigned)((pg * 64 + nn) * 16 + 8 * hf);
            const f32x4 br0 = *(const f32x4*)brp, br1 = *(const f32x4*)(brp + 4), bi0 = *(const f32x4*)bip, bi1 = *(const f32x4*)(bip + 4);
            v4u wr_, wi_;
            wr_.x = pk2(cr * br0[0] - ci * bi0[0], cr * br0[1] - ci * bi0[1]); wr_.y = pk2(cr * br0[2] - ci * bi0[2], cr * br0[3] - ci * bi0[3]);
            wr_.z = pk2(cr * br1[0] - ci * bi1[0], cr * br1[1] - ci * bi1[1]); wr_.w = pk2(cr * br1[2] - ci * bi1[2], cr * br1[3] - ci * bi1[3]);
            wi_.x = pk2(cr * bi0[0] + ci * br0[0], cr * bi0[1] + ci * br0[1]); wi_.y = pk2(cr * bi0[2] + ci * br0[2], cr * bi0[3] + ci * br0[3]);
            wi_.z = pk2(cr * bi1[0] + ci * br1[0], cr * bi1[1] + ci * br1[1]); wi_.w = pk2(cr * bi1[2] + ci * br1[2], cr * bi1[3] + ci * br1[3]);
            c.Bf[d][2 * s] = __builtin_bit_cast(bf16x8, wr_); c.Bf[d][2 * s + 1] = __builtin_bit_cast(bf16x8, wi_); }
        if (wave == 0) {
            const float* crp = a.in[I_CRE] + (unsigned)((pg * 16 + tq) * 64); const float* cip = a.in[I_CIM] + (unsigned)((pg * 16 + tq) * 64);
#pragma unroll
            for (int ks = 0; ks < 4; ++ks) { const int n0 = 8 * ks + 2 * q;
                const f32x2 cr0 = *(const f32x2*)(crp + n0), cr1 = *(const f32x2*)(crp + n0 + 32), ci0 = *(const f32x2*)(cip + n0), ci1 = *(const f32x2*)(cip + n0 + 32);
                v4u w; w.x = pk2(cr0[0], -ci0[0]); w.y = pk2(cr1[0], -ci1[0]); w.z = pk2(cr0[1], -ci0[1]); w.w = pk2(cr1[1], -ci1[1]);
                *(LAS v4u*)(CFB + ((d * 4 + ks) * 64 + lane) * 16) = w; }
        }
    }
}
__device__ __forceinline__ void s5_task(const DArgs& a, LAS unsigned char* lds, int tid, int lane, int wave, int l, int row0, int NC, int g, int bidx, bool latent, const S5C& cst, bf16x8& Afpre, int next_row0) {
#define S5_BAR() do { asm volatile("s_waitcnt lgkmcnt(0)" ::: "memory"); __builtin_amdgcn_s_barrier(); asm volatile("" ::: "memory"); } while (0)
    const int n = lane & 31, hf = lane >> 5, tq = lane & 15, q = lane >> 4;
    LAS float* EB = (LAS float*)lds;
    LAS unsigned char* SB = lds + 65536 + wave * 8704;
    const bf16* U = (const bf16*)(a.ws + WS_U); bf16* Z = (bf16*)(a.ws + WS_Z);
    LAS unsigned char* CFB = lds + 135168;
    const LAS float* A16 = (const LAS float*)(lds + 143360);
    bf16x8 Bf[2][4]; float ar[2][2], ai[2][2];
#pragma unroll
    for (int d = 0; d < 2; ++d) {
#pragma unroll
        for (int cb = 0; cb < 4; ++cb) Bf[d][cb] = cst.Bf[d][cb];
#pragma unroll
        for (int s2 = 0; s2 < 2; ++s2) { ar[d][s2] = cst.ar[d][s2]; ai[d][s2] = cst.ai[d][s2]; } }
    const f32x16 zero16 = {0.f, 0.f, 0.f, 0.f, 0.f, 0.f, 0.f, 0.f, 0.f, 0.f, 0.f, 0.f, 0.f, 0.f, 0.f, 0.f};
    const int cbit = (n >> 2) & 1, tA = (n >> 3) * 4 + (n & 3);
#define S5_PIN_BU() asm volatile("s_nop 15\n\ts_nop 15\n\ts_nop 15\n\ts_nop 15\n\ts_nop 15\n\ts_nop 15\n\ts_nop 15\n\ts_nop 15\n\ts_nop 15\n\ts_nop 15\n\ts_nop 15\n\ts_nop 15\n\ts_nop 15\n\ts_nop 15\n\ts_nop 15\n\ts_nop 15\n\ts_nop 15\n\ts_nop 15\n\ts_nop 15\n\ts_nop 15" : "+v"(acc[0]), "+v"(acc[1]), "+v"(acc[2]), "+v"(acc[3]) : "v"(Afd), "v"(Bf[d][0]), "v"(Bf[d][1]), "v"(Bf[d][2]), "v"(Bf[d][3]))
    bf16x8 Afk = {0, 0, 0, 0, 0, 0, 0, 0};
    bf16x8 Afn = Afpre;
    for (int item = wave; item < NC / 2; item += NWAVES) { const int c0 = 2 * item;
        const bf16x8 Af = Afn;
        if (item + NWAVES < NC / 2) Afn = *(const bf16x8*)(U + (unsigned)((row0 + (c0 + 2 * NWAVES + cbit) * 16 + tA) * SW + g * 16 + 8 * hf));
        Afk = Af;
#pragma unroll
        for (int d = 0; d < 2; ++d) {
            bf16x8 Afd = Af; asm volatile("" : "+v"(Afd) :: "memory");
            f32x16 acc[4];
#pragma unroll
            for (int cb = 0; cb < 4; ++cb) acc[cb] = __builtin_amdgcn_mfma_f32_32x32x16_bf16(Afd, Bf[d][cb], zero16, 0, 0, 0);
            S5_PIN_BU();
            float s0r = 0.f, s0i = 0.f, s1r = 0.f, s1i = 0.f;
#pragma unroll
            for (int ii = 0; ii < 16; ++ii) { const int i = d == 0 ? ii : 15 - ii;
                const float n0r = fmaf(ar[d][0], s0r, fmaf(-ai[d][0], s0i, acc[0][i])), n0i = fmaf(ar[d][0], s0i, fmaf(ai[d][0], s0r, acc[1][i]));
                const float n1r = fmaf(ar[d][1], s1r, fmaf(-ai[d][1], s1i, acc[2][i])), n1i = fmaf(ar[d][1], s1i, fmaf(ai[d][1], s1r, acc[3][i]));
                s0r = n0r; s0i = n0i; s1r = n1r; s1i = n1i; }
            *(LAS f32x4*)(EB + (d * 64 + c0 + hf) * 128 + 4 * n) = (f32x4){s0r, s0i, s1r, s1i};
            asm volatile("s_waitcnt lgkmcnt(0)" :: "v"(s0r), "v"(s0i), "v"(s1r), "v"(s1i) : "memory");
        }
    }
    S5_BAR();
    if (tid < 128) { const int d = tid >> 6, nn = tid & 63, pos = nn < 32 ? 4 * nn : 4 * (nn - 32) + 2;
        const f32x2 p16 = *(const LAS f32x2*)(A16 + (d * 64 + nn) * 2); const float pr = p16[0], pi = p16[1];
        const unsigned sidx = ((((unsigned)bidx * DEPTH + l) * 2 + d) * 64 + g) * 64 + nn;
        float sr = 0.f, si = 0.f;
        if (latent) { sr = a.in[I_SRE][sidx]; si = a.in[I_SIM][sidx]; }
        for (int cb8 = 0; cb8 < NC; cb8 += 8) {
            f32x2 e[8];
#pragma unroll
            for (int j = 0; j < 8; ++j) { const int c = d == 0 ? cb8 + j : NC - 1 - cb8 - j; e[j] = *(const LAS f32x2*)(EB + (d * 64 + c) * 128 + pos); }
#pragma unroll
            for (int j = 0; j < 8; ++j) { const int c = d == 0 ? cb8 + j : NC - 1 - cb8 - j; const f32x2 sv = {sr, si};
                const float nr = fmaf(pr, sr, fmaf(-pi, si, e[j][0])), ni = fmaf(pr, si, fmaf(pi, sr, e[j][1])); sr = nr; si = ni;
                *(LAS f32x2*)(EB + (d * 64 + c) * 128 + pos) = sv; }
        }
        if (!latent) { float* ns = a.out + (size_t)NTOK * DM; ns[sidx] = sr; ns[524288u + sidx] = si; }
    }
    S5_BAR();
    if (next_row0 >= 0) Afpre = *(const bf16x8*)(U + (unsigned)((next_row0 + (2 * wave + cbit) * 16 + tA) * SW + g * 16 + 8 * hf));
    if (latent) Afn = *(const bf16x8*)(U + (unsigned)((row0 + (2 * wave + cbit) * 16 + tA) * SW + g * 16 + 8 * hf));
    const f32x4 dd = *(const f32x4*)(a.in[I_SSMD] + (unsigned)(l * SW + g * 16 + 4 * q));
    for (int item = wave; item < NC / 2; item += NWAVES) { const int c0 = 2 * item;
        bf16x8 Af = Afk;
        if (latent) { Af = Afn; if (item + NWAVES < NC / 2) Afn = *(const bf16x8*)(U + (unsigned)((row0 + (c0 + 2 * NWAVES + cbit) * 16 + tA) * SW + g * 16 + 8 * hf)); }
        v2u uwv[2];
#pragma unroll
        for (int cc = 0; cc < 2; ++cc) uwv[cc] = *(const v2u*)(U + (unsigned)((row0 + (c0 + cc) * 16 + tq) * SW + g * 16 + 4 * q));
        f32x4 yacc[2] = {{0.f, 0.f, 0.f, 0.f}, {0.f, 0.f, 0.f, 0.f}};
#pragma unroll
        for (int d = 0; d < 2; ++d) {
            bf16x8 Afd = Af; asm volatile("" : "+v"(Afd) :: "memory");
            f32x16 acc[4];
#pragma unroll
            for (int cb = 0; cb < 4; ++cb) acc[cb] = __builtin_amdgcn_mfma_f32_32x32x16_bf16(Afd, Bf[d][cb], zero16, 0, 0, 0);
            S5_PIN_BU();
            const f32x4 s_in = *(const LAS f32x4*)(EB + (d * 64 + c0 + hf) * 128 + 4 * n);
            float s0r = s_in[0], s0i = s_in[1], s1r = s_in[2], s1i = s_in[3];
            v2u w[16];
#pragma unroll
            for (int ii = 0; ii < 16; ++ii) { const int i = d == 0 ? ii : 15 - ii;
                const float n0r = fmaf(ar[d][0], s0r, fmaf(-ai[d][0], s0i, acc[0][i])), n0i = fmaf(ar[d][0], s0i, fmaf(ai[d][0], s0r, acc[1][i]));
                const float n1r = fmaf(ar[d][1], s1r, fmaf(-ai[d][1], s1i, acc[2][i])), n1i = fmaf(ar[d][1], s1i, fmaf(ai[d][1], s1r, acc[3][i]));
                s0r = n0r; s0i = n0i; s1r = n1r; s1i = n1i;
                w[i].x = pk2(s0r, s0i); w[i].y = pk2(s1r, s1i); }
#pragma unroll
            for (int i = 0; i < 16; ++i) *(LAS v2u*)(SB + (hf * 16 + i) * 272 + 8 * n) = w[i];
            asm volatile("s_waitcnt lgkmcnt(0)" :: "v"(w[0]), "v"(w[1]), "v"(w[2]), "v"(w[3]), "v"(w[4]), "v"(w[5]), "v"(w[6]), "v"(w[7]), "v"(w[8]), "v"(w[9]), "v"(w[10]), "v"(w[11]), "v"(w[12]), "v"(w[13]), "v"(w[14]), "v"(w[15]) : "memory");
            {
                bf16x8 sf[2][4], cf[4];
#pragma unroll
                for (int ks = 0; ks < 4; ++ks) { cf[ks] = *(const LAS bf16x8*)(CFB + ((d * 4 + ks) * 64 + lane) * 16);
#pragma unroll
                    for (int cc = 0; cc < 2; ++cc) sf[cc][ks] = *(const LAS bf16x8*)(SB + (cc * 16 + tq) * 272 + ks * 64 + q * 16); }
                asm volatile("s_waitcnt lgkmcnt(0)" : "+v"(sf[0][0]), "+v"(sf[0][1]), "+v"(sf[0][2]), "+v"(sf[0][3]), "+v"(sf[1][0]), "+v"(sf[1][1]), "+v"(sf[1][2]), "+v"(sf[1][3]), "+v"(cf[0]), "+v"(cf[1]), "+v"(cf[2]), "+v"(cf[3]) :: "memory");
#pragma unroll
                for (int cc = 0; cc < 2; ++cc)
#pragma unroll
                    for (int ks = 0; ks < 4; ++ks) yacc[cc] = __builtin_amdgcn_mfma_f32_16x16x32_bf16(cf[ks], sf[cc][ks], yacc[cc], 0, 0, 0);
                asm volatile("s_nop 15\n\ts_nop 15\n\ts_nop 15\n\ts_nop 15\n\ts_nop 15\n\ts_nop 15\n\ts_nop 15\n\ts_nop 15\n\ts_nop 15\n\ts_nop 15\n\ts_nop 15\n\ts_nop 15\n\ts_nop 15\n\ts_nop 15\n\ts_nop 15\n\ts_nop 15" : "+v"(yacc[0]), "+v"(yacc[1]) : "v"(sf[0][0]), "v"(sf[0][1]), "v"(sf[0][2]), "v"(sf[0][3]), "v"(sf[1][0]), "v"(sf[1][1]), "v"(sf[1][2]), "v"(sf[1][3]), "v"(cf[0]), "v"(cf[1]), "v"(cf[2]), "v"(cf[3]) : "memory");
            }
        }
#pragma unroll
        for (int cc = 0; cc < 2; ++cc) { const unsigned off = (unsigned)((row0 + (c0 + cc) * 16 + tq) * SW + g * 16 + 4 * q);
            const v2u uw = uwv[cc];
            const float u0 = bflo(uw.x), u1 = bfhi(uw.x), u2 = bflo(uw.y), u3 = bfhi(uw.y);
            const float z0 = gelu_tanh(yacc[cc][0] + dd[0] * u0), z1 = gelu_tanh(yacc[cc][1] + dd[1] * u1), z2 = gelu_tanh(yacc[cc][2] + dd[2] * u2), z3 = gelu_tanh(yacc[cc][3] + dd[3] * u3);
            v2u zw; zw.x = pk2(z0, z1); zw.y = pk2(z2, z3);
            *(v2u*)(Z + off) = zw; }
    }
    S5_BAR();
}
__device__ __forceinline__ void s5_phase(LAS unsigned char* lds, int tid_, int lane_, int wave_, int bx_, int G_, int l) {
    const DArgs a = load_args(); const int tid = fresh_v(tid_), lane = fresh_v(lane_), wave = fresh_s(wave_), bx = fresh_s(bx_), G = fresh_s(G_);
    const bool bal = (G == 256);
    const int nt = bal ? (bx < 128 ? 3 : 6) : (128 + 1024 - bx + G - 1) / G;
    S5C cst; int gprev = -1; bf16x8 Afpre = {0, 0, 0, 0, 0, 0, 0, 0};
    const int lane_n = lane & 31, cbit = (lane_n >> 2) & 1, tA = (lane_n >> 3) * 4 + (lane_n & 3), hf = lane >> 5;
    const bf16* U = (const bf16*)(a.ws + WS_U);
    for (int i = 0; i < nt; ++i) {
        bool latent, latn = false; int b, g, bn = 0, gn = -1;
#define S5_TASK(ii, LAT, B, GG) do { if (bal) { if (bx < 128) { LAT = ((ii) == 0); GG = bx & 63; B = LAT ? (bx >> 6) : 2 * (bx >> 6) + ((ii) - 1); } else { const int w = bx - 128; LAT = false; GG = w >> 1; B = 4 + 6 * (w & 1) + (ii); } } \
        else { const int t = bx + (ii) * G; LAT = t < 128; const int tc = LAT ? t : t - 128; B = tc >> 6; GG = tc & 63; } } while (0)
        S5_TASK(i, latent, b, g);
        if (i + 1 < nt) S5_TASK(i + 1, latn, bn, gn);
        const int row0 = latent ? NCTX + b * 1024 : b * 256;
        const int rown = (i + 1 < nt && gn == g) ? (latn ? NCTX + bn * 1024 : bn * 256) : -1;
        if (g != gprev) { s5_setup(a, lds, lane, wave, l, g, cst); gprev = g;
            Afpre = *(const bf16x8*)(U + (unsigned)((row0 + (2 * wave + cbit) * 16 + tA) * SW + g * 16 + 8 * hf)); }
        s5_task(a, lds, tid, lane, wave, l, row0, latent ? 64 : 16, g, b, latent, cst, Afpre, rown);
#undef S5_TASK
    }
}
#define XB_TMO      128
#define XB_XCNT(j)  (256  + 64 * (j))
#define XB_XSUB(j)  (1280 + 64 * (j))
#define XB_XGEN(j)  (2304 + 64 * (j))
#define XB_TOP      3328
#define XB_TOPGEN   3392
#define XCD_BAR_WORDS 3456
#define XB_SPIN_CAP (1u << 18)

__device__ __forceinline__ unsigned xb_ld(unsigned* p)              { return __hip_atomic_load(p, __ATOMIC_RELAXED, __HIP_MEMORY_SCOPE_AGENT); }
__device__ __forceinline__ unsigned xb_add(unsigned* p, unsigned v) { return __hip_atomic_fetch_add(p, v, __ATOMIC_RELAXED, __HIP_MEMORY_SCOPE_AGENT); }
__device__ __forceinline__ unsigned xb_xcc_id() { return (unsigned)__builtin_amdgcn_s_getreg((3 << 11) | 20) & 0xFu; }
#define XB_SPIN(cond, bar) do { unsigned _sp = 0; while (cond) { __builtin_amdgcn_s_sleep(1); \
    if ((++_sp & 255u) == 0u) { if (xb_ld(&(bar)[XB_TMO])) break; if (_sp > XB_SPIN_CAP) { atomicAdd(&(bar)[XB_TMO], 1u); break; } } } } while (0)

struct XcdBarrier {
    unsigned* bar; unsigned x;
    volatile LAS unsigned* st;
};

__device__ __forceinline__ XcdBarrier xcd_barrier_post(unsigned* bar, volatile LAS unsigned* st) {
    XcdBarrier b; b.bar = bar; b.x = xb_xcc_id(); b.st = st;
    if (threadIdx.x == 0) (void)xb_add(&bar[XB_XCNT(b.x)], 1u);
    return b;
}
__device__ __forceinline__ void xcd_barrier_complete(unsigned* bar, unsigned x, unsigned& nloc, unsigned& nx) {
    const unsigned G = gridDim.x * gridDim.y * gridDim.z;
    unsigned sum, cnt, mine, sp = 0u;
    for (;;) {
        sum = 0u; cnt = 0u; mine = 0u;
#pragma unroll
        for (unsigned j = 0; j < 16; ++j) { const unsigned c = xb_ld(&bar[XB_XCNT(j)]); sum += c; cnt += (c > 0u) ? 1u : 0u; mine = (j == x) ? c : mine; }
        if (sum == G) break;
        __builtin_amdgcn_s_sleep(1);
        if ((++sp & 255u) == 0u) { if (xb_ld(&bar[XB_TMO])) break; if (sp > XB_SPIN_CAP) { atomicAdd(&bar[XB_TMO], 1u); break; } }
    }
    nloc = mine > 0u ? mine : 1u; nx = cnt > 0u ? cnt : 1u;
}

__device__ __forceinline__ void xcd_barrier(const XcdBarrier& b) {
    asm volatile("s_waitcnt vmcnt(0)" ::: "memory");
    __syncthreads();
    if (threadIdx.x == 0) {
        unsigned* bar = b.bar;
        __builtin_amdgcn_s_waitcnt(0);
        unsigned nloc = b.st[0], nx = b.st[1];
        if (nloc == 0u) { xcd_barrier_complete(bar, b.x, nloc, nx); b.st[0] = nloc; b.st[1] = nx; }
        const unsigned old = xb_add(&bar[XB_XSUB(b.x)], 1u);
        const unsigned gen = old / nloc;
        if (old + 1u == (gen + 1u) * nloc) {
            __builtin_amdgcn_fence(__ATOMIC_RELEASE, "agent");
            asm volatile("s_waitcnt vmcnt(0)" ::: "memory");
            const unsigned og = xb_add(&bar[XB_TOP], 1u);
            const unsigned tg = og / nx;
            if (og + 1u == (tg + 1u) * nx) xb_add(&bar[XB_TOPGEN], 1u);
            else XB_SPIN(xb_ld(&bar[XB_TOPGEN]) == tg, bar);
            __builtin_amdgcn_fence(__ATOMIC_ACQUIRE, "agent");
            xb_add(&bar[XB_XGEN(b.x)], 1u);
            asm volatile("s_waitcnt vmcnt(0)" ::: "memory");
        } else {
            XB_SPIN(xb_ld(&bar[XB_XGEN(b.x)]) == gen, bar);
            __builtin_amdgcn_fence(__ATOMIC_ACQUIRE, "agent");
            asm volatile("s_waitcnt vmcnt(0)" ::: "memory");
        }
    }
    __syncthreads();
}


__device__ __forceinline__ void sub_barrier(unsigned* word, unsigned n, unsigned* bar) {
    asm volatile("s_waitcnt vmcnt(0)" ::: "memory");
    __syncthreads();
    if (threadIdx.x == 0) {
        __builtin_amdgcn_s_waitcnt(0);
        __builtin_amdgcn_fence(__ATOMIC_RELEASE, "agent");
        asm volatile("s_waitcnt vmcnt(0)" ::: "memory");
        (void)xb_add(word, 1u);
        XB_SPIN(xb_ld(word) < n, bar);
        __builtin_amdgcn_fence(__ATOMIC_ACQUIRE, "agent");
        asm volatile("s_waitcnt vmcnt(0)" ::: "memory");
    }
    __syncthreads();
}

__global__ void __launch_bounds__(NWAVES * 64, 2) fwd_kernel(Args  ) {
    extern __shared__ __attribute__((aligned(16))) unsigned char lds_raw[];
    LAS unsigned char* lds = (LAS unsigned char*)lds_raw;
    const int tid = threadIdx.x, lane = tid & 63, wave = __builtin_amdgcn_readfirstlane(tid >> 6), G = gridDim.x, bx = blockIdx.x;
    volatile LAS unsigned* MISC = (volatile LAS unsigned*)(lds + MISC_OFF);
    for (int u = tid; u < (LDS_BYTES - LDSCTL_OFF) / 4; u += NWAVES * 64) ((LAS unsigned*)(lds + LDSCTL_OFF))[u] = 0u;
    __syncthreads();
    XcdBarrier bar;
    { const DArgs a = load_args(); gu32* ctl = (gu32*)(a.ws + WS_CTL); bar = xcd_barrier_post((unsigned*)(ctl + CW_BAR), MISC + 8); }
#define GRID_BAR() do { XcdBarrier b_ = bar; asm volatile("" : "+s"(b_.bar), "+s"(b_.x)); xcd_barrier(b_); } while (0)


    for (int t = bx; t < 192; t += G) mod_task(lds, tid, lane, wave, t);
    cvt_fill(lds, tid, 0, (G == 256 && bx < 192) ? 6 : -1);
    cvt_fill(lds, tid, 0, -1);
    GRID_BAR();
    row_pass<0>(0, bx, G, wave, lane);
    GRID_BAR();

    const int nl = fresh_s(DEPTH);
    for (int li = 0; li < nl; ++li) {
        const int l = li;
        const bool dfl = fresh_s(G) == 256;
        { const int x = bx & 7, r = bx >> 3;
          pg8::G5Order S; S.st = !dfl; S.so.init(NTOK, INC, fresh_s(G), fresh_s(bx));
          if (r < 24) { S.u0.pm = 3 * x + r % 3; S.u0.pn = 8 + r / 3; } else if (r < 28) { S.u0.pm = 3 * x + (r - 24) % 3; S.u0.pn = (r - 24) / 3; } else { S.u0.pm = -1; S.u0.pn = 0; }
          if (S.st || S.u0.pm >= 0) {
              const DArgs a = load_args(); pg8::Gemm g{(const bf16*)(a.ws + WS_H), (const bf16*)(a.ws + WS_WIN) + (size_t)l * INC * DM, NTOK, INC, DM};
              pg8::EpiIn E{(bf16*)(a.ws + WS_GB), (bf16*)(a.ws + WS_V), (bf16*)(a.ws + WS_U)};
              pg8::gemm_phase<pg8::EpiIn, pg8::G5Order, true, true>(lds, g, S, E);
          } else if (li + 1 < nl) cvt_fill(lds, tid, l + 1, 12);
        }
        GRID_BAR();
        s5_phase(lds, tid, lane, wave, bx, G, l);
        GRID_BAR();
        { const int x = bx & 7, r = bx >> 3;
          if (dfl && r < 20) {
              pg8::G5Order S; S.st = false; S.u0.pm = 3 * x + (r + 4) % 3; S.u0.pn = (r + 4) / 3;
              const DArgs a = load_args(); pg8::Gemm g{(const bf16*)(a.ws + WS_H), (const bf16*)(a.ws + WS_WIN) + (size_t)l * INC * DM, NTOK, INC, DM};
              pg8::EpiIn E{(bf16*)(a.ws + WS_GB), (bf16*)(a.ws + WS_V), (bf16*)(a.ws + WS_U)};
              pg8::gemm_phase<pg8::EpiIn, pg8::G5Order, true, true>(lds, g, S, E);
          } else {
              pg8::G5Order S; S.st = !dfl; S.so.init(NTOK, SW, fresh_s(G), fresh_s(bx)); S.u0.pm = 3 * x + (r - 20) % 3; S.u0.pn = (r - 20) / 3;
              const DArgs a = load_args(); pg8::Gemm g{(const bf16*)(a.ws + WS_Z), (const bf16*)(a.ws + WS_WGLU) + (size_t)l * SW * SW, NTOK, SW, SW};
              pg8::EpiGlu E{(const bf16*)(a.ws + WS_Z), (bf16*)(a.ws + WS_O), a.in[I_BGLU] + (size_t)l * SW};
              pg8::gemm_phase<pg8::EpiGlu, pg8::G5Order, true, true>(lds, g, S, E);
              if (li + 1 < nl) cvt_fill(lds, tid, l + 1, 4);
          }
        }
        GRID_BAR();
        mix_pass(bx, G, wave, lane, l);
        GRID_BAR();
        { const DArgs a = load_args(); pg8::Gemm g{(const bf16*)(a.ws + WS_MIXIN), (const bf16*)(a.ws + WS_WOUT) + (size_t)l * DM * DM, NTOK, DM, DM}; pg8::G5Order S; S.st = !dfl; S.so.init(NTOK, DM, fresh_s(G), fresh_s(bx)); { const int x = bx & 7, r = bx >> 3; S.u0.pm = r < 24 ? 3 * x + r % 3 : -1; S.u0.pn = r / 3; }
          pg8::EpiBf16<0> E{(bf16*)(a.ws + WS_MIXED), DM, nullptr, 0, 0, 1.f};
          pg8::gemm_phase<pg8::EpiBf16<0>, pg8::G5Order, true, true>(lds, g, S, E); }
        if (li + 1 < nl && bx >= 192) cvt_fill(lds, tid, l + 1, 12);
        GRID_BAR();
        row_pass<1>(l, bx, G, wave, lane);
        GRID_BAR();
        { const DArgs a = load_args(); pg8::Gemm g{(const bf16*)(a.ws + WS_H), (const bf16*)(a.ws + WS_WUP) + (size_t)l * UPN * DM, NTOK, UPN, DM}; pg8::G4Order S{0, dfl ? 1024 : 1056, fresh_s(G), fresh_s(bx), !dfl};
          pg8::EpiFfn E{(bf16*)(a.ws + WS_ACT), a.in[I_FFNW] + (size_t)l * 3 * UPN, (LAS float*)(lds + RING_BYTES)};
          pg8::gemm_phase<pg8::EpiFfn, pg8::G4Order, true, true>(lds, g, S, E); }
        GRID_BAR();
        if (dfl && bx < 32) {
            { const DArgs a = load_args(); pg8::Gemm g{(const bf16*)(a.ws + WS_H), (const bf16*)(a.ws + WS_WUP) + (size_t)l * UPN * DM, NTOK, UPN, DM}; pg8::G4Order S{1024, 1056, fresh_s(G), fresh_s(bx), false};
              pg8::EpiFfn E{(bf16*)(a.ws + WS_ACT), a.in[I_FFNW] + (size_t)l * 3 * UPN, (LAS float*)(lds + RING_BYTES)};
              pg8::gemm_phase<pg8::EpiFfn, pg8::G4Order, true, true>(lds, g, S, E); }
            { const DArgs a = load_args(); sub_barrier((unsigned*)(a.ws + WS_CTL) + CW_SUB + 64 * l, 32u, (unsigned*)(a.ws + WS_CTL) + CW_BAR); }
            { const DArgs a = load_args(); pg8::Gemm g{(const bf16*)(a.ws + WS_ACT) + (size_t)23 * 256 * DFF, (const bf16*)(a.ws + WS_WDN) + (size_t)l * DM * DFF, 256, 4 * DM, DFF / 4, DFF, 4};
              pg8::G5Order S; S.st = false; S.u0.pm = 0; S.u0.pn = fresh_s(bx);
              pg8::EpiBf16<0> E{(bf16*)(a.ws + WS_FFP), DM, nullptr, DM, (size_t)256 * DM, 1.f};
              pg8::gemm_phase<pg8::EpiBf16<0>, pg8::G5Order, true, true>(lds, g, S, E); }
            if (li + 1 < nl) cvt_fill(lds, tid, l + 1, 8);
        } else {
            const int x = bx & 7, r = (bx >> 3) - 4;
            pg8::G5Order S; S.st = !dfl; S.so.init(NTOK, DM, fresh_s(G), fresh_s(bx));
            if (bx < 224 && !(x == 7 && r >= 16)) { S.u0.pm = x < 7 ? 3 * x + r % 3 : 21 + (r & 1); S.u0.pn = x < 7 ? r / 3 : r >> 1; } else { S.u0.pm = -1; S.u0.pn = 0; }
            if (S.st || S.u0.pm >= 0) {
                const DArgs a = load_args(); pg8::Gemm g{(const bf16*)(a.ws + WS_ACT), (const bf16*)(a.ws + WS_WDN) + (size_t)l * DM * DFF, NTOK, DM, DFF};
                pg8::EpiBf16<0> E{(bf16*)(a.ws + WS_FF), DM, nullptr, 0, 0, 1.f};
                pg8::gemm_phase<pg8::EpiBf16<0>, pg8::G5Order, true, true>(lds, g, S, E);
            } else if (li + 1 < nl) cvt_fill(lds, tid, l + 1, 48);
        }
        GRID_BAR();
        if (li < nl - 1) {
            row_pass<2>(l, bx, G, wave, lane, fresh_s(G) == 256);
            cvt_fill(lds, tid, l + 1, -1);
            GRID_BAR();
        } else {
            row_pass<3>(l, bx, G, wave, lane, fresh_s(G) == 256);
        }
    }

#undef GRID_BAR
}

extern "C" void kernel_launch(void* const* d_in, const int* in_sizes, int n_in, void* d_out, int out_size, void* d_ws, size_t ws_size, hipStream_t stream) {
    static int grid = 0;
    if (grid == 0) {
        if (n_in != 30 || out_size != NTOK * DM + 2 * 524288 || ws_size < WS_END) { fprintf(stderr, "kernel_launch: unexpected shapes (n_in %d, out %d, ws %zu); nothing launched\n", n_in, out_size, ws_size); grid = -1; return; }
        int dev = 0, cus = 0, per_cu = 0;
        if (hipGetDevice(&dev) != hipSuccess || hipDeviceGetAttribute(&cus, hipDeviceAttributeMultiprocessorCount, dev) != hipSuccess) { grid = -1; return; }
        if (hipFuncSetAttribute((const void*)fwd_kernel, hipFuncAttributeMaxDynamicSharedMemorySize, LDS_BYTES) != hipSuccess) { fprintf(stderr, "kernel_launch: hipFuncSetAttribute failed\n"); grid = -1; return; }
        if (hipOccupancyMaxActiveBlocksPerMultiprocessor(&per_cu, (const void*)fwd_kernel, NWAVES * 64, LDS_BYTES) != hipSuccess || per_cu < 1)
            fprintf(stderr, "kernel_launch: note: occupancy query reports %d workgroups per CU\n", per_cu);
        (void)hipGetLastError();
        grid = cus;
    }
    if (grid < 0) return;
    if (hipMemsetAsync((char*)d_ws + WS_CTL, 0, CTL_ZERO_BYTES, stream) != hipSuccess) return;
    Args a{};
    for (int i = 0; i < 30; ++i) a.in[i] = (const float*)d_in[i];
    a.out = (float*)d_out; a.ws = (unsigned char*)d_ws;
    hipLaunchKernelGGL(fwd_kernel, dim3(grid), dim3(NWAVES * 64), LDS_BYTES, stream, a);
}
```

```cpp
#include <hip/hip_runtime.h>
#include <cstdio>
#include <cstdint>
namespace pg8 {
#define PG8_LAS __attribute__((address_space(3)))
typedef unsigned short bf16_t;
typedef short bf16x8 __attribute__((ext_vector_type(8)));
typedef float f32x4 __attribute__((ext_vector_type(4)));
typedef unsigned u32x4 __attribute__((ext_vector_type(4)));
constexpr int BM = 256, BK = 64, HALF = 128, HTB = HALF * BK * 2  , STAGE_BYTES = 8 * HTB, NXCD = 8, WGM = 8;

__host__ __device__ __forceinline__ int lds_byte(int r, int c) { const int st = (r >> 4) * 2 + (c >> 5), rr = r & 15, cc = c & 31, ob = rr * 64 + cc * 2; return st * 1024 + (ob ^ (((ob >> 9) & 1) << 5)); }
__host__ __device__ __forceinline__ void stage_rc(int b, int& R, int& C) { const int st = b / 1024, sb = b % 1024, swz = sb ^ (((sb >> 9) & 1) << 5); R = (st >> 1) * 16 + swz / 64; C = (st & 1) * 32 + (swz % 64) / 2; }
__host__ __device__ __forceinline__ int perm32(int rho) { const int n = rho >> 4, i = rho & 15; return 8 * (i >> 2) + 4 * n + (i & 3); }

struct Unit { int pm, pn; };
struct Gemm { const bf16_t* A; const bf16_t* Bt; int M, N, K; int ld = 0; int nsp = 1; };

struct StaticOrder {
    int nM, nN, nwg, G, c;
    __host__ __device__ void init(int M, int N, int G_, int c_) { nM = M / BM; nN = N / BM; nwg = nM * nN; G = G_; c = c_; }
    __host__ __device__ bool next(int i, Unit& u) const {
        const long L = (long)i * G + c; if (L >= nwg) return false;
        int wgid = (int)L; { const int q = nwg / NXCD, r = nwg % NXCD, xcd = wgid % NXCD, off = wgid / NXCD; wgid = (xcd < r ? xcd * (q + 1) : r * (q + 1) + (xcd - r) * q) + off; }
        const int nig = WGM * nN, gid = wgid / nig, fm = gid * WGM, gsz = (nM - fm) < WGM ? (nM - fm) : WGM;
        u.pm = fm + ((wgid % nig) % gsz); u.pn = (wgid % nig) / gsz; return true;
    }
    __device__ __forceinline__ void a_ready(const Unit&) const {}
    __device__ __forceinline__ void done(const Unit&) const {}
};

__device__ __forceinline__ unsigned cvt_pk_bf16(float lo, float hi) { unsigned r; asm volatile("v_cvt_pk_bf16_f32 %0, %1, %2" : "=v"(r) : "v"(lo), "v"(hi)); return r; }
typedef float f32x2 __attribute__((ext_vector_type(2)));
__device__ __forceinline__ f32x2 gelu_pk(f32x2 v) {
    const f32x2 av = __builtin_elementwise_abs(v), d = av * 0.2316418882f + 1.0f;
    f32x2 t; t.x = __builtin_amdgcn_rcpf(d.x); t.y = __builtin_amdgcn_rcpf(d.y);
    f32x2 q = t * 0.5307027145f + (-0.7265760135f); q = q * t + 0.7107068705f; q = q * t + (-0.142248368f); q = q * t + 0.127414796f; q = q * t;
    const f32x2 s = (v * v) * (-0.72134752044f);
    f32x2 e; e.x = __builtin_amdgcn_exp2f(s.x); e.y = __builtin_amdgcn_exp2f(s.y);
    const f32x2 m = v * (q * e), r = v - m;
    f32x2 o; o.x = v.x < 0.f ? m.x : r.x; o.y = v.y < 0.f ? m.y : r.y; return o;
}

template <int ACT  > struct EpiBf16 {
    static constexpr bool PERM = true, AFTER_DRAIN = false; static_assert(ACT == 0 || ACT == 1, "EpiBf16: ACT is 0 (none) or 1 (gelu_pk)");
    bf16_t* O; int ldc; const float* bias; int split_cols; size_t split_stride; float scale0;
    __device__ __forceinline__ void operator()(const f32x4 (&acc)[2][2][4][2], const Unit& u, int wr, int wc, int fr, int fq) const {
        const int row0 = u.pm * BM + wr * 64 + fr; int colt = u.pn * BM; bf16_t* base = O;
        float sc = 1.f; if (split_cols) { const int t = colt / split_cols; base += (size_t)t * split_stride; colt -= t * split_cols; if (t == 0) sc = scale0; }
        const int col0 = colt + wc * 32 + 8 * fq, bcol0 = u.pn * BM + wc * 32 + 8 * fq;
        f32x4 bv[2][2];
#pragma unroll
        for (int bj = 0; bj < 2; ++bj)
#pragma unroll
            for (int n = 0; n < 2; ++n) bv[bj][n] = bias ? *(const f32x4*)(bias + bcol0 + bj * HALF + 4 * n) : (f32x4){0.f, 0.f, 0.f, 0.f};
#pragma unroll
        for (int ai = 0; ai < 2; ++ai)
#pragma unroll
            for (int m = 0; m < 4; ++m) { bf16_t* rowp = base + (size_t)(row0 + ai * HALF + m * 16) * ldc + col0;
#pragma unroll
                for (int bj = 0; bj < 2; ++bj) { f32x4 v0 = acc[ai][bj][m][0] + bv[bj][0], v1 = acc[ai][bj][m][1] + bv[bj][1];
                    if (ACT == 1) { f32x2 a = gelu_pk((f32x2){v0[0], v0[1]}), b = gelu_pk((f32x2){v0[2], v0[3]}), c = gelu_pk((f32x2){v1[0], v1[1]}), d = gelu_pk((f32x2){v1[2], v1[3]});
                        v0 = (f32x4){a.x, a.y, b.x, b.y}; v1 = (f32x4){c.x, c.y, d.x, d.y}; }
                    v0 = v0 * sc; v1 = v1 * sc; u32x4 w; w.x = cvt_pk_bf16(v0[0], v0[1]); w.y = cvt_pk_bf16(v0[2], v0[3]); w.z = cvt_pk_bf16(v1[0], v1[1]); w.w = cvt_pk_bf16(v1[2], v1[3]);
                    *(u32x4*)(rowp + bj * HALF) = w; } }
    }
};
template <class Epi, class Sched, bool ALIGN_EPI = false, bool SP2 = false>
__device__ __forceinline__ void gemm_phase(PG8_LAS unsigned char* lds, const Gemm g, const Sched& S, const Epi& E) {
    int tid_ = threadIdx.x; asm volatile("" : "+v"(tid_));
    const int tid = tid_, wid = __builtin_amdgcn_readfirstlane(tid >> 6), lane = tid & 63, wr = wid >> 2, wc = wid & 3, fr = lane & 15, fq = lane >> 4;
    const int K = g.K, nt = K / BK, ld = g.ld ? g.ld : g.K, nNr = g.N / BM / g.nsp;
    unsigned voffA[2], voffB[2];
#pragma unroll
    for (int i = 0; i < 2; ++i) { int R, C; stage_rc(tid * 16 + i * 8192, R, C); const int Rb = Epi::PERM ? ((R & ~31) + perm32(R & 31)) : R;
        voffA[i] = (unsigned)(R * ld + C) * 2u; voffB[i] = (unsigned)(Rb * ld + C) * 2u; }
    const size_t kstep = (size_t)(BK * 2);
    const size_t hstep = (size_t)HALF * ld * 2;
    const size_t tstep = 2 * hstep;
    const unsigned ldsw = (unsigned)wid * 1024u;
    const int aoff = lds_byte(wr * 64 + fr, fq * 8), boff = lds_byte(wc * 32 + fr, fq * 8);
#define PG8_SA(b, h) (((b) * 2 + (h)) * HTB)
#define PG8_SB(b, h) ((4 + (b) * 2 + (h)) * HTB)
#define PG8_STAGE(bufoff, gbase, voff) do { _Pragma("unroll") for (int _i = 0; _i < 2; ++_i) \
        __builtin_amdgcn_global_load_lds((const unsigned*)((const char*)(gbase) + (voff)[_i]), (PG8_LAS unsigned*)(lds + (bufoff) + ldsw + _i * 8192), 16, 0, 0); } while (0)
#define PG8_LDA(dst, b, h) do { _Pragma("unroll") for (int m = 0; m < 4; ++m) _Pragma("unroll") for (int k = 0; k < 2; ++k) dst[m][k] = *(const PG8_LAS bf16x8*)(lds + PG8_SA(b, h) + aoff + m * 2048 + k * 1024); } while (0)
#define PG8_LDB(dst, b, h) do { _Pragma("unroll") for (int n = 0; n < 2; ++n) _Pragma("unroll") for (int k = 0; k < 2; ++k) dst[n][k] = *(const PG8_LAS bf16x8*)(lds + PG8_SB(b, h) + boff + n * 2048 + k * 1024); } while (0)
#define PG8_MMA(ai, bj, At, Bt) do { __builtin_amdgcn_s_setprio(1); _Pragma("unroll") for (int m = 0; m < 4; ++m) _Pragma("unroll") for (int n = 0; n < 2; ++n) _Pragma("unroll") for (int k = 0; k < 2; ++k) \
        acc[ai][bj][m][n] = __builtin_amdgcn_mfma_f32_16x16x32_bf16(Bt[n][k], At[m][k], acc[ai][bj][m][n], 0, 0, 0); __builtin_amdgcn_s_setprio(0); } while (0)
#define PG8_WAIT_V(n) asm volatile("s_waitcnt vmcnt(" #n ")" ::: "memory")
#define PG8_WAIT_L(n) asm volatile("s_waitcnt lgkmcnt(" #n ")" ::: "memory")
#define PG8_BAR __builtin_amdgcn_s_barrier()
#define PG8_SCHED __builtin_amdgcn_sched_barrier(0)
    Unit cur, nxt; int ui = 0;
    if (!S.next(0, cur)) return;
    f32x4 acc[2][2][4][2];
#pragma unroll
    for (int a = 0; a < 2; ++a)
#pragma unroll
        for (int b = 0; b < 2; ++b)
#pragma unroll
            for (int m = 0; m < 4; ++m)
#pragma unroll
                for (int n = 0; n < 2; ++n) acc[a][b][m][n] = (f32x4){0.f, 0.f, 0.f, 0.f};
    bf16x8 At[4][2], B0[2][2], B1[2][2];
#define PG8_APTR(u) ((const char*)g.A + (size_t)(u).pm * tstep + (size_t)((u).pn / nNr) * K * 2)
#define PG8_BPTR(u) ((const char*)g.Bt + (size_t)((u).pn % nNr) * tstep + (size_t)((u).pn / nNr) * K * 2)
    const char* cA = PG8_APTR(cur); const char* cB = PG8_BPTR(cur);
    S.a_ready(cur);
    if constexpr (SP2) {
        PG8_STAGE(PG8_SB(0, 0), cB, voffB); PG8_STAGE(PG8_SB(0, 1), cB + hstep, voffB); PG8_STAGE(PG8_SA(0, 0), cA, voffA); PG8_STAGE(PG8_SA(0, 1), cA + hstep, voffA);
        if (wr == 1) PG8_BAR;
        PG8_WAIT_V(2); PG8_BAR;
        PG8_STAGE(PG8_SB(1, 0), cB + kstep, voffB); PG8_STAGE(PG8_SA(1, 0), cA + kstep, voffA); PG8_STAGE(PG8_SB(1, 1), cB + hstep + kstep, voffB);
        PG8_WAIT_V(6); PG8_BAR;
    } else {
        PG8_STAGE(PG8_SB(0, 0), cB, voffB); PG8_STAGE(PG8_SA(0, 0), cA, voffA); PG8_STAGE(PG8_SB(0, 1), cB + hstep, voffB); PG8_STAGE(PG8_SA(0, 1), cA + hstep, voffA);
        if (wr == 1) PG8_BAR;
        PG8_WAIT_V(4); PG8_BAR;
        PG8_STAGE(PG8_SB(1, 0), cB + kstep, voffB); PG8_STAGE(PG8_SA(1, 0), cA + kstep, voffA); PG8_STAGE(PG8_SB(1, 1), cB + hstep + kstep, voffB);
        PG8_WAIT_V(6); PG8_BAR;
    }
    for (;;) {
        const bool has_next = S.next(ui + 1, nxt);
        const char* nA = has_next ? PG8_APTR(nxt) : cA; const char* nB = has_next ? PG8_BPTR(nxt) : cB;
        for (int t = 0; t < nt; t += 2) {
            const bool last = (t == nt - 2);
            const char* a1 = cA + (size_t)(t + 1) * kstep;
            const char* a2 = last ? nA : cA + (size_t)(t + 2) * kstep; const char* b2 = last ? nB : cB + (size_t)(t + 2) * kstep;
            const char* a3 = a2 + kstep; const char* b3 = b2 + kstep;
            if (last && has_next) S.a_ready(nxt);
            if constexpr (SP2) {
            PG8_LDB(B0, 0, 0); PG8_LDB(B1, 0, 1); PG8_SCHED; PG8_LDA(At, 0, 0); PG8_STAGE(PG8_SA(1, 1), a1 + hstep, voffA);
            PG8_WAIT_V(8); PG8_WAIT_L(0); PG8_BAR; PG8_MMA(0, 0, At, B0); PG8_MMA(0, 1, At, B1); PG8_BAR; PG8_SCHED;
            PG8_LDA(At, 0, 1); PG8_STAGE(PG8_SB(0, 0), b2, voffB); PG8_STAGE(PG8_SB(0, 1), b2 + hstep, voffB); PG8_STAGE(PG8_SA(0, 0), a2, voffA);
            PG8_WAIT_V(8); PG8_WAIT_L(0); PG8_BAR; PG8_MMA(1, 0, At, B0); PG8_MMA(1, 1, At, B1); PG8_BAR; PG8_SCHED;
            PG8_LDB(B0, 1, 0); PG8_LDB(B1, 1, 1); PG8_SCHED; PG8_LDA(At, 1, 0); PG8_STAGE(PG8_SA(0, 1), a2 + hstep, voffA);
            PG8_WAIT_V(8); PG8_WAIT_L(0); PG8_BAR; PG8_MMA(0, 0, At, B0); PG8_MMA(0, 1, At, B1); PG8_BAR; PG8_SCHED;
            PG8_LDA(At, 1, 1); PG8_STAGE(PG8_SB(1, 0), b3, voffB); PG8_STAGE(PG8_SB(1, 1), b3 + hstep, voffB); PG8_STAGE(PG8_SA(1, 0), a3, voffA);
            PG8_WAIT_V(8); PG8_WAIT_L(0); PG8_BAR; PG8_MMA(1, 0, At, B0); PG8_MMA(1, 1, At, B1); PG8_BAR; PG8_SCHED;
            } else {
            PG8_LDB(B0, 0, 0); PG8_SCHED; PG8_LDA(At, 0, 0); PG8_STAGE(PG8_SA(1, 1), a1 + hstep, voffA);
            PG8_WAIT_L(8); PG8_BAR; PG8_WAIT_L(0); PG8_MMA(0, 0, At, B0); PG8_BAR; PG8_SCHED;
            PG8_LDB(B1, 0, 1); PG8_STAGE(PG8_SB(0, 0), b2, voffB);
            PG8_BAR; PG8_WAIT_L(0); PG8_MMA(0, 1, At, B1); PG8_BAR;
            PG8_LDA(At, 0, 1); PG8_STAGE(PG8_SA(0, 0), a2, voffA);
            PG8_BAR; PG8_WAIT_L(0); PG8_MMA(1, 0, At, B0); PG8_BAR; PG8_SCHED;
            PG8_STAGE(PG8_SB(0, 1), b2 + hstep, voffB);
            PG8_WAIT_V(6); PG8_BAR; PG8_MMA(1, 1, At, B1); PG8_BAR;
            PG8_LDB(B0, 1, 0); PG8_SCHED; PG8_LDA(At, 1, 0); PG8_STAGE(PG8_SA(0, 1), a2 + hstep, voffA);
            PG8_WAIT_L(8); PG8_BAR; PG8_WAIT_L(0); PG8_MMA(0, 0, At, B0); PG8_BAR; PG8_SCHED;
            PG8_LDB(B1, 1, 1); PG8_STAGE(PG8_SB(1, 0), b3, voffB);
            PG8_BAR; PG8_WAIT_L(0); PG8_MMA(0, 1, At, B1); PG8_BAR;
            PG8_LDA(At, 1, 1); PG8_STAGE(PG8_SA(1, 0), a3, voffA);
            PG8_BAR; PG8_WAIT_L(0); PG8_MMA(1, 0, At, B0); PG8_BAR; PG8_SCHED;
            PG8_STAGE(PG8_SB(1, 1), b3 + hstep, voffB);
            PG8_WAIT_V(6); PG8_BAR; PG8_MMA(1, 1, At, B1); PG8_BAR;
            }
        }
        if constexpr (ALIGN_EPI) { if (wr == 0) PG8_BAR; }
        if constexpr (!Epi::AFTER_DRAIN) { E(acc, cur, wr, wc, fr, fq); S.done(cur); }
        if (!has_next) break;
#pragma unroll
        for (int a = 0; a < 2; ++a)
#pragma unroll
            for (int b = 0; b < 2; ++b)
#pragma unroll
                for (int m = 0; m < 4; ++m)
#pragma unroll
                    for (int n = 0; n < 2; ++n) acc[a][b][m][n] = (f32x4){0.f, 0.f, 0.f, 0.f};
        cur = nxt; cA = nA; cB = nB; ++ui;
        if constexpr (ALIGN_EPI) { if (wr == 1) PG8_BAR; }
    }
    PG8_WAIT_V(0);
    if constexpr (!ALIGN_EPI) { if (wr == 0) PG8_BAR; }
    PG8_BAR;
    if constexpr (Epi::AFTER_DRAIN) { E.fused(acc, cur, wr, wc, fr, fq, lds, wid, lane); S.done(cur); }
#undef PG8_APTR
#undef PG8_BPTR
#undef PG8_SA
#undef PG8_SB
#undef PG8_STAGE
#undef PG8_LDA
#undef PG8_LDB
#undef PG8_MMA
#undef PG8_WAIT_V
#undef PG8_WAIT_L
#undef PG8_BAR
#undef PG8_SCHED
}
}

constexpr int DM = 2048, NTOK = 6144, NCTX = 4096, DEPTH = 4;
constexpr int CW = 1024, SW = 1024, INC = 4096, DFF = 5632, UPN = 2 * DFF;
constexpr float EPS = 1e-6f;
constexpr int NWAVES = 8;

constexpr size_t MiB = 1u << 20;
constexpr size_t WS_CTL = 0, CTL_ZERO_BYTES = 1 * MiB;
constexpr size_t WS_MOD = 1 * MiB;
constexpr size_t WS_WIN = 2 * MiB, WS_WGLU = 66 * MiB, WS_WOUT = 74 * MiB, WS_WUP = 106 * MiB, WS_WDN = 282 * MiB;
constexpr size_t WS_H = 370 * MiB;
constexpr size_t WS_GB = 394 * MiB, WS_V = 406 * MiB, WS_U = 418 * MiB;
constexpr size_t WS_Z = 430 * MiB, WS_O = 442 * MiB;
constexpr size_t WS_MIXIN = 454 * MiB, WS_MIXED = 478 * MiB;
constexpr size_t WS_UP = 502 * MiB;
constexpr size_t WS_ACT = 634 * MiB;
constexpr size_t WS_FF = 700 * MiB;
constexpr size_t WS_END = 724 * MiB;
constexpr int CW_SUB = 12288;
constexpr size_t WS_FFP = WS_UP;
constexpr int CW_BAR = 4096;

constexpr int RING_BYTES = 131072;
constexpr int LDS_BYTES = 147456;
constexpr int LDSCTL_OFF = LDS_BYTES - 512, MISC_OFF = LDSCTL_OFF;

#define GAS __attribute__((address_space(1)))
#define LAS __attribute__((address_space(3)))
typedef unsigned short bf16;
typedef unsigned v4u __attribute__((ext_vector_type(4)));
typedef unsigned v2u __attribute__((ext_vector_type(2)));
typedef float f32x4 __attribute__((ext_vector_type(4)));
typedef float f32x2 __attribute__((ext_vector_type(2)));
typedef float f32x16 __attribute__((ext_vector_type(16)));
typedef short bf16x8 __attribute__((ext_vector_type(8)));
typedef GAS unsigned gu32;
#define LDS_WAIT() asm volatile("s_waitcnt lgkmcnt(0)" ::: "memory")

__device__ __forceinline__ unsigned f2bf(float f) { unsigned u = __builtin_bit_cast(unsigned, f); return (u + 0x7fffu + ((u >> 16) & 1u)) >> 16; }
__device__ __forceinline__ unsigned pk2(float lo, float hi) { unsigned r; asm("v_cvt_pk_bf16_f32 %0, %1, %2" : "=v"(r) : "v"(lo), "v"(hi)); return r; }
__device__ __forceinline__ float bflo(unsigned w) { return __uint_as_float(w << 16); }
__device__ __forceinline__ float bfhi(unsigned w) { return __uint_as_float(w & 0xffff0000u); }
__device__ __forceinline__ void unpack8(const v4u w, float (&f)[8]) { f[0] = bflo(w.x); f[1] = bfhi(w.x); f[2] = bflo(w.y); f[3] = bfhi(w.y); f[4] = bflo(w.z); f[5] = bfhi(w.z); f[6] = bflo(w.w); f[7] = bfhi(w.w); }
__device__ __forceinline__ v4u pack8(const float (&f)[8]) { v4u w; w.x = pk2(f[0], f[1]); w.y = pk2(f[2], f[3]); w.z = pk2(f[4], f[5]); w.w = pk2(f[6], f[7]); return w; }
__device__ __forceinline__ float wave_sum(float v) {
#pragma unroll
    for (int o = 1; o < 64; o <<= 1) v += __shfl_xor(v, o);
    return v;
}
__device__ __forceinline__ float sigmoidf_(float x) { return 1.0f / (1.0f + __expf(-x)); }
__device__ __forceinline__ float gelu_tanh(float y) { const float v = 0.7978845608028654f * (y + 0.044715f * y * y * y); const float t = 1.0f - 2.0f / (__expf(2.0f * v) + 1.0f); return 0.5f * y * (1.0f + t); }
__device__ __forceinline__ void sincos_cw(float x, float& s, float& c) {
    const float k = rintf(x * 0.6366197723675814f);
    float r = fmaf(k, -1.5707963705062866f, x);
    r = fmaf(k, 4.371138828673793e-08f, r);
    r = fmaf(k, 1.7763568394002505e-15f, r);
    const float r2 = r * r;
    const float sp = r + r * r2 * fmaf(r2, fmaf(r2, -1.9515295891e-4f, 8.3321608736e-3f), -1.6666654611e-1f);
    const float cp = fmaf(r2 * r2, fmaf(r2, fmaf(r2, 2.443315711809948e-5f, -1.388731625493765e-3f), 4.166664568298827e-2f), fmaf(r2, -0.5f, 1.0f));
    const int q = ((int)k) & 3;
    const float ss = (q & 1) ? cp : sp, cc = (q & 1) ? sp : cp;
    s = (q & 2) ? -ss : ss;
    c = ((q + 1) & 2) ? -cc : cc;
}

__device__ __forceinline__ int fresh_v(int x) { asm volatile("" : "+v"(x)); return x; }
__device__ __forceinline__ int fresh_s(int x) { asm volatile("" : "+s"(x)); return x; }
struct Args { const float* in[30]; float* out; unsigned char* ws; };
struct KImg { unsigned long long in[30]; unsigned long long out; unsigned long long ws; };
struct DArgs { const float* in[30]; float* out; unsigned char* ws; };
__device__ __forceinline__ DArgs load_args() {
    const __attribute__((address_space(4))) KImg* p = (const __attribute__((address_space(4))) KImg*)__builtin_amdgcn_kernarg_segment_ptr();
    asm volatile("" : "+s"(p));
    DArgs a;
#pragma unroll
    for (int i = 0; i < 30; ++i) a.in[i] = (const float*)(GAS const float*)p->in[i];
    a.out = (float*)(GAS float*)p->out; a.ws = (unsigned char*)(GAS unsigned char*)p->ws;
    return a;
}
enum { I_XP = 0, I_XS, I_SRE, I_SIM, I_C, I_CCTX, I_WADA, I_BADA, I_GPRE1, I_WIN, I_CONVW, I_ARE, I_AIM, I_LOGDT, I_BRE, I_BIM, I_CRE, I_CIM, I_SSMD, I_WGLU, I_BGLU,
       I_GCONV, I_GSSM, I_WOUT, I_GPOST1, I_GPRE2, I_WUP, I_FFNW, I_WDOWN, I_GPOST2 };

namespace pg8 {
struct EpiIn {
    static constexpr bool PERM = true, AFTER_DRAIN = false;
    bf16_t *GB, *V, *U;
    __device__ __forceinline__ void operator()(const f32x4 (&acc)[2][2][4][2], const Unit& u, int wr, int wc, int fr, int fq) const {
        const int row0 = u.pm * BM + wr * 64 + fr;
        if (u.pn < 8) {
            const int col0 = u.pn * 128 + wc * 32 + 8 * fq;
#pragma unroll
            for (int ai = 0; ai < 2; ++ai)
#pragma unroll
                for (int m = 0; m < 4; ++m) { bf16_t* rowp = V + (size_t)(row0 + ai * HALF + m * 16) * 1024 + col0;
                    const f32x4 v0 = acc[ai][0][m][0] * acc[ai][1][m][0], v1 = acc[ai][0][m][1] * acc[ai][1][m][1];
                    u32x4 w; w.x = cvt_pk_bf16(v0[0], v0[1]); w.y = cvt_pk_bf16(v0[2], v0[3]); w.z = cvt_pk_bf16(v1[0], v1[1]); w.w = cvt_pk_bf16(v1[2], v1[3]);
                    *(u32x4*)rowp = w; }
        } else {
            const int col0 = (u.pn - 8) * 128 + wc * 32 + 8 * fq;
#pragma unroll
            for (int ai = 0; ai < 2; ++ai)
#pragma unroll
                for (int m = 0; m < 4; ++m) { const size_t off = (size_t)(row0 + ai * HALF + m * 16) * 1024 + col0;
#pragma unroll
                    for (int bj = 0; bj < 2; ++bj) { const f32x4 v0 = acc[ai][bj][m][0], v1 = acc[ai][bj][m][1];
                        u32x4 w; w.x = cvt_pk_bf16(v0[0], v0[1]); w.y = cvt_pk_bf16(v0[2], v0[3]); w.z = cvt_pk_bf16(v1[0], v1[1]); w.w = cvt_pk_bf16(v1[2], v1[3]);
                        *(u32x4*)((bj ? U : GB) + off) = w; } }
        }
    }
};
struct EpiGlu {
    static constexpr bool PERM = true, AFTER_DRAIN = false;
    const bf16_t* Z; bf16_t* O; const float* bias;
    __device__ __forceinline__ void operator()(const f32x4 (&acc)[2][2][4][2], const Unit& u, int wr, int wc, int fr, int fq) const {
        const int row0 = u.pm * BM + wr * 64 + fr, col0 = u.pn * BM + wc * 32 + 8 * fq;
        f32x4 bv[2][2];
#pragma unroll
        for (int bj = 0; bj < 2; ++bj)
#pragma unroll
            for (int n = 0; n < 2; ++n) bv[bj][n] = *(const f32x4*)(bias + col0 + bj * HALF + 4 * n);
#pragma unroll
        for (int ai = 0; ai < 2; ++ai)
#pragma unroll
            for (int m = 0; m < 4; ++m) { const size_t off = (size_t)(row0 + ai * HALF + m * 16) * 1024 + col0;
#pragma unroll
                for (int bj = 0; bj < 2; ++bj) { const u32x4 zw = *(const u32x4*)(Z + off + bj * HALF);
                    const f32x4 g0 = acc[ai][bj][m][0] + bv[bj][0], g1 = acc[ai][bj][m][1] + bv[bj][1];
                    float z[8]; z[0] = __uint_as_float(zw.x << 16); z[1] = __uint_as_float(zw.x & 0xffff0000u); z[2] = __uint_as_float(zw.y << 16); z[3] = __uint_as_float(zw.y & 0xffff0000u);
                    z[4] = __uint_as_float(zw.z << 16); z[5] = __uint_as_float(zw.z & 0xffff0000u); z[6] = __uint_as_float(zw.w << 16); z[7] = __uint_as_float(zw.w & 0xffff0000u);
                    float o[8];
#pragma unroll
                    for (int j = 0; j < 4; ++j) { o[j] = z[j] / (1.0f + __expf(-g0[j])); o[4 + j] = z[4 + j] / (1.0f + __expf(-g1[j])); }
                    u32x4 w; w.x = cvt_pk_bf16(o[0], o[1]); w.y = cvt_pk_bf16(o[2], o[3]); w.z = cvt_pk_bf16(o[4], o[5]); w.w = cvt_pk_bf16(o[6], o[7]);
                    *(u32x4*)(O + off + bj * HALF) = w; } }
    }
};
typedef unsigned u32x2 __attribute__((ext_vector_type(2)));
struct EpiFfn {
    static constexpr bool PERM = true, AFTER_DRAIN = false;
    bf16_t* ACT; const float* fw; PG8_LAS float* xch;
    static __device__ __forceinline__ float ror8(float v) { return __builtin_bit_cast(float, __builtin_amdgcn_mov_dpp(__builtin_bit_cast(int, v), 0x128  , 0xf, 0xf, true)); }
    static __device__ __forceinline__ f32x4 shx8(const f32x4 v) { f32x4 r; r[0] = ror8(v[0]); r[1] = ror8(v[1]); r[2] = ror8(v[2]); r[3] = ror8(v[3]); return r; }
    static __device__ __forceinline__ f32x4 shl(const f32x4 v, int src) { f32x4 r; r[0] = __shfl(v[0], src); r[1] = __shfl(v[1], src); r[2] = __shfl(v[2], src); r[3] = __shfl(v[3], src); return r; }
    static __device__ __forceinline__ f32x4 sel(bool c, const f32x4 a, const f32x4 b) { f32x4 r; r[0] = c ? a[0] : b[0]; r[1] = c ? a[1] : b[1]; r[2] = c ? a[2] : b[2]; r[3] = c ? a[3] : b[3]; return r; }
    __device__ __forceinline__ void operator()(const f32x4 (&acc)[2][2][4][2], const Unit& u, int wr, int wc, int fr, int fq) const {
        const bool ctx = u.pm < 16, h = (fr >> 3) != 0;
        const int c7 = fr & 7, lane = fq * 16 + fr, ch0 = u.pn * 128 + wc * 32 + 8 * fq;
        const f32x4 zero = {0.f, 0.f, 0.f, 0.f};
        f32x4 wa[2][3], wg[2][3];
#pragma unroll
        for (int k = 0; k < 3; ++k) { wa[0][k] = *(const f32x4*)(fw + k * (2 * 5632) + ch0); wg[0][k] = *(const f32x4*)(fw + k * (2 * 5632) + 5632 + ch0); }
        if (ctx) {
            if (wr == 0 && fr == 15) { PG8_LAS f32x4* p = (PG8_LAS f32x4*)(xch + ((wc * 2 + 0) * 4 + fq) * 16); p[0] = acc[1][0][3][0]; p[1] = acc[1][0][3][1]; p[2] = acc[1][1][3][0]; p[3] = acc[1][1][3][1]; }
            if (wr == 1 && fr == 0)  { PG8_LAS f32x4* p = (PG8_LAS f32x4*)(xch + ((wc * 2 + 1) * 4 + fq) * 16); p[0] = acc[0][0][0][0]; p[1] = acc[0][0][0][1]; p[2] = acc[0][1][0][0]; p[3] = acc[0][1][0][1]; }
            asm volatile("s_waitcnt lgkmcnt(0)" ::: "memory"); __builtin_amdgcn_s_barrier(); asm volatile("" ::: "memory");
        }
        const int srcp = (lane + 7) & 63, srcn = (lane - 7) & 63;
        u32x2 keep[8];
#pragma unroll
        for (int n = 0; n < 2; ++n) {
            f32x4 bpa = shl(acc[1][0][3][n], srcp), bpg = shl(acc[1][1][3][n], srcp), bna = shl(acc[0][0][0][n], srcn), bng = shl(acc[0][1][0][n], srcn);
            if (ctx) {
                const PG8_LAS f32x4* p0 = (const PG8_LAS f32x4*)(xch + ((wc * 2 + 0) * 4 + fq) * 16); const PG8_LAS f32x4* p1 = (const PG8_LAS f32x4*)(xch + ((wc * 2 + 1) * 4 + fq) * 16);
                const f32x4 xpa = p0[n], xpg = p0[2 + n], xna = p1[n], xng = p1[2 + n];
                bpa = sel(c7 >= 1, bpa, sel(wr == 1, xpa, zero)); bpg = sel(c7 >= 1, bpg, sel(wr == 1, xpg, zero));
                bna = sel(c7 <= 6, bna, sel(wr == 0, xna, zero)); bng = sel(c7 <= 6, bng, sel(wr == 0, xng, zero));
            } else { bpa = zero; bpg = zero; bna = zero; bng = zero; }
            if (n == 0) {
#pragma unroll
                for (int k = 0; k < 3; ++k) { wa[1][k] = *(const f32x4*)(fw + k * (2 * 5632) + ch0 + 4); wg[1][k] = *(const f32x4*)(fw + k * (2 * 5632) + 5632 + ch0 + 4); }
            }
            f32x4 ea0 = shx8(acc[0][0][0][n]), eg0 = shx8(acc[0][1][0][n]);
            f32x4 pa = sel(h, ea0, bpa), pg = sel(h, eg0, bpg);
#pragma unroll
            for (int s = 0; s < 8; ++s) { const int ai = s >> 2, m = s & 3;
                const f32x4 eap = s < 7 ? shx8(acc[(s + 1) >> 2][0][(s + 1) & 3][n]) : bna, egp = s < 7 ? shx8(acc[(s + 1) >> 2][1][(s + 1) & 3][n]) : bng;
                const f32x4 xa = acc[ai][0][m][n], xg = acc[ai][1][m][n];
                const f32x4 na = sel(h, eap, ea0), ng = sel(h, egp, eg0);
                const f32x4 ca = wa[n][0] * pa + wa[n][1] * xa + wa[n][2] * na, cg = wg[n][0] * pg + wg[n][1] * xg + wg[n][2] * ng;
                const f32x4 t = cg * ca, ex = cg * (-1.442695041f);
                f32x4 den; den[0] = __builtin_amdgcn_exp2f(ex[0]); den[1] = __builtin_amdgcn_exp2f(ex[1]); den[2] = __builtin_amdgcn_exp2f(ex[2]); den[3] = __builtin_amdgcn_exp2f(ex[3]);
                den = den + 1.0f;
                f32x4 rc; rc[0] = __builtin_amdgcn_rcpf(den[0]); rc[1] = __builtin_amdgcn_rcpf(den[1]); rc[2] = __builtin_amdgcn_rcpf(den[2]); rc[3] = __builtin_amdgcn_rcpf(den[3]);
                const f32x4 o = t * rc;
                u32x2 w; w.x = cvt_pk_bf16(o[0], o[1]); w.y = cvt_pk_bf16(o[2], o[3]);
                if (n == 0) keep[s] = w;
                else { u32x4 w4; w4.x = keep[s].x; w4.y = keep[s].y; w4.z = w.x; w4.w = w.y; *(u32x4*)(ACT + (size_t)(u.pm * BM + ai * HALF + wr * 64 + m * 16 + fr) * 5632 + ch0) = w4; }
                pa = na; pg = ng; ea0 = eap; eg0 = egp;
            }
        }
    }
};
struct G4Order {
    int lo, hi, G, c; bool plain;
    __device__ __forceinline__ bool next(int i, Unit& u) const {
        const int L = lo + i * G + c; if (L >= hi) return false;
        StaticOrder so; so.init(24 * BM, 44 * BM, 1, 0);
        if (plain) return so.next(L, u);
        if (L >= 1024) { u.pm = 23; u.pn = 12 + (L - 1024); return true; }
        so.next(L, u); if (u.pm == 23 && u.pn >= 12) so.next(1024 + u.pn - 12, u);
        return true;
    }
    __device__ __forceinline__ void a_ready(const Unit&) const {}
    __device__ __forceinline__ void done(const Unit&) const {}
};
struct G5Order {
    bool st; StaticOrder so; Unit u0;
    __device__ __forceinline__ bool next(int i, Unit& u) const { if (st) return so.next(i, u); if (i != 0 || u0.pm < 0) return false; u = u0; return true; }
    __device__ __forceinline__ void a_ready(const Unit&) const {}
    __device__ __forceinline__ void done(const Unit&) const {}
};
}

__device__ __forceinline__ void cvt_load(const float* __restrict__ W, int N, int k0, int n0, int tid, f32x4 (&r0)[4], f32x4 (&r1)[4]) {
    const int n4 = tid & 31, kp = tid >> 5;
#pragma unroll
    for (int i = 0; i < 4; ++i) { const float* p = W + (size_t)(k0 + 2 * kp + 32 * i) * N + n0 + 4 * n4; r0[i] = __builtin_nontemporal_load((const f32x4*)p); r1[i] = __builtin_nontemporal_load((const f32x4*)(p + N)); }
}
__device__ __forceinline__ void cvt_put(LAS unsigned* T, int tid, const f32x4 (&r0)[4], const f32x4 (&r1)[4]) {
    const int n4 = tid & 31, kp = tid >> 5;
#pragma unroll
    for (int i = 0; i < 4; ++i)
#pragma unroll
        for (int e = 0; e < 4; ++e) T[(4 * n4 + e) * 65 + kp + 16 * i] = pk2(r0[i][e], r1[i][e]);
}
__device__ __forceinline__ void cvt_store(const LAS unsigned* T, bf16* __restrict__ Bt, int K, int k0, int j0, int tid) {
    const int n = tid >> 2, kc = tid & 3;
    unsigned w[16];
#pragma unroll
    for (int i = 0; i < 16; ++i) w[i] = T[n * 65 + 16 * kc + i];
    v4u* dst = (v4u*)(Bt + (size_t)(j0 + n) * K + k0 + 32 * kc);
#pragma unroll
    for (int q = 0; q < 4; ++q) { v4u o; o.x = w[4 * q]; o.y = w[4 * q + 1]; o.z = w[4 * q + 2]; o.w = w[4 * q + 3]; dst[q] = o; }
}
constexpr int CVT_PER_LAYER = 512 + 64 + 256 + 1408 + 704;
struct CvtD { const float* W; bf16* Bt; int N, K, k0, n0, j0; };
__device__ __forceinline__ CvtD cvt_desc(const DArgs& a, int it) {
    const int l = it / CVT_PER_LAYER; int r = it % CVT_PER_LAYER;
    const float* W; bf16* Bt; int N, K, jb, kb, n0;
    if (r < 512) { N = INC; K = DM; W = a.in[I_WIN] + (size_t)l * K * N; Bt = (bf16*)(a.ws + WS_WIN) + (size_t)l * N * K; kb = r >> 5; jb = r & 31;
        const int pn = jb >> 1, bj = jb & 1; n0 = pn < 8 ? ((bj ? 2048 : 1024) + 128 * pn) : ((bj ? 3072 : 0) + 128 * (pn - 8)); }
    else if (r < 576) { r -= 512; N = SW; K = SW; W = a.in[I_WGLU] + (size_t)l * K * N; Bt = (bf16*)(a.ws + WS_WGLU) + (size_t)l * N * K; kb = r >> 3; jb = r & 7; n0 = 128 * jb; }
    else if (r < 832) { r -= 576; N = DM; K = DM; W = a.in[I_WOUT] + (size_t)l * K * N; Bt = (bf16*)(a.ws + WS_WOUT) + (size_t)l * N * K; kb = r >> 4; jb = r & 15; n0 = 128 * jb; }
    else if (r < 2240) { r -= 832; N = UPN; K = DM; W = a.in[I_WUP] + (size_t)l * K * N; Bt = (bf16*)(a.ws + WS_WUP) + (size_t)l * N * K; kb = r / 88; jb = r % 88; n0 = ((jb & 1) ? DFF : 0) + 128 * (jb >> 1); }
    else { r -= 2240; N = DM; K = DFF; W = a.in[I_WDOWN] + (size_t)l * K * N; Bt = (bf16*)(a.ws + WS_WDN) + (size_t)l * N * K; kb = r >> 4; jb = r & 15; n0 = 128 * jb; }
    CvtD d; d.W = W; d.Bt = Bt; d.N = N; d.K = K; d.k0 = 128 * kb; d.n0 = n0; d.j0 = 128 * jb; return d;
}

constexpr int CW_CVT = 8192;
#define CVT_LDS_BAR() asm volatile("s_waitcnt lgkmcnt(0)\n\ts_barrier" ::: "memory")
__device__ __forceinline__ void cvt_fill(LAS unsigned char* lds, int tid_, int ln, int budget  ) {
    const int tid = fresh_v(tid_);
    volatile LAS unsigned* tk = (volatile LAS unsigned*)(lds + MISC_OFF) + 16;
    LAS unsigned* T0 = (LAS unsigned*)lds; LAS unsigned* T1 = T0 + 128 * 65;
    const int npairs = budget < 0 ? 0x7fffffff : (budget + 1) / 2;
    if (npairs <= 0) return;
    if (tid == 0) { const DArgs a = load_args(); tk[0] = __hip_atomic_fetch_add((unsigned*)(a.ws + WS_CTL) + CW_CVT + 64 * ln, 1u, __ATOMIC_RELAXED, __HIP_MEMORY_SCOPE_AGENT); }
    __syncthreads();
    for (int n = 0; n < npairs; ++n) {
        const unsigned t = tk[n & 1];
        if (2u * t >= (unsigned)CVT_PER_LAYER) break;
        const DArgs a = load_args();
        unsigned nx = 0xffffffffu;
        if (tid == 0 && n + 1 < npairs) nx = __hip_atomic_fetch_add((unsigned*)(a.ws + WS_CTL) + CW_CVT + 64 * ln, 1u, __ATOMIC_RELAXED, __HIP_MEMORY_SCOPE_AGENT);
        const CvtD d0 = cvt_desc(a, ln * CVT_PER_LAYER + 2 * (int)t), d1 = cvt_desc(a, ln * CVT_PER_LAYER + 2 * (int)t + 1);
        f32x4 a0[4], a1[4], b0[4], b1[4];
        cvt_load(d0.W, d0.N, d0.k0, d0.n0, tid, a0, a1); cvt_load(d1.W, d1.N, d1.k0, d1.n0, tid, b0, b1);
        cvt_put(T0, tid, a0, a1); cvt_put(T1, tid, b0, b1);
        if (tid == 0) tk[(n + 1) & 1] = nx;
        CVT_LDS_BAR();
        cvt_store(T0, d0.Bt, d0.K, d0.k0, d0.j0, tid); cvt_store(T1, d1.Bt, d1.K, d1.k0, d1.j0, tid);
        CVT_LDS_BAR();
    }
    __syncthreads();
}
__device__ __forceinline__ void mod_task(LAS unsigned char* lds, int tid_, int lane_, int wave_, int task) {
    const DArgs a = load_args(); const int tid = fresh_v(tid_), lane = fresh_v(lane_), wave = fresh_s(wave_);
    LAS float* SC = (LAS float*)(lds + 36864);
    LAS float* RED = (LAS float*)(lds + 36864 + 24576);
    const int l = task / 48, j0 = (task % 48) * 256;
    for (int i = tid; i < 3 * DM; i += 512) { const int v = i >> 11, k = i & 2047; const float x = v == 0 ? a.in[I_CCTX][k] : a.in[I_C][(v - 1) * DM + k]; SC[i] = x / (1.0f + __expf(-x)); }
    __syncthreads();
    const float* W = a.in[I_WADA] + (size_t)l * DM * 12288 + j0 + 4 * lane;
    f32x4 a0 = {0.f, 0.f, 0.f, 0.f}, a1 = a0, a2 = a0;
    const int kbeg = wave * 256;
    for (int k = kbeg; k < kbeg + 256; k += 8) {
        f32x4 w[8];
#pragma unroll
        for (int u = 0; u < 8; ++u) w[u] = __builtin_nontemporal_load((const f32x4*)(W + (size_t)(k + u) * 12288));
#pragma unroll
        for (int u = 0; u < 8; ++u) { const float s0 = SC[k + u], s1 = SC[2048 + k + u], s2 = SC[4096 + k + u]; a0 += w[u] * s0; a1 += w[u] * s1; a2 += w[u] * s2; }
    }
    *(LAS f32x4*)(RED + (wave * 3 + 0) * 256 + 4 * lane) = a0;
    *(LAS f32x4*)(RED + (wave * 3 + 1) * 256 + 4 * lane) = a1;
    *(LAS f32x4*)(RED + (wave * 3 + 2) * 256 + 4 * lane) = a2;
    __syncthreads();
    float* MOD = (float*)(a.ws + WS_MOD);
    for (int i = tid; i < 768; i += 512) { const int v = i >> 8, jj = i & 255; float s = a.in[I_BADA][l * 12288 + j0 + jj];
#pragma unroll
        for (int w8 = 0; w8 < 8; ++w8) s += RED[(w8 * 3 + v) * 256 + jj];
        const int ch = (j0 + jj) >> 11, e = (j0 + jj) & 2047;
        if (ch == 1) s = (1.0f + s) * a.in[I_GPRE1][l * DM + e]; else if (ch == 2) s *= a.in[I_GPOST1][l * DM + e];
        else if (ch == 4) s = (1.0f + s) * a.in[I_GPRE2][l * DM + e]; else if (ch == 5) s *= a.in[I_GPOST2][l * DM + e];
        MOD[(size_t)(l * 3 + v) * 12288 + j0 + jj] = s; }
    __syncthreads();
}

__device__ __forceinline__ int mod_vec(int row) { return row < NCTX ? 0 : 1 + ((row - NCTX) >> 10); }
__device__ __forceinline__ int perm_row(int row) {
    int gr, cc, base;
    if (row < NCTX) { const int t = row & 255; gr = t & 15; cc = t >> 4; base = row & ~255; }
    else { const int q = row - NCTX, p = q & 1023; gr = p >> 6; cc = p & 15; base = NCTX + ((q >> 10) * 4 + ((p >> 4) & 3)) * 256; }
    return base + 128 * (gr >> 3) + 64 * (cc >> 3) + 16 * ((gr >> 1) & 3) + 8 * (gr & 1) + (cc & 7);
}
constexpr size_t WS_XH = WS_UP + 8 * MiB, WS_XL = WS_UP + 40 * MiB;
__device__ __forceinline__ void x24_load(const unsigned char* ws, int row, int e0, float (&o)[8]) {
    const v4u h = __builtin_nontemporal_load((const v4u*)((const unsigned short*)(ws + WS_XH) + (size_t)row * DM + e0)); const v2u lo = __builtin_nontemporal_load((const v2u*)(ws + WS_XL + (size_t)row * DM + e0));
    const unsigned hw[4] = {h.x, h.y, h.z, h.w}, lw[2] = {lo.x, lo.y};
#pragma unroll
    for (int i = 0; i < 8; ++i) { const unsigned hi = (i & 1) ? (hw[i >> 1] & 0xffff0000u) : (hw[i >> 1] << 16); const unsigned l8 = (lw[i >> 2] >> (8 * (i & 3))) & 0xffu; o[i] = __uint_as_float(hi | (l8 << 8)); }
}
__device__ __forceinline__ void x24_store(unsigned char* ws, int row, int e0, const float (&x)[8]) {
    unsigned b[8];
#pragma unroll
    for (int i = 0; i < 8; ++i) b[i] = __float_as_uint(x[i]) + 0x80u;
    v4u h; h.x = (b[0] >> 16) | (b[1] & 0xffff0000u); h.y = (b[2] >> 16) | (b[3] & 0xffff0000u); h.z = (b[4] >> 16) | (b[5] & 0xffff0000u); h.w = (b[6] >> 16) | (b[7] & 0xffff0000u);
    v2u lo; lo.x = ((b[0] >> 8) & 0xffu) | (b[1] & 0xff00u) | ((b[2] << 8) & 0xff0000u) | ((b[3] << 16) & 0xff000000u); lo.y = ((b[4] >> 8) & 0xffu) | (b[5] & 0xff00u) | ((b[6] << 8) & 0xff0000u) | ((b[7] << 16) & 0xff000000u);
    *(v4u*)((unsigned short*)(ws + WS_XH) + (size_t)row * DM + e0) = h; *(v2u*)(ws + WS_XL + (size_t)row * DM + e0) = lo;
}
template <int MODE>
__device__ __forceinline__ void row_pass(int l, int bx_, int G_, int wave_, int lane_, bool split23 = false) {
    const int bx = fresh_s(bx_), G = fresh_s(G_), wave = fresh_s(wave_), lane = fresh_v(lane_);
    constexpr bool FIRST = (MODE == 0), HAS_NEXT = (MODE != 3);
    const DArgs a = load_args();
    const float* MOD = (const float*)(a.ws + WS_MOD);
    const float* modl = MOD + (size_t)l * 3 * 12288;
    const bf16* Y = (const bf16*)(a.ws + (MODE == 1 ? WS_MIXED : WS_FF));
    const float* modg = modl + (MODE == 1 ? 2 : 5) * DM;
    const float* modn = MODE == 2 ? modl + 3 * 12288 : modl;
    const int sc_off = (MODE == 1 ? 4 : 1) * DM, sh_off = (MODE == 1 ? 3 : 0) * DM;
    bf16* Hdst = (bf16*)(a.ws + WS_H);
    const int rpw = (NTOK + G * NWAVES - 1) / (G * NWAVES), rbeg = (bx * NWAVES + wave) * rpw, rend = rbeg + rpw < NTOK ? rbeg + rpw : NTOK;
    int vprev = -1;
    f32x4 gv[8], cv[8], hv[8];
#pragma unroll
    for (int j = 0; j < 8; ++j) { gv[j] = (f32x4){0.f, 0.f, 0.f, 0.f}; cv[j] = gv[j]; hv[j] = gv[j]; }
    for (int row = rbeg; row < rend; ++row) {
        const int v = mod_vec(row);
        if (v != vprev) { vprev = v;
#pragma unroll
            for (int j = 0; j < 4; ++j) { const int e0 = 8 * lane + 512 * j;
                if (!FIRST) { const float* gate = modg + (size_t)v * 12288; gv[2 * j] = *(const f32x4*)(gate + e0); gv[2 * j + 1] = *(const f32x4*)(gate + e0 + 4); }
                if (HAS_NEXT) { const float* sc = modn + (size_t)v * 12288 + sc_off; const float* sh = modn + (size_t)v * 12288 + sh_off;
                    cv[2 * j] = *(const f32x4*)(sc + e0); cv[2 * j + 1] = *(const f32x4*)(sc + e0 + 4); hv[2 * j] = *(const f32x4*)(sh + e0); hv[2 * j + 1] = *(const f32x4*)(sh + e0 + 4); } } }
        float* xr = a.out + (size_t)row * DM;
        float x[32];
        if (FIRST) {
            const float* src = row < NCTX ? a.in[I_XP] + (size_t)row * DM : a.in[I_XS] + (size_t)(row - NCTX) * DM;
#pragma unroll
            for (int j = 0; j < 4; ++j) { const f32x4 p = __builtin_nontemporal_load((const f32x4*)(src + 8 * lane + 512 * j)), q = __builtin_nontemporal_load((const f32x4*)(src + 8 * lane + 512 * j + 4));
                x[8 * j] = p[0]; x[8 * j + 1] = p[1]; x[8 * j + 2] = p[2]; x[8 * j + 3] = p[3]; x[8 * j + 4] = q[0]; x[8 * j + 5] = q[1]; x[8 * j + 6] = q[2]; x[8 * j + 7] = q[3];
                const float t8[8] = {p[0], p[1], p[2], p[3], q[0], q[1], q[2], q[3]}; x24_store(a.ws, row, 8 * lane + 512 * j, t8); }
        } else {
            float y[32]; float ssq = 0.f;
            const int pr = MODE == 1 ? row : perm_row(row);
            const bool sp23 = MODE != 1 && split23 && pr >= 23 * 256;
            const bf16* yr = sp23 ? (const bf16*)(a.ws + WS_FFP) + (size_t)(pr - 23 * 256) * DM : Y + (size_t)pr * DM;
#pragma unroll
            for (int j = 0; j < 4; ++j) { const v4u w = __builtin_nontemporal_load((const v4u*)(yr + 8 * lane + 512 * j)); float t[8]; unpack8(w, t);
                if (sp23) {
#pragma unroll
                    for (int sp = 1; sp < 4; ++sp) { float t2[8]; unpack8(*(const v4u*)(yr + (size_t)sp * 256 * DM + 8 * lane + 512 * j), t2);
#pragma unroll
                        for (int i = 0; i < 8; ++i) t[i] += t2[i]; } }
#pragma unroll
                for (int i = 0; i < 8; ++i) { y[8 * j + i] = t[i]; ssq += t[i] * t[i]; } }
            ssq = wave_sum(ssq);
            const float rs = 1.0f / sqrtf(ssq * (1.0f / DM) + EPS);
#pragma unroll
            for (int j = 0; j < 4; ++j) { const int e0 = 8 * lane + 512 * j;
                float xo[8]; x24_load(a.ws, row, e0, xo);
                const f32x4 g0 = gv[2 * j], g1 = gv[2 * j + 1];
                f32x4 np, nq;
#pragma unroll
                for (int i = 0; i < 4; ++i) { np[i] = xo[i] + g0[i] * (y[8 * j + i] * rs); nq[i] = xo[4 + i] + g1[i] * (y[8 * j + 4 + i] * rs); x[8 * j + i] = np[i]; x[8 * j + 4 + i] = nq[i]; }
                if (MODE == 3) { *(f32x4*)(xr + e0) = np; *(f32x4*)(xr + e0 + 4) = nq; }
                else { const float t8[8] = {np[0], np[1], np[2], np[3], nq[0], nq[1], nq[2], nq[3]}; x24_store(a.ws, row, e0, t8); } }
        }
        if (HAS_NEXT) {
            float ssq = 0.f;
#pragma unroll
            for (int i = 0; i < 32; ++i) ssq += x[i] * x[i];
            ssq = wave_sum(ssq);
            const float rs = 1.0f / sqrtf(ssq * (1.0f / DM) + EPS);
            bf16* hr = Hdst + (size_t)(MODE == 1 ? perm_row(row) : row) * DM;
#pragma unroll
            for (int j = 0; j < 4; ++j) { const int e0 = 8 * lane + 512 * j;
                const f32x4 c0 = cv[2 * j], c1 = cv[2 * j + 1], h0 = hv[2 * j], h1 = hv[2 * j + 1];
                float o[8];
#pragma unroll
                for (int i = 0; i < 4; ++i) { o[i] = x[8 * j + i] * rs * c0[i] + h0[i]; o[4 + i] = x[8 * j + 4 + i] * rs * c1[i] + h1[i]; }
                *(v4u*)(hr + e0) = pack8(o); }
        }
    }
}

__device__ __forceinline__ void mix_pass(int bx_, int G_, int wave_, int lane_, int l) {
    const DArgs a = load_args(); const int bx = fresh_s(bx_), G = fresh_s(G_), wave = fresh_s(wave_), lane = fresh_v(lane_);
    const bf16* GB = (const bf16*)(a.ws + WS_GB); const bf16* V = (const bf16*)(a.ws + WS_V); const bf16* O = (const bf16*)(a.ws + WS_O); bf16* MX = (bf16*)(a.ws + WS_MIXIN);
    const float* cw = a.in[I_CONVW] + (size_t)l * 3 * CW; const float* gc = a.in[I_GCONV] + (size_t)l * CW; const float* gs = a.in[I_GSSM] + (size_t)l * SW;
    float w0r[16], w1r[16], w2r[16], gcr[16], gsr[16];
#pragma unroll
    for (int j = 0; j < 2; ++j) { const int c0 = 8 * lane + 512 * j;
#pragma unroll
        for (int hq = 0; hq < 2; ++hq) { const f32x4 t0 = *(const f32x4*)(cw + c0 + 4 * hq), t1 = *(const f32x4*)(cw + CW + c0 + 4 * hq), t2 = *(const f32x4*)(cw + 2 * CW + c0 + 4 * hq),
                                               t3 = *(const f32x4*)(gc + c0 + 4 * hq), t4 = *(const f32x4*)(gs + c0 + 4 * hq);
#pragma unroll
            for (int i = 0; i < 4; ++i) { w0r[8 * j + 4 * hq + i] = t0[i]; w1r[8 * j + 4 * hq + i] = t1[i]; w2r[8 * j + 4 * hq + i] = t2[i]; gcr[8 * j + 4 * hq + i] = t3[i]; gsr[8 * j + 4 * hq + i] = t4[i]; } } }
    const int rpw = (NTOK + G * NWAVES - 1) / (G * NWAVES), rbeg = (bx * NWAVES + wave) * rpw, rend = rbeg + rpw < NTOK ? rbeg + rpw : NTOK;
    for (int row = rbeg; row < rend; ++row) {
        bool hp, hn;
        if (row < NCTX) { const int t = row & 255; hp = t > 0; hn = t < 255; } else { const int c = (row - NCTX) & 63; hp = c > 0; hn = c < 63; }
#pragma unroll
        for (int j = 0; j < 2; ++j) { const int c0 = 8 * lane + 512 * j; const size_t off = (size_t)row * CW + c0;
            float vc[8], vp[8], vn[8], gb[8];
            unpack8(*(const v4u*)(V + off), vc); unpack8(__builtin_nontemporal_load((const v4u*)(GB + off)), gb);
            if (hp) unpack8(*(const v4u*)(V + off - CW), vp); else {
#pragma unroll
                for (int i = 0; i < 8; ++i) vp[i] = 0.f; }
            if (hn) unpack8(*(const v4u*)(V + off + CW), vn); else {
#pragma unroll
                for (int i = 0; i < 8; ++i) vn[i] = 0.f; }
            float o[8]; float ssq = 0.f;
#pragma unroll
            for (int i = 0; i < 8; ++i) { o[i] = gb[i] * (w0r[8 * j + i] * vp[i] + w1r[8 * j + i] * vc[i] + w2r[8 * j + i] * vn[i]); ssq += o[i] * o[i]; }
            ssq += __shfl_xor(ssq, 1); ssq += __shfl_xor(ssq, 2); ssq += __shfl_xor(ssq, 4);
            const float rs = 1.0f / sqrtf(ssq * (1.0f / 64.0f) + EPS);
#pragma unroll
            for (int i = 0; i < 8; ++i) o[i] = o[i] * rs * gcr[8 * j + i];
            *(v4u*)(MX + (size_t)row * DM + c0) = pack8(o); }
        float s[16]; float ssq = 0.f;
#pragma unroll
        for (int j = 0; j < 2; ++j) { float t[8]; unpack8(__builtin_nontemporal_load((const v4u*)(O + (size_t)row * SW + 8 * lane + 512 * j)), t);
#pragma unroll
            for (int i = 0; i < 8; ++i) { s[8 * j + i] = t[i]; ssq += t[i] * t[i]; } }
        ssq = wave_sum(ssq);
        const float rs = 1.0f / sqrtf(ssq * (1.0f / SW) + EPS);
#pragma unroll
        for (int j = 0; j < 2; ++j) { const int c0 = 8 * lane + 512 * j; float o[8];
#pragma unroll
            for (int i = 0; i < 8; ++i) o[i] = s[8 * j + i] * rs * gsr[8 * j + i];
            *(v4u*)(MX + (size_t)row * DM + CW + c0) = pack8(o); }
    }
}

struct S5C { bf16x8 Bf[2][4]; float ar[2][2], ai[2][2]; };
__device__ __forceinline__ void s5_setup(const DArgs& a, LAS unsigned char* lds, int lane, int wave, int l, int g, S5C& c) {
    const int n = lane & 31, hf = lane >> 5, tq = lane & 15, q = lane >> 4;
    LAS unsigned char* CFB = lds + 135168;
    LAS float* A16 = (LAS float*)(lds + 143360);
#pragma unroll
    for (int d = 0; d < 2; ++d) {
        const int pg = (l * 2 + d) * 64 + g;
        const float dt = expf(a.in[I_LOGDT][pg]);
#pragma unroll
        for (int s = 0; s < 2; ++s) { const int nn = n + 32 * s;
            const float are = a.in[I_ARE][pg * 64 + nn], aim = a.in[I_AIM][pg * 64 + nn];
            const float er = expf(are * dt); float sn, cs; sincos_cw(aim * dt, sn, cs);
            const float abr = er * cs, abi = er * sn; c.ar[d][s] = abr; c.ai[d][s] = abi;
            if (wave == 0 && hf == 0) { const float e16 = expf(16.0f * are * dt); float s16, c16; sincos_cw(16.0f * aim * dt, s16, c16); *(LAS f32x2*)(A16 + (d * 64 + nn) * 2) = (f32x2){e16 * c16, e16 * s16}; }
            const float inv = 1.0f / (are * are + aim * aim);
            const float cr = ((abr - 1.0f) * are + abi * aim) * inv, ci = (abi * are - (abr - 1.0f) * aim) * inv;
            const float* brp = a.in[I_BRE] + (unsigned)((pg * 64 + nn) * 16 + 8 * hf); const float* bip = a.in[I_BIM] + (unsigned)((pg * 64 + nn) * 16 + 8 * hf);
            const f32x4 br0 = *(const f32x4*)brp, br1 = *(const f32x4*)(brp + 4), bi0 = *(const f32x4*)bip, bi1 = *(const f32x4*)(bip + 4);
            v4u wr_, wi_;
            wr_.x = pk2(cr * br0[0] - ci * bi0[0], cr * br0[1] - ci * bi0[1]); wr_.y = pk2(cr * br0[2] - ci * bi0[2], cr * br0[3] - ci * bi0[3]);
            wr_.z = pk2(cr * br1[0] - ci * bi1[0], cr * br1[1] - ci * bi1[1]); wr_.w = pk2(cr * br1[2] - ci * bi1[2], cr * br1[3] - ci * bi1[3]);
            wi_.x = pk2(cr * bi0[0] + ci * br0[0], cr * bi0[1] + ci * br0[1]); wi_.y = pk2(cr * bi0[2] + ci * br0[2], cr * bi0[3] + ci * br0[3]);
            wi_.z = pk2(cr * bi1[0] + ci * br1[0], cr * bi1[1] + ci * br1[1]); wi_.w = pk2(cr * bi1[2] + ci * br1[2], cr * bi1[3] + ci * br1[3]);
            c.Bf[d][2 * s] = __builtin_bit_cast(bf16x8, wr_); c.Bf[d][2 * s + 1] = __builtin_bit_cast(bf16x8, wi_); }
        if (wave == 0) {
            const float* crp = a.in[I_CRE] + (unsigned)((pg * 16 + tq) * 64); const float* cip = a.in[I_CIM] + (unsigned)((pg * 16 + tq) * 64);
#pragma unroll
            for (int ks = 0; ks < 4; ++ks) { const int n0 = 8 * ks + 2 * q;
                const f32x2 cr0 = *(const f32x2*)(crp + n0), cr1 = *(const f32x2*)(crp + n0 + 32), ci0 = *(const f32x2*)(cip + n0), ci1 = *(const f32x2*)(cip + n0 + 32);
                v4u w; w.x = pk2(cr0[0], -ci0[0]); w.y = pk2(cr1[0], -ci1[0]); w.z = pk2(cr0[1], -ci0[1]); w.w = pk2(cr1[1], -ci1[1]);
                *(LAS v4u*)(CFB + ((d * 4 + ks) * 64 + lane) * 16) = w; }
        }
    }
}
__device__ __forceinline__ void s5_task(const DArgs& a, LAS unsigned char* lds, int tid, int lane, int wave, int l, int row0, int NC, int g, int bidx, bool latent, const S5C& cst, bf16x8& Afpre, int next_row0) {
#define S5_BAR() do { asm volatile("s_waitcnt lgkmcnt(0)" ::: "memory"); __builtin_amdgcn_s_barrier(); asm volatile("" ::: "memory"); } while (0)
    const int n = lane & 31, hf = lane >> 5, tq = lane & 15, q = lane >> 4;
    LAS float* EB = (LAS float*)lds;
    LAS unsigned char* SB = lds + 65536 + wave * 8704;
    const bf16* U = (const bf16*)(a.ws + WS_U); bf16* Z = (bf16*)(a.ws + WS_Z);
    LAS unsigned char* CFB = lds + 135168;
    const LAS float* A16 = (const LAS float*)(lds + 143360);
    bf16x8 Bf[2][4]; float ar[2][2], ai[2][2];
#pragma unroll
    for (int d = 0; d < 2; ++d) {
#pragma unroll
        for (int cb = 0; cb < 4; ++cb) Bf[d][cb] = cst.Bf[d][cb];
#pragma unroll
        for (int s2 = 0; s2 < 2; ++s2) { ar[d][s2] = cst.ar[d][s2]; ai[d][s2] = cst.ai[d][s2]; } }
    const f32x16 zero16 = {0.f, 0.f, 0.f, 0.f, 0.f, 0.f, 0.f, 0.f, 0.f, 0.f, 0.f, 0.f, 0.f, 0.f, 0.f, 0.f};
    const int cbit = (n >> 2) & 1, tA = (n >> 3) * 4 + (n & 3);
#define S5_PIN_BU() asm volatile("s_nop 15\n\ts_nop 15\n\ts_nop 15\n\ts_nop 15\n\ts_nop 15\n\ts_nop 15\n\ts_nop 15\n\ts_nop 15\n\ts_nop 15\n\ts_nop 15\n\ts_nop 15\n\ts_nop 15\n\ts_nop 15\n\ts_nop 15\n\ts_nop 15\n\ts_nop 15\n\ts_nop 15\n\ts_nop 15\n\ts_nop 15\n\ts_nop 15" : "+v"(acc[0]), "+v"(acc[1]), "+v"(acc[2]), "+v"(acc[3]) : "v"(Afd), "v"(Bf[d][0]), "v"(Bf[d][1]), "v"(Bf[d][2]), "v"(Bf[d][3]))
    bf16x8 Afk = {0, 0, 0, 0, 0, 0, 0, 0};
    bf16x8 Afn = Afpre;
    for (int item = wave; item < NC / 2; item += NWAVES) { const int c0 = 2 * item;
        const bf16x8 Af = Afn;
        if (item + NWAVES < NC / 2) Afn = *(const bf16x8*)(U + (unsigned)((row0 + (c0 + 2 * NWAVES + cbit) * 16 + tA) * SW + g * 16 + 8 * hf));
        Afk = Af;
#pragma unroll
        for (int d = 0; d < 2; ++d) {
            bf16x8 Afd = Af; asm volatile("" : "+v"(Afd) :: "memory");
            f32x16 acc[4];
#pragma unroll
            for (int cb = 0; cb < 4; ++cb) acc[cb] = __builtin_amdgcn_mfma_f32_32x32x16_bf16(Afd, Bf[d][cb], zero16, 0, 0, 0);
            S5_PIN_BU();
            float s0r = 0.f, s0i = 0.f, s1r = 0.f, s1i = 0.f;
#pragma unroll
            for (int ii = 0; ii < 16; ++ii) { const int i = d == 0 ? ii : 15 - ii;
                const float n0r = fmaf(ar[d][0], s0r, fmaf(-ai[d][0], s0i, acc[0][i])), n0i = fmaf(ar[d][0], s0i, fmaf(ai[d][0], s0r, acc[1][i]));
                const float n1r = fmaf(ar[d][1], s1r, fmaf(-ai[d][1], s1i, acc[2][i])), n1i = fmaf(ar[d][1], s1i, fmaf(ai[d][1], s1r, acc[3][i]));
                s0r = n0r; s0i = n0i; s1r = n1r; s1i = n1i; }
            *(LAS f32x4*)(EB + (d * 64 + c0 + hf) * 128 + 4 * n) = (f32x4){s0r, s0i, s1r, s1i};
            asm volatile("s_waitcnt lgkmcnt(0)" :: "v"(s0r), "v"(s0i), "v"(s1r), "v"(s1i) : "memory");
        }
    }
    S5_BAR();
    if (tid < 128) { const int d = tid >> 6, nn = tid & 63, pos = nn < 32 ? 4 * nn : 4 * (nn - 32) + 2;
        const f32x2 p16 = *(const LAS f32x2*)(A16 + (d * 64 + nn) * 2); const float pr = p16[0], pi = p16[1];
        const unsigned sidx = ((((unsigned)bidx * DEPTH + l) * 2 + d) * 64 + g) * 64 + nn;
        float sr = 0.f, si = 0.f;
        if (latent) { sr = a.in[I_SRE][sidx]; si = a.in[I_SIM][sidx]; }
        for (int cb8 = 0; cb8 < NC; cb8 += 8) {
            f32x2 e[8];
#pragma unroll
            for (int j = 0; j < 8; ++j) { const int c = d == 0 ? cb8 + j : NC - 1 - cb8 - j; e[j] = *(const LAS f32x2*)(EB + (d * 64 + c) * 128 + pos); }
#pragma unroll
            for (int j = 0; j < 8; ++j) { const int c = d == 0 ? cb8 + j : NC - 1 - cb8 - j; const f32x2 sv = {sr, si};
                const float nr = fmaf(pr, sr, fmaf(-pi, si, e[j][0])), ni = fmaf(pr, si, fmaf(pi, sr, e[j][1])); sr = nr; si = ni;
                *(LAS f32x2*)(EB + (d * 64 + c) * 128 + pos) = sv; }
        }
        if (!latent) { float* ns = a.out + (size_t)NTOK * DM; ns[sidx] = sr; ns[524288u + sidx] = si; }
    }
    S5_BAR();
    if (next_row0 >= 0) Afpre = *(const bf16x8*)(U + (unsigned)((next_row0 + (2 * wave + cbit) * 16 + tA) * SW + g * 16 + 8 * hf));
    if (latent) Afn = *(const bf16x8*)(U + (unsigned)((row0 + (2 * wave + cbit) * 16 + tA) * SW + g * 16 + 8 * hf));
    const f32x4 dd = *(const f32x4*)(a.in[I_SSMD] + (unsigned)(l * SW + g * 16 + 4 * q));
    for (int item = wave; item < NC / 2; item += NWAVES) { const int c0 = 2 * item;
        bf16x8 Af = Afk;
        if (latent) { Af = Afn; if (item + NWAVES < NC / 2) Afn = *(const bf16x8*)(U + (unsigned)((row0 + (c0 + 2 * NWAVES + cbit) * 16 + tA) * SW + g * 16 + 8 * hf)); }
        v2u uwv[2];
#pragma unroll
        for (int cc = 0; cc < 2; ++cc) uwv[cc] = *(const v2u*)(U + (unsigned)((row0 + (c0 + cc) * 16 + tq) * SW + g * 16 + 4 * q));
        f32x4 yacc[2] = {{0.f, 0.f, 0.f, 0.f}, {0.f, 0.f, 0.f, 0.f}};
#pragma unroll
        for (int d = 0; d < 2; ++d) {
            bf16x8 Afd = Af; asm volatile("" : "+v"(Afd) :: "memory");
            f32x16 acc[4];
#pragma unroll
            for (int cb = 0; cb < 4; ++cb) acc[cb] = __builtin_amdgcn_mfma_f32_32x32x16_bf16(Afd, Bf[d][cb], zero16, 0, 0, 0);
            S5_PIN_BU();
            const f32x4 s_in = *(const LAS f32x4*)(EB + (d * 64 + c0 + hf) * 128 + 4 * n);
            float s0r = s_in[0], s0i = s_in[1], s1r = s_in[2], s1i = s_in[3];
            v2u w[16];
#pragma unroll
            for (int ii = 0; ii < 16; ++ii) { const int i = d == 0 ? ii : 15 - ii;
                const float n0r = fmaf(ar[d][0], s0r, fmaf(-ai[d][0], s0i, acc[0][i])), n0i = fmaf(ar[d][0], s0i, fmaf(ai[d][0], s0r, acc[1][i]));
                const float n1r = fmaf(ar[d][1], s1r, fmaf(-ai[d][1], s1i, acc[2][i])), n1i = fmaf(ar[d][1], s1i, fmaf(ai[d][1], s1r, acc[3][i]));
                s0r = n0r; s0i = n0i; s1r = n1r; s1i = n1i;
                w[i].x = pk2(s0r, s0i); w[i].y = pk2(s1r, s1i); }
#pragma unroll
            for (int i = 0; i < 16; ++i) *(LAS v2u*)(SB + (hf * 16 + i) * 272 + 8 * n) = w[i];
            asm volatile("s_waitcnt lgkmcnt(0)" :: "v"(w[0]), "v"(w[1]), "v"(w[2]), "v"(w[3]), "v"(w[4]), "v"(w[5]), "v"(w[6]), "v"(w[7]), "v"(w[8]), "v"(w[9]), "v"(w[10]), "v"(w[11]), "v"(w[12]), "v"(w[13]), "v"(w[14]), "v"(w[15]) : "memory");
            {
                bf16x8 sf[2][4], cf[4];
#pragma unroll
                for (int ks = 0; ks < 4; ++ks) { cf[ks] = *(const LAS bf16x8*)(CFB + ((d * 4 + ks) * 64 + lane) * 16);
#pragma unroll
                    for (int cc = 0; cc < 2; ++cc) sf[cc][ks] = *(const LAS bf16x8*)(SB + (cc * 16 + tq) * 272 + ks * 64 + q * 16); }
                asm volatile("s_waitcnt lgkmcnt(0)" : "+v"(sf[0][0]), "+v"(sf[0][1]), "+v"(sf[0][2]), "+v"(sf[0][3]), "+v"(sf[1][0]), "+v"(sf[1][1]), "+v"(sf[1][2]), "+v"(sf[1][3]), "+v"(cf[0]), "+v"(cf[1]), "+v"(cf[2]), "+v"(cf[3]) :: "memory");
#pragma unroll
                for (int cc = 0; cc < 2; ++cc)
#pragma unroll
                    for (int ks = 0; ks < 4; ++ks) yacc[cc] = __builtin_amdgcn_mfma_f32_16x16x32_bf16(cf[ks], sf[cc][ks], yacc[cc], 0, 0, 0);
                asm volatile("s_nop 15\n\ts_nop 15\n\ts_nop 15\n\ts_nop 15\n\ts_nop 15\n\ts_nop 15\n\ts_nop 15\n\ts_nop 15\n\ts_nop 15\n\ts_nop 15\n\ts_nop 15\n\ts_nop 15\n\ts_nop 15\n\ts_nop 15\n\ts_nop 15\n\ts_nop 15" : "+v"(yacc[0]), "+v"(yacc[1]) : "v"(sf[0][0]), "v"(sf[0][1]), "v"(sf[0][2]), "v"(sf[0][3]), "v"(sf[1][0]), "v"(sf[1][1]), "v"(sf[1][2]), "v"(sf[1][3]), "v"(cf[0]), "v"(cf[1]), "v"(cf[2]), "v"(cf[3]) : "memory");
            }
        }
#pragma unroll
        for (int cc = 0; cc < 2; ++cc) { const unsigned off = (unsigned)((row0 + (c0 + cc) * 16 + tq) * SW + g * 16 + 4 * q);
            const v2u uw = uwv[cc];
            const float u0 = bflo(uw.x), u1 = bfhi(uw.x), u2 = bflo(uw.y), u3 = bfhi(uw.y);
            const float z0 = gelu_tanh(yacc[cc][0] + dd[0] * u0), z1 = gelu_tanh(yacc[cc][1] + dd[1] * u1), z2 = gelu_tanh(yacc[cc][2] + dd[2] * u2), z3 = gelu_tanh(yacc[cc][3] + dd[3] * u3);
            v2u zw; zw.x = pk2(z0, z1); zw.y = pk2(z2, z3);
            *(v2u*)(Z + off) = zw; }
    }
    S5_BAR();
}
__device__ __forceinline__ void s5_phase(LAS unsigned char* lds, int tid_, int lane_, int wave_, int bx_, int G_, int l) {
    const DArgs a = load_args(); const int tid = fresh_v(tid_), lane = fresh_v(lane_), wave = fresh_s(wave_), bx = fresh_s(bx_), G = fresh_s(G_);
    const bool bal = (G == 256);
    const int nt = bal ? (bx < 128 ? 3 : 6) : (128 + 1024 - bx + G - 1) / G;
    S5C cst; int gprev = -1; bf16x8 Afpre = {0, 0, 0, 0, 0, 0, 0, 0};
    const int lane_n = lane & 31, cbit = (lane_n >> 2) & 1, tA = (lane_n >> 3) * 4 + (lane_n & 3), hf = lane >> 5;
    const bf16* U = (const bf16*)(a.ws + WS_U);
    for (int i = 0; i < nt; ++i) {
        bool latent, latn = false; int b, g, bn = 0, gn = -1;
#define S5_TASK(ii, LAT, B, GG) do { if (bal) { if (bx < 128) { LAT = ((ii) == 0); GG = bx & 63; B = LAT ? (bx >> 6) : 2 * (bx >> 6) + ((ii) - 1); } else { const int w = bx - 128; LAT = false; GG = w >> 1; B = 4 + 6 * (w & 1) + (ii); } } \
        else { const int t = bx + (ii) * G; LAT = t < 128; const int tc = LAT ? t : t - 128; B = tc >> 6; GG = tc & 63; } } while (0)
        S5_TASK(i, latent, b, g);
        if (i + 1 < nt) S5_TASK(i + 1, latn, bn, gn);
        const int row0 = latent ? NCTX + b * 1024 : b * 256;
        const int rown = (i + 1 < nt && gn == g) ? (latn ? NCTX + bn * 1024 : bn * 256) : -1;
        if (g != gprev) { s5_setup(a, lds, lane, wave, l, g, cst); gprev = g;
            Afpre = *(const bf16x8*)(U + (unsigned)((row0 + (2 * wave + cbit) * 16 + tA) * SW + g * 16 + 8 * hf)); }
        s5_task(a, lds, tid, lane, wave, l, row0, latent ? 64 : 16, g, b, latent, cst, Afpre, rown);
#undef S5_TASK
    }
}
#define XB_TMO      128
#define XB_XCNT(j)  (256  + 64 * (j))
#define XB_XSUB(j)  (1280 + 64 * (j))
#define XB_XGEN(j)  (2304 + 64 * (j))
#define XB_TOP      3328
#define XB_TOPGEN   3392
#define XCD_BAR_WORDS 3456
#define XB_SPIN_CAP (1u << 18)

__device__ __forceinline__ unsigned xb_ld(unsigned* p)              { return __hip_atomic_load(p, __ATOMIC_RELAXED, __HIP_MEMORY_SCOPE_AGENT); }
__device__ __forceinline__ unsigned xb_add(unsigned* p, unsigned v) { return __hip_atomic_fetch_add(p, v, __ATOMIC_RELAXED, __HIP_MEMORY_SCOPE_AGENT); }
__device__ __forceinline__ unsigned xb_xcc_id() { return (unsigned)__builtin_amdgcn_s_getreg((3 << 11) | 20) & 0xFu; }
#define XB_SPIN(cond, bar) do { unsigned _sp = 0; while (cond) { __builtin_amdgcn_s_sleep(1); \
    if ((++_sp & 255u) == 0u) { if (xb_ld(&(bar)[XB_TMO])) break; if (_sp > XB_SPIN_CAP) { atomicAdd(&(bar)[XB_TMO], 1u); break; } } } } while (0)

struct XcdBarrier {
    unsigned* bar; unsigned x;
    volatile LAS unsigned* st;
};

__device__ __forceinline__ XcdBarrier xcd_barrier_post(unsigned* bar, volatile LAS unsigned* st) {
    XcdBarrier b; b.bar = bar; b.x = xb_xcc_id(); b.st = st;
    if (threadIdx.x == 0) (void)xb_add(&bar[XB_XCNT(b.x)], 1u);
    return b;
}
__device__ __forceinline__ void xcd_barrier_complete(unsigned* bar, unsigned x, unsigned& nloc, unsigned& nx) {
    const unsigned G = gridDim.x * gridDim.y * gridDim.z;
    unsigned sum, cnt, mine, sp = 0u;
    for (;;) {
        sum = 0u; cnt = 0u; mine = 0u;
#pragma unroll
        for (unsigned j = 0; j < 16; ++j) { const unsigned c = xb_ld(&bar[XB_XCNT(j)]); sum += c; cnt += (c > 0u) ? 1u : 0u; mine = (j == x) ? c : mine; }
        if (sum == G) break;
        __builtin_amdgcn_s_sleep(1);
        if ((++sp & 255u) == 0u) { if (xb_ld(&bar[XB_TMO])) break; if (sp > XB_SPIN_CAP) { atomicAdd(&bar[XB_TMO], 1u); break; } }
    }
    nloc = mine > 0u ? mine : 1u; nx = cnt > 0u ? cnt : 1u;
}

__device__ __forceinline__ void xcd_barrier(const XcdBarrier& b) {
    asm volatile("s_waitcnt vmcnt(0)" ::: "memory");
    __syncthreads();
    if (threadIdx.x == 0) {
        unsigned* bar = b.bar;
        __builtin_amdgcn_s_waitcnt(0);
        unsigned nloc = b.st[0], nx = b.st[1];
        if (nloc == 0u) { xcd_barrier_complete(bar, b.x, nloc, nx); b.st[0] = nloc; b.st[1] = nx; }
        const unsigned old = xb_add(&bar[XB_XSUB(b.x)], 1u);
        const unsigned gen = old / nloc;
        if (old + 1u == (gen + 1u) * nloc) {
            __builtin_amdgcn_fence(__ATOMIC_RELEASE, "agent");
            asm volatile("s_waitcnt vmcnt(0)" ::: "memory");
            const unsigned og = xb_add(&bar[XB_TOP], 1u);
            const unsigned tg = og / nx;
            if (og + 1u == (tg + 1u) * nx) xb_add(&bar[XB_TOPGEN], 1u);
            else XB_SPIN(xb_ld(&bar[XB_TOPGEN]) == tg, bar);
            __builtin_amdgcn_fence(__ATOMIC_ACQUIRE, "agent");
            xb_add(&bar[XB_XGEN(b.x)], 1u);
            asm volatile("s_waitcnt vmcnt(0)" ::: "memory");
        } else {
            XB_SPIN(xb_ld(&bar[XB_XGEN(b.x)]) == gen, bar);
            __builtin_amdgcn_fence(__ATOMIC_ACQUIRE, "agent");
            asm volatile("s_waitcnt vmcnt(0)" ::: "memory");
        }
    }
    __syncthreads();
}


__device__ __forceinline__ void sub_barrier(unsigned* word, unsigned n, unsigned* bar) {
    asm volatile("s_waitcnt vmcnt(0)" ::: "memory");
    __syncthreads();
    if (threadIdx.x == 0) {
        __builtin_amdgcn_s_waitcnt(0);
        __builtin_amdgcn_fence(__ATOMIC_RELEASE, "agent");
        asm volatile("s_waitcnt vmcnt(0)" ::: "memory");
        (void)xb_add(word, 1u);
        XB_SPIN(xb_ld(word) < n, bar);
        __builtin_amdgcn_fence(__ATOMIC_ACQUIRE, "agent");
        asm volatile("s_waitcnt vmcnt(0)" ::: "memory");
    }
    __syncthreads();
}

__global__ void __launch_bounds__(NWAVES * 64, 2) fwd_kernel(Args  ) {
    extern __shared__ __attribute__((aligned(16))) unsigned char lds_raw[];
    LAS unsigned char* lds = (LAS unsigned char*)lds_raw;
    const int tid = threadIdx.x, lane = tid & 63, wave = __builtin_amdgcn_readfirstlane(tid >> 6), G = gridDim.x, bx = blockIdx.x;
    volatile LAS unsigned* MISC = (volatile LAS unsigned*)(lds + MISC_OFF);
    for (int u = tid; u < (LDS_BYTES - LDSCTL_OFF) / 4; u += NWAVES * 64) ((LAS unsigned*)(lds + LDSCTL_OFF))[u] = 0u;
    __syncthreads();
    XcdBarrier bar;
    { const DArgs a = load_args(); gu32* ctl = (gu32*)(a.ws + WS_CTL); bar = xcd_barrier_post((unsigned*)(ctl + CW_BAR), MISC + 8); }
#define GRID_BAR() do { XcdBarrier b_ = bar; asm volatile("" : "+s"(b_.bar), "+s"(b_.x)); xcd_barrier(b_); } while (0)


    for (int t = bx; t < 192; t += G) mod_task(lds, tid, lane, wave, t);
    cvt_fill(lds, tid, 0, (G == 256 && bx < 192) ? 6 : -1);
    cvt_fill(lds, tid, 0, -1);
    GRID_BAR();
    row_pass<0>(0, bx, G, wave, lane);
    GRID_BAR();

    const int nl = fresh_s(DEPTH);
    for (int li = 0; li < nl; ++li) {
        const int l = li;
        const bool dfl = fresh_s(G) == 256;
        { const int x = bx & 7, r = bx >> 3;
          pg8::G5Order S; S.st = !dfl; S.so.init(NTOK, INC, fresh_s(G), fresh_s(bx));
          if (r < 24) { S.u0.pm = 3 * x + r % 3; S.u0.pn = 8 + r / 3; } else if (r < 28) { S.u0.pm = 3 * x + (r - 24) % 3; S.u0.pn = (r - 24) / 3; } else { S.u0.pm = -1; S.u0.pn = 0; }
          if (S.st || S.u0.pm >= 0) {
              const DArgs a = load_args(); pg8::Gemm g{(const bf16*)(a.ws + WS_H), (const bf16*)(a.ws + WS_WIN) + (size_t)l * INC * DM, NTOK, INC, DM};
              pg8::EpiIn E{(bf16*)(a.ws + WS_GB), (bf16*)(a.ws + WS_V), (bf16*)(a.ws + WS_U)};
              pg8::gemm_phase<pg8::EpiIn, pg8::G5Order, true, true>(lds, g, S, E);
          } else if (li + 1 < nl) cvt_fill(lds, tid, l + 1, 12);
        }
        GRID_BAR();
        s5_phase(lds, tid, lane, wave, bx, G, l);
        GRID_BAR();
        { const int x = bx & 7, r = bx >> 3;
          if (dfl && r < 20) {
              pg8::G5Order S; S.st = false; S.u0.pm = 3 * x + (r + 4) % 3; S.u0.pn = (r + 4) / 3;
              const DArgs a = load_args(); pg8::Gemm g{(const bf16*)(a.ws + WS_H), (const bf16*)(a.ws + WS_WIN) + (size_t)l * INC * DM, NTOK, INC, DM};
              pg8::EpiIn E{(bf16*)(a.ws + WS_GB), (bf16*)(a.ws + WS_V), (bf16*)(a.ws + WS_U)};
              pg8::gemm_phase<pg8::EpiIn, pg8::G5Order, true, true>(lds, g, S, E);
          } else {
              pg8::G5Order S; S.st = !dfl; S.so.init(NTOK, SW, fresh_s(G), fresh_s(bx)); S.u0.pm = 3 * x + (r - 20) % 3; S.u0.pn = (r - 20) / 3;
              const DArgs a = load_args(); pg8::Gemm g{(const bf16*)(a.ws + WS_Z), (const bf16*)(a.ws + WS_WGLU) + (size_t)l * SW * SW, NTOK, SW, SW};
              pg8::EpiGlu E{(const bf16*)(a.ws + WS_Z), (bf16*)(a.ws + WS_O), a.in[I_BGLU] + (size_t)l * SW};
              pg8::gemm_phase<pg8::EpiGlu, pg8::G5Order, true, true>(lds, g, S, E);
              if (li + 1 < nl) cvt_fill(lds, tid, l + 1, 4);
          }
        }
        GRID_BAR();
        mix_pass(bx, G, wave, lane, l);
        GRID_BAR();
        { const DArgs a = load_args(); pg8::Gemm g{(const bf16*)(a.ws + WS_MIXIN), (const bf16*)(a.ws + WS_WOUT) + (size_t)l * DM * DM, NTOK, DM, DM}; pg8::G5Order S; S.st = !dfl; S.so.init(NTOK, DM, fresh_s(G), fresh_s(bx)); { const int x = bx & 7, r = bx >> 3; S.u0.pm = r < 24 ? 3 * x + r % 3 : -1; S.u0.pn = r / 3; }
          pg8::EpiBf16<0> E{(bf16*)(a.ws + WS_MIXED), DM, nullptr, 0, 0, 1.f};
          pg8::gemm_phase<pg8::EpiBf16<0>, pg8::G5Order, true, true>(lds, g, S, E); }
        if (li + 1 < nl && bx >= 192) cvt_fill(lds, tid, l + 1, 12);
        GRID_BAR();
        row_pass<1>(l, bx, G, wave, lane);
        GRID_BAR();
        { const DArgs a = load_args(); pg8::Gemm g{(const bf16*)(a.ws + WS_H), (const bf16*)(a.ws + WS_WUP) + (size_t)l * UPN * DM, NTOK, UPN, DM}; pg8::G4Order S{0, dfl ? 1024 : 1056, fresh_s(G), fresh_s(bx), !dfl};
          pg8::EpiFfn E{(bf16*)(a.ws + WS_ACT), a.in[I_FFNW] + (size_t)l * 3 * UPN, (LAS float*)(lds + RING_BYTES)};
          pg8::gemm_phase<pg8::EpiFfn, pg8::G4Order, true, true>(lds, g, S, E); }
        GRID_BAR();
        if (dfl && bx < 32) {
            { const DArgs a = load_args(); pg8::Gemm g{(const bf16*)(a.ws + WS_H), (const bf16*)(a.ws + WS_WUP) + (size_t)l * UPN * DM, NTOK, UPN, DM}; pg8::G4Order S{1024, 1056, fresh_s(G), fresh_s(bx), false};
              pg8::EpiFfn E{(bf16*)(a.ws + WS_ACT), a.in[I_FFNW] + (size_t)l * 3 * UPN, (LAS float*)(lds + RING_BYTES)};
              pg8::gemm_phase<pg8::EpiFfn, pg8::G4Order, true, true>(lds, g, S, E); }
            { const DArgs a = load_args(); sub_barrier((unsigned*)(a.ws + WS_CTL) + CW_SUB + 64 * l, 32u, (unsigned*)(a.ws + WS_CTL) + CW_BAR); }
            { const DArgs a = load_args(); pg8::Gemm g{(const bf16*)(a.ws + WS_ACT) + (size_t)23 * 256 * DFF, (const bf16*)(a.ws + WS_WDN) + (size_t)l * DM * DFF, 256, 4 * DM, DFF / 4, DFF, 4};
              pg8::G5Order S; S.st = false; S.u0.pm = 0; S.u0.pn = fresh_s(bx);
              pg8::EpiBf16<0> E{(bf16*)(a.ws + WS_FFP), DM, nullptr, DM, (size_t)256 * DM, 1.f};
              pg8::gemm_phase<pg8::EpiBf16<0>, pg8::G5Order, true, true>(lds, g, S, E); }
            if (li + 1 < nl) cvt_fill(lds, tid, l + 1, 8);
        } else {
            const int x = bx & 7, r = (bx >> 3) - 4;
            pg8::G5Order S; S.st = !dfl; S.so.init(NTOK, DM, fresh_s(G), fresh_s(bx));
            if (bx < 224 && !(x == 7 && r >= 16)) { S.u0.pm = x < 7 ? 3 * x + r % 3 : 21 + (r & 1); S.u0.pn = x < 7 ? r / 3 : r >> 1; } else { S.u0.pm = -1; S.u0.pn = 0; }
            if (S.st || S.u0.pm >= 0) {
                const DArgs a = load_args(); pg8::Gemm g{(const bf16*)(a.ws + WS_ACT), (const bf16*)(a.ws + WS_WDN) + (size_t)l * DM * DFF, NTOK, DM, DFF};
                pg8::EpiBf16<0> E{(bf16*)(a.ws + WS_FF), DM, nullptr, 0, 0, 1.f};
                pg8::gemm_phase<pg8::EpiBf16<0>, pg8::G5Order, true, true>(lds, g, S, E);
            } else if (li + 1 < nl) cvt_fill(lds, tid, l + 1, 48);
        }
        GRID_BAR();
        if (li < nl - 1) {
            row_pass<2>(l, bx, G, wave, lane, fresh_s(G) == 256);
            cvt_fill(lds, tid, l + 1, -1);
            GRID_BAR();
        } else {
            row_pass<3>(l, bx, G, wave, lane, fresh_s(G) == 256);
        }
    }

#undef GRID_BAR
}

extern "C" void kernel_launch(void* const* d_in, const int* in_sizes, int n_in, void* d_out, int out_size, void* d_ws, size_t ws_size, hipStream_t stream) {
    static int grid = 0;
    if (grid == 0) {
        if (n_in != 30 || out_size != NTOK * DM + 2 * 524288 || ws_size < WS_END) { fprintf(stderr, "kernel_launch: unexpected shapes (n_in %d, out %d, ws %zu); nothing launched\n", n_in, out_size, ws_size); grid = -1; return; }
        int dev = 0, cus = 0, per_cu = 0;
        if (hipGetDevice(&dev) != hipSuccess || hipDeviceGetAttribute(&cus, hipDeviceAttributeMultiprocessorCount, dev) != hipSuccess) { grid = -1; return; }
        if (hipFuncSetAttribute((const void*)fwd_kernel, hipFuncAttributeMaxDynamicSharedMemorySize, LDS_BYTES) != hipSuccess) { fprintf(stderr, "kernel_launch: hipFuncSetAttribute failed\n"); grid = -1; return; }
        if (hipOccupancyMaxActiveBlocksPerMultiprocessor(&per_cu, (const void*)fwd_kernel, NWAVES * 64, LDS_BYTES) != hipSuccess || per_cu < 1)
            fprintf(stderr, "kernel_launch: note: occupancy query reports %d workgroups per CU\n", per_cu);
        (void)hipGetLastError();
        grid = cus;
    }
    if (grid < 0) return;
    if (hipMemsetAsync((char*)d_ws + WS_CTL, 0, CTL_ZERO_BYTES, stream) != hipSuccess) return;
    Args a{};
    for (int i = 0; i < 30; ++i) a.in[i] = (const float*)d_in[i];
    a.out = (float*)d_out; a.ws = (unsigned char*)d_ws;
    hipLaunchKernelGGL(fwd_kernel, dim3(grid), dim3(NWAVES * 64), LDS_BYTES, stream, a);
}
```

```cpp
#include <hip/hip_runtime.h>
#include <cstdio>
#include <cstdint>
namespace pg8 {
#define PG8_LAS __attribute__((address_space(3)))
typedef unsigned short bf16_t;
typedef short bf16x8 __attribute__((ext_vector_type(8)));
typedef float f32x4 __attribute__((ext_vector_type(4)));
typedef unsigned u32x4 __attribute__((ext_vector_type(4)));
constexpr int BM = 256, BK = 64, HALF = 128, HTB = HALF * BK * 2  , STAGE_BYTES = 8 * HTB, NXCD = 8, WGM = 8;

__host__ __device__ __forceinline__ int lds_byte(int r, int c) { const int st = (r >> 4) * 2 + (c >> 5), rr = r & 15, cc = c & 31, ob = rr * 64 + cc * 2; return st * 1024 + (ob ^ (((ob >> 9) & 1) << 5)); }
__host__ __device__ __forceinline__ void stage_rc(int b, int& R, int& C) { const int st = b / 1024, sb = b % 1024, swz = sb ^ (((sb >> 9) & 1) << 5); R = (st >> 1) * 16 + swz / 64; C = (st & 1) * 32 + (swz % 64) / 2; }
__host__ __device__ __forceinline__ int perm32(int rho) { const int n = rho >> 4, i = rho & 15; return 8 * (i >> 2) + 4 * n + (i & 3); }

struct Unit { int pm, pn; };
struct Gemm { const bf16_t* A; const bf16_t* Bt; int M, N, K; int ld = 0; int nsp = 1; };

struct StaticOrder {
    int nM, nN, nwg, G, c;
    __host__ __device__ void init(int M, int N, int G_, int c_) { nM = M / BM; nN = N / BM; nwg = nM * nN; G = G_; c = c_; }
    __host__ __device__ bool next(int i, Unit& u) const {
        const long L = (long)i * G + c; if (L >= nwg) return false;
        int wgid = (int)L; { const int q = nwg / NXCD, r = nwg % NXCD, xcd = wgid % NXCD, off = wgid / NXCD; wgid = (xcd < r ? xcd * (q + 1) : r * (q + 1) + (xcd - r) * q) + off; }
        const int nig = WGM * nN, gid = wgid / nig, fm = gid * WGM, gsz = (nM - fm) < WGM ? (nM - fm) : WGM;
        u.pm = fm + ((wgid % nig) % gsz); u.pn = (wgid % nig) / gsz; return true;
    }
    __device__ __forceinline__ void a_ready(const Unit&) const {}
    __device__ __forceinline__ void done(const Unit&) const {}
};

__device__ __forceinline__ unsigned cvt_pk_bf16(float lo, float hi) { unsigned r; asm volatile("v_cvt_pk_bf16_f32 %0, %1, %2" : "=v"(r) : "v"(lo), "v"(hi)); return r; }
typedef float f32x2 __attribute__((ext_vector_type(2)));
__device__ __forceinline__ f32x2 gelu_pk(f32x2 v) {
    const f32x2 av = __builtin_elementwise_abs(v), d = av * 0.2316418882f + 1.0f;
    f32x2 t; t.x = __builtin_amdgcn_rcpf(d.x); t.y = __builtin_amdgcn_rcpf(d.y);
    f32x2 q = t * 0.5307027145f + (-0.7265760135f); q = q * t + 0.7107068705f; q = q * t + (-0.142248368f); q = q * t + 0.127414796f; q = q * t;
    const f32x2 s = (v * v) * (-0.72134752044f);
    f32x2 e; e.x = __builtin_amdgcn_exp2f(s.x); e.y = __builtin_amdgcn_exp2f(s.y);
    const f32x2 m = v * (q * e), r = v - m;
    f32x2 o; o.x = v.x < 0.f ? m.x : r.x; o.y = v.y < 0.f ? m.y : r.y; return o;
}

template <int ACT  > struct EpiBf16 {
    static constexpr bool PERM = true, AFTER_DRAIN = false; static_assert(ACT == 0 || ACT == 1, "EpiBf16: ACT is 0 (none) or 1 (gelu_pk)");
    bf16_t* O; int ldc; const float* bias; int split_cols; size_t split_stride; float scale0;
    __device__ __forceinline__ void operator()(const f32x4 (&acc)[2][2][4][2], const Unit& u, int wr, int wc, int fr, int fq) const {
        const int row0 = u.pm * BM + wr * 64 + fr; int colt = u.pn * BM; bf16_t* base = O;
        float sc = 1.f; if (split_cols) { const int t = colt / split_cols; base += (size_t)t * split_stride; colt -= t * split_cols; if (t == 0) sc = scale0; }
        const int col0 = colt + wc * 32 + 8 * fq, bcol0 = u.pn * BM + wc * 32 + 8 * fq;
        f32x4 bv[2][2];
#pragma unroll
        for (int bj = 0; bj < 2; ++bj)
#pragma unroll
            for (int n = 0; n < 2; ++n) bv[bj][n] = bias ? *(const f32x4*)(bias + bcol0 + bj * HALF + 4 * n) : (f32x4){0.f, 0.f, 0.f, 0.f};
#pragma unroll
        for (int ai = 0; ai < 2; ++ai)
#pragma unroll
            for (int m = 0; m < 4; ++m) { bf16_t* rowp = base + (size_t)(row0 + ai * HALF + m * 16) * ldc + col0;
#pragma unroll
                for (int bj = 0; bj < 2; ++bj) { f32x4 v0 = acc[ai][bj][m][0] + bv[bj][0], v1 = acc[ai][bj][m][1] + bv[bj][1];
                    if (ACT == 1) { f32x2 a = gelu_pk((f32x2){v0[0], v0[1]}), b = gelu_pk((f32x2){v0[2], v0[3]}), c = gelu_pk((f32x2){v1[0], v1[1]}), d = gelu_pk((f32x2){v1[2], v1[3]});
                        v0 = (f32x4){a.x, a.y, b.x, b.y}; v1 = (f32x4){c.x, c.y, d.x, d.y}; }
                    v0 = v0 * sc; v1 = v1 * sc; u32x4 w; w.x = cvt_pk_bf16(v0[0], v0[1]); w.y = cvt_pk_bf16(v0[2], v0[3]); w.z = cvt_pk_bf16(v1[0], v1[1]); w.w = cvt_pk_bf16(v1[2], v1[3]);
                    *(u32x4*)(rowp + bj * HALF) = w; } }
    }
};
template <class Epi, class Sched, bool ALIGN_EPI = false, bool SP2 = false>
__device__ __forceinline__ void gemm_phase(PG8_LAS unsigned char* lds, const Gemm g, const Sched& S, const Epi& E) {
    int tid_ = threadIdx.x; asm volatile("" : "+v"(tid_));
    const int tid = tid_, wid = __builtin_amdgcn_readfirstlane(tid >> 6), lane = tid & 63, wr = wid >> 2, wc = wid & 3, fr = lane & 15, fq = lane >> 4;
    const int K = g.K, nt = K / BK, ld = g.ld ? g.ld : g.K, nNr = g.N / BM / g.nsp;
    unsigned voffA[2], voffB[2];
#pragma unroll
    for (int i = 0; i < 2; ++i) { int R, C; stage_rc(tid * 16 + i * 8192, R, C); const int Rb = Epi::PERM ? ((R & ~31) + perm32(R & 31)) : R;
        voffA[i] = (unsigned)(R * ld + C) * 2u; voffB[i] = (unsigned)(Rb * ld + C) * 2u; }
    const size_t kstep = (size_t)(BK * 2);
    const size_t hstep = (size_t)HALF * ld * 2;
    const size_t tstep = 2 * hstep;
    const unsigned ldsw = (unsigned)wid * 1024u;
    const int aoff = lds_byte(wr * 64 + fr, fq * 8), boff = lds_byte(wc * 32 + fr, fq * 8);
#define PG8_SA(b, h) (((b) * 2 + (h)) * HTB)
#define PG8_SB(b, h) ((4 + (b) * 2 + (h)) * HTB)
#define PG8_STAGE(bufoff, gbase, voff) do { _Pragma("unroll") for (int _i = 0; _i < 2; ++_i) \
        __builtin_amdgcn_global_load_lds((const unsigned*)((const char*)(gbase) + (voff)[_i]), (PG8_LAS unsigned*)(lds + (bufoff) + ldsw + _i * 8192), 16, 0, 0); } while (0)
#define PG8_LDA(dst, b, h) do { _Pragma("unroll") for (int m = 0; m < 4; ++m) _Pragma("unroll") for (int k = 0; k < 2; ++k) dst[m][k] = *(const PG8_LAS bf16x8*)(lds + PG8_SA(b, h) + aoff + m * 2048 + k * 1024); } while (0)
#define PG8_LDB(dst, b, h) do { _Pragma("unroll") for (int n = 0; n < 2; ++n) _Pragma("unroll") for (int k = 0; k < 2; ++k) dst[n][k] = *(const PG8_LAS bf16x8*)(lds + PG8_SB(b, h) + boff + n * 2048 + k * 1024); } while (0)
#define PG8_MMA(ai, bj, At, Bt) do { __builtin_amdgcn_s_setprio(1); _Pragma("unroll") for (int m = 0; m < 4; ++m) _Pragma("unroll") for (int n = 0; n < 2; ++n) _Pragma("unroll") for (int k = 0; k < 2; ++k) \
        acc[ai][bj][m][n] = __builtin_amdgcn_mfma_f32_16x16x32_bf16(Bt[n][k], At[m][k], acc[ai][bj][m][n], 0, 0, 0); __builtin_amdgcn_s_setprio(0); } while (0)
#define PG8_WAIT_V(n) asm volatile("s_waitcnt vmcnt(" #n ")" ::: "memory")
#define PG8_WAIT_L(n) asm volatile("s_waitcnt lgkmcnt(" #n ")" ::: "memory")
#define PG8_BAR __builtin_amdgcn_s_barrier()
#define PG8_SCHED __builtin_amdgcn_sched_barrier(0)
    Unit cur, nxt; int ui = 0;
    if (!S.next(0, cur)) return;
    f32x4 acc[2][2][4][2];
#pragma unroll
    for (int a = 0; a < 2; ++a)
#pragma unroll
        for (int b = 0; b < 2; ++b)
#pragma unroll
            for (int m = 0; m < 4; ++m)
#pragma unroll
                for (int n = 0; n < 2; ++n) acc[a][b][m][n] = (f32x4){0.f, 0.f, 0.f, 0.f};
    bf16x8 At[4][2], B0[2][2], B1[2][2];
#define PG8_APTR(u) ((const char*)g.A + (size_t)(u).pm * tstep + (size_t)((u).pn / nNr) * K * 2)
#define PG8_BPTR(u) ((const char*)g.Bt + (size_t)((u).pn % nNr) * tstep + (size_t)((u).pn / nNr) * K * 2)
    const char* cA = PG8_APTR(cur); const char* cB = PG8_BPTR(cur);
    S.a_ready(cur);
    if constexpr (SP2) {
        PG8_STAGE(PG8_SB(0, 0), cB, voffB); PG8_STAGE(PG8_SB(0, 1), cB + hstep, voffB); PG8_STAGE(PG8_SA(0, 0), cA, voffA); PG8_STAGE(PG8_SA(0, 1), cA + hstep, voffA);
        if (wr == 1) PG8_BAR;
        PG8_WAIT_V(2); PG8_BAR;
        PG8_STAGE(PG8_SB(1, 0), cB + kstep, voffB); PG8_STAGE(PG8_SA(1, 0), cA + kstep, voffA); PG8_STAGE(PG8_SB(1, 1), cB + hstep + kstep, voffB);
        PG8_WAIT_V(6); PG8_BAR;
    } else {
        PG8_STAGE(PG8_SB(0, 0), cB, voffB); PG8_STAGE(PG8_SA(0, 0), cA, voffA); PG8_STAGE(PG8_SB(0, 1), cB + hstep, voffB); PG8_STAGE(PG8_SA(0, 1), cA + hstep, voffA);
        if (wr == 1) PG8_BAR;
        PG8_WAIT_V(4); PG8_BAR;
        PG8_STAGE(PG8_SB(1, 0), cB + kstep, voffB); PG8_STAGE(PG8_SA(1, 0), cA + kstep, voffA); PG8_STAGE(PG8_SB(1, 1), cB + hstep + kstep, voffB);
        PG8_WAIT_V(6); PG8_BAR;
    }
    for (;;) {
        const bool has_next = S.next(ui + 1, nxt);
        const char* nA = has_next ? PG8_APTR(nxt) : cA; const char* nB = has_next ? PG8_BPTR(nxt) : cB;
        for (int t = 0; t < nt; t += 2) {
            const bool last = (t == nt - 2);
            const char* a1 = cA + (size_t)(t + 1) * kstep;
            const char* a2 = last ? nA : cA + (size_t)(t + 2) * kstep; const char* b2 = last ? nB : cB + (size_t)(t + 2) * kstep;
            const char* a3 = a2 + kstep; const char* b3 = b2 + kstep;
            if (last && has_next) S.a_ready(nxt);
            if constexpr (SP2) {
            PG8_LDB(B0, 0, 0); PG8_LDB(B1, 0, 1); PG8_SCHED; PG8_LDA(At, 0, 0); PG8_STAGE(PG8_SA(1, 1), a1 + hstep, voffA);
            PG8_WAIT_V(8); PG8_WAIT_L(0); PG8_BAR; PG8_MMA(0, 0, At, B0); PG8_MMA(0, 1, At, B1); PG8_BAR; PG8_SCHED;
            PG8_LDA(At, 0, 1); PG8_STAGE(PG8_SB(0, 0), b2, voffB); PG8_STAGE(PG8_SB(0, 1), b2 + hstep, voffB); PG8_STAGE(PG8_SA(0, 0), a2, voffA);
            PG8_WAIT_V(8); PG8_WAIT_L(0); PG8_BAR; PG8_MMA(1, 0, At, B0); PG8_MMA(1, 1, At, B1); PG8_BAR; PG8_SCHED;
            PG8_LDB(B0, 1, 0); PG8_LDB(B1, 1, 1); PG8_SCHED; PG8_LDA(At, 1, 0); PG8_STAGE(PG8_SA(0, 1), a2 + hstep, voffA);
            PG8_WAIT_V(8); PG8_WAIT_L(0); PG8_BAR; PG8_MMA(0, 0, At, B0); PG8_MMA(0, 1, At, B1); PG8_BAR; PG8_SCHED;
            PG8_LDA(At, 1, 1); PG8_STAGE(PG8_SB(1, 0), b3, voffB); PG8_STAGE(PG8_SB(1, 1), b3 + hstep, voffB); PG8_STAGE(PG8_SA(1, 0), a3, voffA);
            PG8_WAIT_V(8); PG8_WAIT_L(0); PG8_BAR; PG8_MMA(1, 0, At, B0); PG8_MMA(1, 1, At, B1); PG8_BAR; PG8_SCHED;
            } else {
            PG8_LDB(B0, 0, 0); PG8_SCHED; PG8_LDA(At, 0, 0); PG8_STAGE(PG8_SA(1, 1), a1 + hstep, voffA);
            PG8_WAIT_L(8); PG8_BAR; PG8_WAIT_L(0); PG8_MMA(0, 0, At, B0); PG8_BAR; PG8_SCHED;
            PG8_LDB(B1, 0, 1); PG8_STAGE(PG8_SB(0, 0), b2, voffB);
            PG8_BAR; PG8_WAIT_L(0); PG8_MMA(0, 1, At, B1); PG8_BAR;
            PG8_LDA(At, 0, 1); PG8_STAGE(PG8_SA(0, 0), a2, voffA);
            PG8_BAR; PG8_WAIT_L(0); PG8_MMA(1, 0, At, B0); PG8_BAR; PG8_SCHED;
            PG8_STAGE(PG8_SB(0, 1), b2 + hstep, voffB);
            PG8_WAIT_V(6); PG8_BAR; PG8_MMA(1, 1, At, B1); PG8_BAR;
            PG8_LDB(B0, 1, 0); PG8_SCHED; PG8_LDA(At, 1, 0); PG8_STAGE(PG8_SA(0, 1), a2 + hstep, voffA);
            PG8_WAIT_L(8); PG8_BAR; PG8_WAIT_L(0); PG8_MMA(0, 0, At, B0); PG8_BAR; PG8_SCHED;
            PG8_LDB(B1, 1, 1); PG8_STAGE(PG8_SB(1, 0), b3, voffB);
            PG8_BAR; PG8_WAIT_L(0); PG8_MMA(0, 1, At, B1); PG8_BAR;
            PG8_LDA(At, 1, 1); PG8_STAGE(PG8_SA(1, 0), a3, voffA);
            PG8_BAR; PG8_WAIT_L(0); PG8_MMA(1, 0, At, B0); PG8_BAR; PG8_SCHED;
            PG8_STAGE(PG8_SB(1, 1), b3 + hstep, voffB);
            PG8_WAIT_V(6); PG8_BAR; PG8_MMA(1, 1, At, B1); PG8_BAR;
            }
        }
        if constexpr (ALIGN_EPI) { if (wr == 0) PG8_BAR; }
        if constexpr (!Epi::AFTER_DRAIN) { E(acc, cur, wr, wc, fr, fq); S.done(cur); }
        if (!has_next) break;
#pragma unroll
        for (int a = 0; a < 2; ++a)
#pragma unroll
            for (int b = 0; b < 2; ++b)
#pragma unroll
                for (int m = 0; m < 4; ++m)
#pragma unroll
                    for (int n = 0; n < 2; ++n) acc[a][b][m][n] = (f32x4){0.f, 0.f, 0.f, 0.f};
        cur = nxt; cA = nA; cB = nB; ++ui;
        if constexpr (ALIGN_EPI) { if (wr == 1) PG8_BAR; }
    }
    PG8_WAIT_V(0);
    if constexpr (!ALIGN_EPI) { if (wr == 0) PG8_BAR; }
    PG8_BAR;
    if constexpr (Epi::AFTER_DRAIN) { E.fused(acc, cur, wr, wc, fr, fq, lds, wid, lane); S.done(cur); }
#undef PG8_APTR
#undef PG8_BPTR
#undef PG8_SA
#undef PG8_SB
#undef PG8_STAGE
#undef PG8_LDA
#undef PG8_LDB
#undef PG8_MMA
#undef PG8_WAIT_V
#undef PG8_WAIT_L
#undef PG8_BAR
#undef PG8_SCHED
}
}

constexpr int DM = 2048, NTOK = 6144, NCTX = 4096, DEPTH = 4;
constexpr int CW = 1024, SW = 1024, INC = 4096, DFF = 5632, UPN = 2 * DFF;
constexpr float EPS = 1e-6f;
constexpr int NWAVES = 8;

constexpr size_t MiB = 1u << 20;
constexpr size_t WS_CTL = 0, CTL_ZERO_BYTES = 1 * MiB;
constexpr size_t WS_MOD = 1 * MiB;
constexpr size_t WS_WIN = 2 * MiB, WS_WGLU = 66 * MiB, WS_WOUT = 74 * MiB, WS_WUP = 106 * MiB, WS_WDN = 282 * MiB;
constexpr size_t WS_H = 370 * MiB;
constexpr size_t WS_GB = 394 * MiB, WS_V = 406 * MiB, WS_U = 418 * MiB;
constexpr size_t WS_Z = 430 * MiB, WS_O = 442 * MiB;
constexpr size_t WS_MIXIN = 454 * MiB, WS_MIXED = 478 * MiB;
constexpr size_t WS_UP = 502 * MiB;
constexpr size_t WS_ACT = 634 * MiB;
constexpr size_t WS_FF = 700 * MiB;
constexpr size_t WS_END = 724 * MiB;
constexpr int CW_SUB = 12288;
constexpr size_t WS_FFP = WS_UP;
constexpr int CW_BAR = 4096;

constexpr int RING_BYTES = 131072;
constexpr int LDS_BYTES = 147456;
constexpr int LDSCTL_OFF = LDS_BYTES - 512, MISC_OFF = LDSCTL_OFF;

#define GAS __attribute__((address_space(1)))
#define LAS __attribute__((address_space(3)))
typedef unsigned short bf16;
typedef unsigned v4u __attribute__((ext_vector_type(4)));
typedef unsigned v2u __attribute__((ext_vector_type(2)));
typedef float f32x4 __attribute__((ext_vector_type(4)));
typedef float f32x2 __attribute__((ext_vector_type(2)));
typedef float f32x16 __attribute__((ext_vector_type(16)));
typedef short bf16x8 __attribute__((ext_vector_type(8)));
typedef GAS unsigned gu32;
#define LDS_WAIT() asm volatile("s_waitcnt lgkmcnt(0)" ::: "memory")

__device__ __forceinline__ unsigned f2bf(float f) { unsigned u = __builtin_bit_cast(unsigned, f); return (u + 0x7fffu + ((u >> 16) & 1u)) >> 16; }
__device__ __forceinline__ unsigned pk2(float lo, float hi) { unsigned r; asm("v_cvt_pk_bf16_f32 %0, %1, %2" : "=v"(r) : "v"(lo), "v"(hi)); return r; }
__device__ __forceinline__ float bflo(unsigned w) { return __uint_as_float(w << 16); }
__device__ __forceinline__ float bfhi(unsigned w) { return __uint_as_float(w & 0xffff0000u); }
__device__ __forceinline__ void unpack8(const v4u w, float (&f)[8]) { f[0] = bflo(w.x); f[1] = bfhi(w.x); f[2] = bflo(w.y); f[3] = bfhi(w.y); f[4] = bflo(w.z); f[5] = bfhi(w.z); f[6] = bflo(w.w); f[7] = bfhi(w.w); }
__device__ __forceinline__ v4u pack8(const float (&f)[8]) { v4u w; w.x = pk2(f[0], f[1]); w.y = pk2(f[2], f[3]); w.z = pk2(f[4], f[5]); w.w = pk2(f[6], f[7]); return w; }
__device__ __forceinline__ float wave_sum(float v) {
#pragma unroll
    for (int o = 1; o < 64; o <<= 1) v += __shfl_xor(v, o);
    return v;
}
__device__ __forceinline__ float sigmoidf_(float x) { return 1.0f / (1.0f + __expf(-x)); }
__device__ __forceinline__ float gelu_tanh(float y) { const float v = 0.7978845608028654f * (y + 0.044715f * y * y * y); const float t = 1.0f - 2.0f / (__expf(2.0f * v) + 1.0f); return 0.5f * y * (1.0f + t); }
__device__ __forceinline__ void sincos_cw(float x, float& s, float& c) {
    const float k = rintf(x * 0.6366197723675814f);
    float r = fmaf(k, -1.5707963705062866f, x);
    r = fmaf(k, 4.371138828673793e-08f, r);
    r = fmaf(k, 1.7763568394002505e-15f, r);
    const float r2 = r * r;
    const float sp = r + r * r2 * fmaf(r2, fmaf(r2, -1.9515295891e-4f, 8.3321608736e-3f), -1.6666654611e-1f);
    const float cp = fmaf(r2 * r2, fmaf(r2, fmaf(r2, 2.443315711809948e-5f, -1.388731625493765e-3f), 4.166664568298827e-2f), fmaf(r2, -0.5f, 1.0f));
    const int q = ((int)k) & 3;
    const float ss = (q & 1) ? cp : sp, cc = (q & 1) ? sp : cp;
    s = (q & 2) ? -ss : ss;
    c = ((q + 1) & 2) ? -cc : cc;
}

__device__ __forceinline__ int fresh_v(int x) { asm volatile("" : "+v"(x)); return x; }
__device__ __forceinline__ int fresh_s(int x) { asm volatile("" : "+s"(x)); return x; }
struct Args { const float* in[30]; float* out; unsigned char* ws; };
struct KImg { unsigned long long in[30]; unsigned long long out; unsigned long long ws; };
struct DArgs { const float* in[30]; float* out; unsigned char* ws; };
__device__ __forceinline__ DArgs load_args() {
    const __attribute__((address_space(4))) KImg* p = (const __attribute__((address_space(4))) KImg*)__builtin_amdgcn_kernarg_segment_ptr();
    asm volatile("" : "+s"(p));
    DArgs a;
#pragma unroll
    for (int i = 0; i < 30; ++i) a.in[i] = (const float*)(GAS const float*)p->in[i];
    a.out = (float*)(GAS float*)p->out; a.ws = (unsigned char*)(GAS unsigned char*)p->ws;
    return a;
}
enum { I_XP = 0, I_XS, I_SRE, I_SIM, I_C, I_CCTX, I_WADA, I_BADA, I_GPRE1, I_WIN, I_CONVW, I_ARE, I_AIM, I_LOGDT, I_BRE, I_BIM, I_CRE, I_CIM, I_SSMD, I_WGLU, I_BGLU,
       I_GCONV, I_GSSM, I_WOUT, I_GPOST1, I_GPRE2, I_WUP, I_FFNW, I_WDOWN, I_GPOST2 };

namespace pg8 {
struct EpiIn {
    static constexpr bool PERM = true, AFTER_DRAIN = false;
    bf16_t *GB, *V, *U;
    __device__ __forceinline__ void operator()(const f32x4 (&acc)[2][2][4][2], const Unit& u, int wr, int wc, int fr, int fq) const {
        const int row0 = u.pm * BM + wr * 64 + fr;
        if (u.pn < 8) {
            const int col0 = u.pn * 128 + wc * 32 + 8 * fq;
#pragma unroll
            for (int ai = 0; ai < 2; ++ai)
#pragma unroll
                for (int m = 0; m < 4; ++m) { bf16_t* rowp = V + (size_t)(row0 + ai * HALF + m * 16) * 1024 + col0;
                    const f32x4 v0 = acc[ai][0][m][0] * acc[ai][1][m][0], v1 = acc[ai][0][m][1] * acc[ai][1][m][1];
                    u32x4 w; w.x = cvt_pk_bf16(v0[0], v0[1]); w.y = cvt_pk_bf16(v0[2], v0[3]); w.z = cvt_pk_bf16(v1[0], v1[1]); w.w = cvt_pk_bf16(v1[2], v1[3]);
                    *(u32x4*)rowp = w; }
        } else {
            const int col0 = (u.pn - 8) * 128 + wc * 32 + 8 * fq;
#pragma unroll
            for (int ai = 0; ai < 2; ++ai)
#pragma unroll
                for (int m = 0; m < 4; ++m) { const size_t off = (size_t)(row0 + ai * HALF + m * 16) * 1024 + col0;
#pragma unroll
                    for (int bj = 0; bj < 2; ++bj) { const f32x4 v0 = acc[ai][bj][m][0], v1 = acc[ai][bj][m][1];
                        u32x4 w; w.x = cvt_pk_bf16(v0[0], v0[1]); w.y = cvt_pk_bf16(v0[2], v0[3]); w.z = cvt_pk_bf16(v1[0], v1[1]); w.w = cvt_pk_bf16(v1[2], v1[3]);
                        *(u32x4*)((bj ? U : GB) + off) = w; } }
        }
    }
};
struct EpiGlu {
    static constexpr bool PERM = true, AFTER_DRAIN = false;
    const bf16_t* Z; bf16_t* O; const float* bias;
    __device__ __forceinline__ void operator()(const f32x4 (&acc)[2][2][4][2], const Unit& u, int wr, int wc, int fr, int fq) const {
        const int row0 = u.pm * BM + wr * 64 + fr, col0 = u.pn * BM + wc * 32 + 8 * fq;
        f32x4 bv[2][2];
#pragma unroll
        for (int bj = 0; bj < 2; ++bj)
#pragma unroll
            for (int n = 0; n < 2; ++n) bv[bj][n] = *(const f32x4*)(bias + col0 + bj * HALF + 4 * n);
#pragma unroll
        for (int ai = 0; ai < 2; ++ai)
#pragma unroll
            for (int m = 0; m < 4; ++m) { const size_t off = (size_t)(row0 + ai * HALF + m * 16) * 1024 + col0;
#pragma unroll
                for (int bj = 0; bj < 2; ++bj) { const u32x4 zw = *(const u32x4*)(Z + off + bj * HALF);
                    const f32x4 g0 = acc[ai][bj][m][0] + bv[bj][0], g1 = acc[ai][bj][m][1] + bv[bj][1];
                    float z[8]; z[0] = __uint_as_float(zw.x << 16); z[1] = __uint_as_float(zw.x & 0xffff0000u); z[2] = __uint_as_float(zw.y << 16); z[3] = __uint_as_float(zw.y & 0xffff0000u);
                    z[4] = __uint_as_float(zw.z << 16); z[5] = __uint_as_float(zw.z & 0xffff0000u); z[6] = __uint_as_float(zw.w << 16); z[7] = __uint_as_float(zw.w & 0xffff0000u);
                    float o[8];
#pragma unroll
                    for (int j = 0; j < 4; ++j) { o[j] = z[j] / (1.0f + __expf(-g0[j])); o[4 + j] = z[4 + j] / (1.0f + __expf(-g1[j])); }
                    u32x4 w; w.x = cvt_pk_bf16(o[0], o[1]); w.y = cvt_pk_bf16(o[2], o[3]); w.z = cvt_pk_bf16(o[4], o[5]); w.w = cvt_pk_bf16(o[6], o[7]);
                    *(u32x4*)(O + off + bj * HALF) = w; } }
    }
};
typedef unsigned u32x2 __attribute__((ext_vector_type(2)));
struct EpiFfn {
    static constexpr bool PERM = true, AFTER_DRAIN = false;
    bf16_t* ACT; const float* fw; PG8_LAS float* xch;
    static __device__ __forceinline__ float ror8(float v) { return __builtin_bit_cast(float, __builtin_amdgcn_mov_dpp(__builtin_bit_cast(int, v), 0x128  , 0xf, 0xf, true)); }
    static __device__ __forceinline__ f32x4 shx8(const f32x4 v) { f32x4 r; r[0] = ror8(v[0]); r[1] = ror8(v[1]); r[2] = ror8(v[2]); r[3] = ror8(v[3]); return r; }
    static __device__ __forceinline__ f32x4 shl(const f32x4 v, int src) { f32x4 r; r[0] = __shfl(v[0], src); r[1] = __shfl(v[1], src); r[2] = __shfl(v[2], src); r[3] = __shfl(v[3], src); return r; }
    static __device__ __forceinline__ f32x4 sel(bool c, const f32x4 a, const f32x4 b) { f32x4 r; r[0] = c ? a[0] : b[0]; r[1] = c ? a[1] : b[1]; r[2] = c ? a[2] : b[2]; r[3] = c ? a[3] : b[3]; return r; }
    __device__ __forceinline__ void operator()(const f32x4 (&acc)[2][2][4][2], const Unit& u, int wr, int wc, int fr, int fq) const {
        const bool ctx = u.pm < 16, h = (fr >> 3) != 0;
        const int c7 = fr & 7, lane = fq * 16 + fr, ch0 = u.pn * 128 + wc * 32 + 8 * fq;
        const f32x4 zero = {0.f, 0.f, 0.f, 0.f};
        f32x4 wa[2][3], wg[2][3];
#pragma unroll
        for (int k = 0; k < 3; ++k) { wa[0][k] = *(const f32x4*)(fw + k * (2 * 5632) + ch0); wg[0][k] = *(const f32x4*)(fw + k * (2 * 5632) + 5632 + ch0); }
        if (ctx) {
            if (wr == 0 && fr == 15) { PG8_LAS f32x4* p = (PG8_LAS f32x4*)(xch + ((wc * 2 + 0) * 4 + fq) * 16); p[0] = acc[1][0][3][0]; p[1] = acc[1][0][3][1]; p[2] = acc[1][1][3][0]; p[3] = acc[1][1][3][1]; }
            if (wr == 1 && fr == 0)  { PG8_LAS f32x4* p = (PG8_LAS f32x4*)(xch + ((wc * 2 + 1) * 4 + fq) * 16); p[0] = acc[0][0][0][0]; p[1] = acc[0][0][0][1]; p[2] = acc[0][1][0][0]; p[3] = acc[0][1][0][1]; }
            asm volatile("s_waitcnt lgkmcnt(0)" ::: "memory"); __builtin_amdgcn_s_barrier(); asm volatile("" ::: "memory");
        }
        const int srcp = (lane + 7) & 63, srcn = (lane - 7) & 63;
        u32x2 keep[8];
#pragma unroll
        for (int n = 0; n < 2; ++n) {
            f32x4 bpa = shl(acc[1][0][3][n], srcp), bpg = shl(acc[1][1][3][n], srcp), bna = shl(acc[0][0][0][n], srcn), bng = shl(acc[0][1][0][n], srcn);
            if (ctx) {
                const PG8_LAS f32x4* p0 = (const PG8_LAS f32x4*)(xch + ((wc * 2 + 0) * 4 + fq) * 16); const PG8_LAS f32x4* p1 = (const PG8_LAS f32x4*)(xch + ((wc * 2 + 1) * 4 + fq) * 16);
                const f32x4 xpa = p0[n], xpg = p0[2 + n], xna = p1[n], xng = p1[2 + n];
                bpa = sel(c7 >= 1, bpa, sel(wr == 1, xpa, zero)); bpg = sel(c7 >= 1, bpg, sel(wr == 1, xpg, zero));
                bna = sel(c7 <= 6, bna, sel(wr == 0, xna, zero)); bng = sel(c7 <= 6, bng, sel(wr == 0, xng, zero));
            } else { bpa = zero; bpg = zero; bna = zero; bng = zero; }
            if (n == 0) {
#pragma unroll
                for (int k = 0; k < 3; ++k) { wa[1][k] = *(const f32x4*)(fw + k * (2 * 5632) + ch0 + 4); wg[1][k] = *(const f32x4*)(fw + k * (2 * 5632) + 5632 + ch0 + 4); }
            }
            f32x4 ea0 = shx8(acc[0][0][0][n]), eg0 = shx8(acc[0][1][0][n]);
            f32x4 pa = sel(h, ea0, bpa), pg = sel(h, eg0, bpg);
#pragma unroll
            for (int s = 0; s < 8; ++s) { const int ai = s >> 2, m = s & 3;
                const f32x4 eap = s < 7 ? shx8(acc[(s + 1) >> 2][0][(s + 1) & 3][n]) : bna, egp = s < 7 ? shx8(acc[(s + 1) >> 2][1][(s + 1) & 3][n]) : bng;
                const f32x4 xa = acc[ai][0][m][n], xg = acc[ai][1][m][n];
                const f32x4 na = sel(h, eap, ea0), ng = sel(h, egp, eg0);
                const f32x4 ca = wa[n][0] * pa + wa[n][1] * xa + wa[n][2] * na, cg = wg[n][0] * pg + wg[n][1] * xg + wg[n][2] * ng;
                const f32x4 t = cg * ca, ex = cg * (-1.442695041f);
                f32x4 den; den[0] = __builtin_amdgcn_exp2f(ex[0]); den[1] = __builtin_amdgcn_exp2f(ex[1]); den[2] = __builtin_amdgcn_exp2f(ex[2]); den[3] = __builtin_amdgcn_exp2f(ex[3]);
                den = den + 1.0f;
                f32x4 rc; rc[0] = __builtin_amdgcn_rcpf(den[0]); rc[1] = __builtin_amdgcn_rcpf(den[1]); rc[2] = __builtin_amdgcn_rcpf(den[2]); rc[3] = __builtin_amdgcn_rcpf(den[3]);
                const f32x4 o = t * rc;
                u32x2 w; w.x = cvt_pk_bf16(o[0], o[1]); w.y = cvt_pk_bf16(o[2], o[3]);
                if (n == 0) keep[s] = w;
                else { u32x4 w4; w4.x = keep[s].x; w4.y = keep[s].y; w4.z = w.x; w4.w = w.y; *(u32x4*)(ACT + (size_t)(u.pm * BM + ai * HALF + wr * 64 + m * 16 + fr) * 5632 + ch0) = w4; }
                pa = na; pg = ng; ea0 = eap; eg0 = egp;
            }
        }
    }
};
struct G4Order {
    int lo, hi, G, c; bool plain;
    __device__ __forceinline__ bool next(int i, Unit& u) const {
        const int L = lo + i * G + c; if (L >= hi) return false;
        StaticOrder so; so.init(24 * BM, 44 * BM, 1, 0);
        if (plain) return so.next(L, u);
        if (L >= 1024) { u.pm = 23; u.pn = 12 + (L - 1024); return true; }
        so.next(L, u); if (u.pm == 23 && u.pn >= 12) so.next(1024 + u.pn - 12, u);
        return true;
    }
    __device__ __forceinline__ void a_ready(const Unit&) const {}
    __device__ __forceinline__ void done(const Unit&) const {}
};
struct G5Order {
    bool st; StaticOrder so; Unit u0;
    __device__ __forceinline__ bool next(int i, Unit& u) const { if (st) return so.next(i, u); if (i != 0 || u0.pm < 0) return false; u = u0; return true; }
    __device__ __forceinline__ void a_ready(const Unit&) const {}
    __device__ __forceinline__ void done(const Unit&) const {}
};
}

__device__ __forceinline__ void cvt_load(const float* __restrict__ W, int N, int k0, int n0, int tid, f32x4 (&r0)[4], f32x4 (&r1)[4]) {
    const int n4 = tid & 31, kp = tid >> 5;
#pragma unroll
    for (int i = 0; i < 4; ++i) { const float* p = W + (size_t)(k0 + 2 * kp + 32 * i) * N + n0 + 4 * n4; r0[i] = __builtin_nontemporal_load((const f32x4*)p); r1[i] = __builtin_nontemporal_load((const f32x4*)(p + N)); }
}
__device__ __forceinline__ void cvt_put(LAS unsigned* T, int tid, const f32x4 (&r0)[4], const f32x4 (&r1)[4]) {
    const int n4 = tid & 31, kp = tid >> 5;
#pragma unroll
    for (int i = 0; i < 4; ++i)
#pragma unroll
        for (int e = 0; e < 4; ++e) T[(4 * n4 + e) * 65 + kp + 16 * i] = pk2(r0[i][e], r1[i][e]);
}
__device__ __forceinline__ void cvt_store(const LAS unsigned* T, bf16* __restrict__ Bt, int K, int k0, int j0, int tid) {
    const int n = tid >> 2, kc = tid & 3;
    unsigned w[16];
#pragma unroll
    for (int i = 0; i < 16; ++i) w[i] = T[n * 65 + 16 * kc + i];
    v4u* dst = (v4u*)(Bt + (size_t)(j0 + n) * K + k0 + 32 * kc);
#pragma unroll
    for (int q = 0; q < 4; ++q) { v4u o; o.x = w[4 * q]; o.y = w[4 * q + 1]; o.z = w[4 * q + 2]; o.w = w[4 * q + 3]; dst[q] = o; }
}
constexpr int CVT_PER_LAYER = 512 + 64 + 256 + 1408 + 704;
struct CvtD { const float* W; bf16* Bt; int N, K, k0, n0, j0; };
__device__ __forceinline__ CvtD cvt_desc(const DArgs& a, int it) {
    const int l = it / CVT_PER_LAYER; int r = it % CVT_PER_LAYER;
    const float* W; bf16* Bt; int N, K, jb, kb, n0;
    if (r < 512) { N = INC; K = DM; W = a.in[I_WIN] + (size_t)l * K * N; Bt = (bf16*)(a.ws + WS_WIN) + (size_t)l * N * K; kb = r >> 5; jb = r & 31;
        const int pn = jb >> 1, bj = jb & 1; n0 = pn < 8 ? ((bj ? 2048 : 1024) + 128 * pn) : ((bj ? 3072 : 0) + 128 * (pn - 8)); }
    else if (r < 576) { r -= 512; N = SW; K = SW; W = a.in[I_WGLU] + (size_t)l * K * N; Bt = (bf16*)(a.ws + WS_WGLU) + (size_t)l * N * K; kb = r >> 3; jb = r & 7; n0 = 128 * jb; }
    else if (r < 832) { r -= 576; N = DM; K = DM; W = a.in[I_WOUT] + (size_t)l * K * N; Bt = (bf16*)(a.ws + WS_WOUT) + (size_t)l * N * K; kb = r >> 4; jb = r & 15; n0 = 128 * jb; }
    else if (r < 2240) { r -= 832; N = UPN; K = DM; W = a.in[I_WUP] + (size_t)l * K * N; Bt = (bf16*)(a.ws + WS_WUP) + (size_t)l * N * K; kb = r / 88; jb = r % 88; n0 = ((jb & 1) ? DFF : 0) + 128 * (jb >> 1); }
    else { r -= 2240; N = DM; K = DFF; W = a.in[I_WDOWN] + (size_t)l * K * N; Bt = (bf16*)(a.ws + WS_WDN) + (size_t)l * N * K; kb = r >> 4; jb = r & 15; n0 = 128 * jb; }
    CvtD d; d.W = W; d.Bt = Bt; d.N = N; d.K = K; d.k0 = 128 * kb; d.n0 = n0; d.j0 = 128 * jb; return d;
}

constexpr int CW_CVT = 8192;
#define CVT_LDS_BAR() asm volatile("s_waitcnt lgkmcnt(0)\n\ts_barrier" ::: "memory")
__device__ __forceinline__ void cvt_fill(LAS unsigned char* lds, int tid_, int ln, int budget  ) {
    const int tid = fresh_v(tid_);
    volatile LAS unsigned* tk = (volatile LAS unsigned*)(lds + MISC_OFF) + 16;
    LAS unsigned* T0 = (LAS unsigned*)lds; LAS unsigned* T1 = T0 + 128 * 65;
    const int npairs = budget < 0 ? 0x7fffffff : (budget + 1) / 2;
    if (npairs <= 0) return;
    if (tid == 0) { const DArgs a = load_args(); tk[0] = __hip_atomic_fetch_add((unsigned*)(a.ws + WS_CTL) + CW_CVT + 64 * ln, 1u, __ATOMIC_RELAXED, __HIP_MEMORY_SCOPE_AGENT); }
    __syncthreads();
    for (int n = 0; n < npairs; ++n) {
        const unsigned t = tk[n & 1];
        if (2u * t >= (unsigned)CVT_PER_LAYER) break;
        const DArgs a = load_args();
        unsigned nx = 0xffffffffu;
        if (tid == 0 && n + 1 < npairs) nx = __hip_atomic_fetch_add((unsigned*)(a.ws + WS_CTL) + CW_CVT + 64 * ln, 1u, __ATOMIC_RELAXED, __HIP_MEMORY_SCOPE_AGENT);
        const CvtD d0 = cvt_desc(a, ln * CVT_PER_LAYER + 2 * (int)t), d1 = cvt_desc(a, ln * CVT_PER_LAYER + 2 * (int)t + 1);
        f32x4 a0[4], a1[4], b0[4], b1[4];
        cvt_load(d0.W, d0.N, d0.k0, d0.n0, tid, a0, a1); cvt_load(d1.W, d1.N, d1.k0, d1.n0, tid, b0, b1);
        cvt_put(T0, tid, a0, a1); cvt_put(T1, tid, b0, b1);
        if (tid == 0) tk[(n + 1) & 1] = nx;
        CVT_LDS_BAR();
        cvt_store(T0, d0.Bt, d0.K, d0.k0, d0.j0, tid); cvt_store(T1, d1.Bt, d1.K, d1.k0, d1.j0, tid);
        CVT_LDS_BAR();
    }
    __syncthreads();
}
__device__ __forceinline__ void mod_task(LAS unsigned char* lds, int tid_, int lane_, int wave_, int task) {
    const DArgs a = load_args(); const int tid = fresh_v(tid_), lane = fresh_v(lane_), wave = fresh_s(wave_);
    LAS float* SC = (LAS float*)(lds + 36864);
    LAS float* RED = (LAS float*)(lds + 36864 + 24576);
    const int l = task / 48, j0 = (task % 48) * 256;
    for (int i = tid; i < 3 * DM; i += 512) { const int v = i >> 11, k = i & 2047; const float x = v == 0 ? a.in[I_CCTX][k] : a.in[I_C][(v - 1) * DM + k]; SC[i] = x / (1.0f + __expf(-x)); }
    __syncthreads();
    const float* W = a.in[I_WADA] + (size_t)l * DM * 12288 + j0 + 4 * lane;
    f32x4 a0 = {0.f, 0.f, 0.f, 0.f}, a1 = a0, a2 = a0;
    const int kbeg = wave * 256;
    for (int k = kbeg; k < kbeg + 256; k += 8) {
        f32x4 w[8];
#pragma unroll
        for (int u = 0; u < 8; ++u) w[u] = __builtin_nontemporal_load((const f32x4*)(W + (size_t)(k + u) * 12288));
#pragma unroll
        for (int u = 0; u < 8; ++u) { const float s0 = SC[k + u], s1 = SC[2048 + k + u], s2 = SC[4096 + k + u]; a0 += w[u] * s0; a1 += w[u] * s1; a2 += w[u] * s2; }
    }
    *(LAS f32x4*)(RED + (wave * 3 + 0) * 256 + 4 * lane) = a0;
    *(LAS f32x4*)(RED + (wave * 3 + 1) * 256 + 4 * lane) = a1;
    *(LAS f32x4*)(RED + (wave * 3 + 2) * 256 + 4 * lane) = a2;
    __syncthreads();
    float* MOD = (float*)(a.ws + WS_MOD);
    for (int i = tid; i < 768; i += 512) { const int v = i >> 8, jj = i & 255; float s = a.in[I_BADA][l * 12288 + j0 + jj];
#pragma unroll
        for (int w8 = 0; w8 < 8; ++w8) s += RED[(w8 * 3 + v) * 256 + jj];
        const int ch = (j0 + jj) >> 11, e = (j0 + jj) & 2047;
        if (ch == 1) s = (1.0f + s) * a.in[I_GPRE1][l * DM + e]; else if (ch == 2) s *= a.in[I_GPOST1][l * DM + e];
        else if (ch == 4) s = (1.0f + s) * a.in[I_GPRE2][l * DM + e]; else if (ch == 5) s *= a.in[I_GPOST2][l * DM + e];
        MOD[(size_t)(l * 3 + v) * 12288 + j0 + jj] = s; }
    __syncthreads();
}

__device__ __forceinline__ int mod_vec(int row) { return row < NCTX ? 0 : 1 + ((row - NCTX) >> 10); }
__device__ __forceinline__ int perm_row(int row) {
    int gr, cc, base;
    if (row < NCTX) { const int t = row & 255; gr = t & 15; cc = t >> 4; base = row & ~255; }
    else { const int q = row - NCTX, p = q & 1023; gr = p >> 6; cc = p & 15; base = NCTX + ((q >> 10) * 4 + ((p >> 4) & 3)) * 256; }
    return base + 128 * (gr >> 3) + 64 * (cc >> 3) + 16 * ((gr >> 1) & 3) + 8 * (gr & 1) + (cc & 7);
}
constexpr size_t WS_XH = WS_UP + 8 * MiB, WS_XL = WS_UP + 40 * MiB;
__device__ __forceinline__ void x24_load(const unsigned char* ws, int row, int e0, float (&o)[8]) {
    const v4u h = __builtin_nontemporal_load((const v4u*)((const unsigned short*)(ws + WS_XH) + (size_t)row * DM + e0)); const v2u lo = __builtin_nontemporal_load((const v2u*)(ws + WS_XL + (size_t)row * DM + e0));
    const unsigned hw[4] = {h.x, h.y, h.z, h.w}, lw[2] = {lo.x, lo.y};
#pragma unroll
    for (int i = 0; i < 8; ++i) { const unsigned hi = (i & 1) ? (hw[i >> 1] & 0xffff0000u) : (hw[i >> 1] << 16); const unsigned l8 = (lw[i >> 2] >> (8 * (i & 3))) & 0xffu; o[i] = __uint_as_float(hi | (l8 << 8)); }
}
__device__ __forceinline__ void x24_store(unsigned char* ws, int row, int e0, const float (&x)[8]) {
    unsigned b[8];
#pragma unroll
    for (int i = 0; i < 8; ++i) b[i] = __float_as_uint(x[i]) + 0x80u;
    v4u h; h.x = (b[0] >> 16) | (b[1] & 0xffff0000u); h.y = (b[2] >> 16) | (b[3] & 0xffff0000u); h.z = (b[4] >> 16) | (b[5] & 0xffff0000u); h.w = (b[6] >> 16) | (b[7] & 0xffff0000u);
    v2u lo; lo.x = ((b[0] >> 8) & 0xffu) | (b[1] & 0xff00u) | ((b[2] << 8) & 0xff0000u) | ((b[3] << 16) & 0xff000000u); lo.y = ((b[4] >> 8) & 0xffu) | (b[5] & 0xff00u) | ((b[6] << 8) & 0xff0000u) | ((b[7] << 16) & 0xff000000u);
    __builtin_nontemporal_store(h, (v4u*)((unsigned short*)(ws + WS_XH) + (size_t)row * DM + e0)); __builtin_nontemporal_store(lo, (v2u*)(ws + WS_XL + (size_t)row * DM + e0));
}
template <int MODE>
__device__ __forceinline__ void row_pass(int l, int bx_, int G_, int wave_, int lane_, bool split23 = false) {
    const int bx = fresh_s(bx_), G = fresh_s(G_), wave = fresh_s(wave_), lane = fresh_v(lane_);
    constexpr bool FIRST = (MODE == 0), HAS_NEXT = (MODE != 3);
    const DArgs a = load_args();
    const float* MOD = (const float*)(a.ws + WS_MOD);
    const float* modl = MOD + (size_t)l * 3 * 12288;
    const bf16* Y = (const bf16*)(a.ws + (MODE == 1 ? WS_MIXED : WS_FF));
    const float* modg = modl + (MODE == 1 ? 2 : 5) * DM;
    const float* modn = MODE == 2 ? modl + 3 * 12288 : modl;
    const int sc_off = (MODE == 1 ? 4 : 1) * DM, sh_off = (MODE == 1 ? 3 : 0) * DM;
    bf16* Hdst = (bf16*)(a.ws + WS_H);
    const int rpw = (NTOK + G * NWAVES - 1) / (G * NWAVES), rbeg = (bx * NWAVES + wave) * rpw, rend = rbeg + rpw < NTOK ? rbeg + rpw : NTOK;
    int vprev = -1;
    f32x4 gv[8], cv[8], hv[8];
#pragma unroll
    for (int j = 0; j < 8; ++j) { gv[j] = (f32x4){0.f, 0.f, 0.f, 0.f}; cv[j] = gv[j]; hv[j] = gv[j]; }
    for (int row = rbeg; row < rend; ++row) {
        const int v = mod_vec(row);
        if (v != vprev) { vprev = v;
#pragma unroll
            for (int j = 0; j < 4; ++j) { const int e0 = 8 * lane + 512 * j;
                if (!FIRST) { const float* gate = modg + (size_t)v * 12288; gv[2 * j] = *(const f32x4*)(gate + e0); gv[2 * j + 1] = *(const f32x4*)(gate + e0 + 4); }
                if (HAS_NEXT) { const float* sc = modn + (size_t)v * 12288 + sc_off; const float* sh = modn + (size_t)v * 12288 + sh_off;
                    cv[2 * j] = *(const f32x4*)(sc + e0); cv[2 * j + 1] = *(const f32x4*)(sc + e0 + 4); hv[2 * j] = *(const f32x4*)(sh + e0); hv[2 * j + 1] = *(const f32x4*)(sh + e0 + 4); } } }
        float* xr = a.out + (size_t)row * DM;
        float x[32];
        if (FIRST) {
            const float* src = row < NCTX ? a.in[I_XP] + (size_t)row * DM : a.in[I_XS] + (size_t)(row - NCTX) * DM;
#pragma unroll
            for (int j = 0; j < 4; ++j) { const f32x4 p = __builtin_nontemporal_load((const f32x4*)(src + 8 * lane + 512 * j)), q = __builtin_nontemporal_load((const f32x4*)(src + 8 * lane + 512 * j + 4));
                x[8 * j] = p[0]; x[8 * j + 1] = p[1]; x[8 * j + 2] = p[2]; x[8 * j + 3] = p[3]; x[8 * j + 4] = q[0]; x[8 * j + 5] = q[1]; x[8 * j + 6] = q[2]; x[8 * j + 7] = q[3];
                const float t8[8] = {p[0], p[1], p[2], p[3], q[0], q[1], q[2], q[3]}; x24_store(a.ws, row, 8 * lane + 512 * j, t8); }
        } else {
            float y[32]; float ssq = 0.f;
            const int pr = MODE == 1 ? row : perm_row(row);
            const bool sp23 = MODE != 1 && split23 && pr >= 23 * 256;
            const bf16* yr = sp23 ? (const bf16*)(a.ws + WS_FFP) + (size_t)(pr - 23 * 256) * DM : Y + (size_t)pr * DM;
#pragma unroll
            for (int j = 0; j < 4; ++j) { const v4u w = __builtin_nontemporal_load((const v4u*)(yr + 8 * lane + 512 * j)); float t[8]; unpack8(w, t);
                if (sp23) {
#pragma unroll
                    for (int sp = 1; sp < 4; ++sp) { float t2[8]; unpack8(*(const v4u*)(yr + (size_t)sp * 256 * DM + 8 * lane + 512 * j), t2);
#pragma unroll
                        for (int i = 0; i < 8; ++i) t[i] += t2[i]; } }
#pragma unroll
                for (int i = 0; i < 8; ++i) { y[8 * j + i] = t[i]; ssq += t[i] * t[i]; } }
            ssq = wave_sum(ssq);
            const float rs = 1.0f / sqrtf(ssq * (1.0f / DM) + EPS);
#pragma unroll
            for (int j = 0; j < 4; ++j) { const int e0 = 8 * lane + 512 * j;
                float xo[8]; x24_load(a.ws, row, e0, xo);
                const f32x4 g0 = gv[2 * j], g1 = gv[2 * j + 1];
                f32x4 np, nq;
#pragma unroll
                for (int i = 0; i < 4; ++i) { np[i] = xo[i] + g0[i] * (y[8 * j + i] * rs); nq[i] = xo[4 + i] + g1[i] * (y[8 * j + 4 + i] * rs); x[8 * j + i] = np[i]; x[8 * j + 4 + i] = nq[i]; }
                if (MODE == 3) { __builtin_nontemporal_store(np, (f32x4*)(xr + e0)); __builtin_nontemporal_store(nq, (f32x4*)(xr + e0 + 4)); }
                else { const float t8[8] = {np[0], np[1], np[2], np[3], nq[0], nq[1], nq[2], nq[3]}; x24_store(a.ws, row, e0, t8); } }
        }
        if (HAS_NEXT) {
            float ssq = 0.f;
#pragma unroll
            for (int i = 0; i < 32; ++i) ssq += x[i] * x[i];
            ssq = wave_sum(ssq);
            const float rs = 1.0f / sqrtf(ssq * (1.0f / DM) + EPS);
            bf16* hr = Hdst + (size_t)(MODE == 1 ? perm_row(row) : row) * DM;
#pragma unroll
            for (int j = 0; j < 4; ++j) { const int e0 = 8 * lane + 512 * j;
                const f32x4 c0 = cv[2 * j], c1 = cv[2 * j + 1], h0 = hv[2 * j], h1 = hv[2 * j + 1];
                float o[8];
#pragma unroll
                for (int i = 0; i < 4; ++i) { o[i] = x[8 * j + i] * rs * c0[i] + h0[i]; o[4 + i] = x[8 * j + 4 + i] * rs * c1[i] + h1[i]; }
                *(v4u*)(hr + e0) = pack8(o); }
        }
    }
}

__device__ __forceinline__ void mix_pass(int bx_, int G_, int wave_, int lane_, int l) {
    const DArgs a = load_args(); const int bx = fresh_s(bx_), G = fresh_s(G_), wave = fresh_s(wave_), lane = fresh_v(lane_);
    const bf16* GB = (const bf16*)(a.ws + WS_GB); const bf16* V = (const bf16*)(a.ws + WS_V); const bf16* O = (const bf16*)(a.ws + WS_O); bf16* MX = (bf16*)(a.ws + WS_MIXIN);
    const float* cw = a.in[I_CONVW] + (size_t)l * 3 * CW; const float* gc = a.in[I_GCONV] + (size_t)l * CW; const float* gs = a.in[I_GSSM] + (size_t)l * SW;
    float w0r[16], w1r[16], w2r[16], gcr[16], gsr[16];
#pragma unroll
    for (int j = 0; j < 2; ++j) { const int c0 = 8 * lane + 512 * j;
#pragma unroll
        for (int hq = 0; hq < 2; ++hq) { const f32x4 t0 = *(const f32x4*)(cw + c0 + 4 * hq), t1 = *(const f32x4*)(cw + CW + c0 + 4 * hq), t2 = *(const f32x4*)(cw + 2 * CW + c0 + 4 * hq),
                                               t3 = *(const f32x4*)(gc + c0 + 4 * hq), t4 = *(const f32x4*)(gs + c0 + 4 * hq);
#pragma unroll
            for (int i = 0; i < 4; ++i) { w0r[8 * j + 4 * hq + i] = t0[i]; w1r[8 * j + 4 * hq + i] = t1[i]; w2r[8 * j + 4 * hq + i] = t2[i]; gcr[8 * j + 4 * hq + i] = t3[i]; gsr[8 * j + 4 * hq + i] = t4[i]; } } }
    const int rpw = (NTOK + G * NWAVES - 1) / (G * NWAVES), rbeg = (bx * NWAVES + wave) * rpw, rend = rbeg + rpw < NTOK ? rbeg + rpw : NTOK;
    for (int row = rbeg; row < rend; ++row) {
        bool hp, hn;
        if (row < NCTX) { const int t = row & 255; hp = t > 0; hn = t < 255; } else { const int c = (row - NCTX) & 63; hp = c > 0; hn = c < 63; }
#pragma unroll
        for (int j = 0; j < 2; ++j) { const int c0 = 8 * lane + 512 * j; const size_t off = (size_t)row * CW + c0;
            float vc[8], vp[8], vn[8], gb[8];
            unpack8(*(const v4u*)(V + off), vc); unpack8(__builtin_nontemporal_load((const v4u*)(GB + off)), gb);
            if (hp) unpack8(*(const v4u*)(V + off - CW), vp); else {
#pragma unroll
                for (int i = 0; i < 8; ++i) vp[i] = 0.f; }
            if (hn) unpack8(*(const v4u*)(V + off + CW), vn); else {
#pragma unroll
                for (int i = 0; i < 8; ++i) vn[i] = 0.f; }
            float o[8]; float ssq = 0.f;
#pragma unroll
            for (int i = 0; i < 8; ++i) { o[i] = gb[i] * (w0r[8 * j + i] * vp[i] + w1r[8 * j + i] * vc[i] + w2r[8 * j + i] * vn[i]); ssq += o[i] * o[i]; }
            ssq += __shfl_xor(ssq, 1); ssq += __shfl_xor(ssq, 2); ssq += __shfl_xor(ssq, 4);
            const float rs = 1.0f / sqrtf(ssq * (1.0f / 64.0f) + EPS);
#pragma unroll
            for (int i = 0; i < 8; ++i) o[i] = o[i] * rs * gcr[8 * j + i];
            *(v4u*)(MX + (size_t)row * DM + c0) = pack8(o); }
        float s[16]; float ssq = 0.f;
#pragma unroll
        for (int j = 0; j < 2; ++j) { float t[8]; unpack8(__builtin_nontemporal_load((const v4u*)(O + (size_t)row * SW + 8 * lane + 512 * j)), t);
#pragma unroll
            for (int i = 0; i < 8; ++i) { s[8 * j + i] = t[i]; ssq += t[i] * t[i]; } }
        ssq = wave_sum(ssq);
        const float rs = 1.0f / sqrtf(ssq * (1.0f / SW) + EPS);
#pragma unroll
        for (int j = 0; j < 2; ++j) { const int c0 = 8 * lane + 512 * j; float o[8];
#pragma unroll
            for (int i = 0; i < 8; ++i) o[i] = s[8 * j + i] * rs * gsr[8 * j + i];
            *(v4u*)(MX + (size_t)row * DM + CW + c0) = pack8(o); }
    }
}

struct S5C { bf16x8 Bf[2][4]; float ar[2][2], ai[2][2]; };
__device__ __forceinline__ void s5_setup(const DArgs& a, LAS unsigned char* lds, int lane, int wave, int l, int g, S5C& c) {
    const int n = lane & 31, hf = lane >> 5, tq = lane & 15, q = lane >> 4;
    LAS unsigned char* CFB = lds + 135168;
    LAS float* A16 = (LAS float*)(lds + 143360);
#pragma unroll
    for (int d = 0; d < 2; ++d) {
        const int pg = (l * 2 + d) * 64 + g;
        const float dt = expf(a.in[I_LOGDT][pg]);
#pragma unroll
        for (int s = 0; s < 2; ++s) { const int nn = n + 32 * s;
            const float are = a.in[I_ARE][pg * 64 + nn], aim = a.in[I_AIM][pg * 64 + nn];
            const float er = expf(are * dt); float sn, cs; sincos_cw(aim * dt, sn, cs);
            const float abr = er * cs, abi = er * sn; c.ar[d][s] = abr; c.ai[d][s] = abi;
            if (wave == 0 && hf == 0) { const float e16 = expf(16.0f * are * dt); float s16, c16; sincos_cw(16.0f * aim * dt, s16, c16); *(LAS f32x2*)(A16 + (d * 64 + nn) * 2) = (f32x2){e16 * c16, e16 * s16}; }
            const float inv = 1.0f / (are * are + aim * aim);
            const float cr = ((abr - 1.0f) * are + abi * aim) * inv, ci = (abi * are - (abr - 1.0f) * aim) * inv;
            const float* brp = a.in[I_BRE] + (unsigned)((pg * 64 + nn) * 16 + 8 * hf); const float* bip = a.in[I_BIM] + (unsigned)((pg * 64 + nn) * 16 + 8 * hf);
            const f32x4 br0 = *(const f32x4*)brp, br1 = *(const f32x4*)(brp + 4), bi0 = *(const f32x4*)bip, bi1 = *(const f32x4*)(bip + 4);
            v4u wr_, wi_;
            wr_.x = pk2(cr * br0[0] - ci * bi0[0], cr * br0[1] - ci * bi0[1]); wr_.y = pk2(cr * br0[2] - ci * bi0[2], cr * br0[3] - ci * bi0[3]);
            wr_.z = pk2(cr * br1[0] - ci * bi1[0], cr * br1[1] - ci * bi1[1]); wr_.w = pk2(cr * br1[2] - ci * bi1[2], cr * br1[3] - ci * bi1[3]);
            wi_.x = pk2(cr * bi0[0] + ci * br0[0], cr * bi0[1] + ci * br0[1]); wi_.y = pk2(cr * bi0[2] + ci * br0[2], cr * bi0[3] + ci * br0[3]);
            wi_.z = pk2(cr * bi1[0] + ci * br1[0], cr * bi1[1] + ci * br1[1]); wi_.w = pk2(cr * bi1[2] + ci * br1[2], cr * bi1[3] + ci * br1[3]);
            c.Bf[d][2 * s] = __builtin_bit_cast(bf16x8, wr_); c.Bf[d][2 * s + 1] = __builtin_bit_cast(bf16x8, wi_); }
        if (wave == 0) {
            const float* crp = a.in[I_CRE] + (unsigned)((pg * 16 + tq) * 64); const float* cip = a.in[I_CIM] + (unsigned)((pg * 16 + tq) * 64);
#pragma unroll
            for (int ks = 0; ks < 4; ++ks) { const int n0 = 8 * ks + 2 * q;
                const f32x2 cr0 = *(const f32x2*)(crp + n0), cr1 = *(const f32x2*)(crp + n0 + 32), ci0 = *(const f32x2*)(cip + n0), ci1 = *(const f32x2*)(cip + n0 + 32);
                v4u w; w.x = pk2(cr0[0], -ci0[0]); w.y = pk2(cr1[0], -ci1[0]); w.z = pk2(cr0[1], -ci0[1]); w.w = pk2(cr1[1], -ci1[1]);
                *(LAS v4u*)(CFB + ((d * 4 + ks) * 64 + lane) * 16) = w; }
        }
    }
}
__device__ __forceinline__ void s5_task(const DArgs& a, LAS unsigned char* lds, int tid, int lane, int wave, int l, int row0, int NC, int g, int bidx, bool latent, const S5C& cst, bf16x8& Afpre, int next_row0) {
#define S5_BAR() do { asm volatile("s_waitcnt lgkmcnt(0)" ::: "memory"); __builtin_amdgcn_s_barrier(); asm volatile("" ::: "memory"); } while (0)
    const int n = lane & 31, hf = lane >> 5, tq = lane & 15, q = lane >> 4;
    LAS float* EB = (LAS float*)lds;
    LAS unsigned char* SB = lds + 65536 + wave * 8704;
    const bf16* U = (const bf16*)(a.ws + WS_U); bf16* Z = (bf16*)(a.ws + WS_Z);
    LAS unsigned char* CFB = lds + 135168;
    const LAS float* A16 = (const LAS float*)(lds + 143360);
    bf16x8 Bf[2][4]; float ar[2][2], ai[2][2];
#pragma unroll
    for (int d = 0; d < 2; ++d) {
#pragma unroll
        for (int cb = 0; cb < 4; ++cb) Bf[d][cb] = cst.Bf[d][cb];
#pragma unroll
        for (int s2 = 0; s2 < 2; ++s2) { ar[d][s2] = cst.ar[d][s2]; ai[d][s2] = cst.ai[d][s2]; } }
    const f32x16 zero16 = {0.f, 0.f, 0.f, 0.f, 0.f, 0.f, 0.f, 0.f, 0.f, 0.f, 0.f, 0.f, 0.f, 0.f, 0.f, 0.f};
    const int cbit = (n >> 2) & 1, tA = (n >> 3) * 4 + (n & 3);
#define S5_PIN_BU() asm volatile("s_nop 15\n\ts_nop 15\n\ts_nop 15\n\ts_nop 15\n\ts_nop 15\n\ts_nop 15\n\ts_nop 15\n\ts_nop 15\n\ts_nop 15\n\ts_nop 15\n\ts_nop 15\n\ts_nop 15\n\ts_nop 15\n\ts_nop 15\n\ts_nop 15\n\ts_nop 15\n\ts_nop 15\n\ts_nop 15\n\ts_nop 15\n\ts_nop 15" : "+v"(acc[0]), "+v"(acc[1]), "+v"(acc[2]), "+v"(acc[3]) : "v"(Afd), "v"(Bf[d][0]), "v"(Bf[d][1]), "v"(Bf[d][2]), "v"(Bf[d][3]))
    bf16x8 Afk = {0, 0, 0, 0, 0, 0, 0, 0};
    bf16x8 Afn = Afpre;
    for (int item = wave; item < NC / 2; item += NWAVES) { const int c0 = 2 * item;
        const bf16x8 Af = Afn;
        if (item + NWAVES < NC / 2) Afn = *(const bf16x8*)(U + (unsigned)((row0 + (c0 + 2 * NWAVES + cbit) * 16 + tA) * SW + g * 16 + 8 * hf));
        Afk = Af;
#pragma unroll
        for (int d = 0; d < 2; ++d) {
            bf16x8 Afd = Af; asm volatile("" : "+v"(Afd) :: "memory");
            f32x16 acc[4];
#pragma unroll
            for (int cb = 0; cb < 4; ++cb) acc[cb] = __builtin_amdgcn_mfma_f32_32x32x16_bf16(Afd, Bf[d][cb], zero16, 0, 0, 0);
            S5_PIN_BU();
            float s0r = 0.f, s0i = 0.f, s1r = 0.f, s1i = 0.f;
#pragma unroll
            for (int ii = 0; ii < 16; ++ii) { const int i = d == 0 ? ii : 15 - ii;
                const float n0r = fmaf(ar[d][0], s0r, fmaf(-ai[d][0], s0i, acc[0][i])), n0i = fmaf(ar[d][0], s0i, fmaf(ai[d][0], s0r, acc[1][i]));
                const float n1r = fmaf(ar[d][1], s1r, fmaf(-ai[d][1], s1i, acc[2][i])), n1i = fmaf(ar[d][1], s1i, fmaf(ai[d][1], s1r, acc[3][i]));
                s0r = n0r; s0i = n0i; s1r = n1r; s1i = n1i; }
            *(LAS f32x4*)(EB + (d * 64 + c0 + hf) * 128 + 4 * n) = (f32x4){s0r, s0i, s1r, s1i};
            asm volatile("s_waitcnt lgkmcnt(0)" :: "v"(s0r), "v"(s0i), "v"(s1r), "v"(s1i) : "memory");
        }
    }
    S5_BAR();
    if (tid < 128) { const int d = tid >> 6, nn = tid & 63, pos = nn < 32 ? 4 * nn : 4 * (nn - 32) + 2;
        const f32x2 p16 = *(const LAS f32x2*)(A16 + (d * 64 + nn) * 2); const float pr = p16[0], pi = p16[1];
        const unsigned sidx = ((((unsigned)bidx * DEPTH + l) * 2 + d) * 64 + g) * 64 + nn;
        float sr = 0.f, si = 0.f;
        if (latent) { sr = a.in[I_SRE][sidx]; si = a.in[I_SIM][sidx]; }
        for (int cb8 = 0; cb8 < NC; cb8 += 8) {
            f32x2 e[8];
#pragma unroll
            for (int j = 0; j < 8; ++j) { const int c = d == 0 ? cb8 + j : NC - 1 - cb8 - j; e[j] = *(const LAS f32x2*)(EB + (d * 64 + c) * 128 + pos); }
#pragma unroll
            for (int j = 0; j < 8; ++j) { const int c = d == 0 ? cb8 + j : NC - 1 - cb8 - j; const f32x2 sv = {sr, si};
                const float nr = fmaf(pr, sr, fmaf(-pi, si, e[j][0])), ni = fmaf(pr, si, fmaf(pi, sr, e[j][1])); sr = nr; si = ni;
                *(LAS f32x2*)(EB + (d * 64 + c) * 128 + pos) = sv; }
        }
        if (!latent) { float* ns = a.out + (size_t)NTOK * DM; ns[sidx] = sr; ns[524288u + sidx] = si; }
    }
    S5_BAR();
    if (next_row0 >= 0) Afpre = *(const bf16x8*)(U + (unsigned)((next_row0 + (2 * wave + cbit) * 16 + tA) * SW + g * 16 + 8 * hf));
    if (latent) Afn = *(const bf16x8*)(U + (unsigned)((row0 + (2 * wave + cbit) * 16 + tA) * SW + g * 16 + 8 * hf));
    const f32x4 dd = *(const f32x4*)(a.in[I_SSMD] + (unsigned)(l * SW + g * 16 + 4 * q));
    for (int item = wave; item < NC / 2; item += NWAVES) { const int c0 = 2 * item;
        bf16x8 Af = Afk;
        if (latent) { Af = Afn; if (item + NWAVES < NC / 2) Afn = *(const bf16x8*)(U + (unsigned)((row0 + (c0 + 2 * NWAVES + cbit) * 16 + tA) * SW + g * 16 + 8 * hf)); }
        v2u uwv[2];
#pragma unroll
        for (int cc = 0; cc < 2; ++cc) uwv[cc] = *(const v2u*)(U + (unsigned)((row0 + (c0 + cc) * 16 + tq) * SW + g * 16 + 4 * q));
        f32x4 yacc[2] = {{0.f, 0.f, 0.f, 0.f}, {0.f, 0.f, 0.f, 0.f}};
#pragma unroll
        for (int d = 0; d < 2; ++d) {
            bf16x8 Afd = Af; asm volatile("" : "+v"(Afd) :: "memory");
            f32x16 acc[4];
#pragma unroll
            for (int cb = 0; cb < 4; ++cb) acc[cb] = __builtin_amdgcn_mfma_f32_32x32x16_bf16(Afd, Bf[d][cb], zero16, 0, 0, 0);
            S5_PIN_BU();
            const f32x4 s_in = *(const LAS f32x4*)(EB + (d * 64 + c0 + hf) * 128 + 4 * n);
            float s0r = s_in[0], s0i = s_in[1], s1r = s_in[2], s1i = s_in[3];
            v2u w[16];
#pragma unroll
            for (int ii = 0; ii < 16; ++ii) { const int i = d == 0 ? ii : 15 - ii;
                const float n0r = fmaf(ar[d][0], s0r, fmaf(-ai[d][0], s0i, acc[0][i])), n0i = fmaf(ar[d][0], s0i, fmaf(ai[d][0], s0r, acc[1][i]));
                const float n1r = fmaf(ar[d][1], s1r, fmaf(-ai[d][1], s1i, acc[2][i])), n1i = fmaf(ar[d][1], s1i, fmaf(ai[d][1], s1r, acc[3][i]));
                s0r = n0r; s0i = n0i; s1r = n1r; s1i = n1i;
                w[i].x = pk2(s0r, s0i); w[i].y = pk2(s1r, s1i); }
#pragma unroll
            for (int i = 0; i < 16; ++i) *(LAS v2u*)(SB + (hf * 16 + i) * 272 + 8 * n) = w[i];
            asm volatile("s_waitcnt lgkmcnt(0)" :: "v"(w[0]), "v"(w[1]), "v"(w[2]), "v"(w[3]), "v"(w[4]), "v"(w[5]), "v"(w[6]), "v"(w[7]), "v"(w[8]), "v"(w[9]), "v"(w[10]), "v"(w[11]), "v"(w[12]), "v"(w[13]), "v"(w[14]), "v"(w[15]) : "memory");
            {
                bf16x8 sf[2][4], cf[4];
#pragma unroll
                for (int ks = 0; ks < 4; ++ks) { cf[ks] = *(const LAS bf16x8*)(CFB + ((d * 4 + ks) * 64 + lane) * 16);
#pragma unroll
                    for (int cc = 0; cc < 2; ++cc) sf[cc][ks] = *(const LAS bf16x8*)(SB + (cc * 16 + tq) * 272 + ks * 64 + q * 16); }
                asm volatile("s_waitcnt lgkmcnt(0)" : "+v"(sf[0][0]), "+v"(sf[0][1]), "+v"(sf[0][2]), "+v"(sf[0][3]), "+v"(sf[1][0]), "+v"(sf[1][1]), "+v"(sf[1][2]), "+v"(sf[1][3]), "+v"(cf[0]), "+v"(cf[1]), "+v"(cf[2]), "+v"(cf[3]) :: "memory");
#pragma unroll
                for (int cc = 0; cc < 2; ++cc)
#pragma unroll
                    for (int ks = 0; ks < 4; ++ks) yacc[cc] = __builtin_amdgcn_mfma_f32_16x16x32_bf16(cf[ks], sf[cc][ks], yacc[cc], 0, 0, 0);
                asm volatile("s_nop 15\n\ts_nop 15\n\ts_nop 15\n\ts_nop 15\n\ts_nop 15\n\ts_nop 15\n\ts_nop 15\n\ts_nop 15\n\ts_nop 15\n\ts_nop 15\n\ts_nop 15\n\ts_nop 15\n\ts_nop 15\n\ts_nop 15\n\ts_nop 15\n\ts_nop 15" : "+v"(yacc[0]), "+v"(yacc[1]) : "v"(sf[0][0]), "v"(sf[0][1]), "v"(sf[0][2]), "v"(sf[0][3]), "v"(sf[1][0]), "v"(sf[1][1]), "v"(sf[1][2]), "v"(sf[1][3]), "v"(cf[0]), "v"(cf[1]), "v"(cf[2]), "v"(cf[3]) : "memory");
            }
        }
#pragma unroll
        for (int cc = 0; cc < 2; ++cc) { const unsigned off = (unsigned)((row0 + (c0 + cc) * 16 + tq) * SW + g * 16 + 4 * q);
            const v2u uw = uwv[cc];
            const float u0 = bflo(uw.x), u1 = bfhi(uw.x), u2 = bflo(uw.y), u3 = bfhi(uw.y);
            const float z0 = gelu_tanh(yacc[cc][0] + dd[0] * u0), z1 = gelu_tanh(yacc[cc][1] + dd[1] * u1), z2 = gelu_tanh(yacc[cc][2] + dd[2] * u2), z3 = gelu_tanh(yacc[cc][3] + dd[3] * u3);
            v2u zw; zw.x = pk2(z0, z1); zw.y = pk2(z2, z3);
            *(v2u*)(Z + off) = zw; }
    }
    S5_BAR();
}
__device__ __forceinline__ void s5_phase(LAS unsigned char* lds, int tid_, int lane_, int wave_, int bx_, int G_, int l) {
    const DArgs a = load_args(); const int tid = fresh_v(tid_), lane = fresh_v(lane_), wave = fresh_s(wave_), bx = fresh_s(bx_), G = fresh_s(G_);
    const bool bal = (G == 256);
    const int nt = bal ? (bx < 128 ? 3 : 6) : (128 + 1024 - bx + G - 1) / G;
    S5C cst; int gprev = -1; bf16x8 Afpre = {0, 0, 0, 0, 0, 0, 0, 0};
    const int lane_n = lane & 31, cbit = (lane_n >> 2) & 1, tA = (lane_n >> 3) * 4 + (lane_n & 3), hf = lane >> 5;
    const bf16* U = (const bf16*)(a.ws + WS_U);
    for (int i = 0; i < nt; ++i) {
        bool latent, latn = false; int b, g, bn = 0, gn = -1;
#define S5_TASK(ii, LAT, B, GG) do { if (bal) { if (bx < 128) { LAT = ((ii) == 0); GG = bx & 63; B = LAT ? (bx >> 6) : 2 * (bx >> 6) + ((ii) - 1); } else { const int w = bx - 128; LAT = false; GG = w >> 1; B = 4 + 6 * (w & 1) + (ii); } } \
        else { const int t = bx + (ii) * G; LAT = t < 128; const int tc = LAT ? t : t - 128; B = tc >> 6; GG = tc & 63; } } while (0)
        S5_TASK(i, latent, b, g);
        if (i + 1 < nt) S5_TASK(i + 1, latn, bn, gn);
        const int row0 = latent ? NCTX + b * 1024 : b * 256;
        const int rown = (i + 1 < nt && gn == g) ? (latn ? NCTX + bn * 1024 : bn * 256) : -1;
        if (g != gprev) { s5_setup(a, lds, lane, wave, l, g, cst); gprev = g;
            Afpre = *(const bf16x8*)(U + (unsigned)((row0 + (2 * wave + cbit) * 16 + tA) * SW + g * 16 + 8 * hf)); }
        s5_task(a, lds, tid, lane, wave, l, row0, latent ? 64 : 16, g, b, latent, cst, Afpre, rown);
#undef S5_TASK
    }
}
#define XB_TMO      128
#define XB_XCNT(j)  (256  + 64 * (j))
#define XB_XSUB(j)  (1280 + 64 * (j))
#define XB_XGEN(j)  (2304 + 64 * (j))
#define XB_TOP      3328
#define XB_TOPGEN   3392
#define XCD_BAR_WORDS 3456
#define XB_SPIN_CAP (1u << 18)

__device__ __forceinline__ unsigned xb_ld(unsigned* p)              { return __hip_atomic_load(p, __ATOMIC_RELAXED, __HIP_MEMORY_SCOPE_AGENT); }
__device__ __forceinline__ unsigned xb_add(unsigned* p, unsigned v) { return __hip_atomic_fetch_add(p, v, __ATOMIC_RELAXED, __HIP_MEMORY_SCOPE_AGENT); }
__device__ __forceinline__ unsigned xb_xcc_id() { return (unsigned)__builtin_amdgcn_s_getreg((3 << 11) | 20) & 0xFu; }
#define XB_SPIN(cond, bar) do { unsigned _sp = 0; while (cond) { __builtin_amdgcn_s_sleep(1); \
    if ((++_sp & 255u) == 0u) { if (xb_ld(&(bar)[XB_TMO])) break; if (_sp > XB_SPIN_CAP) { atomicAdd(&(bar)[XB_TMO], 1u); break; } } } } while (0)

struct XcdBarrier {
    unsigned* bar; unsigned x;
    volatile LAS unsigned* st;
};

__device__ __forceinline__ XcdBarrier xcd_barrier_post(unsigned* bar, volatile LAS unsigned* st) {
    XcdBarrier b; b.bar = bar; b.x = xb_xcc_id(); b.st = st;
    if (threadIdx.x == 0) (void)xb_add(&bar[XB_XCNT(b.x)], 1u);
    return b;
}
__device__ __forceinline__ void xcd_barrier_complete(unsigned* bar, unsigned x, unsigned& nloc, unsigned& nx) {
    const unsigned G = gridDim.x * gridDim.y * gridDim.z;
    unsigned sum, cnt, mine, sp = 0u;
    for (;;) {
        sum = 0u; cnt = 0u; mine = 0u;
#pragma unroll
        for (unsigned j = 0; j < 16; ++j) { const unsigned c = xb_ld(&bar[XB_XCNT(j)]); sum += c; cnt += (c > 0u) ? 1u : 0u; mine = (j == x) ? c : mine; }
        if (sum == G) break;
        __builtin_amdgcn_s_sleep(1);
        if ((++sp & 255u) == 0u) { if (xb_ld(&bar[XB_TMO])) break; if (sp > XB_SPIN_CAP) { atomicAdd(&bar[XB_TMO], 1u); break; } }
    }
    nloc = mine > 0u ? mine : 1u; nx = cnt > 0u ? cnt : 1u;
}

__device__ __forceinline__ void xcd_barrier(const XcdBarrier& b) {
    asm volatile("s_waitcnt vmcnt(0)" ::: "memory");
    __syncthreads();
    if (threadIdx.x == 0) {
        unsigned* bar = b.bar;
        __builtin_amdgcn_s_waitcnt(0);
        unsigned nloc = b.st[0], nx = b.st[1];
        if (nloc == 0u) { xcd_barrier_complete(bar, b.x, nloc, nx); b.st[0] = nloc; b.st[1] = nx; }
        const unsigned old = xb_add(&bar[XB_XSUB(b.x)], 1u);
        const unsigned gen = old / nloc;
        if (old + 1u == (gen + 1u) * nloc) {
            __builtin_amdgcn_fence(__ATOMIC_RELEASE, "agent");
            asm volatile("s_waitcnt vmcnt(0)" ::: "memory");
            const unsigned og = xb_add(&bar[XB_TOP], 1u);
            const unsigned tg = og / nx;
            if (og + 1u == (tg + 1u) * nx) xb_add(&bar[XB_TOPGEN], 1u);
            else XB_SPIN(xb_ld(&bar[XB_TOPGEN]) == tg, bar);
            __builtin_amdgcn_fence(__ATOMIC_ACQUIRE, "agent");
            xb_add(&bar[XB_XGEN(b.x)], 1u);
            asm volatile("s_waitcnt vmcnt(0)" ::: "memory");
        } else {
            XB_SPIN(xb_ld(&bar[XB_XGEN(b.x)]) == gen, bar);
            __builtin_amdgcn_fence(__ATOMIC_ACQUIRE, "agent");
            asm volatile("s_waitcnt vmcnt(0)" ::: "memory");
        }
    }
    __syncthreads();
}


__device__ __forceinline__ void sub_barrier(unsigned* word, unsigned n, unsigned* bar) {
    asm volatile("s_waitcnt vmcnt(0)" ::: "memory");
    __syncthreads();
    if (threadIdx.x == 0) {
        __builtin_amdgcn_s_waitcnt(0);
        __builtin_amdgcn_fence(__ATOMIC_RELEASE, "agent");
        asm volatile("s_waitcnt vmcnt(0)" ::: "memory");
        (void)xb_add(word, 1u);
        XB_SPIN(xb_ld(word) < n, bar);
        __builtin_amdgcn_fence(__ATOMIC_ACQUIRE, "agent");
        asm volatile("s_waitcnt vmcnt(0)" ::: "memory");
    }
    __syncthreads();
}

__global__ void __launch_bounds__(NWAVES * 64, 2) fwd_kernel(Args  ) {
    extern __shared__ __attribute__((aligned(16))) unsigned char lds_raw[];
    LAS unsigned char* lds = (LAS unsigned char*)lds_raw;
    const int tid = threadIdx.x, lane = tid & 63, wave = __builtin_amdgcn_readfirstlane(tid >> 6), G = gridDim.x, bx = blockIdx.x;
    volatile LAS unsigned* MISC = (volatile LAS unsigned*)(lds + MISC_OFF);
    for (int u = tid; u < (LDS_BYTES - LDSCTL_OFF) / 4; u += NWAVES * 64) ((LAS unsigned*)(lds + LDSCTL_OFF))[u] = 0u;
    __syncthreads();
    XcdBarrier bar;
    { const DArgs a = load_args(); gu32* ctl = (gu32*)(a.ws + WS_CTL); bar = xcd_barrier_post((unsigned*)(ctl + CW_BAR), MISC + 8); }
#define GRID_BAR() do { XcdBarrier b_ = bar; asm volatile("" : "+s"(b_.bar), "+s"(b_.x)); xcd_barrier(b_); } while (0)


    for (int t = bx; t < 192; t += G) mod_task(lds, tid, lane, wave, t);
    cvt_fill(lds, tid, 0, (G == 256 && bx < 192) ? 6 : -1);
    cvt_fill(lds, tid, 0, -1);
    GRID_BAR();
    row_pass<0>(0, bx, G, wave, lane);
    GRID_BAR();

    const int nl = fresh_s(DEPTH);
    for (int li = 0; li < nl; ++li) {
        const int l = li;
        const bool dfl = fresh_s(G) == 256;
        { const int x = bx & 7, r = bx >> 3;
          pg8::G5Order S; S.st = !dfl; S.so.init(NTOK, INC, fresh_s(G), fresh_s(bx));
          if (r < 24) { S.u0.pm = 3 * x + r % 3; S.u0.pn = 8 + r / 3; } else if (r < 28) { S.u0.pm = 3 * x + (r - 24) % 3; S.u0.pn = (r - 24) / 3; } else { S.u0.pm = -1; S.u0.pn = 0; }
          if (S.st || S.u0.pm >= 0) {
              const DArgs a = load_args(); pg8::Gemm g{(const bf16*)(a.ws + WS_H), (const bf16*)(a.ws + WS_WIN) + (size_t)l * INC * DM, NTOK, INC, DM};
              pg8::EpiIn E{(bf16*)(a.ws + WS_GB), (bf16*)(a.ws + WS_V), (bf16*)(a.ws + WS_U)};
              pg8::gemm_phase<pg8::EpiIn, pg8::G5Order, true, true>(lds, g, S, E);
          } else if (li + 1 < nl) cvt_fill(lds, tid, l + 1, 12);
        }
        GRID_BAR();
        s5_phase(lds, tid, lane, wave, bx, G, l);
        GRID_BAR();
        { const int x = bx & 7, r = bx >> 3;
          if (dfl && r < 20) {
              pg8::G5Order S; S.st = false; S.u0.pm = 3 * x + (r + 4) % 3; S.u0.pn = (r + 4) / 3;
              const DArgs a = load_args(); pg8::Gemm g{(const bf16*)(a.ws + WS_H), (const bf16*)(a.ws + WS_WIN) + (size_t)l * INC * DM, NTOK, INC, DM};
              pg8::EpiIn E{(bf16*)(a.ws + WS_GB), (bf16*)(a.ws + WS_V), (bf16*)(a.ws + WS_U)};
              pg8::gemm_phase<pg8::EpiIn, pg8::G5Order, true, true>(lds, g, S, E);
          } else {
              pg8::G5Order S; S.st = !dfl; S.so.init(NTOK, SW, fresh_s(G), fresh_s(bx)); S.u0.pm = 3 * x + (r - 20) % 3; S.u0.pn = (r - 20) / 3;
              const DArgs a = load_args(); pg8::Gemm g{(const bf16*)(a.ws + WS_Z), (const bf16*)(a.ws + WS_WGLU) + (size_t)l * SW * SW, NTOK, SW, SW};
              pg8::EpiGlu E{(const bf16*)(a.ws + WS_Z), (bf16*)(a.ws + WS_O), a.in[I_BGLU] + (size_t)l * SW};
              pg8::gemm_phase<pg8::EpiGlu, pg8::G5Order, true, true>(lds, g, S, E);
              if (li + 1 < nl) cvt_fill(lds, tid, l + 1, 4);
          }
        }
        GRID_BAR();
        mix_pass(bx, G, wave, lane, l);
        GRID_BAR();
        { const DArgs a = load_args(); pg8::Gemm g{(const bf16*)(a.ws + WS_MIXIN), (const bf16*)(a.ws + WS_WOUT) + (size_t)l * DM * DM, NTOK, DM, DM}; pg8::G5Order S; S.st = !dfl; S.so.init(NTOK, DM, fresh_s(G), fresh_s(bx)); { const int x = bx & 7, r = bx >> 3; S.u0.pm = r < 24 ? 3 * x + r % 3 : -1; S.u0.pn = r / 3; }
          pg8::EpiBf16<0> E{(bf16*)(a.ws + WS_MIXED), DM, nullptr, 0, 0, 1.f};
          pg8::gemm_phase<pg8::EpiBf16<0>, pg8::G5Order, true, true>(lds, g, S, E); }
        if (li + 1 < nl && bx >= 192) cvt_fill(lds, tid, l + 1, 12);
        GRID_BAR();
        row_pass<1>(l, bx, G, wave, lane);
        GRID_BAR();
        { const DArgs a = load_args(); pg8::Gemm g{(const bf16*)(a.ws + WS_H), (const bf16*)(a.ws + WS_WUP) + (size_t)l * UPN * DM, NTOK, UPN, DM}; pg8::G4Order S{0, dfl ? 1024 : 1056, fresh_s(G), fresh_s(bx), !dfl};
          pg8::EpiFfn E{(bf16*)(a.ws + WS_ACT), a.in[I_FFNW] + (size_t)l * 3 * UPN, (LAS float*)(lds + RING_BYTES)};
          pg8::gemm_phase<pg8::EpiFfn, pg8::G4Order, true, true>(lds, g, S, E); }
        GRID_BAR();
        if (dfl && bx < 32) {
            { const DArgs a = load_args(); pg8::Gemm g{(const bf16*)(a.ws + WS_H), (const bf16*)(a.ws + WS_WUP) + (size_t)l * UPN * DM, NTOK, UPN, DM}; pg8::G4Order S{1024, 1056, fresh_s(G), fresh_s(bx), false};
              pg8::EpiFfn E{(bf16*)(a.ws + WS_ACT), a.in[I_FFNW] + (size_t)l * 3 * UPN, (LAS float*)(lds + RING_BYTES)};
              pg8::gemm_phase<pg8::EpiFfn, pg8::G4Order, true, true>(lds, g, S, E); }
            { const DArgs a = load_args(); sub_barrier((unsigned*)(a.ws + WS_CTL) + CW_SUB + 64 * l, 32u, (unsigned*)(a.ws + WS_CTL) + CW_BAR); }
            { const DArgs a = load_args(); pg8::Gemm g{(const bf16*)(a.ws + WS_ACT) + (size_t)23 * 256 * DFF, (const bf16*)(a.ws + WS_WDN) + (size_t)l * DM * DFF, 256, 4 * DM, DFF / 4, DFF, 4};
              pg8::G5Order S; S.st = false; S.u0.pm = 0; S.u0.pn = fresh_s(bx);
              pg8::EpiBf16<0> E{(bf16*)(a.ws + WS_FFP), DM, nullptr, DM, (size_t)256 * DM, 1.f};
              pg8::gemm_phase<pg8::EpiBf16<0>, pg8::G5Order, true, true>(lds, g, S, E); }
            if (li + 1 < nl) cvt_fill(lds, tid, l + 1, 8);
        } else {
            const int x = bx & 7, r = (bx >> 3) - 4;
            pg8::G5Order S; S.st = !dfl; S.so.init(NTOK, DM, fresh_s(G), fresh_s(bx));
            if (bx < 224 && !(x == 7 && r >= 16)) { S.u0.pm = x < 7 ? 3 * x + r % 3 : 21 + (r & 1); S.u0.pn = x < 7 ? r / 3 : r >> 1; } else { S.u0.pm = -1; S.u0.pn = 0; }
            if (S.st || S.u0.pm >= 0) {
                const DArgs a = load_args(); pg8::Gemm g{(const bf16*)(a.ws + WS_ACT), (const bf16*)(a.ws + WS_WDN) + (size_t)l * DM * DFF, NTOK, DM, DFF};
                pg8::EpiBf16<0> E{(bf16*)(a.ws + WS_FF), DM, nullptr, 0, 0, 1.f};
                pg8::gemm_phase<pg8::EpiBf16<0>, pg8::G5Order, true, true>(lds, g, S, E);
            } else if (li + 1 < nl) cvt_fill(lds, tid, l + 1, 48);
        }
        GRID_BAR();
        if (li < nl - 1) {
            row_pass<2>(l, bx, G, wave, lane, fresh_s(G) == 256);
            cvt_fill(lds, tid, l + 1, -1);
            GRID_BAR();
        } else {
            row_pass<3>(l, bx, G, wave, lane, fresh_s(G) == 256);
        }
    }

#undef GRID_BAR
}

extern "C" void kernel_launch(void* const* d_in, const int* in_sizes, int n_in, void* d_out, int out_size, void* d_ws, size_t ws_size, hipStream_t stream) {
    static int grid = 0;
    if (grid == 0) {
        if (n_in != 30 || out_size != NTOK * DM + 2 * 524288 || ws_size < WS_END) { fprintf(stderr, "kernel_launch: unexpected shapes (n_in %d, out %d, ws %zu); nothing launched\n", n_in, out_size, ws_size); grid = -1; return; }
        int dev = 0, cus = 0, per_cu = 0;
        if (hipGetDevice(&dev) != hipSuccess || hipDeviceGetAttribute(&cus, hipDeviceAttributeMultiprocessorCount, dev) != hipSuccess) { grid = -1; return; }
        if (hipFuncSetAttribute((const void*)fwd_kernel, hipFuncAttributeMaxDynamicSharedMemorySize, LDS_BYTES) != hipSuccess) { fprintf(stderr, "kernel_launch: hipFuncSetAttribute failed\n"); grid = -1; return; }
        if (hipOccupancyMaxActiveBlocksPerMultiprocessor(&per_cu, (const void*)fwd_kernel, NWAVES * 64, LDS_BYTES) != hipSuccess || per_cu < 1)
            fprintf(stderr, "kernel_launch: note: occupancy query reports %d workgroups per CU\n", per_cu);
        (void)hipGetLastError();
        grid = cus;
    }
    if (grid < 0) return;
    if (hipMemsetAsync((char*)d_ws + WS_CTL, 0, CTL_ZERO_BYTES, stream) != hipSuccess) return;
    Args a{};
    for (int i = 0; i < 30; ++i) a.in[i] = (const float*)d_in[i];
    a.out = (float*)d_out; a.ws = (unsigned char*)d_ws;
    hipLaunchKernelGGL(fwd_kernel, dim3(grid), dim3(NWAVES * 64), LDS_BYTES, stream, a);
}
```

```cpp
#include <hip/hip_runtime.h>
#include <cstdio>
#include <cstdint>
namespace pg8 {
#define PG8_LAS __attribute__((address_space(3)))
typedef unsigned short bf16_t;
typedef short bf16x8 __attribute__((ext_vector_type(8)));
typedef float f32x4 __attribute__((ext_vector_type(4)));
typedef unsigned u32x4 __attribute__((ext_vector_type(4)));
constexpr int BM = 256, BK = 64, HALF = 128, HTB = HALF * BK * 2  , STAGE_BYTES = 8 * HTB, NXCD = 8, WGM = 8;

__host__ __device__ __forceinline__ int lds_byte(int r, int c) { const int st = (r >> 4) * 2 + (c >> 5), rr = r & 15, cc = c & 31, ob = rr * 64 + cc * 2; return st * 1024 + (ob ^ (((ob >> 9) & 1) << 5)); }
__host__ __device__ __forceinline__ void stage_rc(int b, int& R, int& C) { const int st = b / 1024, sb = b % 1024, swz = sb ^ (((sb >> 9) & 1) << 5); R = (st >> 1) * 16 + swz / 64; C = (st & 1) * 32 + (swz % 64) / 2; }
__host__ __device__ __forceinline__ int perm32(int rho) { const int n = rho >> 4, i = rho & 15; return 8 * (i >> 2) + 4 * n + (i & 3); }

struct Unit { int pm, pn; };
struct Gemm { const bf16_t* A; const bf16_t* Bt; int M, N, K; int ld = 0; int nsp = 1; };

struct StaticOrder {
    int nM, nN, nwg, G, c;
    __host__ __device__ void init(int M, int N, int G_, int c_) { nM = M / BM; nN = N / BM; nwg = nM * nN; G = G_; c = c_; }
    __host__ __device__ bool next(int i, Unit& u) const {
        const long L = (long)i * G + c; if (L >= nwg) return false;
        int wgid = (int)L; { const int q = nwg / NXCD, r = nwg % NXCD, xcd = wgid % NXCD, off = wgid / NXCD; wgid = (xcd < r ? xcd * (q + 1) : r * (q + 1) + (xcd - r) * q) + off; }
        const int nig = WGM * nN, gid = wgid / nig, fm = gid * WGM, gsz = (nM - fm) < WGM ? (nM - fm) : WGM;
        u.pm = fm + ((wgid % nig) % gsz); u.pn = (wgid % nig) / gsz; return true;
    }
    __device__ __forceinline__ void a_ready(const Unit&) const {}
    __device__ __forceinline__ void done(const Unit&) const {}
};

__device__ __forceinline__ unsigned cvt_pk_bf16(float lo, float hi) { unsigned r; asm volatile("v_cvt_pk_bf16_f32 %0, %1, %2" : "=v"(r) : "v"(lo), "v"(hi)); return r; }
typedef float f32x2 __attribute__((ext_vector_type(2)));
__device__ __forceinline__ f32x2 gelu_pk(f32x2 v) {
    const f32x2 av = __builtin_elementwise_abs(v), d = av * 0.2316418882f + 1.0f;
    f32x2 t; t.x = __builtin_amdgcn_rcpf(d.x); t.y = __builtin_amdgcn_rcpf(d.y);
    f32x2 q = t * 0.5307027145f + (-0.7265760135f); q = q * t + 0.7107068705f; q = q * t + (-0.142248368f); q = q * t + 0.127414796f; q = q * t;
    const f32x2 s = (v * v) * (-0.72134752044f);
    f32x2 e; e.x = __builtin_amdgcn_exp2f(s.x); e.y = __builtin_amdgcn_exp2f(s.y);
    const f32x2 m = v * (q * e), r = v - m;
    f32x2 o; o.x = v.x < 0.f ? m.x : r.x; o.y = v.y < 0.f ? m.y : r.y; return o;
}

template <int ACT  > struct EpiBf16 {
    static constexpr bool PERM = true, AFTER_DRAIN = false; static_assert(ACT == 0 || ACT == 1, "EpiBf16: ACT is 0 (none) or 1 (gelu_pk)");
    bf16_t* O; int ldc; const float* bias; int split_cols; size_t split_stride; float scale0;
    __device__ __forceinline__ void operator()(const f32x4 (&acc)[2][2][4][2], const Unit& u, int wr, int wc, int fr, int fq) const {
        const int row0 = u.pm * BM + wr * 64 + fr; int colt = u.pn * BM; bf16_t* base = O;
        float sc = 1.f; if (split_cols) { const int t = colt / split_cols; base += (size_t)t * split_stride; colt -= t * split_cols; if (t == 0) sc = scale0; }
        const int col0 = colt + wc * 32 + 8 * fq, bcol0 = u.pn * BM + wc * 32 + 8 * fq;
        f32x4 bv[2][2];
#pragma unroll
        for (int bj = 0; bj < 2; ++bj)
#pragma unroll
            for (int n = 0; n < 2; ++n) bv[bj][n] = bias ? *(const f32x4*)(bias + bcol0 + bj * HALF + 4 * n) : (f32x4){0.f, 0.f, 0.f, 0.f};
#pragma unroll
        for (int ai = 0; ai < 2; ++ai)
#pragma unroll
            for (int m = 0; m < 4; ++m) { bf16_t* rowp = base + (size_t)(row0 + ai * HALF + m * 16) * ldc + col0;
#pragma unroll
                for (int bj = 0; bj < 2; ++bj) { f32x4 v0 = acc[ai][bj][m][0] + bv[bj][0], v1 = acc[ai][bj][m][1] + bv[bj][1];
                    if (ACT == 1) { f32x2 a = gelu_pk((f32x2){v0[0], v0[1]}), b = gelu_pk((f32x2){v0[2], v0[3]}), c = gelu_pk((f32x2){v1[0], v1[1]}), d = gelu_pk((f32x2){v1[2], v1[3]});
                        v0 = (f32x4){a.x, a.y, b.x, b.y}; v1 = (f32x4){c.x, c.y, d.x, d.y}; }
                    v0 = v0 * sc; v1 = v1 * sc; u32x4 w; w.x = cvt_pk_bf16(v0[0], v0[1]); w.y = cvt_pk_bf16(v0[2], v0[3]); w.z = cvt_pk_bf16(v1[0], v1[1]); w.w = cvt_pk_bf16(v1[2], v1[3]);
                    *(u32x4*)(rowp + bj * HALF) = w; } }
    }
};
template <class Epi, class Sched, bool ALIGN_EPI = false, bool SP2 = false>
__device__ __forceinline__ void gemm_phase(PG8_LAS unsigned char* lds, const Gemm g, const Sched& S, const Epi& E) {
    int tid_ = threadIdx.x; asm volatile("" : "+v"(tid_));
    const int tid = tid_, wid = __builtin_amdgcn_readfirstlane(tid >> 6), lane = tid & 63, wr = wid >> 2, wc = wid & 3, fr = lane & 15, fq = lane >> 4;
    const int K = g.K, nt = K / BK, ld = g.ld ? g.ld : g.K, nNr = g.N / BM / g.nsp;
    unsigned voffA[2], voffB[2];
#pragma unroll
    for (int i = 0; i < 2; ++i) { int R, C; stage_rc(tid * 16 + i * 8192, R, C); const int Rb = Epi::PERM ? ((R & ~31) + perm32(R & 31)) : R;
        voffA[i] = (unsigned)(R * ld + C) * 2u; voffB[i] = (unsigned)(Rb * ld + C) * 2u; }
    const size_t kstep = (size_t)(BK * 2);
    const size_t hstep = (size_t)HALF * ld * 2;
    const size_t tstep = 2 * hstep;
    const unsigned ldsw = (unsigned)wid * 1024u;
    const int aoff = lds_byte(wr * 64 + fr, fq * 8), boff = lds_byte(wc * 32 + fr, fq * 8);
#define PG8_SA(b, h) (((b) * 2 + (h)) * HTB)
#define PG8_SB(b, h) ((4 + (b) * 2 + (h)) * HTB)
#define PG8_STAGE(bufoff, gbase, voff) do { _Pragma("unroll") for (int _i = 0; _i < 2; ++_i) \
        __builtin_amdgcn_global_load_lds((const unsigned*)((const char*)(gbase) + (voff)[_i]), (PG8_LAS unsigned*)(lds + (bufoff) + ldsw + _i * 8192), 16, 0, 0); } while (0)
#define PG8_LDA(dst, b, h) do { _Pragma("unroll") for (int m = 0; m < 4; ++m) _Pragma("unroll") for (int k = 0; k < 2; ++k) dst[m][k] = *(const PG8_LAS bf16x8*)(lds + PG8_SA(b, h) + aoff + m * 2048 + k * 1024); } while (0)
#define PG8_LDB(dst, b, h) do { _Pragma("unroll") for (int n = 0; n < 2; ++n) _Pragma("unroll") for (int k = 0; k < 2; ++k) dst[n][k] = *(const PG8_LAS bf16x8*)(lds + PG8_SB(b, h) + boff + n * 2048 + k * 1024); } while (0)
#define PG8_MMA(ai, bj, At, Bt) do { __builtin_amdgcn_s_setprio(1); _Pragma("unroll") for (int m = 0; m < 4; ++m) _Pragma("unroll") for (int n = 0; n < 2; ++n) _Pragma("unroll") for (int k = 0; k < 2; ++k) \
        acc[ai][bj][m][n] = __builtin_amdgcn_mfma_f32_16x16x32_bf16(Bt[n][k], At[m][k], acc[ai][bj][m][n], 0, 0, 0); __builtin_amdgcn_s_setprio(0); } while (0)
#define PG8_WAIT_V(n) asm volatile("s_waitcnt vmcnt(" #n ")" ::: "memory")
#define PG8_WAIT_L(n) asm volatile("s_waitcnt lgkmcnt(" #n ")" ::: "memory")
#define PG8_BAR __builtin_amdgcn_s_barrier()
#define PG8_SCHED __builtin_amdgcn_sched_barrier(0)
    Unit cur, nxt; int ui = 0;
    if (!S.next(0, cur)) return;
    f32x4 acc[2][2][4][2];
#pragma unroll
    for (int a = 0; a < 2; ++a)
#pragma unroll
        for (int b = 0; b < 2; ++b)
#pragma unroll
            for (int m = 0; m < 4; ++m)
#pragma unroll
                for (int n = 0; n < 2; ++n) acc[a][b][m][n] = (f32x4){0.f, 0.f, 0.f, 0.f};
    bf16x8 At[4][2], B0[2][2], B1[2][2];
#define PG8_APTR(u) ((const char*)g.A + (size_t)(u).pm * tstep + (size_t)((u).pn / nNr) * K * 2)
#define PG8_BPTR(u) ((const char*)g.Bt + (size_t)((u).pn % nNr) * tstep + (size_t)((u).pn / nNr) * K * 2)
    const char* cA = PG8_APTR(cur); const char* cB = PG8_BPTR(cur);
    S.a_ready(cur);
    if constexpr (SP2) {
        PG8_STAGE(PG8_SB(0, 0), cB, voffB); PG8_STAGE(PG8_SB(0, 1), cB + hstep, voffB); PG8_STAGE(PG8_SA(0, 0), cA, voffA); PG8_STAGE(PG8_SA(0, 1), cA + hstep, voffA);
        if (wr == 1) PG8_BAR;
        PG8_WAIT_V(2); PG8_BAR;
        PG8_STAGE(PG8_SB(1, 0), cB + kstep, voffB); PG8_STAGE(PG8_SA(1, 0), cA + kstep, voffA); PG8_STAGE(PG8_SB(1, 1), cB + hstep + kstep, voffB);
        PG8_WAIT_V(6); PG8_BAR;
    } else {
        PG8_STAGE(PG8_SB(0, 0), cB, voffB); PG8_STAGE(PG8_SA(0, 0), cA, voffA); PG8_STAGE(PG8_SB(0, 1), cB + hstep, voffB); PG8_STAGE(PG8_SA(0, 1), cA + hstep, voffA);
        if (wr == 1) PG8_BAR;
        PG8_WAIT_V(4); PG8_BAR;
        PG8_STAGE(PG8_SB(1, 0), cB + kstep, voffB); PG8_STAGE(PG8_SA(1, 0), cA + kstep, voffA); PG8_STAGE(PG8_SB(1, 1), cB + hstep + kstep, voffB);
        PG8_WAIT_V(6); PG8_BAR;
    }
    for (;;) {
        const bool has_next = S.next(ui + 1, nxt);
        const char* nA = has_next ? PG8_APTR(nxt) : cA; const char* nB = has_next ? PG8_BPTR(nxt) : cB;
        for (int t = 0; t < nt; t += 2) {
            const bool last = (t == nt - 2);
            const char* a1 = cA + (size_t)(t + 1) * kstep;
            const char* a2 = last ? nA : cA + (size_t)(t + 2) * kstep; const char* b2 = last ? nB : cB + (size_t)(t + 2) * kstep;
            const char* a3 = a2 + kstep; const char* b3 = b2 + kstep;
            if (last && has_next) S.a_ready(nxt);
            if constexpr (SP2) {
            PG8_LDB(B0, 0, 0); PG8_LDB(B1, 0, 1); PG8_SCHED; PG8_LDA(At, 0, 0); PG8_STAGE(PG8_SA(1, 1), a1 + hstep, voffA);
            PG8_WAIT_V(8); PG8_WAIT_L(0); PG8_BAR; PG8_MMA(0, 0, At, B0); PG8_MMA(0, 1, At, B1); PG8_BAR; PG8_SCHED;
            PG8_LDA(At, 0, 1); PG8_STAGE(PG8_SB(0, 0), b2, voffB); PG8_STAGE(PG8_SB(0, 1), b2 + hstep, voffB); PG8_STAGE(PG8_SA(0, 0), a2, voffA);
            PG8_WAIT_V(8); PG8_WAIT_L(0); PG8_BAR; PG8_MMA(1, 0, At, B0); PG8_MMA(1, 1, At, B1); PG8_BAR; PG8_SCHED;
            PG8_LDB(B0, 1, 0); PG8_LDB(B1, 1, 1); PG8_SCHED; PG8_LDA(At, 1, 0); PG8_STAGE(PG8_SA(0, 1), a2 + hstep, voffA);
            PG8_WAIT_V(8); PG8_WAIT_L(0); PG8_BAR; PG8_MMA(0, 0, At, B0); PG8_MMA(0, 1, At, B1); PG8_BAR; PG8_SCHED;
            PG8_LDA(At, 1, 1); PG8_STAGE(PG8_SB(1, 0), b3, voffB); PG8_STAGE(PG8_SB(1, 1), b3 + hstep, voffB); PG8_STAGE(PG8_SA(1, 0), a3, voffA);
            PG8_WAIT_V(8); PG8_WAIT_L(0); PG8_BAR; PG8_MMA(1, 0, At, B0); PG8_MMA(1, 1, At, B1); PG8_BAR; PG8_SCHED;
            } else {
            PG8_LDB(B0, 0, 0); PG8_SCHED; PG8_LDA(At, 0, 0); PG8_STAGE(PG8_SA(1, 1), a1 + hstep, voffA);
            PG8_WAIT_L(8); PG8_BAR; PG8_WAIT_L(0); PG8_MMA(0, 0, At, B0); PG8_BAR; PG8_SCHED;
            PG8_LDB(B1, 0, 1); PG8_STAGE(PG8_SB(0, 0), b2, voffB);
            PG8_BAR; PG8_WAIT_L(0); PG8_MMA(0, 1, At, B1); PG8_BAR;
            PG8_LDA(At, 0, 1); PG8_STAGE(PG8_SA(0, 0), a2, voffA);
            PG8_BAR; PG8_WAIT_L(0); PG8_MMA(1, 0, At, B0); PG8_BAR; PG8_SCHED;
            PG8_STAGE(PG8_SB(0, 1), b2 + hstep, voffB);
            PG8_WAIT_V(6); PG8_BAR; PG8_MMA(1, 1, At, B1); PG8_BAR;
            PG8_LDB(B0, 1, 0); PG8_SCHED; PG8_LDA(At, 1, 0); PG8_STAGE(PG8_SA(0, 1), a2 + hstep, voffA);
            PG8_WAIT_L(8); PG8_BAR; PG8_WAIT_L(0); PG8_MMA(0, 0, At, B0); PG8_BAR; PG8_SCHED;
            PG8_LDB(B1, 1, 1); PG8_STAGE(PG8_SB(1, 0), b3, voffB);
            PG8_BAR; PG8_WAIT_L(0); PG8_MMA(0, 1, At, B1); PG8_BAR;
            PG8_LDA(At, 1, 1); PG8_STAGE(PG8_SA(1, 0), a3, voffA);
            PG8_BAR; PG8_WAIT_L(0); PG8_MMA(1, 0, At, B0); PG8_BAR; PG8_SCHED;
            PG8_STAGE(PG8_SB(1, 1), b3 + hstep, voffB);
            PG8_WAIT_V(6); PG8_BAR; PG8_MMA(1, 1, At, B1); PG8_BAR;
            }
        }
        if constexpr (ALIGN_EPI) { if (wr == 0) PG8_BAR; }
        if constexpr (!Epi::AFTER_DRAIN) { E(acc, cur, wr, wc, fr, fq); S.done(cur); }
        if (!has_next) break;
#pragma unroll
        for (int a = 0; a < 2; ++a)
#pragma unroll
            for (int b = 0; b < 2; ++b)
#pragma unroll
                for (int m = 0; m < 4; ++m)
#pragma unroll
                    for (int n = 0; n < 2; ++n) acc[a][b][m][n] = (f32x4){0.f, 0.f, 0.f, 0.f};
        cur = nxt; cA = nA; cB = nB; ++ui;
        if constexpr (ALIGN_EPI) { if (wr == 1) PG8_BAR; }
    }
    PG8_WAIT_V(0);
    if constexpr (!ALIGN_EPI) { if (wr == 0) PG8_BAR; }
    PG8_BAR;
    if constexpr (Epi::AFTER_DRAIN) { E.fused(acc, cur, wr, wc, fr, fq, lds, wid, lane); S.done(cur); }
#undef PG8_APTR
#undef PG8_BPTR
#undef PG8_SA
#undef PG8_SB
#undef PG8_STAGE
#undef PG8_LDA
#undef PG8_LDB
#undef PG8_MMA
#undef PG8_WAIT_V
#undef PG8_WAIT_L
#undef PG8_BAR
#undef PG8_SCHED
}
}

constexpr int DM = 2048, NTOK = 6144, NCTX = 4096, DEPTH = 4;
constexpr int CW = 1024, SW = 1024, INC = 4096, DFF = 5632, UPN = 2 * DFF;
constexpr float EPS = 1e-6f;
constexpr int NWAVES = 8;

constexpr size_t MiB = 1u << 20;
constexpr size_t WS_CTL = 0, CTL_ZERO_BYTES = 1 * MiB;
constexpr size_t WS_MOD = 1 * MiB;
constexpr size_t WS_WIN = 2 * MiB, WS_WGLU = 66 * MiB, WS_WOUT = 74 * MiB, WS_WUP = 106 * MiB, WS_WDN = 282 * MiB;
constexpr size_t WS_H = 370 * MiB;
constexpr size_t WS_GB = 394 * MiB, WS_V = 406 * MiB, WS_U = 418 * MiB;
constexpr size_t WS_Z = 430 * MiB, WS_O = 442 * MiB;
constexpr size_t WS_MIXIN = 454 * MiB, WS_MIXED = 478 * MiB;
constexpr size_t WS_UP = 502 * MiB;
constexpr size_t WS_ACT = 634 * MiB;
constexpr size_t WS_FF = 700 * MiB;
constexpr size_t WS_END = 724 * MiB;
constexpr int CW_SUB = 12288;
constexpr size_t WS_FFP = WS_UP;
constexpr int CW_BAR = 4096;

constexpr int RING_BYTES = 131072;
constexpr int LDS_BYTES = 147456;
constexpr int LDSCTL_OFF = LDS_BYTES - 512, MISC_OFF = LDSCTL_OFF;

#define GAS __attribute__((address_space(1)))
#define LAS __attribute__((address_space(3)))
typedef unsigned short bf16;
typedef unsigned v4u __attribute__((ext_vector_type(4)));
typedef unsigned v2u __attribute__((ext_vector_type(2)));
typedef float f32x4 __attribute__((ext_vector_type(4)));
typedef float f32x2 __attribute__((ext_vector_type(2)));
typedef float f32x16 __attribute__((ext_vector_type(16)));
typedef short bf16x8 __attribute__((ext_vector_type(8)));
typedef GAS unsigned gu32;
#define LDS_WAIT() asm volatile("s_waitcnt lgkmcnt(0)" ::: "memory")

__device__ __forceinline__ unsigned f2bf(float f) { unsigned u = __builtin_bit_cast(unsigned, f); return (u + 0x7fffu + ((u >> 16) & 1u)) >> 16; }
__device__ __forceinline__ unsigned pk2(float lo, float hi) { unsigned r; asm("v_cvt_pk_bf16_f32 %0, %1, %2" : "=v"(r) : "v"(lo), "v"(hi)); return r; }
__device__ __forceinline__ float bflo(unsigned w) { return __uint_as_float(w << 16); }
__device__ __forceinline__ float bfhi(unsigned w) { return __uint_as_float(w & 0xffff0000u); }
__device__ __forceinline__ void unpack8(const v4u w, float (&f)[8]) { f[0] = bflo(w.x); f[1] = bfhi(w.x); f[2] = bflo(w.y); f[3] = bfhi(w.y); f[4] = bflo(w.z); f[5] = bfhi(w.z); f[6] = bflo(w.w); f[7] = bfhi(w.w); }
__device__ __forceinline__ v4u pack8(const float (&f)[8]) { v4u w; w.x = pk2(f[0], f[1]); w.y = pk2(f[2], f[3]); w.z = pk2(f[4], f[5]); w.w = pk2(f[6], f[7]); return w; }
__device__ __forceinline__ float wave_sum(float v) {
#pragma unroll
    for (int o = 1; o < 64; o <<= 1) v += __shfl_xor(v, o);
    return v;
}
__device__ __forceinline__ float sigmoidf_(float x) { return 1.0f / (1.0f + __expf(-x)); }
__device__ __forceinline__ float gelu_tanh(float y) { const float v = 0.7978845608028654f * (y + 0.044715f * y * y * y); const float t = 1.0f - 2.0f / (__expf(2.0f * v) + 1.0f); return 0.5f * y * (1.0f + t); }
__device__ __forceinline__ void sincos_cw(float x, float& s, float& c) {
    const float k = rintf(x * 0.6366197723675814f);
    float r = fmaf(k, -1.5707963705062866f, x);
    r = fmaf(k, 4.371138828673793e-08f, r);
    r = fmaf(k, 1.7763568394002505e-15f, r);
    const float r2 = r * r;
    const float sp = r + r * r2 * fmaf(r2, fmaf(r2, -1.9515295891e-4f, 8.3321608736e-3f), -1.6666654611e-1f);
    const float cp = fmaf(r2 * r2, fmaf(r2, fmaf(r2, 2.443315711809948e-5f, -1.388731625493765e-3f), 4.166664568298827e-2f), fmaf(r2, -0.5f, 1.0f));
    const int q = ((int)k) & 3;
    const float ss = (q & 1) ? cp : sp, cc = (q & 1) ? sp : cp;
    s = (q & 2) ? -ss : ss;
    c = ((q + 1) & 2) ? -cc : cc;
}

__device__ __forceinline__ int fresh_v(int x) { asm volatile("" : "+v"(x)); return x; }
__device__ __forceinline__ int fresh_s(int x) { asm volatile("" : "+s"(x)); return x; }
struct Args { const float* in[30]; float* out; unsigned char* ws; };
struct KImg { unsigned long long in[30]; unsigned long long out; unsigned long long ws; };
struct DArgs { const float* in[30]; float* out; unsigned char* ws; };
__device__ __forceinline__ DArgs load_args() {
    const __attribute__((address_space(4))) KImg* p = (const __attribute__((address_space(4))) KImg*)__builtin_amdgcn_kernarg_segment_ptr();
    asm volatile("" : "+s"(p));
    DArgs a;
#pragma unroll
    for (int i = 0; i < 30; ++i) a.in[i] = (const float*)(GAS const float*)p->in[i];
    a.out = (float*)(GAS float*)p->out; a.ws = (unsigned char*)(GAS unsigned char*)p->ws;
    return a;
}
enum { I_XP = 0, I_XS, I_SRE, I_SIM, I_C, I_CCTX, I_WADA, I_BADA, I_GPRE1, I_WIN, I_CONVW, I_ARE, I_AIM, I_LOGDT, I_BRE, I_BIM, I_CRE, I_CIM, I_SSMD, I_WGLU, I_BGLU,
       I_GCONV, I_GSSM, I_WOUT, I_GPOST1, I_GPRE2, I_WUP, I_FFNW, I_WDOWN, I_GPOST2 };

namespace pg8 {
struct EpiIn {
    static constexpr bool PERM = true, AFTER_DRAIN = false;
    bf16_t *GB, *V, *U;
    __device__ __forceinline__ void operator()(const f32x4 (&acc)[2][2][4][2], const Unit& u, int wr, int wc, int fr, int fq) const {
        const int row0 = u.pm * BM + wr * 64 + fr;
        if (u.pn < 8) {
            const int col0 = u.pn * 128 + wc * 32 + 8 * fq;
#pragma unroll
            for (int ai = 0; ai < 2; ++ai)
#pragma unroll
                for (int m = 0; m < 4; ++m) { bf16_t* rowp = V + (size_t)(row0 + ai * HALF + m * 16) * 1024 + col0;
                    const f32x4 v0 = acc[ai][0][m][0] * acc[ai][1][m][0], v1 = acc[ai][0][m][1] * acc[ai][1][m][1];
                    u32x4 w; w.x = cvt_pk_bf16(v0[0], v0[1]); w.y = cvt_pk_bf16(v0[2], v0[3]); w.z = cvt_pk_bf16(v1[0], v1[1]); w.w = cvt_pk_bf16(v1[2], v1[3]);
                    *(u32x4*)rowp = w; }
        } else {
            const int col0 = (u.pn - 8) * 128 + wc * 32 + 8 * fq;
#pragma unroll
            for (int ai = 0; ai < 2; ++ai)
#pragma unroll
                for (int m = 0; m < 4; ++m) { const size_t off = (size_t)(row0 + ai * HALF + m * 16) * 1024 + col0;
#pragma unroll
                    for (int bj = 0; bj < 2; ++bj) { const f32x4 v0 = acc[ai][bj][m][0], v1 = acc[ai][bj][m][1];
                        u32x4 w; w.x = cvt_pk_bf16(v0[0], v0[1]); w.y = cvt_pk_bf16(v0[2], v0[3]); w.z = cvt_pk_bf16(v1[0], v1[1]); w.w = cvt_pk_bf16(v1[2], v1[3]);
                        *(u32x4*)((bj ? U : GB) + off) = w; } }
        }
    }
};
struct EpiGlu {
    static constexpr bool PERM = true, AFTER_DRAIN = false;
    const bf16_t* Z; bf16_t* O; const float* bias;
    __device__ __forceinline__ void operator()(const f32x4 (&acc)[2][2][4][2], const Unit& u, int wr, int wc, int fr, int fq) const {
        const int row0 = u.pm * BM + wr * 64 + fr, col0 = u.pn * BM + wc * 32 + 8 * fq;
        f32x4 bv[2][2];
#pragma unroll
        for (int bj = 0; bj < 2; ++bj)
#pragma unroll
            for (int n = 0; n < 2; ++n) bv[bj][n] = *(const f32x4*)(bias + col0 + bj * HALF + 4 * n);
#pragma unroll
        for (int ai = 0; ai < 2; ++ai)
#pragma unroll
            for (int m = 0; m < 4; ++m) { const size_t off = (size_t)(row0 + ai * HALF + m * 16) * 1024 + col0;
#pragma unroll
                for (int bj = 0; bj < 2; ++bj) { const u32x4 zw = *(const u32x4*)(Z + off + bj * HALF);
                    const f32x4 g0 = acc[ai][bj][m][0] + bv[bj][0], g1 = acc[ai][bj][m][1] + bv[bj][1];
                    float z[8]; z[0] = __uint_as_float(zw.x << 16); z[1] = __uint_as_float(zw.x & 0xffff0000u); z[2] = __uint_as_float(zw.y << 16); z[3] = __uint_as_float(zw.y & 0xffff0000u);
                    z[4] = __uint_as_float(zw.z << 16); z[5] = __uint_as_float(zw.z & 0xffff0000u); z[6] = __uint_as_float(zw.w << 16); z[7] = __uint_as_float(zw.w & 0xffff0000u);
                    float o[8];
#pragma unroll
                    for (int j = 0; j < 4; ++j) { o[j] = z[j] / (1.0f + __expf(-g0[j])); o[4 + j] = z[4 + j] / (1.0f + __expf(-g1[j])); }
                    u32x4 w; w.x = cvt_pk_bf16(o[0], o[1]); w.y = cvt_pk_bf16(o[2], o[3]); w.z = cvt_pk_bf16(o[4], o[5]); w.w = cvt_pk_bf16(o[6], o[7]);
                    *(u32x4*)(O + off + bj * HALF) = w; } }
    }
};
typedef unsigned u32x2 __attribute__((ext_vector_type(2)));
struct EpiFfn {
    static constexpr bool PERM = true, AFTER_DRAIN = false;
    bf16_t* ACT; const float* fw; PG8_LAS float* xch;
    static __device__ __forceinline__ float ror8(float v) { return __builtin_bit_cast(float, __builtin_amdgcn_mov_dpp(__builtin_bit_cast(int, v), 0x128  , 0xf, 0xf, true)); }
    static __device__ __forceinline__ f32x4 shx8(const f32x4 v) { f32x4 r; r[0] = ror8(v[0]); r[1] = ror8(v[1]); r[2] = ror8(v[2]); r[3] = ror8(v[3]); return r; }
    static __device__ __forceinline__ f32x4 shl(const f32x4 v, int src) { f32x4 r; r[0] = __shfl(v[0], src); r[1] = __shfl(v[1], src); r[2] = __shfl(v[2], src); r[3] = __shfl(v[3], src); return r; }
    static __device__ __forceinline__ f32x4 sel(bool c, const f32x4 a, const f32x4 b) { f32x4 r; r[0] = c ? a[0] : b[0]; r[1] = c ? a[1] : b[1]; r[2] = c ? a[2] : b[2]; r[3] = c ? a[3] : b[3]; return r; }
    __device__ __forceinline__ void operator()(const f32x4 (&acc)[2][2][4][2], const Unit& u, int wr, int wc, int fr, int fq) const {
        const bool ctx = u.pm < 16, h = (fr >> 3) != 0;
        const int c7 = fr & 7, lane = fq * 16 + fr, ch0 = u.pn * 128 + wc * 32 + 8 * fq;
        const f32x4 zero = {0.f, 0.f, 0.f, 0.f};
        f32x4 wa[2][3], wg[2][3];
#pragma unroll
        for (int k = 0; k < 3; ++k) { wa[0][k] = *(const f32x4*)(fw + k * (2 * 5632) + ch0); wg[0][k] = *(const f32x4*)(fw + k * (2 * 5632) + 5632 + ch0); }
        if (ctx) {
            if (wr == 0 && fr == 15) { PG8_LAS f32x4* p = (PG8_LAS f32x4*)(xch + ((wc * 2 + 0) * 4 + fq) * 16); p[0] = acc[1][0][3][0]; p[1] = acc[1][0][3][1]; p[2] = acc[1][1][3][0]; p[3] = acc[1][1][3][1]; }
            if (wr == 1 && fr == 0)  { PG8_LAS f32x4* p = (PG8_LAS f32x4*)(xch + ((wc * 2 + 1) * 4 + fq) * 16); p[0] = acc[0][0][0][0]; p[1] = acc[0][0][0][1]; p[2] = acc[0][1][0][0]; p[3] = acc[0][1][0][1]; }
            asm volatile("s_waitcnt lgkmcnt(0)" ::: "memory"); __builtin_amdgcn_s_barrier(); asm volatile("" ::: "memory");
        }
        const int srcp = (lane + 7) & 63, srcn = (lane - 7) & 63;
        u32x2 keep[8];
#pragma unroll
        for (int n = 0; n < 2; ++n) {
            f32x4 bpa = shl(acc[1][0][3][n], srcp), bpg = shl(acc[1][1][3][n], srcp), bna = shl(acc[0][0][0][n], srcn), bng = shl(acc[0][1][0][n], srcn);
            if (ctx) {
                const PG8_LAS f32x4* p0 = (const PG8_LAS f32x4*)(xch + ((wc * 2 + 0) * 4 + fq) * 16); const PG8_LAS f32x4* p1 = (const PG8_LAS f32x4*)(xch + ((wc * 2 + 1) * 4 + fq) * 16);
                const f32x4 xpa = p0[n], xpg = p0[2 + n], xna = p1[n], xng = p1[2 + n];
                bpa = sel(c7 >= 1, bpa, sel(wr == 1, xpa, zero)); bpg = sel(c7 >= 1, bpg, sel(wr == 1, xpg, zero));
                bna = sel(c7 <= 6, bna, sel(wr == 0, xna, zero)); bng = sel(c7 <= 6, bng, sel(wr == 0, xng, zero));
            } else { bpa = zero; bpg = zero; bna = zero; bng = zero; }
            if (n == 0) {
#pragma unroll
                for (int k = 0; k < 3; ++k) { wa[1][k] = *(const f32x4*)(fw + k * (2 * 5632) + ch0 + 4); wg[1][k] = *(const f32x4*)(fw + k * (2 * 5632) + 5632 + ch0 + 4); }
            }
            f32x4 ea0 = shx8(acc[0][0][0][n]), eg0 = shx8(acc[0][1][0][n]);
            f32x4 pa = sel(h, ea0, bpa), pg = sel(h, eg0, bpg);
#pragma unroll
            for (int s = 0; s < 8; ++s) { const int ai = s >> 2, m = s & 3;
                const f32x4 eap = s < 7 ? shx8(acc[(s + 1) >> 2][0][(s + 1) & 3][n]) : bna, egp = s < 7 ? shx8(acc[(s + 1) >> 2][1][(s + 1) & 3][n]) : bng;
                const f32x4 xa = acc[ai][0][m][n], xg = acc[ai][1][m][n];
                const f32x4 na = sel(h, eap, ea0), ng = sel(h, egp, eg0);
                const f32x4 ca = wa[n][0] * pa + wa[n][1] * xa + wa[n][2] * na, cg = wg[n][0] * pg + wg[n][1] * xg + wg[n][2] * ng;
                const f32x4 t = cg * ca, ex = cg * (-1.442695041f);
                f32x4 den; den[0] = __builtin_amdgcn_exp2f(ex[0]); den[1] = __builtin_amdgcn_exp2f(ex[1]); den[2] = __builtin_amdgcn_exp2f(ex[2]); den[3] = __builtin_amdgcn_exp2f(ex[3]);
                den = den + 1.0f;
                f32x4 rc; rc[0] = __builtin_amdgcn_rcpf(den[0]); rc[1] = __builtin_amdgcn_rcpf(den[1]); rc[2] = __builtin_amdgcn_rcpf(den[2]); rc[3] = __builtin_amdgcn_rcpf(den[3]);
                const f32x4 o = t * rc;
                u32x2 w; w.x = cvt_pk_bf16(o[0], o[1]); w.y = cvt_pk_bf16(o[2], o[3]);
                if (n == 0) keep[s] = w;
                else { u32x4 w4; w4.x = keep[s].x; w4.y = keep[s].y; w4.z = w.x; w4.w = w.y; *(u32x4*)(ACT + (size_t)(u.pm * BM + ai * HALF + wr * 64 + m * 16 + fr) * 5632 + ch0) = w4; }
                pa = na; pg = ng; ea0 = eap; eg0 = egp;
            }
        }
    }
};
struct G4Order {
    int lo, hi, G, c; bool plain;
    __device__ __forceinline__ bool next(int i, Unit& u) const {
        const int L = lo + i * G + c; if (L >= hi) return false;
        StaticOrder so; so.init(24 * BM, 44 * BM, 1, 0);
        if (plain) return so.next(L, u);
        if (L >= 1024) { u.pm = 23; u.pn = 12 + (L - 1024); return true; }
        so.next(L, u); if (u.pm == 23 && u.pn >= 12) so.next(1024 + u.pn - 12, u);
        return true;
    }
    __device__ __forceinline__ void a_ready(const Unit&) const {}
    __device__ __forceinline__ void done(const Unit&) const {}
};
struct G5Order {
    bool st; StaticOrder so; Unit u0;
    __device__ __forceinline__ bool next(int i, Unit& u) const { if (st) return so.next(i, u); if (i != 0 || u0.pm < 0) return false; u = u0; return true; }
    __device__ __forceinline__ void a_ready(const Unit&) const {}
    __device__ __forceinline__ void done(const Unit&) const {}
};
}

__device__ __forceinline__ void cvt_load(const float* __restrict__ W, int N, int k0, int n0, int tid, f32x4 (&r0)[4], f32x4 (&r1)[4]) {
    const int n4 = tid & 31, kp = tid >> 5;
#pragma unroll
    for (int i = 0; i < 4; ++i) { const float* p = W + (size_t)(k0 + 2 * kp + 32 * i) * N + n0 + 4 * n4; r0[i] = __builtin_nontemporal_load((const f32x4*)p); r1[i] = __builtin_nontemporal_load((const f32x4*)(p + N)); }
}
__device__ __forceinline__ void cvt_put(LAS unsigned* T, int tid, const f32x4 (&r0)[4], const f32x4 (&r1)[4]) {
    const int n4 = tid & 31, kp = tid >> 5;
#pragma unroll
    for (int i = 0; i < 4; ++i)
#pragma unroll
        for (int e = 0; e < 4; ++e) T[(4 * n4 + e) * 65 + kp + 16 * i] = pk2(r0[i][e], r1[i][e]);
}
__device__ __forceinline__ void cvt_store(const LAS unsigned* T, bf16* __restrict__ Bt, int K, int k0, int j0, int tid) {
    const int n = tid >> 2, kc = tid & 3;
    unsigned w[16];
#pragma unroll
    for (int i = 0; i < 16; ++i) w[i] = T[n * 65 + 16 * kc + i];
    v4u* dst = (v4u*)(Bt + (size_t)(j0 + n) * K + k0 + 32 * kc);
#pragma unroll
    for (int q = 0; q < 4; ++q) { v4u o; o.x = w[4 * q]; o.y = w[4 * q + 1]; o.z = w[4 * q + 2]; o.w = w[4 * q + 3]; dst[q] = o; }
}
constexpr int CVT_PER_LAYER = 512 + 64 + 256 + 1408 + 704;
struct CvtD { const float* W; bf16* Bt; int N, K, k0, n0, j0; };
__device__ __forceinline__ CvtD cvt_desc(const DArgs& a, int it) {
    const int l = it / CVT_PER_LAYER; int r = it % CVT_PER_LAYER;
    const float* W; bf16* Bt; int N, K, jb, kb, n0;
    if (r < 512) { N = INC; K = DM; W = a.in[I_WIN] + (size_t)l * K * N; Bt = (bf16*)(a.ws + WS_WIN) + (size_t)l * N * K; kb = r >> 5; jb = r & 31;
        const int pn = jb >> 1, bj = jb & 1; n0 = pn < 8 ? ((bj ? 2048 : 1024) + 128 * pn) : ((bj ? 3072 : 0) + 128 * (pn - 8)); }
    else if (r < 576) { r -= 512; N = SW; K = SW; W = a.in[I_WGLU] + (size_t)l * K * N; Bt = (bf16*)(a.ws + WS_WGLU) + (size_t)l * N * K; kb = r >> 3; jb = r & 7; n0 = 128 * jb; }
    else if (r < 832) { r -= 576; N = DM; K = DM; W = a.in[I_WOUT] + (size_t)l * K * N; Bt = (bf16*)(a.ws + WS_WOUT) + (size_t)l * N * K; kb = r >> 4; jb = r & 15; n0 = 128 * jb; }
    else if (r < 2240) { r -= 832; N = UPN; K = DM; W = a.in[I_WUP] + (size_t)l * K * N; Bt = (bf16*)(a.ws + WS_WUP) + (size_t)l * N * K; kb = r / 88; jb = r % 88; n0 = ((jb & 1) ? DFF : 0) + 128 * (jb >> 1); }
    else { r -= 2240; N = DM; K = DFF; W = a.in[I_WDOWN] + (size_t)l * K * N; Bt = (bf16*)(a.ws + WS_WDN) + (size_t)l * N * K; kb = r >> 4; jb = r & 15; n0 = 128 * jb; }
    CvtD d; d.W = W; d.Bt = Bt; d.N = N; d.K = K; d.k0 = 128 * kb; d.n0 = n0; d.j0 = 128 * jb; return d;
}

constexpr int CW_CVT = 8192;
#define CVT_LDS_BAR() asm volatile("s_waitcnt lgkmcnt(0)\n\ts_barrier" ::: "memory")
__device__ __forceinline__ void cvt_fill(LAS unsigned char* lds, int tid_, int ln, int budget  ) {
    const int tid = fresh_v(tid_);
    volatile LAS unsigned* tk = (volatile LAS unsigned*)(lds + MISC_OFF) + 16;
    LAS unsigned* T0 = (LAS unsigned*)lds; LAS unsigned* T1 = T0 + 128 * 65;
    const int npairs = budget < 0 ? 0x7fffffff : (budget + 1) / 2;
    if (npairs <= 0) return;
    if (tid == 0) { const DArgs a = load_args(); tk[0] = __hip_atomic_fetch_add((unsigned*)(a.ws + WS_CTL) + CW_CVT + 64 * ln, 1u, __ATOMIC_RELAXED, __HIP_MEMORY_SCOPE_AGENT); }
    __syncthreads();
    for (int n = 0; n < npairs; ++n) {
        const unsigned t = tk[n & 1];
        if (2u * t >= (unsigned)CVT_PER_LAYER) break;
        const DArgs a = load_args();
        unsigned nx = 0xffffffffu;
        if (tid == 0 && n + 1 < npairs) nx = __hip_atomic_fetch_add((unsigned*)(a.ws + WS_CTL) + CW_CVT + 64 * ln, 1u, __ATOMIC_RELAXED, __HIP_MEMORY_SCOPE_AGENT);
        const CvtD d0 = cvt_desc(a, ln * CVT_PER_LAYER + 2 * (int)t), d1 = cvt_desc(a, ln * CVT_PER_LAYER + 2 * (int)t + 1);
        f32x4 a0[4], a1[4], b0[4], b1[4];
        cvt_load(d0.W, d0.N, d0.k0, d0.n0, tid, a0, a1); cvt_load(d1.W, d1.N, d1.k0, d1.n0, tid, b0, b1);
        cvt_put(T0, tid, a0, a1); cvt_put(T1, tid, b0, b1);
        if (tid == 0) tk[(n + 1) & 1] = nx;
        CVT_LDS_BAR();
        cvt_store(T0, d0.Bt, d0.K, d0.k0, d0.j0, tid); cvt_store(T1, d1.Bt, d1.K, d1.k0, d1.j0, tid);
        CVT_LDS_BAR();
    }
    __syncthreads();
}
__device__ __forceinline__ void mod_task(LAS unsigned char* lds, int tid_, int lane_, int wave_, int task) {
    const DArgs a = load_args(); const int tid = fresh_v(tid_), lane = fresh_v(lane_), wave = fresh_s(wave_);
    LAS float* SC = (LAS float*)(lds + 36864);
    LAS float* RED = (LAS float*)(lds + 36864 + 24576);
    const int l = task / 48, j0 = (task % 48) * 256;
    for (int i = tid; i < 3 * DM; i += 512) { const int v = i >> 11, k = i & 2047; const float x = v == 0 ? a.in[I_CCTX][k] : a.in[I_C][(v - 1) * DM + k]; SC[i] = x / (1.0f + __expf(-x)); }
    __syncthreads();
    const float* W = a.in[I_WADA] + (size_t)l * DM * 12288 + j0 + 4 * lane;
    f32x4 a0 = {0.f, 0.f, 0.f, 0.f}, a1 = a0, a2 = a0;
    const int kbeg = wave * 256;
    for (int k = kbeg; k < kbeg + 256; k += 8) {
        f32x4 w[8];
#pragma unroll
        for (int u = 0; u < 8; ++u) w[u] = __builtin_nontemporal_load((const f32x4*)(W + (size_t)(k + u) * 12288));
#pragma unroll
        for (int u = 0; u < 8; ++u) { const float s0 = SC[k + u], s1 = SC[2048 + k + u], s2 = SC[4096 + k + u]; a0 += w[u] * s0; a1 += w[u] * s1; a2 += w[u] * s2; }
    }
    *(LAS f32x4*)(RED + (wave * 3 + 0) * 256 + 4 * lane) = a0;
    *(LAS f32x4*)(RED + (wave * 3 + 1) * 256 + 4 * lane) = a1;
    *(LAS f32x4*)(RED + (wave * 3 + 2) * 256 + 4 * lane) = a2;
    __syncthreads();
    float* MOD = (float*)(a.ws + WS_MOD);
    for (int i = tid; i < 768; i += 512) { const int v = i >> 8, jj = i & 255; float s = a.in[I_BADA][l * 12288 + j0 + jj];
#pragma unroll
        for (int w8 = 0; w8 < 8; ++w8) s += RED[(w8 * 3 + v) * 256 + jj];
        const int ch = (j0 + jj) >> 11, e = (j0 + jj) & 2047;
        if (ch == 1) s = (1.0f + s) * a.in[I_GPRE1][l * DM + e]; else if (ch == 2) s *= a.in[I_GPOST1][l * DM + e];
        else if (ch == 4) s = (1.0f + s) * a.in[I_GPRE2][l * DM + e]; else if (ch == 5) s *= a.in[I_GPOST2][l * DM + e];
        MOD[(size_t)(l * 3 + v) * 12288 + j0 + jj] = s; }
    __syncthreads();
}

__device__ __forceinline__ void mod_task64(LAS unsigned char* lds, int tid_, int lane_, int wave_, int l, int task) {
    const DArgs a = load_args(); const int tid = fresh_v(tid_), lane = fresh_v(lane_), wave = fresh_s(wave_);
    LAS float* SC = (LAS float*)(lds + 36864);
    LAS float* RED = (LAS float*)(lds + 36864 + 24576);
    const int j0 = task * 64, c4 = lane & 15, rsub = lane >> 4;
    for (int i = tid; i < 3 * DM; i += 512) { const int v = i >> 11, k = i & 2047; const float x = v == 0 ? a.in[I_CCTX][k] : a.in[I_C][(v - 1) * DM + k]; SC[i] = x / (1.0f + __expf(-x)); }
    __syncthreads();
    const float* W = a.in[I_WADA] + (size_t)l * DM * 12288 + j0 + 4 * c4;
    f32x4 a0 = {0.f, 0.f, 0.f, 0.f}, a1 = a0, a2 = a0;
    const int kbeg = wave * 256;
    for (int k = kbeg; k < kbeg + 256; k += 32) {
        f32x4 w[8];
#pragma unroll
        for (int u = 0; u < 8; ++u) w[u] = __builtin_nontemporal_load((const f32x4*)(W + (size_t)(k + 4 * u + rsub) * 12288));
#pragma unroll
        for (int u = 0; u < 8; ++u) { const int kk = k + 4 * u + rsub; const float s0 = SC[kk], s1 = SC[2048 + kk], s2 = SC[4096 + kk]; a0 += w[u] * s0; a1 += w[u] * s1; a2 += w[u] * s2; }
    }
#pragma unroll
    for (int i = 0; i < 4; ++i) { a0[i] += __shfl_xor(a0[i], 16); a0[i] += __shfl_xor(a0[i], 32); a1[i] += __shfl_xor(a1[i], 16); a1[i] += __shfl_xor(a1[i], 32); a2[i] += __shfl_xor(a2[i], 16); a2[i] += __shfl_xor(a2[i], 32); }
    if (rsub == 0) { *(LAS f32x4*)(RED + (wave * 3 + 0) * 64 + 4 * c4) = a0; *(LAS f32x4*)(RED + (wave * 3 + 1) * 64 + 4 * c4) = a1; *(LAS f32x4*)(RED + (wave * 3 + 2) * 64 + 4 * c4) = a2; }
    __syncthreads();
    float* MOD = (float*)(a.ws + WS_MOD);
    if (tid < 192) { const int v = tid >> 6, jj = tid & 63; float s = a.in[I_BADA][l * 12288 + j0 + jj];
#pragma unroll
        for (int w8 = 0; w8 < 8; ++w8) s += RED[(w8 * 3 + v) * 64 + jj];
        const int ch = (j0 + jj) >> 11, e = (j0 + jj) & 2047;
        if (ch == 1) s = (1.0f + s) * a.in[I_GPRE1][l * DM + e]; else if (ch == 2) s *= a.in[I_GPOST1][l * DM + e];
        else if (ch == 4) s = (1.0f + s) * a.in[I_GPRE2][l * DM + e]; else if (ch == 5) s *= a.in[I_GPOST2][l * DM + e];
        MOD[(size_t)(l * 3 + v) * 12288 + j0 + jj] = s; }
    __syncthreads();
}

__device__ __forceinline__ int mod_vec(int row) { return row < NCTX ? 0 : 1 + ((row - NCTX) >> 10); }
__device__ __forceinline__ int perm_row(int row) {
    int gr, cc, base;
    if (row < NCTX) { const int t = row & 255; gr = t & 15; cc = t >> 4; base = row & ~255; }
    else { const int q = row - NCTX, p = q & 1023; gr = p >> 6; cc = p & 15; base = NCTX + ((q >> 10) * 4 + ((p >> 4) & 3)) * 256; }
    return base + 128 * (gr >> 3) + 64 * (cc >> 3) + 16 * ((gr >> 1) & 3) + 8 * (gr & 1) + (cc & 7);
}
constexpr size_t WS_XH = WS_UP + 8 * MiB, WS_XL = WS_UP + 40 * MiB;
__device__ __forceinline__ void x24_load(const unsigned char* ws, int row, int e0, float (&o)[8]) {
    const v4u h = __builtin_nontemporal_load((const v4u*)((const unsigned short*)(ws + WS_XH) + (size_t)row * DM + e0)); const v2u lo = __builtin_nontemporal_load((const v2u*)(ws + WS_XL + (size_t)row * DM + e0));
    const unsigned hw[4] = {h.x, h.y, h.z, h.w}, lw[2] = {lo.x, lo.y};
#pragma unroll
    for (int i = 0; i < 8; ++i) { const unsigned hi = (i & 1) ? (hw[i >> 1] & 0xffff0000u) : (hw[i >> 1] << 16); const unsigned l8 = (lw[i >> 2] >> (8 * (i & 3))) & 0xffu; o[i] = __uint_as_float(hi | (l8 << 8)); }
}
__device__ __forceinline__ void x24_store(unsigned char* ws, int row, int e0, const float (&x)[8]) {
    unsigned b[8];
#pragma unroll
    for (int i = 0; i < 8; ++i) b[i] = __float_as_uint(x[i]) + 0x80u;
    v4u h; h.x = (b[0] >> 16) | (b[1] & 0xffff0000u); h.y = (b[2] >> 16) | (b[3] & 0xffff0000u); h.z = (b[4] >> 16) | (b[5] & 0xffff0000u); h.w = (b[6] >> 16) | (b[7] & 0xffff0000u);
    v2u lo; lo.x = ((b[0] >> 8) & 0xffu) | (b[1] & 0xff00u) | ((b[2] << 8) & 0xff0000u) | ((b[3] << 16) & 0xff000000u); lo.y = ((b[4] >> 8) & 0xffu) | (b[5] & 0xff00u) | ((b[6] << 8) & 0xff0000u) | ((b[7] << 16) & 0xff000000u);
    __builtin_nontemporal_store(h, (v4u*)((unsigned short*)(ws + WS_XH) + (size_t)row * DM + e0)); __builtin_nontemporal_store(lo, (v2u*)(ws + WS_XL + (size_t)row * DM + e0));
}
template <int MODE>
__device__ __forceinline__ void row_pass(int l, int bx_, int G_, int wave_, int lane_, bool split23 = false) {
    const int bx = fresh_s(bx_), G = fresh_s(G_), wave = fresh_s(wave_), lane = fresh_v(lane_);
    constexpr bool FIRST = (MODE == 0), HAS_NEXT = (MODE != 3);
    const DArgs a = load_args();
    const float* MOD = (const float*)(a.ws + WS_MOD);
    const float* modl = MOD + (size_t)l * 3 * 12288;
    const bf16* Y = (const bf16*)(a.ws + (MODE == 1 ? WS_MIXED : WS_FF));
    const float* modg = modl + (MODE == 1 ? 2 : 5) * DM;
    const float* modn = MODE == 2 ? modl + 3 * 12288 : modl;
    const int sc_off = (MODE == 1 ? 4 : 1) * DM, sh_off = (MODE == 1 ? 3 : 0) * DM;
    bf16* Hdst = (bf16*)(a.ws + WS_H);
    const int rpw = (NTOK + G * NWAVES - 1) / (G * NWAVES), rbeg = (bx * NWAVES + wave) * rpw, rend = rbeg + rpw < NTOK ? rbeg + rpw : NTOK;
    int vprev = -1;
    f32x4 gv[8], cv[8], hv[8];
#pragma unroll
    for (int j = 0; j < 8; ++j) { gv[j] = (f32x4){0.f, 0.f, 0.f, 0.f}; cv[j] = gv[j]; hv[j] = gv[j]; }
    for (int row = rbeg; row < rend; ++row) {
        const int v = mod_vec(row);
        if (v != vprev) { vprev = v;
#pragma unroll
            for (int j = 0; j < 4; ++j) { const int e0 = 8 * lane + 512 * j;
                if (!FIRST) { const float* gate = modg + (size_t)v * 12288; gv[2 * j] = *(const f32x4*)(gate + e0); gv[2 * j + 1] = *(const f32x4*)(gate + e0 + 4); }
                if (HAS_NEXT) { const float* sc = modn + (size_t)v * 12288 + sc_off; const float* sh = modn + (size_t)v * 12288 + sh_off;
                    cv[2 * j] = *(const f32x4*)(sc + e0); cv[2 * j + 1] = *(const f32x4*)(sc + e0 + 4); hv[2 * j] = *(const f32x4*)(sh + e0); hv[2 * j + 1] = *(const f32x4*)(sh + e0 + 4); } } }
        float* xr = a.out + (size_t)row * DM;
        float x[32];
        if (FIRST) {
            const float* src = row < NCTX ? a.in[I_XP] + (size_t)row * DM : a.in[I_XS] + (size_t)(row - NCTX) * DM;
#pragma unroll
            for (int j = 0; j < 4; ++j) { const f32x4 p = __builtin_nontemporal_load((const f32x4*)(src + 8 * lane + 512 * j)), q = __builtin_nontemporal_load((const f32x4*)(src + 8 * lane + 512 * j + 4));
                x[8 * j] = p[0]; x[8 * j + 1] = p[1]; x[8 * j + 2] = p[2]; x[8 * j + 3] = p[3]; x[8 * j + 4] = q[0]; x[8 * j + 5] = q[1]; x[8 * j + 6] = q[2]; x[8 * j + 7] = q[3];
                const float t8[8] = {p[0], p[1], p[2], p[3], q[0], q[1], q[2], q[3]}; x24_store(a.ws, row, 8 * lane + 512 * j, t8); }
        } else {
            float y[32]; float ssq = 0.f;
            const int pr = MODE == 1 ? row : perm_row(row);
            const bool sp23 = MODE != 1 && split23 && pr >= 23 * 256;
            const bf16* yr = sp23 ? (const bf16*)(a.ws + WS_FFP) + (size_t)(pr - 23 * 256) * DM : Y + (size_t)pr * DM;
#pragma unroll
            for (int j = 0; j < 4; ++j) { const v4u w = __builtin_nontemporal_load((const v4u*)(yr + 8 * lane + 512 * j)); float t[8]; unpack8(w, t);
                if (sp23) {
#pragma unroll
                    for (int sp = 1; sp < 4; ++sp) { float t2[8]; unpack8(*(const v4u*)(yr + (size_t)sp * 256 * DM + 8 * lane + 512 * j), t2);
#pragma unroll
                        for (int i = 0; i < 8; ++i) t[i] += t2[i]; } }
#pragma unroll
                for (int i = 0; i < 8; ++i) { y[8 * j + i] = t[i]; ssq += t[i] * t[i]; } }
            ssq = wave_sum(ssq);
            const float rs = 1.0f / sqrtf(ssq * (1.0f / DM) + EPS);
#pragma unroll
            for (int j = 0; j < 4; ++j) { const int e0 = 8 * lane + 512 * j;
                float xo[8]; x24_load(a.ws, row, e0, xo);
                const f32x4 g0 = gv[2 * j], g1 = gv[2 * j + 1];
                f32x4 np, nq;
#pragma unroll
                for (int i = 0; i < 4; ++i) { np[i] = xo[i] + g0[i] * (y[8 * j + i] * rs); nq[i] = xo[4 + i] + g1[i] * (y[8 * j + 4 + i] * rs); x[8 * j + i] = np[i]; x[8 * j + 4 + i] = nq[i]; }
                if (MODE == 3) { __builtin_nontemporal_store(np, (f32x4*)(xr + e0)); __builtin_nontemporal_store(nq, (f32x4*)(xr + e0 + 4)); }
                else { const float t8[8] = {np[0], np[1], np[2], np[3], nq[0], nq[1], nq[2], nq[3]}; x24_store(a.ws, row, e0, t8); } }
        }
        if (HAS_NEXT) {
            float ssq = 0.f;
#pragma unroll
            for (int i = 0; i < 32; ++i) ssq += x[i] * x[i];
            ssq = wave_sum(ssq);
            const float rs = 1.0f / sqrtf(ssq * (1.0f / DM) + EPS);
            bf16* hr = Hdst + (size_t)(MODE == 1 ? perm_row(row) : row) * DM;
#pragma unroll
            for (int j = 0; j < 4; ++j) { const int e0 = 8 * lane + 512 * j;
                const f32x4 c0 = cv[2 * j], c1 = cv[2 * j + 1], h0 = hv[2 * j], h1 = hv[2 * j + 1];
                float o[8];
#pragma unroll
                for (int i = 0; i < 4; ++i) { o[i] = x[8 * j + i] * rs * c0[i] + h0[i]; o[4 + i] = x[8 * j + 4 + i] * rs * c1[i] + h1[i]; }
                *(v4u*)(hr + e0) = pack8(o); }
        }
    }
}

__device__ __forceinline__ void mix_pass(int bx_, int G_, int wave_, int lane_, int l) {
    const DArgs a = load_args(); const int bx = fresh_s(bx_), G = fresh_s(G_), wave = fresh_s(wave_), lane = fresh_v(lane_);
    const bf16* GB = (const bf16*)(a.ws + WS_GB); const bf16* V = (const bf16*)(a.ws + WS_V); const bf16* O = (const bf16*)(a.ws + WS_O); bf16* MX = (bf16*)(a.ws + WS_MIXIN);
    const float* cw = a.in[I_CONVW] + (size_t)l * 3 * CW; const float* gc = a.in[I_GCONV] + (size_t)l * CW; const float* gs = a.in[I_GSSM] + (size_t)l * SW;
    float w0r[16], w1r[16], w2r[16], gcr[16], gsr[16];
#pragma unroll
    for (int j = 0; j < 2; ++j) { const int c0 = 8 * lane + 512 * j;
#pragma unroll
        for (int hq = 0; hq < 2; ++hq) { const f32x4 t0 = *(const f32x4*)(cw + c0 + 4 * hq), t1 = *(const f32x4*)(cw + CW + c0 + 4 * hq), t2 = *(const f32x4*)(cw + 2 * CW + c0 + 4 * hq),
                                               t3 = *(const f32x4*)(gc + c0 + 4 * hq), t4 = *(const f32x4*)(gs + c0 + 4 * hq);
#pragma unroll
            for (int i = 0; i < 4; ++i) { w0r[8 * j + 4 * hq + i] = t0[i]; w1r[8 * j + 4 * hq + i] = t1[i]; w2r[8 * j + 4 * hq + i] = t2[i]; gcr[8 * j + 4 * hq + i] = t3[i]; gsr[8 * j + 4 * hq + i] = t4[i]; } } }
    const int rpw = (NTOK + G * NWAVES - 1) / (G * NWAVES), rbeg = (bx * NWAVES + wave) * rpw, rend = rbeg + rpw < NTOK ? rbeg + rpw : NTOK;
    for (int row = rbeg; row < rend; ++row) {
        bool hp, hn;
        if (row < NCTX) { const int t = row & 255; hp = t > 0; hn = t < 255; } else { const int c = (row - NCTX) & 63; hp = c > 0; hn = c < 63; }
#pragma unroll
        for (int j = 0; j < 2; ++j) { const int c0 = 8 * lane + 512 * j; const size_t off = (size_t)row * CW + c0;
            float vc[8], vp[8], vn[8], gb[8];
            unpack8(*(const v4u*)(V + off), vc); unpack8(__builtin_nontemporal_load((const v4u*)(GB + off)), gb);
            if (hp) unpack8(*(const v4u*)(V + off - CW), vp); else {
#pragma unroll
                for (int i = 0; i < 8; ++i) vp[i] = 0.f; }
            if (hn) unpack8(*(const v4u*)(V + off + CW), vn); else {
#pragma unroll
                for (int i = 0; i < 8; ++i) vn[i] = 0.f; }
            float o[8]; float ssq = 0.f;
#pragma unroll
            for (int i = 0; i < 8; ++i) { o[i] = gb[i] * (w0r[8 * j + i] * vp[i] + w1r[8 * j + i] * vc[i] + w2r[8 * j + i] * vn[i]); ssq += o[i] * o[i]; }
            ssq += __shfl_xor(ssq, 1); ssq += __shfl_xor(ssq, 2); ssq += __shfl_xor(ssq, 4);
            const float rs = 1.0f / sqrtf(ssq * (1.0f / 64.0f) + EPS);
#pragma unroll
            for (int i = 0; i < 8; ++i) o[i] = o[i] * rs * gcr[8 * j + i];
            *(v4u*)(MX + (size_t)row * DM + c0) = pack8(o); }
        float s[16]; float ssq = 0.f;
#pragma unroll
        for (int j = 0; j < 2; ++j) { float t[8]; unpack8(__builtin_nontemporal_load((const v4u*)(O + (size_t)row * SW + 8 * lane + 512 * j)), t);
#pragma unroll
            for (int i = 0; i < 8; ++i) { s[8 * j + i] = t[i]; ssq += t[i] * t[i]; } }
        ssq = wave_sum(ssq);
        const float rs = 1.0f / sqrtf(ssq * (1.0f / SW) + EPS);
#pragma unroll
        for (int j = 0; j < 2; ++j) { const int c0 = 8 * lane + 512 * j; float o[8];
#pragma unroll
            for (int i = 0; i < 8; ++i) o[i] = s[8 * j + i] * rs * gsr[8 * j + i];
            *(v4u*)(MX + (size_t)row * DM + CW + c0) = pack8(o); }
    }
}

struct S5C { bf16x8 Bf[2][4]; float ar[2][2], ai[2][2]; };
__device__ __forceinline__ void s5_setup(const DArgs& a, LAS unsigned char* lds, int lane, int wave, int l, int g, S5C& c) {
    const int n = lane & 31, hf = lane >> 5, tq = lane & 15, q = lane >> 4;
    LAS unsigned char* CFB = lds + 135168;
    LAS float* A16 = (LAS float*)(lds + 143360);
#pragma unroll
    for (int d = 0; d < 2; ++d) {
        const int pg = (l * 2 + d) * 64 + g;
        const float dt = expf(a.in[I_LOGDT][pg]);
#pragma unroll
        for (int s = 0; s < 2; ++s) { const int nn = n + 32 * s;
            const float are = a.in[I_ARE][pg * 64 + nn], aim = a.in[I_AIM][pg * 64 + nn];
            const float er = expf(are * dt); float sn, cs; sincos_cw(aim * dt, sn, cs);
            const float abr = er * cs, abi = er * sn; c.ar[d][s] = abr; c.ai[d][s] = abi;
            if (wave == 0 && hf == 0) { const float e16 = expf(16.0f * are * dt); float s16, c16; sincos_cw(16.0f * aim * dt, s16, c16); *(LAS f32x2*)(A16 + (d * 64 + nn) * 2) = (f32x2){e16 * c16, e16 * s16}; }
            const float inv = 1.0f / (are * are + aim * aim);
            const float cr = ((abr - 1.0f) * are + abi * aim) * inv, ci = (abi * are - (abr - 1.0f) * aim) * inv;
            const float* brp = a.in[I_BRE] + (unsigned)((pg * 64 + nn) * 16 + 8 * hf); const float* bip = a.in[I_BIM] + (unsigned)((pg * 64 + nn) * 16 + 8 * hf);
            const f32x4 br0 = *(const f32x4*)brp, br1 = *(const f32x4*)(brp + 4), bi0 = *(const f32x4*)bip, bi1 = *(const f32x4*)(bip + 4);
            v4u wr_, wi_;
            wr_.x = pk2(cr * br0[0] - ci * bi0[0], cr * br0[1] - ci * bi0[1]); wr_.y = pk2(cr * br0[2] - ci * bi0[2], cr * br0[3] - ci * bi0[3]);
            wr_.z = pk2(cr * br1[0] - ci * bi1[0], cr * br1[1] - ci * bi1[1]); wr_.w = pk2(cr * br1[2] - ci * bi1[2], cr * br1[3] - ci * bi1[3]);
            wi_.x = pk2(cr * bi0[0] + ci * br0[0], cr * bi0[1] + ci * br0[1]); wi_.y = pk2(cr * bi0[2] + ci * br0[2], cr * bi0[3] + ci * br0[3]);
            wi_.z = pk2(cr * bi1[0] + ci * br1[0], cr * bi1[1] + ci * br1[1]); wi_.w = pk2(cr * bi1[2] + ci * br1[2], cr * bi1[3] + ci * br1[3]);
            c.Bf[d][2 * s] = __builtin_bit_cast(bf16x8, wr_); c.Bf[d][2 * s + 1] = __builtin_bit_cast(bf16x8, wi_); }
        if (wave == 0) {
            const float* crp = a.in[I_CRE] + (unsigned)((pg * 16 + tq) * 64); const float* cip = a.in[I_CIM] + (unsigned)((pg * 16 + tq) * 64);
#pragma unroll
            for (int ks = 0; ks < 4; ++ks) { const int n0 = 8 * ks + 2 * q;
                const f32x2 cr0 = *(const f32x2*)(crp + n0), cr1 = *(const f32x2*)(crp + n0 + 32), ci0 = *(const f32x2*)(cip + n0), ci1 = *(const f32x2*)(cip + n0 + 32);
                v4u w; w.x = pk2(cr0[0], -ci0[0]); w.y = pk2(cr1[0], -ci1[0]); w.z = pk2(cr0[1], -ci0[1]); w.w = pk2(cr1[1], -ci1[1]);
                *(LAS v4u*)(CFB + ((d * 4 + ks) * 64 + lane) * 16) = w; }
        }
    }
}
__device__ __forceinline__ void s5_task(const DArgs& a, LAS unsigned char* lds, int tid, int lane, int wave, int l, int row0, int NC, int g, int bidx, bool latent, const S5C& cst, bf16x8& Afpre, int next_row0) {
#define S5_BAR() do { asm volatile("s_waitcnt lgkmcnt(0)" ::: "memory"); __builtin_amdgcn_s_barrier(); asm volatile("" ::: "memory"); } while (0)
    const int n = lane & 31, hf = lane >> 5, tq = lane & 15, q = lane >> 4;
    LAS float* EB = (LAS float*)lds;
    LAS unsigned char* SB = lds + 65536 + wave * 8704;
    const bf16* U = (const bf16*)(a.ws + WS_U); bf16* Z = (bf16*)(a.ws + WS_Z);
    LAS unsigned char* CFB = lds + 135168;
    const LAS float* A16 = (const LAS float*)(lds + 143360);
    bf16x8 Bf[2][4]; float ar[2][2], ai[2][2];
#pragma unroll
    for (int d = 0; d < 2; ++d) {
#pragma unroll
        for (int cb = 0; cb < 4; ++cb) Bf[d][cb] = cst.Bf[d][cb];
#pragma unroll
        for (int s2 = 0; s2 < 2; ++s2) { ar[d][s2] = cst.ar[d][s2]; ai[d][s2] = cst.ai[d][s2]; } }
    const f32x16 zero16 = {0.f, 0.f, 0.f, 0.f, 0.f, 0.f, 0.f, 0.f, 0.f, 0.f, 0.f, 0.f, 0.f, 0.f, 0.f, 0.f};
    const int cbit = (n >> 2) & 1, tA = (n >> 3) * 4 + (n & 3);
#define S5_PIN_BU() asm volatile("s_nop 15\n\ts_nop 15\n\ts_nop 15\n\ts_nop 15\n\ts_nop 15\n\ts_nop 15\n\ts_nop 15\n\ts_nop 15\n\ts_nop 15\n\ts_nop 15\n\ts_nop 15\n\ts_nop 15\n\ts_nop 15\n\ts_nop 15\n\ts_nop 15\n\ts_nop 15\n\ts_nop 15\n\ts_nop 15\n\ts_nop 15\n\ts_nop 15" : "+v"(acc[0]), "+v"(acc[1]), "+v"(acc[2]), "+v"(acc[3]) : "v"(Afd), "v"(Bf[d][0]), "v"(Bf[d][1]), "v"(Bf[d][2]), "v"(Bf[d][3]))
    bf16x8 Afk = {0, 0, 0, 0, 0, 0, 0, 0};
    bf16x8 Afn = Afpre;
    for (int item = wave; item < NC / 2; item += NWAVES) { const int c0 = 2 * item;
        const bf16x8 Af = Afn;
        if (item + NWAVES < NC / 2) Afn = *(const bf16x8*)(U + (unsigned)((row0 + (c0 + 2 * NWAVES + cbit) * 16 + tA) * SW + g * 16 + 8 * hf));
        Afk = Af;
#pragma unroll
        for (int d = 0; d < 2; ++d) {
            bf16x8 Afd = Af; asm volatile("" : "+v"(Afd) :: "memory");
            f32x16 acc[4];
#pragma unroll
            for (int cb = 0; cb < 4; ++cb) acc[cb] = __builtin_amdgcn_mfma_f32_32x32x16_bf16(Afd, Bf[d][cb], zero16, 0, 0, 0);
            S5_PIN_BU();
            float s0r = 0.f, s0i = 0.f, s1r = 0.f, s1i = 0.f;
#pragma unroll
            for (int ii = 0; ii < 16; ++ii) { const int i = d == 0 ? ii : 15 - ii;
                const float n0r = fmaf(ar[d][0], s0r, fmaf(-ai[d][0], s0i, acc[0][i])), n0i = fmaf(ar[d][0], s0i, fmaf(ai[d][0], s0r, acc[1][i]));
                const float n1r = fmaf(ar[d][1], s1r, fmaf(-ai[d][1], s1i, acc[2][i])), n1i = fmaf(ar[d][1], s1i, fmaf(ai[d][1], s1r, acc[3][i]));
                s0r = n0r; s0i = n0i; s1r = n1r; s1i = n1i; }
            *(LAS f32x4*)(EB + (d * 64 + c0 + hf) * 128 + 4 * n) = (f32x4){s0r, s0i, s1r, s1i};
            asm volatile("s_waitcnt lgkmcnt(0)" :: "v"(s0r), "v"(s0i), "v"(s1r), "v"(s1i) : "memory");
        }
    }
    S5_BAR();
    if (tid < 128) { const int d = tid >> 6, nn = tid & 63, pos = nn < 32 ? 4 * nn : 4 * (nn - 32) + 2;
        const f32x2 p16 = *(const LAS f32x2*)(A16 + (d * 64 + nn) * 2); const float pr = p16[0], pi = p16[1];
        const unsigned sidx = ((((unsigned)bidx * DEPTH + l) * 2 + d) * 64 + g) * 64 + nn;
        float sr = 0.f, si = 0.f;
        if (latent) { sr = a.in[I_SRE][sidx]; si = a.in[I_SIM][sidx]; }
        for (int cb8 = 0; cb8 < NC; cb8 += 8) {
            f32x2 e[8];
#pragma unroll
            for (int j = 0; j < 8; ++j) { const int c = d == 0 ? cb8 + j : NC - 1 - cb8 - j; e[j] = *(const LAS f32x2*)(EB + (d * 64 + c) * 128 + pos); }
#pragma unroll
            for (int j = 0; j < 8; ++j) { const int c = d == 0 ? cb8 + j : NC - 1 - cb8 - j; const f32x2 sv = {sr, si};
                const float nr = fmaf(pr, sr, fmaf(-pi, si, e[j][0])), ni = fmaf(pr, si, fmaf(pi, sr, e[j][1])); sr = nr; si = ni;
                *(LAS f32x2*)(EB + (d * 64 + c) * 128 + pos) = sv; }
        }
        if (!latent) { float* ns = a.out + (size_t)NTOK * DM; ns[sidx] = sr; ns[524288u + sidx] = si; }
    }
    S5_BAR();
    if (next_row0 >= 0) Afpre = *(const bf16x8*)(U + (unsigned)((next_row0 + (2 * wave + cbit) * 16 + tA) * SW + g * 16 + 8 * hf));
    if (latent) Afn = *(const bf16x8*)(U + (unsigned)((row0 + (2 * wave + cbit) * 16 + tA) * SW + g * 16 + 8 * hf));
    const f32x4 dd = *(const f32x4*)(a.in[I_SSMD] + (unsigned)(l * SW + g * 16 + 4 * q));
    for (int item = wave; item < NC / 2; item += NWAVES) { const int c0 = 2 * item;
        bf16x8 Af = Afk;
        if (latent) { Af = Afn; if (item + NWAVES < NC / 2) Afn = *(const bf16x8*)(U + (unsigned)((row0 + (c0 + 2 * NWAVES + cbit) * 16 + tA) * SW + g * 16 + 8 * hf)); }
        v2u uwv[2];
#pragma unroll
        for (int cc = 0; cc < 2; ++cc) uwv[cc] = *(const v2u*)(U + (unsigned)((row0 + (c0 + cc) * 16 + tq) * SW + g * 16 + 4 * q));
        f32x4 yacc[2] = {{0.f, 0.f, 0.f, 0.f}, {0.f, 0.f, 0.f, 0.f}};
#pragma unroll
        for (int d = 0; d < 2; ++d) {
            bf16x8 Afd = Af; asm volatile("" : "+v"(Afd) :: "memory");
            f32x16 acc[4];
#pragma unroll
            for (int cb = 0; cb < 4; ++cb) acc[cb] = __builtin_amdgcn_mfma_f32_32x32x16_bf16(Afd, Bf[d][cb], zero16, 0, 0, 0);
            S5_PIN_BU();
            const f32x4 s_in = *(const LAS f32x4*)(EB + (d * 64 + c0 + hf) * 128 + 4 * n);
            float s0r = s_in[0], s0i = s_in[1], s1r = s_in[2], s1i = s_in[3];
            v2u w[16];
#pragma unroll
            for (int ii = 0; ii < 16; ++ii) { const int i = d == 0 ? ii : 15 - ii;
                const float n0r = fmaf(ar[d][0], s0r, fmaf(-ai[d][0], s0i, acc[0][i])), n0i = fmaf(ar[d][0], s0i, fmaf(ai[d][0], s0r, acc[1][i]));
                const float n1r = fmaf(ar[d][1], s1r, fmaf(-ai[d][1], s1i, acc[2][i])), n1i = fmaf(ar[d][1], s1i, fmaf(ai[d][1], s1r, acc[3][i]));
                s0r = n0r; s0i = n0i; s1r = n1r; s1i = n1i;
                w[i].x = pk2(s0r, s0i); w[i].y = pk2(s1r, s1i); }
#pragma unroll
            for (int i = 0; i < 16; ++i) *(LAS v2u*)(SB + (hf * 16 + i) * 272 + 8 * n) = w[i];
            asm volatile("s_waitcnt lgkmcnt(0)" :: "v"(w[0]), "v"(w[1]), "v"(w[2]), "v"(w[3]), "v"(w[4]), "v"(w[5]), "v"(w[6]), "v"(w[7]), "v"(w[8]), "v"(w[9]), "v"(w[10]), "v"(w[11]), "v"(w[12]), "v"(w[13]), "v"(w[14]), "v"(w[15]) : "memory");
            {
                bf16x8 sf[2][4], cf[4];
#pragma unroll
                for (int ks = 0; ks < 4; ++ks) { cf[ks] = *(const LAS bf16x8*)(CFB + ((d * 4 + ks) * 64 + lane) * 16);
#pragma unroll
                    for (int cc = 0; cc < 2; ++cc) sf[cc][ks] = *(const LAS bf16x8*)(SB + (cc * 16 + tq) * 272 + ks * 64 + q * 16); }
                asm volatile("s_waitcnt lgkmcnt(0)" : "+v"(sf[0][0]), "+v"(sf[0][1]), "+v"(sf[0][2]), "+v"(sf[0][3]), "+v"(sf[1][0]), "+v"(sf[1][1]), "+v"(sf[1][2]), "+v"(sf[1][3]), "+v"(cf[0]), "+v"(cf[1]), "+v"(cf[2]), "+v"(cf[3]) :: "memory");
#pragma unroll
                for (int cc = 0; cc < 2; ++cc)
#pragma unroll
                    for (int ks = 0; ks < 4; ++ks) yacc[cc] = __builtin_amdgcn_mfma_f32_16x16x32_bf16(cf[ks], sf[cc][ks], yacc[cc], 0, 0, 0);
                asm volatile("s_nop 15\n\ts_nop 15\n\ts_nop 15\n\ts_nop 15\n\ts_nop 15\n\ts_nop 15\n\ts_nop 15\n\ts_nop 15\n\ts_nop 15\n\ts_nop 15\n\ts_nop 15\n\ts_nop 15\n\ts_nop 15\n\ts_nop 15\n\ts_nop 15\n\ts_nop 15" : "+v"(yacc[0]), "+v"(yacc[1]) : "v"(sf[0][0]), "v"(sf[0][1]), "v"(sf[0][2]), "v"(sf[0][3]), "v"(sf[1][0]), "v"(sf[1][1]), "v"(sf[1][2]), "v"(sf[1][3]), "v"(cf[0]), "v"(cf[1]), "v"(cf[2]), "v"(cf[3]) : "memory");
            }
        }
#pragma unroll
        for (int cc = 0; cc < 2; ++cc) { const unsigned off = (unsigned)((row0 + (c0 + cc) * 16 + tq) * SW + g * 16 + 4 * q);
            const v2u uw = uwv[cc];
            const float u0 = bflo(uw.x), u1 = bfhi(uw.x), u2 = bflo(uw.y), u3 = bfhi(uw.y);
            const float z0 = gelu_tanh(yacc[cc][0] + dd[0] * u0), z1 = gelu_tanh(yacc[cc][1] + dd[1] * u1), z2 = gelu_tanh(yacc[cc][2] + dd[2] * u2), z3 = gelu_tanh(yacc[cc][3] + dd[3] * u3);
            v2u zw; zw.x = pk2(z0, z1); zw.y = pk2(z2, z3);
            *(v2u*)(Z + off) = zw; }
    }
    S5_BAR();
}
__device__ __forceinline__ void s5_phase(LAS unsigned char* lds, int tid_, int lane_, int wave_, int bx_, int G_, int l) {
    const DArgs a = load_args(); const int tid = fresh_v(tid_), lane = fresh_v(lane_), wave = fresh_s(wave_), bx = fresh_s(bx_), G = fresh_s(G_);
    const bool bal = (G == 256);
    const int nt = bal ? (bx < 128 ? 3 : 6) : (128 + 1024 - bx + G - 1) / G;
    S5C cst; int gprev = -1; bf16x8 Afpre = {0, 0, 0, 0, 0, 0, 0, 0};
    const int lane_n = lane & 31, cbit = (lane_n >> 2) & 1, tA = (lane_n >> 3) * 4 + (lane_n & 3), hf = lane >> 5;
    const bf16* U = (const bf16*)(a.ws + WS_U);
    for (int i = 0; i < nt; ++i) {
        bool latent, latn = false; int b, g, bn = 0, gn = -1;
#define S5_TASK(ii, LAT, B, GG) do { if (bal) { if (bx < 128) { LAT = ((ii) == 0); GG = bx & 63; B = LAT ? (bx >> 6) : 2 * (bx >> 6) + ((ii) - 1); } else { const int w = bx - 128; LAT = false; GG = w >> 1; B = 4 + 6 * (w & 1) + (ii); } } \
        else { const int t = bx + (ii) * G; LAT = t < 128; const int tc = LAT ? t : t - 128; B = tc >> 6; GG = tc & 63; } } while (0)
        S5_TASK(i, latent, b, g);
        if (i + 1 < nt) S5_TASK(i + 1, latn, bn, gn);
        const int row0 = latent ? NCTX + b * 1024 : b * 256;
        const int rown = (i + 1 < nt && gn == g) ? (latn ? NCTX + bn * 1024 : bn * 256) : -1;
        if (g != gprev) { s5_setup(a, lds, lane, wave, l, g, cst); gprev = g;
            Afpre = *(const bf16x8*)(U + (unsigned)((row0 + (2 * wave + cbit) * 16 + tA) * SW + g * 16 + 8 * hf)); }
        s5_task(a, lds, tid, lane, wave, l, row0, latent ? 64 : 16, g, b, latent, cst, Afpre, rown);
#undef S5_TASK
    }
}
#define XB_TMO      128
#define XB_XCNT(j)  (256  + 64 * (j))
#define XB_XSUB(j)  (1280 + 64 * (j))
#define XB_XGEN(j)  (2304 + 64 * (j))
#define XB_TOP      3328
#define XB_TOPGEN   3392
#define XCD_BAR_WORDS 3456
#define XB_SPIN_CAP (1u << 18)

__device__ __forceinline__ unsigned xb_ld(unsigned* p)              { return __hip_atomic_load(p, __ATOMIC_RELAXED, __HIP_MEMORY_SCOPE_AGENT); }
__device__ __forceinline__ unsigned xb_add(unsigned* p, unsigned v) { return __hip_atomic_fetch_add(p, v, __ATOMIC_RELAXED, __HIP_MEMORY_SCOPE_AGENT); }
__device__ __forceinline__ unsigned xb_xcc_id() { return (unsigned)__builtin_amdgcn_s_getreg((3 << 11) | 20) & 0xFu; }
#define XB_SPIN(cond, bar) do { unsigned _sp = 0; while (cond) { __builtin_amdgcn_s_sleep(1); \
    if ((++_sp & 255u) == 0u) { if (xb_ld(&(bar)[XB_TMO])) break; if (_sp > XB_SPIN_CAP) { atomicAdd(&(bar)[XB_TMO], 1u); break; } } } } while (0)

struct XcdBarrier {
    unsigned* bar; unsigned x;
    volatile LAS unsigned* st;
};

__device__ __forceinline__ XcdBarrier xcd_barrier_post(unsigned* bar, volatile LAS unsigned* st) {
    XcdBarrier b; b.bar = bar; b.x = xb_xcc_id(); b.st = st;
    if (threadIdx.x == 0) (void)xb_add(&bar[XB_XCNT(b.x)], 1u);
    return b;
}
__device__ __forceinline__ void xcd_barrier_complete(unsigned* bar, unsigned x, unsigned& nloc, unsigned& nx) {
    const unsigned G = gridDim.x * gridDim.y * gridDim.z;
    unsigned sum, cnt, mine, sp = 0u;
    for (;;) {
        sum = 0u; cnt = 0u; mine = 0u;
#pragma unroll
        for (unsigned j = 0; j < 16; ++j) { const unsigned c = xb_ld(&bar[XB_XCNT(j)]); sum += c; cnt += (c > 0u) ? 1u : 0u; mine = (j == x) ? c : mine; }
        if (sum == G) break;
        __builtin_amdgcn_s_sleep(1);
        if ((++sp & 255u) == 0u) { if (xb_ld(&bar[XB_TMO])) break; if (sp > XB_SPIN_CAP) { atomicAdd(&bar[XB_TMO], 1u); break; } }
    }
    nloc = mine > 0u ? mine : 1u; nx = cnt > 0u ? cnt : 1u;
}

__device__ __forceinline__ void xcd_barrier(const XcdBarrier& b) {
    asm volatile("s_waitcnt vmcnt(0)" ::: "memory");
    __syncthreads();
    if (threadIdx.x == 0) {
        unsigned* bar = b.bar;
        __builtin_amdgcn_s_waitcnt(0);
        unsigned nloc = b.st[0], nx = b.st[1];
        if (nloc == 0u) { xcd_barrier_complete(bar, b.x, nloc, nx); b.st[0] = nloc; b.st[1] = nx; }
        const unsigned old = xb_add(&bar[XB_XSUB(b.x)], 1u);
        const unsigned gen = old / nloc;
        if (old + 1u == (gen + 1u) * nloc) {
            __builtin_amdgcn_fence(__ATOMIC_RELEASE, "agent");
            asm volatile("s_waitcnt vmcnt(0)" ::: "memory");
            const unsigned og = xb_add(&bar[XB_TOP], 1u);
            const unsigned tg = og / nx;
            if (og + 1u == (tg + 1u) * nx) xb_add(&bar[XB_TOPGEN], 1u);
            else XB_SPIN(xb_ld(&bar[XB_TOPGEN]) == tg, bar);
            __builtin_amdgcn_fence(__ATOMIC_ACQUIRE, "agent");
            xb_add(&bar[XB_XGEN(b.x)], 1u);
            asm volatile("s_waitcnt vmcnt(0)" ::: "memory");
        } else {
            XB_SPIN(xb_ld(&bar[XB_XGEN(b.x)]) == gen, bar);
            __builtin_amdgcn_fence(__ATOMIC_ACQUIRE, "agent");
            asm volatile("s_waitcnt vmcnt(0)" ::: "memory");
        }
    }
    __syncthreads();
}


__device__ __forceinline__ void sub_barrier(unsigned* word, unsigned n, unsigned* bar) {
    asm volatile("s_waitcnt vmcnt(0)" ::: "memory");
    __syncthreads();
    if (threadIdx.x == 0) {
        __builtin_amdgcn_s_waitcnt(0);
        __builtin_amdgcn_fence(__ATOMIC_RELEASE, "agent");
        asm volatile("s_waitcnt vmcnt(0)" ::: "memory");
        (void)xb_add(word, 1u);
        XB_SPIN(xb_ld(word) < n, bar);
        __builtin_amdgcn_fence(__ATOMIC_ACQUIRE, "agent");
        asm volatile("s_waitcnt vmcnt(0)" ::: "memory");
    }
    __syncthreads();
}

__global__ void __launch_bounds__(NWAVES * 64, 2) fwd_kernel(Args  ) {
    extern __shared__ __attribute__((aligned(16))) unsigned char lds_raw[];
    LAS unsigned char* lds = (LAS unsigned char*)lds_raw;
    const int tid = threadIdx.x, lane = tid & 63, wave = __builtin_amdgcn_readfirstlane(tid >> 6), G = gridDim.x, bx = blockIdx.x;
    volatile LAS unsigned* MISC = (volatile LAS unsigned*)(lds + MISC_OFF);
    for (int u = tid; u < (LDS_BYTES - LDSCTL_OFF) / 4; u += NWAVES * 64) ((LAS unsigned*)(lds + LDSCTL_OFF))[u] = 0u;
    __syncthreads();
    XcdBarrier bar;
    { const DArgs a = load_args(); gu32* ctl = (gu32*)(a.ws + WS_CTL); bar = xcd_barrier_post((unsigned*)(ctl + CW_BAR), MISC + 8); }
#define GRID_BAR() do { XcdBarrier b_ = bar; asm volatile("" : "+s"(b_.bar), "+s"(b_.x)); xcd_barrier(b_); } while (0)


    for (int t = bx; t < 192; t += G) mod_task64(lds, tid, lane, wave, 0, t);
    cvt_fill(lds, tid, 0, -1);
    cvt_fill(lds, tid, 0, -1);
    GRID_BAR();
    row_pass<0>(0, bx, G, wave, lane);
    GRID_BAR();

    const int nl = fresh_s(DEPTH);
    for (int li = 0; li < nl; ++li) {
        const int l = li;
        const bool dfl = fresh_s(G) == 256;
        { const int x = bx & 7, r = bx >> 3;
          pg8::G5Order S; S.st = !dfl; S.so.init(NTOK, INC, fresh_s(G), fresh_s(bx));
          if (r < 24) { S.u0.pm = 3 * x + r % 3; S.u0.pn = 8 + r / 3; } else if (r < 28) { S.u0.pm = 3 * x + (r - 24) % 3; S.u0.pn = (r - 24) / 3; } else { S.u0.pm = -1; S.u0.pn = 0; }
          if (S.st || S.u0.pm >= 0) {
              const DArgs a = load_args(); pg8::Gemm g{(const bf16*)(a.ws + WS_H), (const bf16*)(a.ws + WS_WIN) + (size_t)l * INC * DM, NTOK, INC, DM};
              pg8::EpiIn E{(bf16*)(a.ws + WS_GB), (bf16*)(a.ws + WS_V), (bf16*)(a.ws + WS_U)};
              pg8::gemm_phase<pg8::EpiIn, pg8::G5Order, true, true>(lds, g, S, E);
          } else if (li + 1 < nl) cvt_fill(lds, tid, l + 1, 12);
        }
        GRID_BAR();
        s5_phase(lds, tid, lane, wave, bx, G, l);
        GRID_BAR();
        { const int x = bx & 7, r = bx >> 3;
          if (dfl && r < 20) {
              pg8::G5Order S; S.st = false; S.u0.pm = 3 * x + (r + 4) % 3; S.u0.pn = (r + 4) / 3;
              const DArgs a = load_args(); pg8::Gemm g{(const bf16*)(a.ws + WS_H), (const bf16*)(a.ws + WS_WIN) + (size_t)l * INC * DM, NTOK, INC, DM};
              pg8::EpiIn E{(bf16*)(a.ws + WS_GB), (bf16*)(a.ws + WS_V), (bf16*)(a.ws + WS_U)};
              pg8::gemm_phase<pg8::EpiIn, pg8::G5Order, true, true>(lds, g, S, E);
          } else {
              pg8::G5Order S; S.st = !dfl; S.so.init(NTOK, SW, fresh_s(G), fresh_s(bx)); S.u0.pm = 3 * x + (r - 20) % 3; S.u0.pn = (r - 20) / 3;
              const DArgs a = load_args(); pg8::Gemm g{(const bf16*)(a.ws + WS_Z), (const bf16*)(a.ws + WS_WGLU) + (size_t)l * SW * SW, NTOK, SW, SW};
              pg8::EpiGlu E{(const bf16*)(a.ws + WS_Z), (bf16*)(a.ws + WS_O), a.in[I_BGLU] + (size_t)l * SW};
              pg8::gemm_phase<pg8::EpiGlu, pg8::G5Order, true, true>(lds, g, S, E);
              if (li + 1 < nl) cvt_fill(lds, tid, l + 1, 4);
          }
        }
        GRID_BAR();
        mix_pass(bx, G, wave, lane, l);
        GRID_BAR();
        { const DArgs a = load_args(); pg8::Gemm g{(const bf16*)(a.ws + WS_MIXIN), (const bf16*)(a.ws + WS_WOUT) + (size_t)l * DM * DM, NTOK, DM, DM}; pg8::G5Order S; S.st = !dfl; S.so.init(NTOK, DM, fresh_s(G), fresh_s(bx)); { const int x = bx & 7, r = bx >> 3; S.u0.pm = r < 24 ? 3 * x + r % 3 : -1; S.u0.pn = r / 3; }
          pg8::EpiBf16<0> E{(bf16*)(a.ws + WS_MIXED), DM, nullptr, 0, 0, 1.f};
          pg8::gemm_phase<pg8::EpiBf16<0>, pg8::G5Order, true, true>(lds, g, S, E); }
        if (li + 1 < nl && G != 256) for (int t = bx; t < 48; t += G) mod_task(lds, tid, lane, wave, 48 * (l + 1) + t);
        if (li + 1 < nl && bx >= 192) cvt_fill(lds, tid, l + 1, 12);
        GRID_BAR();
        row_pass<1>(l, bx, G, wave, lane);
        GRID_BAR();
        { const DArgs a = load_args(); pg8::Gemm g{(const bf16*)(a.ws + WS_H), (const bf16*)(a.ws + WS_WUP) + (size_t)l * UPN * DM, NTOK, UPN, DM}; pg8::G4Order S{0, dfl ? 1024 : 1056, fresh_s(G), fresh_s(bx), !dfl};
          pg8::EpiFfn E{(bf16*)(a.ws + WS_ACT), a.in[I_FFNW] + (size_t)l * 3 * UPN, (LAS float*)(lds + RING_BYTES)};
          pg8::gemm_phase<pg8::EpiFfn, pg8::G4Order, true, true>(lds, g, S, E); }
        GRID_BAR();
        if (dfl && bx < 32) {
            { const DArgs a = load_args(); pg8::Gemm g{(const bf16*)(a.ws + WS_H), (const bf16*)(a.ws + WS_WUP) + (size_t)l * UPN * DM, NTOK, UPN, DM}; pg8::G4Order S{1024, 1056, fresh_s(G), fresh_s(bx), false};
              pg8::EpiFfn E{(bf16*)(a.ws + WS_ACT), a.in[I_FFNW] + (size_t)l * 3 * UPN, (LAS float*)(lds + RING_BYTES)};
              pg8::gemm_phase<pg8::EpiFfn, pg8::G4Order, true, true>(lds, g, S, E); }
            { const DArgs a = load_args(); sub_barrier((unsigned*)(a.ws + WS_CTL) + CW_SUB + 64 * l, 32u, (unsigned*)(a.ws + WS_CTL) + CW_BAR); }
            { const DArgs a = load_args(); pg8::Gemm g{(const bf16*)(a.ws + WS_ACT) + (size_t)23 * 256 * DFF, (const bf16*)(a.ws + WS_WDN) + (size_t)l * DM * DFF, 256, 4 * DM, DFF / 4, DFF, 4};
              pg8::G5Order S; S.st = false; S.u0.pm = 0; S.u0.pn = fresh_s(bx);
              pg8::EpiBf16<0> E{(bf16*)(a.ws + WS_FFP), DM, nullptr, DM, (size_t)256 * DM, 1.f};
              pg8::gemm_phase<pg8::EpiBf16<0>, pg8::G5Order, true, true>(lds, g, S, E); }
            if (li + 1 < nl) cvt_fill(lds, tid, l + 1, 8);
        } else {
            const int x = bx & 7, r = (bx >> 3) - 4;
            pg8::G5Order S; S.st = !dfl; S.so.init(NTOK, DM, fresh_s(G), fresh_s(bx));
            if (bx < 224 && !(x == 7 && r >= 16)) { S.u0.pm = x < 7 ? 3 * x + r % 3 : 21 + (r & 1); S.u0.pn = x < 7 ? r / 3 : r >> 1; } else { S.u0.pm = -1; S.u0.pn = 0; }
            if (S.st || S.u0.pm >= 0) {
                const DArgs a = load_args(); pg8::Gemm g{(const bf16*)(a.ws + WS_ACT), (const bf16*)(a.ws + WS_WDN) + (size_t)l * DM * DFF, NTOK, DM, DFF};
                pg8::EpiBf16<0> E{(bf16*)(a.ws + WS_FF), DM, nullptr, 0, 0, 1.f};
                pg8::gemm_phase<pg8::EpiBf16<0>, pg8::G5Order, true, true>(lds, g, S, E);
            } else if (li + 1 < nl) {
                if (dfl) { const int q = bx >= 224 ? bx - 224 : 32 + (r - 16);
                    mod_task(lds, tid, lane, wave, 48 * (l + 1) + q); if (q + 40 < 48) mod_task(lds, tid, lane, wave, 48 * (l + 1) + q + 40); }
                cvt_fill(lds, tid, l + 1, dfl ? 4 : 48);
            }
        }
        GRID_BAR();
        if (li < nl - 1) {
            row_pass<2>(l, bx, G, wave, lane, fresh_s(G) == 256);
            cvt_fill(lds, tid, l + 1, -1);
            GRID_BAR();
        } else {
            row_pass<3>(l, bx, G, wave, lane, fresh_s(G) == 256);
        }
    }

#undef GRID_BAR
}

extern "C" void kernel_launch(void* const* d_in, const int* in_sizes, int n_in, void* d_out, int out_size, void* d_ws, size_t ws_size, hipStream_t stream) {
    static int grid = 0;
    if (grid == 0) {
        if (n_in != 30 || out_size != NTOK * DM + 2 * 524288 || ws_size < WS_END) { fprintf(stderr, "kernel_launch: unexpected shapes (n_in %d, out %d, ws %zu); nothing launched\n", n_in, out_size, ws_size); grid = -1; return; }
        int dev = 0, cus = 0, per_cu = 0;
        if (hipGetDevice(&dev) != hipSuccess || hipDeviceGetAttribute(&cus, hipDeviceAttributeMultiprocessorCount, dev) != hipSuccess) { grid = -1; return; }
        if (hipFuncSetAttribute((const void*)fwd_kernel, hipFuncAttributeMaxDynamicSharedMemorySize, LDS_BYTES) != hipSuccess) { fprintf(stderr, "kernel_launch: hipFuncSetAttribute failed\n"); grid = -1; return; }
        if (hipOccupancyMaxActiveBlocksPerMultiprocessor(&per_cu, (const void*)fwd_kernel, NWAVES * 64, LDS_BYTES) != hipSuccess || per_cu < 1)
            fprintf(stderr, "kernel_launch: note: occupancy query reports %d workgroups per CU\n", per_cu);
        (void)hipGetLastError();
        grid = cus;
    }
    if (grid < 0) return;
    if (hipMemsetAsync((char*)d_ws + WS_CTL, 0, CTL_ZERO_BYTES, stream) != hipSuccess) return;
    Args a{};
    for (int i = 0; i < 30; ++i) a.in[i] = (const float*)d_in[i];
    a.out = (float*)d_out; a.ws = (unsigned char*)d_ws;
    hipLaunchKernelGGL(fwd_kernel, dim3(grid), dim3(NWAVES * 64), LDS_BYTES, stream, a);
}
```

```cpp
#include <hip/hip_runtime.h>
#include <cstdio>
#include <cstdint>
namespace pg8 {
#define PG8_LAS __attribute__((address_space(3)))
typedef unsigned short bf16_t;
typedef short bf16x8 __attribute__((ext_vector_type(8)));
typedef float f32x4 __attribute__((ext_vector_type(4)));
typedef unsigned u32x4 __attribute__((ext_vector_type(4)));
constexpr int BM = 256, BK = 64, HALF = 128, HTB = HALF * BK * 2  , STAGE_BYTES = 8 * HTB, NXCD = 8, WGM = 8;

__host__ __device__ __forceinline__ int lds_byte(int r, int c) { const int st = (r >> 4) * 2 + (c >> 5), rr = r & 15, cc = c & 31, ob = rr * 64 + cc * 2; return st * 1024 + (ob ^ (((ob >> 9) & 1) << 5)); }
__host__ __device__ __forceinline__ void stage_rc(int b, int& R, int& C) { const int st = b / 1024, sb = b % 1024, swz = sb ^ (((sb >> 9) & 1) << 5); R = (st >> 1) * 16 + swz / 64; C = (st & 1) * 32 + (swz % 64) / 2; }
__host__ __device__ __forceinline__ int perm32(int rho) { const int n = rho >> 4, i = rho & 15; return 8 * (i >> 2) + 4 * n + (i & 3); }

struct Unit { int pm, pn; };
struct Gemm { const bf16_t* A; const bf16_t* Bt; int M, N, K; int ld = 0; int nsp = 1; };

struct StaticOrder {
    int nM, nN, nwg, G, c;
    __host__ __device__ void init(int M, int N, int G_, int c_) { nM = M / BM; nN = N / BM; nwg = nM * nN; G = G_; c = c_; }
    __host__ __device__ bool next(int i, Unit& u) const {
        const long L = (long)i * G + c; if (L >= nwg) return false;
        int wgid = (int)L; { const int q = nwg / NXCD, r = nwg % NXCD, xcd = wgid % NXCD, off = wgid / NXCD; wgid = (xcd < r ? xcd * (q + 1) : r * (q + 1) + (xcd - r) * q) + off; }
        const int nig = WGM * nN, gid = wgid / nig, fm = gid * WGM, gsz = (nM - fm) < WGM ? (nM - fm) : WGM;
        u.pm = fm + ((wgid % nig) % gsz); u.pn = (wgid % nig) / gsz; return true;
    }
    __device__ __forceinline__ void a_ready(const Unit&) const {}
    __device__ __forceinline__ void done(const Unit&) const {}
};

__device__ __forceinline__ unsigned cvt_pk_bf16(float lo, float hi) { unsigned r; asm volatile("v_cvt_pk_bf16_f32 %0, %1, %2" : "=v"(r) : "v"(lo), "v"(hi)); return r; }
typedef float f32x2 __attribute__((ext_vector_type(2)));
__device__ __forceinline__ f32x2 gelu_pk(f32x2 v) {
    const f32x2 av = __builtin_elementwise_abs(v), d = av * 0.2316418882f + 1.0f;
    f32x2 t; t.x = __builtin_amdgcn_rcpf(d.x); t.y = __builtin_amdgcn_rcpf(d.y);
    f32x2 q = t * 0.5307027145f + (-0.7265760135f); q = q * t + 0.7107068705f; q = q * t + (-0.142248368f); q = q * t + 0.127414796f; q = q * t;
    const f32x2 s = (v * v) * (-0.72134752044f);
    f32x2 e; e.x = __builtin_amdgcn_exp2f(s.x); e.y = __builtin_amdgcn_exp2f(s.y);
    const f32x2 m = v * (q * e), r = v - m;
    f32x2 o; o.x = v.x < 0.f ? m.x : r.x; o.y = v.y < 0.f ? m.y : r.y; return o;
}

template <int ACT  > struct EpiBf16 {
    static constexpr bool PERM = true, AFTER_DRAIN = false; static_assert(ACT == 0 || ACT == 1, "EpiBf16: ACT is 0 (none) or 1 (gelu_pk)");
    bf16_t* O; int ldc; const float* bias; int split_cols; size_t split_stride; float scale0;
    __device__ __forceinline__ void operator()(const f32x4 (&acc)[2][2][4][2], const Unit& u, int wr, int wc, int fr, int fq) const {
        const int row0 = u.pm * BM + wr * 64 + fr; int colt = u.pn * BM; bf16_t* base = O;
        float sc = 1.f; if (split_cols) { const int t = colt / split_cols; base += (size_t)t * split_stride; colt -= t * split_cols; if (t == 0) sc = scale0; }
        const int col0 = colt + wc * 32 + 8 * fq, bcol0 = u.pn * BM + wc * 32 + 8 * fq;
        f32x4 bv[2][2];
#pragma unroll
        for (int bj = 0; bj < 2; ++bj)
#pragma unroll
            for (int n = 0; n < 2; ++n) bv[bj][n] = bias ? *(const f32x4*)(bias + bcol0 + bj * HALF + 4 * n) : (f32x4){0.f, 0.f, 0.f, 0.f};
#pragma unroll
        for (int ai = 0; ai < 2; ++ai)
#pragma unroll
            for (int m = 0; m < 4; ++m) { bf16_t* rowp = base + (size_t)(row0 + ai * HALF + m * 16) * ldc + col0;
#pragma unroll
                for (int bj = 0; bj < 2; ++bj) { f32x4 v0 = acc[ai][bj][m][0] + bv[bj][0], v1 = acc[ai][bj][m][1] + bv[bj][1];
                    if (ACT == 1) { f32x2 a = gelu_pk((f32x2){v0[0], v0[1]}), b = gelu_pk((f32x2){v0[2], v0[3]}), c = gelu_pk((f32x2){v1[0], v1[1]}), d = gelu_pk((f32x2){v1[2], v1[3]});
                        v0 = (f32x4){a.x, a.y, b.x, b.y}; v1 = (f32x4){c.x, c.y, d.x, d.y}; }
                    v0 = v0 * sc; v1 = v1 * sc; u32x4 w; w.x = cvt_pk_bf16(v0[0], v0[1]); w.y = cvt_pk_bf16(v0[2], v0[3]); w.z = cvt_pk_bf16(v1[0], v1[1]); w.w = cvt_pk_bf16(v1[2], v1[3]);
                    *(u32x4*)(rowp + bj * HALF) = w; } }
    }
};
template <class Epi, class Sched, bool ALIGN_EPI = false, bool SP2 = false>
__device__ __forceinline__ void gemm_phase(PG8_LAS unsigned char* lds, const Gemm g, const Sched& S, const Epi& E) {
    int tid_ = threadIdx.x; asm volatile("" : "+v"(tid_));
    const int tid = tid_, wid = __builtin_amdgcn_readfirstlane(tid >> 6), lane = tid & 63, wr = wid >> 2, wc = wid & 3, fr = lane & 15, fq = lane >> 4;
    const int K = g.K, nt = K / BK, ld = g.ld ? g.ld : g.K, nNr = g.N / BM / g.nsp;
    unsigned voffA[2], voffB[2];
#pragma unroll
    for (int i = 0; i < 2; ++i) { int R, C; stage_rc(tid * 16 + i * 8192, R, C); const int Rb = Epi::PERM ? ((R & ~31) + perm32(R & 31)) : R;
        voffA[i] = (unsigned)(R * ld + C) * 2u; voffB[i] = (unsigned)(Rb * ld + C) * 2u; }
    const size_t kstep = (size_t)(BK * 2);
    const size_t hstep = (size_t)HALF * ld * 2;
    const size_t tstep = 2 * hstep;
    const unsigned ldsw = (unsigned)wid * 1024u;
    const int aoff = lds_byte(wr * 64 + fr, fq * 8), boff = lds_byte(wc * 32 + fr, fq * 8);
#define PG8_SA(b, h) (((b) * 2 + (h)) * HTB)
#define PG8_SB(b, h) ((4 + (b) * 2 + (h)) * HTB)
#define PG8_STAGE(bufoff, gbase, voff) do { _Pragma("unroll") for (int _i = 0; _i < 2; ++_i) \
        __builtin_amdgcn_global_load_lds((const unsigned*)((const char*)(gbase) + (voff)[_i]), (PG8_LAS unsigned*)(lds + (bufoff) + ldsw + _i * 8192), 16, 0, 0); } while (0)
#define PG8_LDA(dst, b, h) do { _Pragma("unroll") for (int m = 0; m < 4; ++m) _Pragma("unroll") for (int k = 0; k < 2; ++k) dst[m][k] = *(const PG8_LAS bf16x8*)(lds + PG8_SA(b, h) + aoff + m * 2048 + k * 1024); } while (0)
#define PG8_LDB(dst, b, h) do { _Pragma("unroll") for (int n = 0; n < 2; ++n) _Pragma("unroll") for (int k = 0; k < 2; ++k) dst[n][k] = *(const PG8_LAS bf16x8*)(lds + PG8_SB(b, h) + boff + n * 2048 + k * 1024); } while (0)
#define PG8_MMA(ai, bj, At, Bt) do { __builtin_amdgcn_s_setprio(1); _Pragma("unroll") for (int m = 0; m < 4; ++m) _Pragma("unroll") for (int n = 0; n < 2; ++n) _Pragma("unroll") for (int k = 0; k < 2; ++k) \
        acc[ai][bj][m][n] = __builtin_amdgcn_mfma_f32_16x16x32_bf16(Bt[n][k], At[m][k], acc[ai][bj][m][n], 0, 0, 0); __builtin_amdgcn_s_setprio(0); } while (0)
#define PG8_WAIT_V(n) asm volatile("s_waitcnt vmcnt(" #n ")" ::: "memory")
#define PG8_WAIT_L(n) asm volatile("s_waitcnt lgkmcnt(" #n ")" ::: "memory")
#define PG8_BAR __builtin_amdgcn_s_barrier()
#define PG8_SCHED __builtin_amdgcn_sched_barrier(0)
    Unit cur, nxt; int ui = 0;
    if (!S.next(0, cur)) return;
    f32x4 acc[2][2][4][2];
#pragma unroll
    for (int a = 0; a < 2; ++a)
#pragma unroll
        for (int b = 0; b < 2; ++b)
#pragma unroll
            for (int m = 0; m < 4; ++m)
#pragma unroll
                for (int n = 0; n < 2; ++n) acc[a][b][m][n] = (f32x4){0.f, 0.f, 0.f, 0.f};
    bf16x8 At[4][2], B0[2][2], B1[2][2];
#define PG8_APTR(u) ((const char*)g.A + (size_t)(u).pm * tstep + (size_t)((u).pn / nNr) * K * 2)
#define PG8_BPTR(u) ((const char*)g.Bt + (size_t)((u).pn % nNr) * tstep + (size_t)((u).pn / nNr) * K * 2)
    const char* cA = PG8_APTR(cur); const char* cB = PG8_BPTR(cur);
    S.a_ready(cur);
    if constexpr (SP2) {
        PG8_STAGE(PG8_SB(0, 0), cB, voffB); PG8_STAGE(PG8_SB(0, 1), cB + hstep, voffB); PG8_STAGE(PG8_SA(0, 0), cA, voffA); PG8_STAGE(PG8_SA(0, 1), cA + hstep, voffA);
        if (wr == 1) PG8_BAR;
        PG8_WAIT_V(2); PG8_BAR;
        PG8_STAGE(PG8_SB(1, 0), cB + kstep, voffB); PG8_STAGE(PG8_SA(1, 0), cA + kstep, voffA); PG8_STAGE(PG8_SB(1, 1), cB + hstep + kstep, voffB);
        PG8_WAIT_V(6); PG8_BAR;
    } else {
        PG8_STAGE(PG8_SB(0, 0), cB, voffB); PG8_STAGE(PG8_SA(0, 0), cA, voffA); PG8_STAGE(PG8_SB(0, 1), cB + hstep, voffB); PG8_STAGE(PG8_SA(0, 1), cA + hstep, voffA);
        if (wr == 1) PG8_BAR;
        PG8_WAIT_V(4); PG8_BAR;
        PG8_STAGE(PG8_SB(1, 0), cB + kstep, voffB); PG8_STAGE(PG8_SA(1, 0), cA + kstep, voffA); PG8_STAGE(PG8_SB(1, 1), cB + hstep + kstep, voffB);
        PG8_WAIT_V(6); PG8_BAR;
    }
    for (;;) {
        const bool has_next = S.next(ui + 1, nxt);
        const char* nA = has_next ? PG8_APTR(nxt) : cA; const char* nB = has_next ? PG8_BPTR(nxt) : cB;
        for (int t = 0; t < nt; t += 2) {
            const bool last = (t == nt - 2);
            const char* a1 = cA + (size_t)(t + 1) * kstep;
            const char* a2 = last ? nA : cA + (size_t)(t + 2) * kstep; const char* b2 = last ? nB : cB + (size_t)(t + 2) * kstep;
            const char* a3 = a2 + kstep; const char* b3 = b2 + kstep;
            if (last && has_next) S.a_ready(nxt);
            if constexpr (SP2) {
            PG8_LDB(B0, 0, 0); PG8_LDB(B1, 0, 1); PG8_SCHED; PG8_LDA(At, 0, 0); PG8_STAGE(PG8_SA(1, 1), a1 + hstep, voffA);
            PG8_WAIT_V(8); PG8_WAIT_L(0); PG8_BAR; PG8_MMA(0, 0, At, B0); PG8_MMA(0, 1, At, B1); PG8_BAR; PG8_SCHED;
            PG8_LDA(At, 0, 1); PG8_STAGE(PG8_SB(0, 0), b2, voffB); PG8_STAGE(PG8_SB(0, 1), b2 + hstep, voffB); PG8_STAGE(PG8_SA(0, 0), a2, voffA);
            PG8_WAIT_V(8); PG8_WAIT_L(0); PG8_BAR; PG8_MMA(1, 0, At, B0); PG8_MMA(1, 1, At, B1); PG8_BAR; PG8_SCHED;
            PG8_LDB(B0, 1, 0); PG8_LDB(B1, 1, 1); PG8_SCHED; PG8_LDA(At, 1, 0); PG8_STAGE(PG8_SA(0, 1), a2 + hstep, voffA);
            PG8_WAIT_V(8); PG8_WAIT_L(0); PG8_BAR; PG8_MMA(0, 0, At, B0); PG8_MMA(0, 1, At, B1); PG8_BAR; PG8_SCHED;
            PG8_LDA(At, 1, 1); PG8_STAGE(PG8_SB(1, 0), b3, voffB); PG8_STAGE(PG8_SB(1, 1), b3 + hstep, voffB); PG8_STAGE(PG8_SA(1, 0), a3, voffA);
            PG8_WAIT_V(8); PG8_WAIT_L(0); PG8_BAR; PG8_MMA(1, 0, At, B0); PG8_MMA(1, 1, At, B1); PG8_BAR; PG8_SCHED;
            } else {
            PG8_LDB(B0, 0, 0); PG8_SCHED; PG8_LDA(At, 0, 0); PG8_STAGE(PG8_SA(1, 1), a1 + hstep, voffA);
            PG8_WAIT_L(8); PG8_BAR; PG8_WAIT_L(0); PG8_MMA(0, 0, At, B0); PG8_BAR; PG8_SCHED;
            PG8_LDB(B1, 0, 1); PG8_STAGE(PG8_SB(0, 0), b2, voffB);
            PG8_BAR; PG8_WAIT_L(0); PG8_MMA(0, 1, At, B1); PG8_BAR;
            PG8_LDA(At, 0, 1); PG8_STAGE(PG8_SA(0, 0), a2, voffA);
            PG8_BAR; PG8_WAIT_L(0); PG8_MMA(1, 0, At, B0); PG8_BAR; PG8_SCHED;
            PG8_STAGE(PG8_SB(0, 1), b2 + hstep, voffB);
            PG8_WAIT_V(6); PG8_BAR; PG8_MMA(1, 1, At, B1); PG8_BAR;
            PG8_LDB(B0, 1, 0); PG8_SCHED; PG8_LDA(At, 1, 0); PG8_STAGE(PG8_SA(0, 1), a2 + hstep, voffA);
            PG8_WAIT_L(8); PG8_BAR; PG8_WAIT_L(0); PG8_MMA(0, 0, At, B0); PG8_BAR; PG8_SCHED;
            PG8_LDB(B1, 1, 1); PG8_STAGE(PG8_SB(1, 0), b3, voffB);
            PG8_BAR; PG8_WAIT_L(0); PG8_MMA(0, 1, At, B1); PG8_BAR;
            PG8_LDA(At, 1, 1); PG8_STAGE(PG8_SA(1, 0), a3, voffA);
            PG8_BAR; PG8_WAIT_L(0); PG8_MMA(1, 0, At, B0); PG8_BAR; PG8_SCHED;
            PG8_STAGE(PG8_SB(1, 1), b3 + hstep, voffB);
            PG8_WAIT_V(6); PG8_BAR; PG8_MMA(1, 1, At, B1); PG8_BAR;
            }
        }
        if constexpr (ALIGN_EPI) { if (wr == 0) PG8_BAR; }
        if constexpr (!Epi::AFTER_DRAIN) { E(acc, cur, wr, wc, fr, fq); S.done(cur); }
        if (!has_next) break;
#pragma unroll
        for (int a = 0; a < 2; ++a)
#pragma unroll
            for (int b = 0; b < 2; ++b)
#pragma unroll
                for (int m = 0; m < 4; ++m)
#pragma unroll
                    for (int n = 0; n < 2; ++n) acc[a][b][m][n] = (f32x4){0.f, 0.f, 0.f, 0.f};
        cur = nxt; cA = nA; cB = nB; ++ui;
        if constexpr (ALIGN_EPI) { if (wr == 1) PG8_BAR; }
    }
    PG8_WAIT_V(0);
    if constexpr (!ALIGN_EPI) { if (wr == 0) PG8_BAR; }
    PG8_BAR;
    if constexpr (Epi::AFTER_DRAIN) { E.fused(acc, cur, wr, wc, fr, fq, lds, wid, lane); S.done(cur); }
#undef PG8_APTR
#undef PG8_BPTR
#undef PG8_SA
#undef PG8_SB
#undef PG8_STAGE
#undef PG8_LDA
#undef PG8_LDB
#undef PG8_MMA
#undef PG8_WAIT_V
#undef PG8_WAIT_L
#undef PG8_BAR
#undef PG8_SCHED
}
}

constexpr int DM = 2048, NTOK = 6144, NCTX = 4096, DEPTH = 4;
constexpr int CW = 1024, SW = 1024, INC = 4096, DFF = 5632, UPN = 2 * DFF;
constexpr float EPS = 1e-6f;
constexpr int NWAVES = 8;

constexpr size_t MiB = 1u << 20;
constexpr size_t WS_CTL = 0, CTL_ZERO_BYTES = 1 * MiB;
constexpr size_t WS_MOD = 1 * MiB;
constexpr size_t WS_WIN = 2 * MiB, WS_WGLU = 66 * MiB, WS_WOUT = 74 * MiB, WS_WUP = 106 * MiB, WS_WDN = 282 * MiB;
constexpr size_t WS_H = 370 * MiB;
constexpr size_t WS_GB = 394 * MiB, WS_V = 406 * MiB, WS_U = 418 * MiB;
constexpr size_t WS_Z = 430 * MiB, WS_O = 442 * MiB;
constexpr size_t WS_MIXIN = 454 * MiB, WS_MIXED = 478 * MiB;
constexpr size_t WS_UP = 502 * MiB;
constexpr size_t WS_ACT = 634 * MiB;
constexpr size_t WS_FF = 700 * MiB;
constexpr size_t WS_END = 724 * MiB;
constexpr int CW_SUB = 12288;
constexpr size_t WS_FFP = WS_UP;
constexpr int CW_BAR = 4096;

constexpr int RING_BYTES = 131072;
constexpr int LDS_BYTES = 147456;
constexpr int LDSCTL_OFF = LDS_BYTES - 512, MISC_OFF = LDSCTL_OFF;

#define GAS __attribute__((address_space(1)))
#define LAS __attribute__((address_space(3)))
typedef unsigned short bf16;
typedef unsigned v4u __attribute__((ext_vector_type(4)));
typedef unsigned v2u __attribute__((ext_vector_type(2)));
typedef float f32x4 __attribute__((ext_vector_type(4)));
typedef float f32x2 __attribute__((ext_vector_type(2)));
typedef float f32x16 __attribute__((ext_vector_type(16)));
typedef short bf16x8 __attribute__((ext_vector_type(8)));
typedef GAS unsigned gu32;
#define LDS_WAIT() asm volatile("s_waitcnt lgkmcnt(0)" ::: "memory")

__device__ __forceinline__ unsigned f2bf(float f) { unsigned u = __builtin_bit_cast(unsigned, f); return (u + 0x7fffu + ((u >> 16) & 1u)) >> 16; }
__device__ __forceinline__ unsigned pk2(float lo, float hi) { unsigned r; asm("v_cvt_pk_bf16_f32 %0, %1, %2" : "=v"(r) : "v"(lo), "v"(hi)); return r; }
__device__ __forceinline__ float bflo(unsigned w) { return __uint_as_float(w << 16); }
__device__ __forceinline__ float bfhi(unsigned w) { return __uint_as_float(w & 0xffff0000u); }
__device__ __forceinline__ void unpack8(const v4u w, float (&f)[8]) { f[0] = bflo(w.x); f[1] = bfhi(w.x); f[2] = bflo(w.y); f[3] = bfhi(w.y); f[4] = bflo(w.z); f[5] = bfhi(w.z); f[6] = bflo(w.w); f[7] = bfhi(w.w); }
__device__ __forceinline__ v4u pack8(const float (&f)[8]) { v4u w; w.x = pk2(f[0], f[1]); w.y = pk2(f[2], f[3]); w.z = pk2(f[4], f[5]); w.w = pk2(f[6], f[7]); return w; }
__device__ __forceinline__ float wave_sum(float v) {
#pragma unroll
    for (int o = 1; o < 64; o <<= 1) v += __shfl_xor(v, o);
    return v;
}
__device__ __forceinline__ float sigmoidf_(float x) { return 1.0f / (1.0f + __expf(-x)); }
__device__ __forceinline__ float gelu_tanh(float y) { const float v = 0.7978845608028654f * (y + 0.044715f * y * y * y); const float t = 1.0f - 2.0f / (__expf(2.0f * v) + 1.0f); return 0.5f * y * (1.0f + t); }
__device__ __forceinline__ void sincos_cw(float x, float& s, float& c) {
    const float k = rintf(x * 0.6366197723675814f);
    float r = fmaf(k, -1.5707963705062866f, x);
    r = fmaf(k, 4.371138828673793e-08f, r);
    r = fmaf(k, 1.7763568394002505e-15f, r);
    const float r2 = r * r;
    const float sp = r + r * r2 * fmaf(r2, fmaf(r2, -1.9515295891e-4f, 8.3321608736e-3f), -1.6666654611e-1f);
    const float cp = fmaf(r2 * r2, fmaf(r2, fmaf(r2, 2.443315711809948e-5f, -1.388731625493765e-3f), 4.166664568298827e-2f), fmaf(r2, -0.5f, 1.0f));
    const int q = ((int)k) & 3;
    const float ss = (q & 1) ? cp : sp, cc = (q & 1) ? sp : cp;
    s = (q & 2) ? -ss : ss;
    c = ((q + 1) & 2) ? -cc : cc;
}

__device__ __forceinline__ int fresh_v(int x) { asm volatile("" : "+v"(x)); return x; }
__device__ __forceinline__ int fresh_s(int x) { asm volatile("" : "+s"(x)); return x; }
struct Args { const float* in[30]; float* out; unsigned char* ws; };
struct KImg { unsigned long long in[30]; unsigned long long out; unsigned long long ws; };
struct DArgs { const float* in[30]; float* out; unsigned char* ws; };
__device__ __forceinline__ DArgs load_args() {
    const __attribute__((address_space(4))) KImg* p = (const __attribute__((address_space(4))) KImg*)__builtin_amdgcn_kernarg_segment_ptr();
    asm volatile("" : "+s"(p));
    DArgs a;
#pragma unroll
    for (int i = 0; i < 30; ++i) a.in[i] = (const float*)(GAS const float*)p->in[i];
    a.out = (float*)(GAS float*)p->out; a.ws = (unsigned char*)(GAS unsigned char*)p->ws;
    return a;
}
enum { I_XP = 0, I_XS, I_SRE, I_SIM, I_C, I_CCTX, I_WADA, I_BADA, I_GPRE1, I_WIN, I_CONVW, I_ARE, I_AIM, I_LOGDT, I_BRE, I_BIM, I_CRE, I_CIM, I_SSMD, I_WGLU, I_BGLU,
       I_GCONV, I_GSSM, I_WOUT, I_GPOST1, I_GPRE2, I_WUP, I_FFNW, I_WDOWN, I_GPOST2 };

namespace pg8 {
struct EpiIn {
    static constexpr bool PERM = true, AFTER_DRAIN = false;
    bf16_t *GB, *V, *U;
    __device__ __forceinline__ void operator()(const f32x4 (&acc)[2][2][4][2], const Unit& u, int wr, int wc, int fr, int fq) const {
        const int row0 = u.pm * BM + wr * 64 + fr;
        if (u.pn < 8) {
            const int col0 = u.pn * 128 + wc * 32 + 8 * fq;
#pragma unroll
            for (int ai = 0; ai < 2; ++ai)
#pragma unroll
                for (int m = 0; m < 4; ++m) { bf16_t* rowp = V + (size_t)(row0 + ai * HALF + m * 16) * 1024 + col0;
                    const f32x4 v0 = acc[ai][0][m][0] * acc[ai][1][m][0], v1 = acc[ai][0][m][1] * acc[ai][1][m][1];
                    u32x4 w; w.x = cvt_pk_bf16(v0[0], v0[1]); w.y = cvt_pk_bf16(v0[2], v0[3]); w.z = cvt_pk_bf16(v1[0], v1[1]); w.w = cvt_pk_bf16(v1[2], v1[3]);
                    *(u32x4*)rowp = w; }
        } else {
            const int col0 = (u.pn - 8) * 128 + wc * 32 + 8 * fq;
#pragma unroll
            for (int ai = 0; ai < 2; ++ai)
#pragma unroll
                for (int m = 0; m < 4; ++m) { const size_t off = (size_t)(row0 + ai * HALF + m * 16) * 1024 + col0;
#pragma unroll
                    for (int bj = 0; bj < 2; ++bj) { const f32x4 v0 = acc[ai][bj][m][0], v1 = acc[ai][bj][m][1];
                        u32x4 w; w.x = cvt_pk_bf16(v0[0], v0[1]); w.y = cvt_pk_bf16(v0[2], v0[3]); w.z = cvt_pk_bf16(v1[0], v1[1]); w.w = cvt_pk_bf16(v1[2], v1[3]);
                        *(u32x4*)((bj ? U : GB) + off) = w; } }
        }
    }
};
struct EpiGlu {
    static constexpr bool PERM = true, AFTER_DRAIN = false;
    const bf16_t* Z; bf16_t* O; const float* bias;
    __device__ __forceinline__ void operator()(const f32x4 (&acc)[2][2][4][2], const Unit& u, int wr, int wc, int fr, int fq) const {
        const int row0 = u.pm * BM + wr * 64 + fr, col0 = u.pn * BM + wc * 32 + 8 * fq;
        f32x4 bv[2][2];
#pragma unroll
        for (int bj = 0; bj < 2; ++bj)
#pragma unroll
            for (int n = 0; n < 2; ++n) bv[bj][n] = *(const f32x4*)(bias + col0 + bj * HALF + 4 * n);
#pragma unroll
        for (int ai = 0; ai < 2; ++ai)
#pragma unroll
            for (int m = 0; m < 4; ++m) { const size_t off = (size_t)(row0 + ai * HALF + m * 16) * 1024 + col0;
#pragma unroll
                for (int bj = 0; bj < 2; ++bj) { const u32x4 zw = *(const u32x4*)(Z + off + bj * HALF);
                    const f32x4 g0 = acc[ai][bj][m][0] + bv[bj][0], g1 = acc[ai][bj][m][1] + bv[bj][1];
                    float z[8]; z[0] = __uint_as_float(zw.x << 16); z[1] = __uint_as_float(zw.x & 0xffff0000u); z[2] = __uint_as_float(zw.y << 16); z[3] = __uint_as_float(zw.y & 0xffff0000u);
                    z[4] = __uint_as_float(zw.z << 16); z[5] = __uint_as_float(zw.z & 0xffff0000u); z[6] = __uint_as_float(zw.w << 16); z[7] = __uint_as_float(zw.w & 0xffff0000u);
                    float o[8];
#pragma unroll
                    for (int j = 0; j < 4; ++j) { o[j] = z[j] / (1.0f + __expf(-g0[j])); o[4 + j] = z[4 + j] / (1.0f + __expf(-g1[j])); }
                    u32x4 w; w.x = cvt_pk_bf16(o[0], o[1]); w.y = cvt_pk_bf16(o[2], o[3]); w.z = cvt_pk_bf16(o[4], o[5]); w.w = cvt_pk_bf16(o[6], o[7]);
                    *(u32x4*)(O + off + bj * HALF) = w; } }
    }
};
typedef unsigned u32x2 __attribute__((ext_vector_type(2)));
struct EpiFfn {
    static constexpr bool PERM = true, AFTER_DRAIN = false;
    bf16_t* ACT; const float* fw; PG8_LAS float* xch;
    static __device__ __forceinline__ float ror8(float v) { return __builtin_bit_cast(float, __builtin_amdgcn_mov_dpp(__builtin_bit_cast(int, v), 0x128  , 0xf, 0xf, true)); }
    static __device__ __forceinline__ f32x4 shx8(const f32x4 v) { f32x4 r; r[0] = ror8(v[0]); r[1] = ror8(v[1]); r[2] = ror8(v[2]); r[3] = ror8(v[3]); return r; }
    static __device__ __forceinline__ f32x4 shl(const f32x4 v, int src) { f32x4 r; r[0] = __shfl(v[0], src); r[1] = __shfl(v[1], src); r[2] = __shfl(v[2], src); r[3] = __shfl(v[3], src); return r; }
    static __device__ __forceinline__ f32x4 sel(bool c, const f32x4 a, const f32x4 b) { f32x4 r; r[0] = c ? a[0] : b[0]; r[1] = c ? a[1] : b[1]; r[2] = c ? a[2] : b[2]; r[3] = c ? a[3] : b[3]; return r; }
    __device__ __forceinline__ void operator()(const f32x4 (&acc)[2][2][4][2], const Unit& u, int wr, int wc, int fr, int fq) const {
        const bool ctx = u.pm < 16, h = (fr >> 3) != 0;
        const int c7 = fr & 7, lane = fq * 16 + fr, ch0 = u.pn * 128 + wc * 32 + 8 * fq;
        const f32x4 zero = {0.f, 0.f, 0.f, 0.f};
        f32x4 wa[2][3], wg[2][3];
#pragma unroll
        for (int k = 0; k < 3; ++k) { wa[0][k] = *(const f32x4*)(fw + k * (2 * 5632) + ch0); wg[0][k] = *(const f32x4*)(fw + k * (2 * 5632) + 5632 + ch0); }
        if (ctx) {
            if (wr == 0 && fr == 15) { PG8_LAS f32x4* p = (PG8_LAS f32x4*)(xch + ((wc * 2 + 0) * 4 + fq) * 16); p[0] = acc[1][0][3][0]; p[1] = acc[1][0][3][1]; p[2] = acc[1][1][3][0]; p[3] = acc[1][1][3][1]; }
            if (wr == 1 && fr == 0)  { PG8_LAS f32x4* p = (PG8_LAS f32x4*)(xch + ((wc * 2 + 1) * 4 + fq) * 16); p[0] = acc[0][0][0][0]; p[1] = acc[0][0][0][1]; p[2] = acc[0][1][0][0]; p[3] = acc[0][1][0][1]; }
            asm volatile("s_waitcnt lgkmcnt(0)" ::: "memory"); __builtin_amdgcn_s_barrier(); asm volatile("" ::: "memory");
        }
        const int srcp = (lane + 7) & 63, srcn = (lane - 7) & 63;
        u32x2 keep[8];
#pragma unroll
        for (int n = 0; n < 2; ++n) {
            f32x4 bpa = shl(acc[1][0][3][n], srcp), bpg = shl(acc[1][1][3][n], srcp), bna = shl(acc[0][0][0][n], srcn), bng = shl(acc[0][1][0][n], srcn);
            if (ctx) {
                const PG8_LAS f32x4* p0 = (const PG8_LAS f32x4*)(xch + ((wc * 2 + 0) * 4 + fq) * 16); const PG8_LAS f32x4* p1 = (const PG8_LAS f32x4*)(xch + ((wc * 2 + 1) * 4 + fq) * 16);
                const f32x4 xpa = p0[n], xpg = p0[2 + n], xna = p1[n], xng = p1[2 + n];
                bpa = sel(c7 >= 1, bpa, sel(wr == 1, xpa, zero)); bpg = sel(c7 >= 1, bpg, sel(wr == 1, xpg, zero));
                bna = sel(c7 <= 6, bna, sel(wr == 0, xna, zero)); bng = sel(c7 <= 6, bng, sel(wr == 0, xng, zero));
            } else { bpa = zero; bpg = zero; bna = zero; bng = zero; }
            if (n == 0) {
#pragma unroll
                for (int k = 0; k < 3; ++k) { wa[1][k] = *(const f32x4*)(fw + k * (2 * 5632) + ch0 + 4); wg[1][k] = *(const f32x4*)(fw + k * (2 * 5632) + 5632 + ch0 + 4); }
            }
            f32x4 ea0 = shx8(acc[0][0][0][n]), eg0 = shx8(acc[0][1][0][n]);
            f32x4 pa = sel(h, ea0, bpa), pg = sel(h, eg0, bpg);
#pragma unroll
            for (int s = 0; s < 8; ++s) { const int ai = s >> 2, m = s & 3;
                const f32x4 eap = s < 7 ? shx8(acc[(s + 1) >> 2][0][(s + 1) & 3][n]) : bna, egp = s < 7 ? shx8(acc[(s + 1) >> 2][1][(s + 1) & 3][n]) : bng;
                const f32x4 xa = acc[ai][0][m][n], xg = acc[ai][1][m][n];
                const f32x4 na = sel(h, eap, ea0), ng = sel(h, egp, eg0);
                const f32x4 ca = wa[n][0] * pa + wa[n][1] * xa + wa[n][2] * na, cg = wg[n][0] * pg + wg[n][1] * xg + wg[n][2] * ng;
                const f32x4 t = cg * ca, ex = cg * (-1.442695041f);
                f32x4 den; den[0] = __builtin_amdgcn_exp2f(ex[0]); den[1] = __builtin_amdgcn_exp2f(ex[1]); den[2] = __builtin_amdgcn_exp2f(ex[2]); den[3] = __builtin_amdgcn_exp2f(ex[3]);
                den = den + 1.0f;
                f32x4 rc; rc[0] = __builtin_amdgcn_rcpf(den[0]); rc[1] = __builtin_amdgcn_rcpf(den[1]); rc[2] = __builtin_amdgcn_rcpf(den[2]); rc[3] = __builtin_amdgcn_rcpf(den[3]);
                const f32x4 o = t * rc;
                u32x2 w; w.x = cvt_pk_bf16(o[0], o[1]); w.y = cvt_pk_bf16(o[2], o[3]);
                if (n == 0) keep[s] = w;
                else { u32x4 w4; w4.x = keep[s].x; w4.y = keep[s].y; w4.z = w.x; w4.w = w.y; *(u32x4*)(ACT + (size_t)(u.pm * BM + ai * HALF + wr * 64 + m * 16 + fr) * 5632 + ch0) = w4; }
                pa = na; pg = ng; ea0 = eap; eg0 = egp;
            }
        }
    }
};
struct G4Order {
    int lo, hi, G, c; bool plain;
    __device__ __forceinline__ bool next(int i, Unit& u) const {
        const int L = lo + i * G + c; if (L >= hi) return false;
        StaticOrder so; so.init(24 * BM, 44 * BM, 1, 0);
        if (plain) return so.next(L, u);
        if (L >= 1024) { u.pm = 23; u.pn = 12 + (L - 1024); return true; }
        so.next(L, u); if (u.pm == 23 && u.pn >= 12) so.next(1024 + u.pn - 12, u);
        return true;
    }
    __device__ __forceinline__ void a_ready(const Unit&) const {}
    __device__ __forceinline__ void done(const Unit&) const {}
};
struct G5Order {
    bool st; StaticOrder so; Unit u0;
    __device__ __forceinline__ bool next(int i, Unit& u) const { if (st) return so.next(i, u); if (i != 0 || u0.pm < 0) return false; u = u0; return true; }
    __device__ __forceinline__ void a_ready(const Unit&) const {}
    __device__ __forceinline__ void done(const Unit&) const {}
};
}

__device__ __forceinline__ void cvt_load(const float* __restrict__ W, int N, int k0, int n0, int tid, f32x4 (&r0)[4], f32x4 (&r1)[4]) {
    const int n4 = tid & 31, kp = tid >> 5;
#pragma unroll
    for (int i = 0; i < 4; ++i) { const float* p = W + (size_t)(k0 + 2 * kp + 32 * i) * N + n0 + 4 * n4; r0[i] = __builtin_nontemporal_load((const f32x4*)p); r1[i] = __builtin_nontemporal_load((const f32x4*)(p + N)); }
}
__device__ __forceinline__ void cvt_put(LAS unsigned* T, int tid, const f32x4 (&r0)[4], const f32x4 (&r1)[4]) {
    const int n4 = tid & 31, kp = tid >> 5;
#pragma unroll
    for (int i = 0; i < 4; ++i)
#pragma unroll
        for (int e = 0; e < 4; ++e) T[(4 * n4 + e) * 65 + kp + 16 * i] = pk2(r0[i][e], r1[i][e]);
}
__device__ __forceinline__ void cvt_store(const LAS unsigned* T, bf16* __restrict__ Bt, int K, int k0, int j0, int tid) {
    const int n = tid >> 2, kc = tid & 3;
    unsigned w[16];
#pragma unroll
    for (int i = 0; i < 16; ++i) w[i] = T[n * 65 + 16 * kc + i];
    v4u* dst = (v4u*)(Bt + (size_t)(j0 + n) * K + k0 + 32 * kc);
#pragma unroll
    for (int q = 0; q < 4; ++q) { v4u o; o.x = w[4 * q]; o.y = w[4 * q + 1]; o.z = w[4 * q + 2]; o.w = w[4 * q + 3]; dst[q] = o; }
}
constexpr int CVT_PER_LAYER = 512 + 64 + 256 + 1408 + 704;
struct CvtD { const float* W; bf16* Bt; int N, K, k0, n0, j0; };
__device__ __forceinline__ CvtD cvt_desc(const DArgs& a, int it) {
    const int l = it / CVT_PER_LAYER; int r = it % CVT_PER_LAYER;
    const float* W; bf16* Bt; int N, K, jb, kb, n0;
    if (r < 512) { N = INC; K = DM; W = a.in[I_WIN] + (size_t)l * K * N; Bt = (bf16*)(a.ws + WS_WIN) + (size_t)l * N * K; kb = r >> 5; jb = r & 31;
        const int pn = jb >> 1, bj = jb & 1; n0 = pn < 8 ? ((bj ? 2048 : 1024) + 128 * pn) : ((bj ? 3072 : 0) + 128 * (pn - 8)); }
    else if (r < 576) { r -= 512; N = SW; K = SW; W = a.in[I_WGLU] + (size_t)l * K * N; Bt = (bf16*)(a.ws + WS_WGLU) + (size_t)l * N * K; kb = r >> 3; jb = r & 7; n0 = 128 * jb; }
    else if (r < 832) { r -= 576; N = DM; K = DM; W = a.in[I_WOUT] + (size_t)l * K * N; Bt = (bf16*)(a.ws + WS_WOUT) + (size_t)l * N * K; kb = r >> 4; jb = r & 15; n0 = 128 * jb; }
    else if (r < 2240) { r -= 832; N = UPN; K = DM; W = a.in[I_WUP] + (size_t)l * K * N; Bt = (bf16*)(a.ws + WS_WUP) + (size_t)l * N * K; kb = r / 88; jb = r % 88; n0 = ((jb & 1) ? DFF : 0) + 128 * (jb >> 1); }
    else { r -= 2240; N = DM; K = DFF; W = a.in[I_WDOWN] + (size_t)l * K * N; Bt = (bf16*)(a.ws + WS_WDN) + (size_t)l * N * K; kb = r >> 4; jb = r & 15; n0 = 128 * jb; }
    CvtD d; d.W = W; d.Bt = Bt; d.N = N; d.K = K; d.k0 = 128 * kb; d.n0 = n0; d.j0 = 128 * jb; return d;
}

constexpr int CW_CVT = 8192;
#define CVT_LDS_BAR() asm volatile("s_waitcnt lgkmcnt(0)\n\ts_barrier" ::: "memory")
__device__ __forceinline__ void cvt_fill(LAS unsigned char* lds, int tid_, int ln, int budget  ) {
    const int tid = fresh_v(tid_);
    volatile LAS unsigned* tk = (volatile LAS unsigned*)(lds + MISC_OFF) + 16;
    LAS unsigned* T0 = (LAS unsigned*)lds; LAS unsigned* T1 = T0 + 128 * 65;
    const int npairs = budget < 0 ? 0x7fffffff : (budget + 1) / 2;
    if (npairs <= 0) return;
    if (tid == 0) { const DArgs a = load_args(); tk[0] = __hip_atomic_fetch_add((unsigned*)(a.ws + WS_CTL) + CW_CVT + 64 * ln, 1u, __ATOMIC_RELAXED, __HIP_MEMORY_SCOPE_AGENT); }
    __syncthreads();
    for (int n = 0; n < npairs; ++n) {
        const unsigned t = tk[n & 1];
        if (2u * t >= (unsigned)CVT_PER_LAYER) break;
        const DArgs a = load_args();
        unsigned nx = 0xffffffffu;
        if (tid == 0 && n + 1 < npairs) nx = __hip_atomic_fetch_add((unsigned*)(a.ws + WS_CTL) + CW_CVT + 64 * ln, 1u, __ATOMIC_RELAXED, __HIP_MEMORY_SCOPE_AGENT);
        const CvtD d0 = cvt_desc(a, ln * CVT_PER_LAYER + 2 * (int)t), d1 = cvt_desc(a, ln * CVT_PER_LAYER + 2 * (int)t + 1);
        f32x4 a0[4], a1[4], b0[4], b1[4];
        cvt_load(d0.W, d0.N, d0.k0, d0.n0, tid, a0, a1); cvt_load(d1.W, d1.N, d1.k0, d1.n0, tid, b0, b1);
        cvt_put(T0, tid, a0, a1); cvt_put(T1, tid, b0, b1);
        if (tid == 0) tk[(n + 1) & 1] = nx;
        CVT_LDS_BAR();
        cvt_store(T0, d0.Bt, d0.K, d0.k0, d0.j0, tid); cvt_store(T1, d1.Bt, d1.K, d1.k0, d1.j0, tid);
        CVT_LDS_BAR();
    }
    __syncthreads();
}
__device__ __forceinline__ void mod_task(LAS unsigned char* lds, int tid_, int lane_, int wave_, int task) {
    const DArgs a = load_args(); const int tid = fresh_v(tid_), lane = fresh_v(lane_), wave = fresh_s(wave_);
    LAS float* SC = (LAS float*)(lds + 36864);
    LAS float* RED = (LAS float*)(lds + 36864 + 24576);
    const int l = task / 48, j0 = (task % 48) * 256;
    for (int i = tid; i < 3 * DM; i += 512) { const int v = i >> 11, k = i & 2047; const float x = v == 0 ? a.in[I_CCTX][k] : a.in[I_C][(v - 1) * DM + k]; SC[i] = x / (1.0f + __expf(-x)); }
    __syncthreads();
    const float* W = a.in[I_WADA] + (size_t)l * DM * 12288 + j0 + 4 * lane;
    f32x4 a0 = {0.f, 0.f, 0.f, 0.f}, a1 = a0, a2 = a0;
    const int kbeg = wave * 256;
    for (int k = kbeg; k < kbeg + 256; k += 8) {
        f32x4 w[8];
#pragma unroll
        for (int u = 0; u < 8; ++u) w[u] = __builtin_nontemporal_load((const f32x4*)(W + (size_t)(k + u) * 12288));
#pragma unroll
        for (int u = 0; u < 8; ++u) { const float s0 = SC[k + u], s1 = SC[2048 + k + u], s2 = SC[4096 + k + u]; a0 += w[u] * s0; a1 += w[u] * s1; a2 += w[u] * s2; }
    }
    *(LAS f32x4*)(RED + (wave * 3 + 0) * 256 + 4 * lane) = a0;
    *(LAS f32x4*)(RED + (wave * 3 + 1) * 256 + 4 * lane) = a1;
    *(LAS f32x4*)(RED + (wave * 3 + 2) * 256 + 4 * lane) = a2;
    __syncthreads();
    float* MOD = (float*)(a.ws + WS_MOD);
    for (int i = tid; i < 768; i += 512) { const int v = i >> 8, jj = i & 255; float s = a.in[I_BADA][l * 12288 + j0 + jj];
#pragma unroll
        for (int w8 = 0; w8 < 8; ++w8) s += RED[(w8 * 3 + v) * 256 + jj];
        const int ch = (j0 + jj) >> 11, e = (j0 + jj) & 2047;
        if (ch == 1) s = (1.0f + s) * a.in[I_GPRE1][l * DM + e]; else if (ch == 2) s *= a.in[I_GPOST1][l * DM + e];
        else if (ch == 4) s = (1.0f + s) * a.in[I_GPRE2][l * DM + e]; else if (ch == 5) s *= a.in[I_GPOST2][l * DM + e];
        MOD[(size_t)(l * 3 + v) * 12288 + j0 + jj] = s; }
    __syncthreads();
}

__device__ __forceinline__ void mod_task64(LAS unsigned char* lds, int tid_, int lane_, int wave_, int l, int task) {
    const DArgs a = load_args(); const int tid = fresh_v(tid_), lane = fresh_v(lane_), wave = fresh_s(wave_);
    LAS float* SC = (LAS float*)(lds + 36864);
    LAS float* RED = (LAS float*)(lds + 36864 + 24576);
    const int j0 = task * 64, c4 = lane & 15, rsub = lane >> 4;
    for (int i = tid; i < 3 * DM; i += 512) { const int v = i >> 11, k = i & 2047; const float x = v == 0 ? a.in[I_CCTX][k] : a.in[I_C][(v - 1) * DM + k]; SC[i] = x / (1.0f + __expf(-x)); }
    __syncthreads();
    const float* W = a.in[I_WADA] + (size_t)l * DM * 12288 + j0 + 4 * c4;
    f32x4 a0 = {0.f, 0.f, 0.f, 0.f}, a1 = a0, a2 = a0;
    const int kbeg = wave * 256;
    for (int k = kbeg; k < kbeg + 256; k += 32) {
        f32x4 w[8];
#pragma unroll
        for (int u = 0; u < 8; ++u) w[u] = __builtin_nontemporal_load((const f32x4*)(W + (size_t)(k + 4 * u + rsub) * 12288));
#pragma unroll
        for (int u = 0; u < 8; ++u) { const int kk = k + 4 * u + rsub; const float s0 = SC[kk], s1 = SC[2048 + kk], s2 = SC[4096 + kk]; a0 += w[u] * s0; a1 += w[u] * s1; a2 += w[u] * s2; }
    }
#pragma unroll
    for (int i = 0; i < 4; ++i) { a0[i] += __shfl_xor(a0[i], 16); a0[i] += __shfl_xor(a0[i], 32); a1[i] += __shfl_xor(a1[i], 16); a1[i] += __shfl_xor(a1[i], 32); a2[i] += __shfl_xor(a2[i], 16); a2[i] += __shfl_xor(a2[i], 32); }
    if (rsub == 0) { *(LAS f32x4*)(RED + (wave * 3 + 0) * 64 + 4 * c4) = a0; *(LAS f32x4*)(RED + (wave * 3 + 1) * 64 + 4 * c4) = a1; *(LAS f32x4*)(RED + (wave * 3 + 2) * 64 + 4 * c4) = a2; }
    __syncthreads();
    float* MOD = (float*)(a.ws + WS_MOD);
    if (tid < 192) { const int v = tid >> 6, jj = tid & 63; float s = a.in[I_BADA][l * 12288 + j0 + jj];
#pragma unroll
        for (int w8 = 0; w8 < 8; ++w8) s += RED[(w8 * 3 + v) * 64 + jj];
        const int ch = (j0 + jj) >> 11, e = (j0 + jj) & 2047;
        if (ch == 1) s = (1.0f + s) * a.in[I_GPRE1][l * DM + e]; else if (ch == 2) s *= a.in[I_GPOST1][l * DM + e];
        else if (ch == 4) s = (1.0f + s) * a.in[I_GPRE2][l * DM + e]; else if (ch == 5) s *= a.in[I_GPOST2][l * DM + e];
        MOD[(size_t)(l * 3 + v) * 12288 + j0 + jj] = s; }
    __syncthreads();
}

__device__ __forceinline__ int mod_vec(int row) { return row < NCTX ? 0 : 1 + ((row - NCTX) >> 10); }
__device__ __forceinline__ int perm_row(int row) {
    int gr, cc, base;
    if (row < NCTX) { const int t = row & 255; gr = t & 15; cc = t >> 4; base = row & ~255; }
    else { const int q = row - NCTX, p = q & 1023; gr = p >> 6; cc = p & 15; base = NCTX + ((q >> 10) * 4 + ((p >> 4) & 3)) * 256; }
    return base + 128 * (gr >> 3) + 64 * (cc >> 3) + 16 * ((gr >> 1) & 3) + 8 * (gr & 1) + (cc & 7);
}
constexpr size_t WS_XH = WS_UP + 8 * MiB, WS_XL = WS_UP + 40 * MiB;
__device__ __forceinline__ void x24_load(const unsigned char* ws, int row, int e0, float (&o)[8]) {
    const v4u h = __builtin_nontemporal_load((const v4u*)((const unsigned short*)(ws + WS_XH) + (size_t)row * DM + e0)); const v2u lo = __builtin_nontemporal_load((const v2u*)(ws + WS_XL + (size_t)row * DM + e0));
    const unsigned hw[4] = {h.x, h.y, h.z, h.w}, lw[2] = {lo.x, lo.y};
#pragma unroll
    for (int i = 0; i < 8; ++i) { const unsigned hi = (i & 1) ? (hw[i >> 1] & 0xffff0000u) : (hw[i >> 1] << 16); const unsigned l8 = (lw[i >> 2] >> (8 * (i & 3))) & 0xffu; o[i] = __uint_as_float(hi | (l8 << 8)); }
}
__device__ __forceinline__ void x24_store(unsigned char* ws, int row, int e0, const float (&x)[8]) {
    unsigned b[8];
#pragma unroll
    for (int i = 0; i < 8; ++i) b[i] = __float_as_uint(x[i]) + 0x80u;
    v4u h; h.x = (b[0] >> 16) | (b[1] & 0xffff0000u); h.y = (b[2] >> 16) | (b[3] & 0xffff0000u); h.z = (b[4] >> 16) | (b[5] & 0xffff0000u); h.w = (b[6] >> 16) | (b[7] & 0xffff0000u);
    v2u lo; lo.x = ((b[0] >> 8) & 0xffu) | (b[1] & 0xff00u) | ((b[2] << 8) & 0xff0000u) | ((b[3] << 16) & 0xff000000u); lo.y = ((b[4] >> 8) & 0xffu) | (b[5] & 0xff00u) | ((b[6] << 8) & 0xff0000u) | ((b[7] << 16) & 0xff000000u);
    __builtin_nontemporal_store(h, (v4u*)((unsigned short*)(ws + WS_XH) + (size_t)row * DM + e0)); __builtin_nontemporal_store(lo, (v2u*)(ws + WS_XL + (size_t)row * DM + e0));
}
template <int MODE>
__device__ __forceinline__ void row_pass(int l, int bx_, int G_, int wave_, int lane_, bool split23 = false) {
    const int bx = fresh_s(bx_), G = fresh_s(G_), wave = fresh_s(wave_), lane = fresh_v(lane_);
    constexpr bool FIRST = (MODE == 0), HAS_NEXT = (MODE != 3);
    const DArgs a = load_args();
    const float* MOD = (const float*)(a.ws + WS_MOD);
    const float* modl = MOD + (size_t)l * 3 * 12288;
    const bf16* Y = (const bf16*)(a.ws + (MODE == 1 ? WS_MIXED : WS_FF));
    const float* modg = modl + (MODE == 1 ? 2 : 5) * DM;
    const float* modn = MODE == 2 ? modl + 3 * 12288 : modl;
    const int sc_off = (MODE == 1 ? 4 : 1) * DM, sh_off = (MODE == 1 ? 3 : 0) * DM;
    bf16* Hdst = (bf16*)(a.ws + WS_H);
    const int rpw = (NTOK + G * NWAVES - 1) / (G * NWAVES), rbeg = (bx * NWAVES + wave) * rpw, rend = rbeg + rpw < NTOK ? rbeg + rpw : NTOK;
    int vprev = -1;
    f32x4 gv[8], cv[8], hv[8];
#pragma unroll
    for (int j = 0; j < 8; ++j) { gv[j] = (f32x4){0.f, 0.f, 0.f, 0.f}; cv[j] = gv[j]; hv[j] = gv[j]; }
    for (int row = rbeg; row < rend; ++row) {
        const int v = mod_vec(row);
        if (v != vprev) { vprev = v;
#pragma unroll
            for (int j = 0; j < 4; ++j) { const int e0 = 8 * lane + 512 * j;
                if (!FIRST) { const float* gate = modg + (size_t)v * 12288; gv[2 * j] = *(const f32x4*)(gate + e0); gv[2 * j + 1] = *(const f32x4*)(gate + e0 + 4); }
                if (HAS_NEXT) { const float* sc = modn + (size_t)v * 12288 + sc_off; const float* sh = modn + (size_t)v * 12288 + sh_off;
                    cv[2 * j] = *(const f32x4*)(sc + e0); cv[2 * j + 1] = *(const f32x4*)(sc + e0 + 4); hv[2 * j] = *(const f32x4*)(sh + e0); hv[2 * j + 1] = *(const f32x4*)(sh + e0 + 4); } } }
        float* xr = a.out + (size_t)row * DM;
        float x[32];
        if (FIRST) {
            const float* src = row < NCTX ? a.in[I_XP] + (size_t)row * DM : a.in[I_XS] + (size_t)(row - NCTX) * DM;
#pragma unroll
            for (int j = 0; j < 4; ++j) { const f32x4 p = __builtin_nontemporal_load((const f32x4*)(src + 8 * lane + 512 * j)), q = __builtin_nontemporal_load((const f32x4*)(src + 8 * lane + 512 * j + 4));
                x[8 * j] = p[0]; x[8 * j + 1] = p[1]; x[8 * j + 2] = p[2]; x[8 * j + 3] = p[3]; x[8 * j + 4] = q[0]; x[8 * j + 5] = q[1]; x[8 * j + 6] = q[2]; x[8 * j + 7] = q[3];
                const float t8[8] = {p[0], p[1], p[2], p[3], q[0], q[1], q[2], q[3]}; x24_store(a.ws, row, 8 * lane + 512 * j, t8); }
        } else {
            float y[32]; float ssq = 0.f;
            const int pr = MODE == 1 ? row : perm_row(row);
            const bool sp23 = MODE != 1 && split23 && pr >= 23 * 256;
            const bf16* yr = sp23 ? (const bf16*)(a.ws + WS_FFP) + (size_t)(pr - 23 * 256) * DM : Y + (size_t)pr * DM;
#pragma unroll
            for (int j = 0; j < 4; ++j) { const v4u w = __builtin_nontemporal_load((const v4u*)(yr + 8 * lane + 512 * j)); float t[8]; unpack8(w, t);
                if (sp23) {
#pragma unroll
                    for (int sp = 1; sp < 4; ++sp) { float t2[8]; unpack8(*(const v4u*)(yr + (size_t)sp * 256 * DM + 8 * lane + 512 * j), t2);
#pragma unroll
                        for (int i = 0; i < 8; ++i) t[i] += t2[i]; } }
#pragma unroll
                for (int i = 0; i < 8; ++i) { y[8 * j + i] = t[i]; ssq += t[i] * t[i]; } }
            ssq = wave_sum(ssq);
            const float rs = 1.0f / sqrtf(ssq * (1.0f / DM) + EPS);
#pragma unroll
            for (int j = 0; j < 4; ++j) { const int e0 = 8 * lane + 512 * j;
                float xo[8]; x24_load(a.ws, row, e0, xo);
                const f32x4 g0 = gv[2 * j], g1 = gv[2 * j + 1];
                f32x4 np, nq;
#pragma unroll
                for (int i = 0; i < 4; ++i) { np[i] = xo[i] + g0[i] * (y[8 * j + i] * rs); nq[i] = xo[4 + i] + g1[i] * (y[8 * j + 4 + i] * rs); x[8 * j + i] = np[i]; x[8 * j + 4 + i] = nq[i]; }
                if (MODE == 3) { __builtin_nontemporal_store(np, (f32x4*)(xr + e0)); __builtin_nontemporal_store(nq, (f32x4*)(xr + e0 + 4)); }
                else { const float t8[8] = {np[0], np[1], np[2], np[3], nq[0], nq[1], nq[2], nq[3]}; x24_store(a.ws, row, e0, t8); } }
        }
        if (HAS_NEXT) {
            float ssq = 0.f;
#pragma unroll
            for (int i = 0; i < 32; ++i) ssq += x[i] * x[i];
            ssq = wave_sum(ssq);
            const float rs = 1.0f / sqrtf(ssq * (1.0f / DM) + EPS);
            bf16* hr = Hdst + (size_t)(MODE == 1 ? perm_row(row) : row) * DM;
#pragma unroll
            for (int j = 0; j < 4; ++j) { const int e0 = 8 * lane + 512 * j;
                const f32x4 c0 = cv[2 * j], c1 = cv[2 * j + 1], h0 = hv[2 * j], h1 = hv[2 * j + 1];
                float o[8];
#pragma unroll
                for (int i = 0; i < 4; ++i) { o[i] = x[8 * j + i] * rs * c0[i] + h0[i]; o[4 + i] = x[8 * j + 4 + i] * rs * c1[i] + h1[i]; }
                *(v4u*)(hr + e0) = pack8(o); }
        }
    }
}

__device__ __forceinline__ void mix_pass(int bx_, int G_, int wave_, int lane_, int l) {
    const DArgs a = load_args(); const int bx = fresh_s(bx_), G = fresh_s(G_), wave = fresh_s(wave_), lane = fresh_v(lane_);
    const bf16* GB = (const bf16*)(a.ws + WS_GB); const bf16* V = (const bf16*)(a.ws + WS_V); const bf16* O = (const bf16*)(a.ws + WS_O); bf16* MX = (bf16*)(a.ws + WS_MIXIN);
    const float* cw = a.in[I_CONVW] + (size_t)l * 3 * CW; const float* gc = a.in[I_GCONV] + (size_t)l * CW; const float* gs = a.in[I_GSSM] + (size_t)l * SW;
    float w0r[16], w1r[16], w2r[16], gcr[16], gsr[16];
#pragma unroll
    for (int j = 0; j < 2; ++j) { const int c0 = 8 * lane + 512 * j;
#pragma unroll
        for (int hq = 0; hq < 2; ++hq) { const f32x4 t0 = *(const f32x4*)(cw + c0 + 4 * hq), t1 = *(const f32x4*)(cw + CW + c0 + 4 * hq), t2 = *(const f32x4*)(cw + 2 * CW + c0 + 4 * hq),
                                               t3 = *(const f32x4*)(gc + c0 + 4 * hq), t4 = *(const f32x4*)(gs + c0 + 4 * hq);
#pragma unroll
            for (int i = 0; i < 4; ++i) { w0r[8 * j + 4 * hq + i] = t0[i]; w1r[8 * j + 4 * hq + i] = t1[i]; w2r[8 * j + 4 * hq + i] = t2[i]; gcr[8 * j + 4 * hq + i] = t3[i]; gsr[8 * j + 4 * hq + i] = t4[i]; } } }
    const int rpw = (NTOK + G * NWAVES - 1) / (G * NWAVES), rbeg = (bx * NWAVES + wave) * rpw, rend = rbeg + rpw < NTOK ? rbeg + rpw : NTOK;
    for (int row = rbeg; row < rend; ++row) {
        bool hp, hn;
        if (row < NCTX) { const int t = row & 255; hp = t > 0; hn = t < 255; } else { const int c = (row - NCTX) & 63; hp = c > 0; hn = c < 63; }
#pragma unroll
        for (int j = 0; j < 2; ++j) { const int c0 = 8 * lane + 512 * j; const size_t off = (size_t)row * CW + c0;
            float vc[8], vp[8], vn[8], gb[8];
            unpack8(*(const v4u*)(V + off), vc); unpack8(__builtin_nontemporal_load((const v4u*)(GB + off)), gb);
            if (hp) unpack8(*(const v4u*)(V + off - CW), vp); else {
#pragma unroll
                for (int i = 0; i < 8; ++i) vp[i] = 0.f; }
            if (hn) unpack8(*(const v4u*)(V + off + CW), vn); else {
#pragma unroll
                for (int i = 0; i < 8; ++i) vn[i] = 0.f; }
            float o[8]; float ssq = 0.f;
#pragma unroll
            for (int i = 0; i < 8; ++i) { o[i] = gb[i] * (w0r[8 * j + i] * vp[i] + w1r[8 * j + i] * vc[i] + w2r[8 * j + i] * vn[i]); ssq += o[i] * o[i]; }
            ssq += __shfl_xor(ssq, 1); ssq += __shfl_xor(ssq, 2); ssq += __shfl_xor(ssq, 4);
            const float rs = 1.0f / sqrtf(ssq * (1.0f / 64.0f) + EPS);
#pragma unroll
            for (int i = 0; i < 8; ++i) o[i] = o[i] * rs * gcr[8 * j + i];
            *(v4u*)(MX + (size_t)row * DM + c0) = pack8(o); }
        float s[16]; float ssq = 0.f;
#pragma unroll
        for (int j = 0; j < 2; ++j) { float t[8]; unpack8(__builtin_nontemporal_load((const v4u*)(O + (size_t)row * SW + 8 * lane + 512 * j)), t);
#pragma unroll
            for (int i = 0; i < 8; ++i) { s[8 * j + i] = t[i]; ssq += t[i] * t[i]; } }
        ssq = wave_sum(ssq);
        const float rs = 1.0f / sqrtf(ssq * (1.0f / SW) + EPS);
#pragma unroll
        for (int j = 0; j < 2; ++j) { const int c0 = 8 * lane + 512 * j; float o[8];
#pragma unroll
            for (int i = 0; i < 8; ++i) o[i] = s[8 * j + i] * rs * gsr[8 * j + i];
            *(v4u*)(MX + (size_t)row * DM + CW + c0) = pack8(o); }
    }
}

struct S5C { bf16x8 Bf[2][4]; float ar[2][2], ai[2][2]; };
__device__ __forceinline__ void s5_setup(const DArgs& a, LAS unsigned char* lds, int lane, int wave, int l, int g, S5C& c) {
    const int n = lane & 31, hf = lane >> 5, tq = lane & 15, q = lane >> 4;
    LAS unsigned char* CFB = lds + 135168;
    LAS float* A16 = (LAS float*)(lds + 143360);
#pragma unroll
    for (int d = 0; d < 2; ++d) {
        const int pg = (l * 2 + d) * 64 + g;
        const float dt = expf(a.in[I_LOGDT][pg]);
#pragma unroll
        for (int s = 0; s < 2; ++s) { const int nn = n + 32 * s;
            const float are = a.in[I_ARE][pg * 64 + nn], aim = a.in[I_AIM][pg * 64 + nn];
            const float er = expf(are * dt); float sn, cs; sincos_cw(aim * dt, sn, cs);
            const float abr = er * cs, abi = er * sn; c.ar[d][s] = abr; c.ai[d][s] = abi;
            if (wave == 0 && hf == 0) { const float e16 = expf(16.0f * are * dt); float s16, c16; sincos_cw(16.0f * aim * dt, s16, c16); *(LAS f32x2*)(A16 + (d * 64 + nn) * 2) = (f32x2){e16 * c16, e16 * s16}; }
            const float inv = 1.0f / (are * are + aim * aim);
            const float cr = ((abr - 1.0f) * are + abi * aim) * inv, ci = (abi * are - (abr - 1.0f) * aim) * inv;
            const float* brp = a.in[I_BRE] + (unsigned)((pg * 64 + nn) * 16 + 8 * hf); const float* bip = a.in[I_BIM] + (unsigned)((pg * 64 + nn) * 16 + 8 * hf);
            const f32x4 br0 = *(const f32x4*)brp, br1 = *(const f32x4*)(brp + 4), bi0 = *(const f32x4*)bip, bi1 = *(const f32x4*)(bip + 4);
            v4u wr_, wi_;
            wr_.x = pk2(cr * br0[0] - ci * bi0[0], cr * br0[1] - ci * bi0[1]); wr_.y = pk2(cr * br0[2] - ci * bi0[2], cr * br0[3] - ci * bi0[3]);
            wr_.z = pk2(cr * br1[0] - ci * bi1[0], cr * br1[1] - ci * bi1[1]); wr_.w = pk2(cr * br1[2] - ci * bi1[2], cr * br1[3] - ci * bi1[3]);
            wi_.x = pk2(cr * bi0[0] + ci * br0[0], cr * bi0[1] + ci * br0[1]); wi_.y = pk2(cr * bi0[2] + ci * br0[2], cr * bi0[3] + ci * br0[3]);
            wi_.z = pk2(cr * bi1[0] + ci * br1[0], cr * bi1[1] + ci * br1[1]); wi_.w = pk2(cr * bi1[2] + ci * br1[2], cr * bi1[3] + ci * br1[3]);
            c.Bf[d][2 * s] = __builtin_bit_cast(bf16x8, wr_); c.Bf[d][2 * s + 1] = __builtin_bit_cast(bf16x8, wi_); }
        if (wave == 0) {
            const float* crp = a.in[I_CRE] + (unsigned)((pg * 16 + tq) * 64); const float* cip = a.in[I_CIM] + (unsigned)((pg * 16 + tq) * 64);
#pragma unroll
            for (int ks = 0; ks < 4; ++ks) { const int n0 = 8 * ks + 2 * q;
                const f32x2 cr0 = *(const f32x2*)(crp + n0), cr1 = *(const f32x2*)(crp + n0 + 32), ci0 = *(const f32x2*)(cip + n0), ci1 = *(const f32x2*)(cip + n0 + 32);
                v4u w; w.x = pk2(cr0[0], -ci0[0]); w.y = pk2(cr1[0], -ci1[0]); w.z = pk2(cr0[1], -ci0[1]); w.w = pk2(cr1[1], -ci1[1]);
                *(LAS v4u*)(CFB + ((d * 4 + ks) * 64 + lane) * 16) = w; }
        }
    }
}
__device__ __forceinline__ void s5_task(const DArgs& a, LAS unsigned char* lds, int tid, int lane, int wave, int l, int row0, int NC, int g, int bidx, bool latent, const S5C& cst, bf16x8& Afpre, int next_row0) {
#define S5_BAR() do { asm volatile("s_waitcnt lgkmcnt(0)" ::: "memory"); __builtin_amdgcn_s_barrier(); asm volatile("" ::: "memory"); } while (0)
    const int n = lane & 31, hf = lane >> 5, tq = lane & 15, q = lane >> 4;
    LAS float* EB = (LAS float*)lds;
    LAS unsigned char* SB = lds + 65536 + wave * 8704;
    const bf16* U = (const bf16*)(a.ws + WS_U); bf16* Z = (bf16*)(a.ws + WS_Z);
    LAS unsigned char* CFB = lds + 135168;
    const LAS float* A16 = (const LAS float*)(lds + 143360);
    bf16x8 Bf[2][4]; float ar[2][2], ai[2][2];
#pragma unroll
    for (int d = 0; d < 2; ++d) {
#pragma unroll
        for (int cb = 0; cb < 4; ++cb) Bf[d][cb] = cst.Bf[d][cb];
#pragma unroll
        for (int s2 = 0; s2 < 2; ++s2) { ar[d][s2] = cst.ar[d][s2]; ai[d][s2] = cst.ai[d][s2]; } }
    const f32x16 zero16 = {0.f, 0.f, 0.f, 0.f, 0.f, 0.f, 0.f, 0.f, 0.f, 0.f, 0.f, 0.f, 0.f, 0.f, 0.f, 0.f};
    const int cbit = (n >> 2) & 1, tA = (n >> 3) * 4 + (n & 3);
#define S5_PIN_BU() asm volatile("s_nop 15\n\ts_nop 15\n\ts_nop 15\n\ts_nop 15\n\ts_nop 15\n\ts_nop 15\n\ts_nop 15\n\ts_nop 15\n\ts_nop 15\n\ts_nop 15\n\ts_nop 15\n\ts_nop 15\n\ts_nop 15\n\ts_nop 15\n\ts_nop 15\n\ts_nop 15\n\ts_nop 15\n\ts_nop 15\n\ts_nop 15\n\ts_nop 15" : "+v"(acc[0]), "+v"(acc[1]), "+v"(acc[2]), "+v"(acc[3]) : "v"(Afd), "v"(Bf[d][0]), "v"(Bf[d][1]), "v"(Bf[d][2]), "v"(Bf[d][3]))
    bf16x8 Afk = {0, 0, 0, 0, 0, 0, 0, 0};
    bf16x8 Afn = Afpre;
    for (int item = wave; item < NC / 2; item += NWAVES) { const int c0 = 2 * item;
        const bf16x8 Af = Afn;
        if (item + NWAVES < NC / 2) Afn = *(const bf16x8*)(U + (unsigned)((row0 + (c0 + 2 * NWAVES + cbit) * 16 + tA) * SW + g * 16 + 8 * hf));
        Afk = Af;
#pragma unroll
        for (int d = 0; d < 2; ++d) {
            bf16x8 Afd = Af; asm volatile("" : "+v"(Afd) :: "memory");
            f32x16 acc[4];
#pragma unroll
            for (int cb = 0; cb < 4; ++cb) acc[cb] = __builtin_amdgcn_mfma_f32_32x32x16_bf16(Afd, Bf[d][cb], zero16, 0, 0, 0);
            S5_PIN_BU();
            float s0r = 0.f, s0i = 0.f, s1r = 0.f, s1i = 0.f;
#pragma unroll
            for (int ii = 0; ii < 16; ++ii) { const int i = d == 0 ? ii : 15 - ii;
                const float n0r = fmaf(ar[d][0], s0r, fmaf(-ai[d][0], s0i, acc[0][i])), n0i = fmaf(ar[d][0], s0i, fmaf(ai[d][0], s0r, acc[1][i]));
                const float n1r = fmaf(ar[d][1], s1r, fmaf(-ai[d][1], s1i, acc[2][i])), n1i = fmaf(ar[d][1], s1i, fmaf(ai[d][1], s1r, acc[3][i]));
                s0r = n0r; s0i = n0i; s1r = n1r; s1i = n1i; }
            *(LAS f32x4*)(EB + (d * 64 + c0 + hf) * 128 + 4 * n) = (f32x4){s0r, s0i, s1r, s1i};
            asm volatile("s_waitcnt lgkmcnt(0)" :: "v"(s0r), "v"(s0i), "v"(s1r), "v"(s1i) : "memory");
        }
    }
    S5_BAR();
    if (tid < 128) { const int d = tid >> 6, nn = tid & 63, pos = nn < 32 ? 4 * nn : 4 * (nn - 32) + 2;
        const f32x2 p16 = *(const LAS f32x2*)(A16 + (d * 64 + nn) * 2); const float pr = p16[0], pi = p16[1];
        const unsigned sidx = ((((unsigned)bidx * DEPTH + l) * 2 + d) * 64 + g) * 64 + nn;
        float sr = 0.f, si = 0.f;
        if (latent) { sr = a.in[I_SRE][sidx]; si = a.in[I_SIM][sidx]; }
        for (int cb8 = 0; cb8 < NC; cb8 += 8) {
            f32x2 e[8];
#pragma unroll
            for (int j = 0; j < 8; ++j) { const int c = d == 0 ? cb8 + j : NC - 1 - cb8 - j; e[j] = *(const LAS f32x2*)(EB + (d * 64 + c) * 128 + pos); }
#pragma unroll
            for (int j = 0; j < 8; ++j) { const int c = d == 0 ? cb8 + j : NC - 1 - cb8 - j; const f32x2 sv = {sr, si};
                const float nr = fmaf(pr, sr, fmaf(-pi, si, e[j][0])), ni = fmaf(pr, si, fmaf(pi, sr, e[j][1])); sr = nr; si = ni;
                *(LAS f32x2*)(EB + (d * 64 + c) * 128 + pos) = sv; }
        }
        if (!latent) { float* ns = a.out + (size_t)NTOK * DM; ns[sidx] = sr; ns[524288u + sidx] = si; }
    }
    S5_BAR();
    if (next_row0 >= 0) Afpre = *(const bf16x8*)(U + (unsigned)((next_row0 + (2 * wave + cbit) * 16 + tA) * SW + g * 16 + 8 * hf));
    if (latent) Afn = *(const bf16x8*)(U + (unsigned)((row0 + (2 * wave + cbit) * 16 + tA) * SW + g * 16 + 8 * hf));
    const f32x4 dd = *(const f32x4*)(a.in[I_SSMD] + (unsigned)(l * SW + g * 16 + 4 * q));
    for (int item = wave; item < NC / 2; item += NWAVES) { const int c0 = 2 * item;
        bf16x8 Af = Afk;
        if (latent) { Af = Afn; if (item + NWAVES < NC / 2) Afn = *(const bf16x8*)(U + (unsigned)((row0 + (c0 + 2 * NWAVES + cbit) * 16 + tA) * SW + g * 16 + 8 * hf)); }
        v2u uwv[2];
#pragma unroll
        for (int cc = 0; cc < 2; ++cc) uwv[cc] = *(const v2u*)(U + (unsigned)((row0 + (c0 + cc) * 16 + tq) * SW + g * 16 + 4 * q));
        f32x4 yacc[2] = {{0.f, 0.f, 0.f, 0.f}, {0.f, 0.f, 0.f, 0.f}};
#pragma unroll
        for (int d = 0; d < 2; ++d) {
            bf16x8 Afd = Af; asm volatile("" : "+v"(Afd) :: "memory");
            f32x16 acc[4];
#pragma unroll
            for (int cb = 0; cb < 4; ++cb) acc[cb] = __builtin_amdgcn_mfma_f32_32x32x16_bf16(Afd, Bf[d][cb], zero16, 0, 0, 0);
            S5_PIN_BU();
            const f32x4 s_in = *(const LAS f32x4*)(EB + (d * 64 + c0 + hf) * 128 + 4 * n);
            float s0r = s_in[0], s0i = s_in[1], s1r = s_in[2], s1i = s_in[3];
            v2u w[16];
#pragma unroll
            for (int ii = 0; ii < 16; ++ii) { const int i = d == 0 ? ii : 15 - ii;
                const float n0r = fmaf(ar[d][0], s0r, fmaf(-ai[d][0], s0i, acc[0][i])), n0i = fmaf(ar[d][0], s0i, fmaf(ai[d][0], s0r, acc[1][i]));
                const float n1r = fmaf(ar[d][1], s1r, fmaf(-ai[d][1], s1i, acc[2][i])), n1i = fmaf(ar[d][1], s1i, fmaf(ai[d][1], s1r, acc[3][i]));
                s0r = n0r; s0i = n0i; s1r = n1r; s1i = n1i;
                w[i].x = pk2(s0r, s0i); w[i].y = pk2(s1r, s1i); }
#pragma unroll
            for (int i = 0; i < 16; ++i) *(LAS v2u*)(SB + (hf * 16 + i) * 272 + 8 * n) = w[i];
            asm volatile("s_waitcnt lgkmcnt(0)" :: "v"(w[0]), "v"(w[1]), "v"(w[2]), "v"(w[3]), "v"(w[4]), "v"(w[5]), "v"(w[6]), "v"(w[7]), "v"(w[8]), "v"(w[9]), "v"(w[10]), "v"(w[11]), "v"(w[12]), "v"(w[13]), "v"(w[14]), "v"(w[15]) : "memory");
            {
                bf16x8 sf[2][4], cf[4];
#pragma unroll
                for (int ks = 0; ks < 4; ++ks) { cf[ks] = *(const LAS bf16x8*)(CFB + ((d * 4 + ks) * 64 + lane) * 16);
#pragma unroll
                    for (int cc = 0; cc < 2; ++cc) sf[cc][ks] = *(const LAS bf16x8*)(SB + (cc * 16 + tq) * 272 + ks * 64 + q * 16); }
                asm volatile("s_waitcnt lgkmcnt(0)" : "+v"(sf[0][0]), "+v"(sf[0][1]), "+v"(sf[0][2]), "+v"(sf[0][3]), "+v"(sf[1][0]), "+v"(sf[1][1]), "+v"(sf[1][2]), "+v"(sf[1][3]), "+v"(cf[0]), "+v"(cf[1]), "+v"(cf[2]), "+v"(cf[3]) :: "memory");
#pragma unroll
                for (int cc = 0; cc < 2; ++cc)
#pragma unroll
                    for (int ks = 0; ks < 4; ++ks) yacc[cc] = __builtin_amdgcn_mfma_f32_16x16x32_bf16(cf[ks], sf[cc][ks], yacc[cc], 0, 0, 0);
                asm volatile("s_nop 15\n\ts_nop 15\n\ts_nop 15\n\ts_nop 15\n\ts_nop 15\n\ts_nop 15\n\ts_nop 15\n\ts_nop 15\n\ts_nop 15\n\ts_nop 15\n\ts_nop 15\n\ts_nop 15\n\ts_nop 15\n\ts_nop 15\n\ts_nop 15\n\ts_nop 15" : "+v"(yacc[0]), "+v"(yacc[1]) : "v"(sf[0][0]), "v"(sf[0][1]), "v"(sf[0][2]), "v"(sf[0][3]), "v"(sf[1][0]), "v"(sf[1][1]), "v"(sf[1][2]), "v"(sf[1][3]), "v"(cf[0]), "v"(cf[1]), "v"(cf[2]), "v"(cf[3]) : "memory");
            }
        }
#pragma unroll
        for (int cc = 0; cc < 2; ++cc) { const unsigned off = (unsigned)((row0 + (c0 + cc) * 16 + tq) * SW + g * 16 + 4 * q);
            const v2u uw = uwv[cc];
            const float u0 = bflo(uw.x), u1 = bfhi(uw.x), u2 = bflo(uw.y), u3 = bfhi(uw.y);
            const float z0 = gelu_tanh(yacc[cc][0] + dd[0] * u0), z1 = gelu_tanh(yacc[cc][1] + dd[1] * u1), z2 = gelu_tanh(yacc[cc][2] + dd[2] * u2), z3 = gelu_tanh(yacc[cc][3] + dd[3] * u3);
            v2u zw; zw.x = pk2(z0, z1); zw.y = pk2(z2, z3);
            *(v2u*)(Z + off) = zw; }
    }
    S5_BAR();
}
__device__ __forceinline__ void s5_phase(LAS unsigned char* lds, int tid_, int lane_, int wave_, int bx_, int G_, int l) {
    const DArgs a = load_args(); const int tid = fresh_v(tid_), lane = fresh_v(lane_), wave = fresh_s(wave_), bx = fresh_s(bx_), G = fresh_s(G_);
    const bool bal = (G == 256);
    const int nt = bal ? (bx < 128 ? 3 : 6) : (128 + 1024 - bx + G - 1) / G;
    S5C cst; int gprev = -1; bf16x8 Afpre = {0, 0, 0, 0, 0, 0, 0, 0};
    const int lane_n = lane & 31, cbit = (lane_n >> 2) & 1, tA = (lane_n >> 3) * 4 + (lane_n & 3), hf = lane >> 5;
    const bf16* U = (const bf16*)(a.ws + WS_U);
    for (int i = 0; i < nt; ++i) {
        bool latent, latn = false; int b, g, bn = 0, gn = -1;
#define S5_TASK(ii, LAT, B, GG) do { if (bal) { if (bx < 128) { LAT = ((ii) == 0); GG = bx & 63; B = LAT ? (bx >> 6) : 2 * (bx >> 6) + ((ii) - 1); } else { const int w = bx - 128; LAT = false; GG = w >> 1; B = 4 + 6 * (w & 1) + (ii); } } \
        else { const int t = bx + (ii) * G; LAT = t < 128; const int tc = LAT ? t : t - 128; B = tc >> 6; GG = tc & 63; } } while (0)
        S5_TASK(i, latent, b, g);
        if (i + 1 < nt) S5_TASK(i + 1, latn, bn, gn);
        const int row0 = latent ? NCTX + b * 1024 : b * 256;
        const int rown = (i + 1 < nt && gn == g) ? (latn ? NCTX + bn * 1024 : bn * 256) : -1;
        if (g != gprev) { s5_setup(a, lds, lane, wave, l, g, cst); gprev = g;
            Afpre = *(const bf16x8*)(U + (unsigned)((row0 + (2 * wave + cbit) * 16 + tA) * SW + g * 16 + 8 * hf)); }
        s5_task(a, lds, tid, lane, wave, l, row0, latent ? 64 : 16, g, b, latent, cst, Afpre, rown);
#undef S5_TASK
    }
}
#define XB_TMO      128
#define XB_XCNT(j)  (256  + 64 * (j))
#define XB_XSUB(j)  (1280 + 64 * (j))
#define XB_XGEN(j)  (2304 + 64 * (j))
#define XB_TOP      3328
#define XB_TOPGEN   3392
#define XCD_BAR_WORDS 3456
#define XB_SPIN_CAP (1u << 18)

__device__ __forceinline__ unsigned xb_ld(unsigned* p)              { return __hip_atomic_load(p, __ATOMIC_RELAXED, __HIP_MEMORY_SCOPE_AGENT); }
__device__ __forceinline__ unsigned xb_add(unsigned* p, unsigned v) { return __hip_atomic_fetch_add(p, v, __ATOMIC_RELAXED, __HIP_MEMORY_SCOPE_AGENT); }
__device__ __forceinline__ unsigned xb_xcc_id() { return (unsigned)__builtin_amdgcn_s_getreg((3 << 11) | 20) & 0xFu; }
#define XB_SPIN(cond, bar) do { unsigned _sp = 0; while (cond) { __builtin_amdgcn_s_sleep(1); \
    if ((++_sp & 255u) == 0u) { if (xb_ld(&(bar)[XB_TMO])) break; if (_sp > XB_SPIN_CAP) { atomicAdd(&(bar)[XB_TMO], 1u); break; } } } } while (0)

struct XcdBarrier {
    unsigned* bar; unsigned x;
    volatile LAS unsigned* st;
};

__device__ __forceinline__ XcdBarrier xcd_barrier_post(unsigned* bar, volatile LAS unsigned* st) {
    XcdBarrier b; b.bar = bar; b.x = xb_xcc_id(); b.st = st;
    if (threadIdx.x == 0) (void)xb_add(&bar[XB_XCNT(b.x)], 1u);
    return b;
}
__device__ __forceinline__ void xcd_barrier_complete(unsigned* bar, unsigned x, unsigned& nloc, unsigned& nx) {
    const unsigned G = gridDim.x * gridDim.y * gridDim.z;
    unsigned sum, cnt, mine, sp = 0u;
    for (;;) {
        sum = 0u; cnt = 0u; mine = 0u;
#pragma unroll
        for (unsigned j = 0; j < 16; ++j) { const unsigned c = xb_ld(&bar[XB_XCNT(j)]); sum += c; cnt += (c > 0u) ? 1u : 0u; mine = (j == x) ? c : mine; }
        if (sum == G) break;
        __builtin_amdgcn_s_sleep(1);
        if ((++sp & 255u) == 0u) { if (xb_ld(&bar[XB_TMO])) break; if (sp > XB_SPIN_CAP) { atomicAdd(&bar[XB_TMO], 1u); break; } }
    }
    nloc = mine > 0u ? mine : 1u; nx = cnt > 0u ? cnt : 1u;
}

__device__ __forceinline__ void xcd_barrier(const XcdBarrier& b) {
    asm volatile("s_waitcnt vmcnt(0)" ::: "memory");
    __syncthreads();
    if (threadIdx.x == 0) {
        unsigned* bar = b.bar;
        __builtin_amdgcn_s_waitcnt(0);
        unsigned nloc = b.st[0], nx = b.st[1];
        if (nloc == 0u) { xcd_barrier_complete(bar, b.x, nloc, nx); b.st[0] = nloc; b.st[1] = nx; }
        const unsigned old = xb_add(&bar[XB_XSUB(b.x)], 1u);
        const unsigned gen = old / nloc;
        if (old + 1u == (gen + 1u) * nloc) {
            __builtin_amdgcn_fence(__ATOMIC_RELEASE, "agent");
            asm volatile("s_waitcnt vmcnt(0)" ::: "memory");
            const unsigned og = xb_add(&bar[XB_TOP], 1u);
            const unsigned tg = og / nx;
            if (og + 1u == (tg + 1u) * nx) xb_add(&bar[XB_TOPGEN], 1u);
            else XB_SPIN(xb_ld(&bar[XB_TOPGEN]) == tg, bar);
            __builtin_amdgcn_fence(__ATOMIC_ACQUIRE, "agent");
            xb_add(&bar[XB_XGEN(b.x)], 1u);
            asm volatile("s_waitcnt vmcnt(0)" ::: "memory");
        } else {
            XB_SPIN(xb_ld(&bar[XB_XGEN(b.x)]) == gen, bar);
            __builtin_amdgcn_fence(__ATOMIC_ACQUIRE, "agent");
            asm volatile("s_waitcnt vmcnt(0)" ::: "memory");
        }
    }
    __syncthreads();
}


__device__ __forceinline__ void sub_barrier(unsigned* word, unsigned n, unsigned* bar) {
    asm volatile("s_waitcnt vmcnt(0)" ::: "memory");
    __syncthreads();
    if (threadIdx.x == 0) {
        __builtin_amdgcn_s_waitcnt(0);
        __builtin_amdgcn_fence(__ATOMIC_RELEASE, "agent");
        asm volatile("s_waitcnt vmcnt(0)" ::: "memory");
        (void)xb_add(word, 1u);
        XB_SPIN(xb_ld(word) < n, bar);
        __builtin_amdgcn_fence(__ATOMIC_ACQUIRE, "agent");
        asm volatile("s_waitcnt vmcnt(0)" ::: "memory");
    }
    __syncthreads();
}

__global__ void __launch_bounds__(NWAVES * 64, 2) fwd_kernel(Args  ) {
    extern __shared__ __attribute__((aligned(16))) unsigned char lds_raw[];
    LAS unsigned char* lds = (LAS unsigned char*)lds_raw;
    const int tid = threadIdx.x, lane = tid & 63, wave = __builtin_amdgcn_readfirstlane(tid >> 6), G = gridDim.x, bx = blockIdx.x;
    volatile LAS unsigned* MISC = (volatile LAS unsigned*)(lds + MISC_OFF);
    for (int u = tid; u < (LDS_BYTES - LDSCTL_OFF) / 4; u += NWAVES * 64) ((LAS unsigned*)(lds + LDSCTL_OFF))[u] = 0u;
    __syncthreads();
    XcdBarrier bar;
    { const DArgs a = load_args(); gu32* ctl = (gu32*)(a.ws + WS_CTL); bar = xcd_barrier_post((unsigned*)(ctl + CW_BAR), MISC + 8); }
#define GRID_BAR() do { XcdBarrier b_ = bar; asm volatile("" : "+s"(b_.bar), "+s"(b_.x)); xcd_barrier(b_); } while (0)


    for (int t = bx; t < 192; t += G) mod_task64(lds, tid, lane, wave, 0, t);
    cvt_fill(lds, tid, 0, -1);
    GRID_BAR();
    row_pass<0>(0, bx, G, wave, lane);
    GRID_BAR();

    const int nl = fresh_s(DEPTH);
    for (int li = 0; li < nl; ++li) {
        const int l = li;
        const bool dfl = fresh_s(G) == 256;
        { const int x = bx & 7, r = bx >> 3;
          pg8::G5Order S; S.st = !dfl; S.so.init(NTOK, INC, fresh_s(G), fresh_s(bx));
          if (r < 24) { S.u0.pm = 3 * x + r % 3; S.u0.pn = 8 + r / 3; } else if (r < 28) { S.u0.pm = 3 * x + (r - 24) % 3; S.u0.pn = (r - 24) / 3; } else { S.u0.pm = -1; S.u0.pn = 0; }
          if (S.st || S.u0.pm >= 0) {
              const DArgs a = load_args(); pg8::Gemm g{(const bf16*)(a.ws + WS_H), (const bf16*)(a.ws + WS_WIN) + (size_t)l * INC * DM, NTOK, INC, DM};
              pg8::EpiIn E{(bf16*)(a.ws + WS_GB), (bf16*)(a.ws + WS_V), (bf16*)(a.ws + WS_U)};
              pg8::gemm_phase<pg8::EpiIn, pg8::G5Order, true, true>(lds, g, S, E);
          } else if (li + 1 < nl) cvt_fill(lds, tid, l + 1, 12);
        }
        GRID_BAR();
        s5_phase(lds, tid, lane, wave, bx, G, l);
        GRID_BAR();
        { const int x = bx & 7, r = bx >> 3;
          if (dfl && r < 20) {
              pg8::G5Order S; S.st = false; S.u0.pm = 3 * x + (r + 4) % 3; S.u0.pn = (r + 4) / 3;
              const DArgs a = load_args(); pg8::Gemm g{(const bf16*)(a.ws + WS_H), (const bf16*)(a.ws + WS_WIN) + (size_t)l * INC * DM, NTOK, INC, DM};
              pg8::EpiIn E{(bf16*)(a.ws + WS_GB), (bf16*)(a.ws + WS_V), (bf16*)(a.ws + WS_U)};
              pg8::gemm_phase<pg8::EpiIn, pg8::G5Order, true, true>(lds, g, S, E);
          } else {
              pg8::G5Order S; S.st = !dfl; S.so.init(NTOK, SW, fresh_s(G), fresh_s(bx)); S.u0.pm = 3 * x + (r - 20) % 3; S.u0.pn = (r - 20) / 3;
              const DArgs a = load_args(); pg8::Gemm g{(const bf16*)(a.ws + WS_Z), (const bf16*)(a.ws + WS_WGLU) + (size_t)l * SW * SW, NTOK, SW, SW};
              pg8::EpiGlu E{(const bf16*)(a.ws + WS_Z), (bf16*)(a.ws + WS_O), a.in[I_BGLU] + (size_t)l * SW};
              pg8::gemm_phase<pg8::EpiGlu, pg8::G5Order, true, true>(lds, g, S, E);
              if (li + 1 < nl) cvt_fill(lds, tid, l + 1, 4);
          }
        }
        GRID_BAR();
        mix_pass(bx, G, wave, lane, l);
        GRID_BAR();
        { const DArgs a = load_args(); pg8::Gemm g{(const bf16*)(a.ws + WS_MIXIN), (const bf16*)(a.ws + WS_WOUT) + (size_t)l * DM * DM, NTOK, DM, DM}; pg8::G5Order S; S.st = !dfl; S.so.init(NTOK, DM, fresh_s(G), fresh_s(bx)); { const int x = bx & 7, r = bx >> 3; S.u0.pm = r < 24 ? 3 * x + r % 3 : -1; S.u0.pn = r / 3; }
          pg8::EpiBf16<0> E{(bf16*)(a.ws + WS_MIXED), DM, nullptr, 0, 0, 1.f};
          pg8::gemm_phase<pg8::EpiBf16<0>, pg8::G5Order, true, true>(lds, g, S, E); }
        if (li + 1 < nl && G != 256) for (int t = bx; t < 48; t += G) mod_task(lds, tid, lane, wave, 48 * (l + 1) + t);
        if (li + 1 < nl && bx >= 192) cvt_fill(lds, tid, l + 1, 12);
        GRID_BAR();
        row_pass<1>(l, bx, G, wave, lane);
        GRID_BAR();
        { const DArgs a = load_args(); pg8::Gemm g{(const bf16*)(a.ws + WS_H), (const bf16*)(a.ws + WS_WUP) + (size_t)l * UPN * DM, NTOK, UPN, DM}; pg8::G4Order S{0, dfl ? 1024 : 1056, fresh_s(G), fresh_s(bx), !dfl};
          pg8::EpiFfn E{(bf16*)(a.ws + WS_ACT), a.in[I_FFNW] + (size_t)l * 3 * UPN, (LAS float*)(lds + RING_BYTES)};
          pg8::gemm_phase<pg8::EpiFfn, pg8::G4Order, true, true>(lds, g, S, E); }
        GRID_BAR();
        if (dfl && bx < 32) {
            { const DArgs a = load_args(); pg8::Gemm g{(const bf16*)(a.ws + WS_H), (const bf16*)(a.ws + WS_WUP) + (size_t)l * UPN * DM, NTOK, UPN, DM}; pg8::G4Order S{1024, 1056, fresh_s(G), fresh_s(bx), false};
              pg8::EpiFfn E{(bf16*)(a.ws + WS_ACT), a.in[I_FFNW] + (size_t)l * 3 * UPN, (LAS float*)(lds + RING_BYTES)};
              pg8::gemm_phase<pg8::EpiFfn, pg8::G4Order, true, true>(lds, g, S, E); }
            { const DArgs a = load_args(); sub_barrier((unsigned*)(a.ws + WS_CTL) + CW_SUB + 64 * l, 32u, (unsigned*)(a.ws + WS_CTL) + CW_BAR); }
            { const DArgs a = load_args(); pg8::Gemm g{(const bf16*)(a.ws + WS_ACT) + (size_t)23 * 256 * DFF, (const bf16*)(a.ws + WS_WDN) + (size_t)l * DM * DFF, 256, 4 * DM, DFF / 4, DFF, 4};
              pg8::G5Order S; S.st = false; S.u0.pm = 0; S.u0.pn = fresh_s(bx);
              pg8::EpiBf16<0> E{(bf16*)(a.ws + WS_FFP), DM, nullptr, DM, (size_t)256 * DM, 1.f};
              pg8::gemm_phase<pg8::EpiBf16<0>, pg8::G5Order, true, true>(lds, g, S, E); }
            if (li + 1 < nl) cvt_fill(lds, tid, l + 1, 8);
        } else {
            const int x = bx & 7, r = (bx >> 3) - 4;
            pg8::G5Order S; S.st = !dfl; S.so.init(NTOK, DM, fresh_s(G), fresh_s(bx));
            if (bx < 224 && !(x == 7 && r >= 16)) { S.u0.pm = x < 7 ? 3 * x + r % 3 : 21 + (r & 1); S.u0.pn = x < 7 ? r / 3 : r >> 1; } else { S.u0.pm = -1; S.u0.pn = 0; }
            if (S.st || S.u0.pm >= 0) {
                const DArgs a = load_args(); pg8::Gemm g{(const bf16*)(a.ws + WS_ACT), (const bf16*)(a.ws + WS_WDN) + (size_t)l * DM * DFF, NTOK, DM, DFF};
                pg8::EpiBf16<0> E{(bf16*)(a.ws + WS_FF), DM, nullptr, 0, 0, 1.f};
                pg8::gemm_phase<pg8::EpiBf16<0>, pg8::G5Order, true, true>(lds, g, S, E);
            } else if (li + 1 < nl) {
                if (dfl) { const int q = bx >= 224 ? bx - 224 : 32 + (r - 16);
                    mod_task(lds, tid, lane, wave, 48 * (l + 1) + q); if (q + 40 < 48) mod_task(lds, tid, lane, wave, 48 * (l + 1) + q + 40); }
                cvt_fill(lds, tid, l + 1, dfl ? 4 : 48);
            }
        }
        GRID_BAR();
        if (li < nl - 1) {
            row_pass<2>(l, bx, G, wave, lane, fresh_s(G) == 256);
            cvt_fill(lds, tid, l + 1, -1);
            GRID_BAR();
        } else {
            row_pass<3>(l, bx, G, wave, lane, fresh_s(G) == 256);
        }
    }

#undef GRID_BAR
}

extern "C" void kernel_launch(void* const* d_in, const int* in_sizes, int n_in, void* d_out, int out_size, void* d_ws, size_t ws_size, hipStream_t stream) {
    static int grid = 0;
    if (grid == 0) {
        if (n_in != 30 || out_size != NTOK * DM + 2 * 524288 || ws_size < WS_END) { fprintf(stderr, "kernel_launch: unexpected shapes (n_in %d, out %d, ws %zu); nothing launched\n", n_in, out_size, ws_size); grid = -1; return; }
        int dev = 0, cus = 0, per_cu = 0;
        if (hipGetDevice(&dev) != hipSuccess || hipDeviceGetAttribute(&cus, hipDeviceAttributeMultiprocessorCount, dev) != hipSuccess) { grid = -1; return; }
        if (hipFuncSetAttribute((const void*)fwd_kernel, hipFuncAttributeMaxDynamicSharedMemorySize, LDS_BYTES) != hipSuccess) { fprintf(stderr, "kernel_launch: hipFuncSetAttribute failed\n"); grid = -1; return; }
        if (hipOccupancyMaxActiveBlocksPerMultiprocessor(&per_cu, (const void*)fwd_kernel, NWAVES * 64, LDS_BYTES) != hipSuccess || per_cu < 1)
            fprintf(stderr, "kernel_launch: note: occupancy query reports %d workgroups per CU\n", per_cu);
        (void)hipGetLastError();
        grid = cus;
    }
    if (grid < 0) return;
    if (hipMemsetAsync((char*)d_ws + WS_CTL, 0, CTL_ZERO_BYTES, stream) != hipSuccess) return;
    Args a{};
    for (int i = 0; i < 30; ++i) a.in[i] = (const float*)d_in[i];
    a.out = (float*)d_out; a.ws = (unsigned char*)d_ws;
    hipLaunchKernelGGL(fwd_kernel, dim3(grid), dim3(NWAVES * 64), LDS_BYTES, stream, a);
}
```

```cpp
#include <hip/hip_runtime.h>
#include <cstdio>
#include <cstdint>
namespace pg8 {
#define PG8_LAS __attribute__((address_space(3)))
typedef unsigned short bf16_t;
typedef short bf16x8 __attribute__((ext_vector_type(8)));
typedef float f32x4 __attribute__((ext_vector_type(4)));
typedef unsigned u32x4 __attribute__((ext_vector_type(4)));
constexpr int BM = 256, BK = 64, HALF = 128, HTB = HALF * BK * 2  , STAGE_BYTES = 8 * HTB, NXCD = 8, WGM = 8;

__host__ __device__ __forceinline__ int lds_byte(int r, int c) { const int st = (r >> 4) * 2 + (c >> 5), rr = r & 15, cc = c & 31, ob = rr * 64 + cc * 2; return st * 1024 + (ob ^ (((ob >> 9) & 1) << 5)); }
__host__ __device__ __forceinline__ void stage_rc(int b, int& R, int& C) { const int st = b / 1024, sb = b % 1024, swz = sb ^ (((sb >> 9) & 1) << 5); R = (st >> 1) * 16 + swz / 64; C = (st & 1) * 32 + (swz % 64) / 2; }
__host__ __device__ __forceinline__ int perm32(int rho) { const int n = rho >> 4, i = rho & 15; return 8 * (i >> 2) + 4 * n + (i & 3); }

struct Unit { int pm, pn; };
struct Gemm { const bf16_t* A; const bf16_t* Bt; int M, N, K; int ld = 0; int nsp = 1; };

struct StaticOrder {
    int nM, nN, nwg, G, c;
    __host__ __device__ void init(int M, int N, int G_, int c_) { nM = M / BM; nN = N / BM; nwg = nM * nN; G = G_; c = c_; }
    __host__ __device__ bool next(int i, Unit& u) const {
        const long L = (long)i * G + c; if (L >= nwg) return false;
        int wgid = (int)L; { const int q = nwg / NXCD, r = nwg % NXCD, xcd = wgid % NXCD, off = wgid / NXCD; wgid = (xcd < r ? xcd * (q + 1) : r * (q + 1) + (xcd - r) * q) + off; }
        const int nig = WGM * nN, gid = wgid / nig, fm = gid * WGM, gsz = (nM - fm) < WGM ? (nM - fm) : WGM;
        u.pm = fm + ((wgid % nig) % gsz); u.pn = (wgid % nig) / gsz; return true;
    }
    __device__ __forceinline__ void a_ready(const Unit&) const {}
    __device__ __forceinline__ void done(const Unit&) const {}
};

__device__ __forceinline__ unsigned cvt_pk_bf16(float lo, float hi) { unsigned r; asm volatile("v_cvt_pk_bf16_f32 %0, %1, %2" : "=v"(r) : "v"(lo), "v"(hi)); return r; }
typedef float f32x2 __attribute__((ext_vector_type(2)));
__device__ __forceinline__ f32x2 gelu_pk(f32x2 v) {
    const f32x2 av = __builtin_elementwise_abs(v), d = av * 0.2316418882f + 1.0f;
    f32x2 t; t.x = __builtin_amdgcn_rcpf(d.x); t.y = __builtin_amdgcn_rcpf(d.y);
    f32x2 q = t * 0.5307027145f + (-0.7265760135f); q = q * t + 0.7107068705f; q = q * t + (-0.142248368f); q = q * t + 0.127414796f; q = q * t;
    const f32x2 s = (v * v) * (-0.72134752044f);
    f32x2 e; e.x = __builtin_amdgcn_exp2f(s.x); e.y = __builtin_amdgcn_exp2f(s.y);
    const f32x2 m = v * (q * e), r = v - m;
    f32x2 o; o.x = v.x < 0.f ? m.x : r.x; o.y = v.y < 0.f ? m.y : r.y; return o;
}

template <int ACT  > struct EpiBf16 {
    static constexpr bool PERM = true, AFTER_DRAIN = false; static_assert(ACT == 0 || ACT == 1, "EpiBf16: ACT is 0 (none) or 1 (gelu_pk)");
    bf16_t* O; int ldc; const float* bias; int split_cols; size_t split_stride; float scale0;
    __device__ __forceinline__ void operator()(const f32x4 (&acc)[2][2][4][2], const Unit& u, int wr, int wc, int fr, int fq) const {
        const int row0 = u.pm * BM + wr * 64 + fr; int colt = u.pn * BM; bf16_t* base = O;
        float sc = 1.f; if (split_cols) { const int t = colt / split_cols; base += (size_t)t * split_stride; colt -= t * split_cols; if (t == 0) sc = scale0; }
        const int col0 = colt + wc * 32 + 8 * fq, bcol0 = u.pn * BM + wc * 32 + 8 * fq;
        f32x4 bv[2][2];
#pragma unroll
        for (int bj = 0; bj < 2; ++bj)
#pragma unroll
            for (int n = 0; n < 2; ++n) bv[bj][n] = bias ? *(const f32x4*)(bias + bcol0 + bj * HALF + 4 * n) : (f32x4){0.f, 0.f, 0.f, 0.f};
#pragma unroll
        for (int ai = 0; ai < 2; ++ai)
#pragma unroll
            for (int m = 0; m < 4; ++m) { bf16_t* rowp = base + (size_t)(row0 + ai * HALF + m * 16) * ldc + col0;
#pragma unroll
                for (int bj = 0; bj < 2; ++bj) { f32x4 v0 = acc[ai][bj][m][0] + bv[bj][0], v1 = acc[ai][bj][m][1] + bv[bj][1];
                    if (ACT == 1) { f32x2 a = gelu_pk((f32x2){v0[0], v0[1]}), b = gelu_pk((f32x2){v0[2], v0[3]}), c = gelu_pk((f32x2){v1[0], v1[1]}), d = gelu_pk((f32x2){v1[2], v1[3]});
                        v0 = (f32x4){a.x, a.y, b.x, b.y}; v1 = (f32x4){c.x, c.y, d.x, d.y}; }
                    v0 = v0 * sc; v1 = v1 * sc; u32x4 w; w.x = cvt_pk_bf16(v0[0], v0[1]); w.y = cvt_pk_bf16(v0[2], v0[3]); w.z = cvt_pk_bf16(v1[0], v1[1]); w.w = cvt_pk_bf16(v1[2], v1[3]);
                    *(u32x4*)(rowp + bj * HALF) = w; } }
    }
};
template <class Epi, class Sched, bool ALIGN_EPI = false, bool SP2 = false>
__device__ __forceinline__ void gemm_phase(PG8_LAS unsigned char* lds, const Gemm g, const Sched& S, const Epi& E) {
    int tid_ = threadIdx.x; asm volatile("" : "+v"(tid_));
    const int tid = tid_, wid = __builtin_amdgcn_readfirstlane(tid >> 6), lane = tid & 63, wr = wid >> 2, wc = wid & 3, fr = lane & 15, fq = lane >> 4;
    const int K = g.K, nt = K / BK, ld = g.ld ? g.ld : g.K, nNr = g.N / BM / g.nsp;
    unsigned voffA[2], voffB[2];
#pragma unroll
    for (int i = 0; i < 2; ++i) { int R, C; stage_rc(tid * 16 + i * 8192, R, C); const int Rb = Epi::PERM ? ((R & ~31) + perm32(R & 31)) : R;
        voffA[i] = (unsigned)(R * ld + C) * 2u; voffB[i] = (unsigned)(Rb * ld + C) * 2u; }
    const size_t kstep = (size_t)(BK * 2);
    const size_t hstep = (size_t)HALF * ld * 2;
    const size_t tstep = 2 * hstep;
    const unsigned ldsw = (unsigned)wid * 1024u;
    const int aoff = lds_byte(wr * 64 + fr, fq * 8), boff = lds_byte(wc * 32 + fr, fq * 8);
#define PG8_SA(b, h) (((b) * 2 + (h)) * HTB)
#define PG8_SB(b, h) ((4 + (b) * 2 + (h)) * HTB)
#define PG8_STAGE(bufoff, gbase, voff) do { _Pragma("unroll") for (int _i = 0; _i < 2; ++_i) \
        __builtin_amdgcn_global_load_lds((const unsigned*)((const char*)(gbase) + (voff)[_i]), (PG8_LAS unsigned*)(lds + (bufoff) + ldsw + _i * 8192), 16, 0, 0); } while (0)
#define PG8_LDA(dst, b, h) do { _Pragma("unroll") for (int m = 0; m < 4; ++m) _Pragma("unroll") for (int k = 0; k < 2; ++k) dst[m][k] = *(const PG8_LAS bf16x8*)(lds + PG8_SA(b, h) + aoff + m * 2048 + k * 1024); } while (0)
#define PG8_LDB(dst, b, h) do { _Pragma("unroll") for (int n = 0; n < 2; ++n) _Pragma("unroll") for (int k = 0; k < 2; ++k) dst[n][k] = *(const PG8_LAS bf16x8*)(lds + PG8_SB(b, h) + boff + n * 2048 + k * 1024); } while (0)
#define PG8_MMA(ai, bj, At, Bt) do { __builtin_amdgcn_s_setprio(1); _Pragma("unroll") for (int m = 0; m < 4; ++m) _Pragma("unroll") for (int n = 0; n < 2; ++n) _Pragma("unroll") for (int k = 0; k < 2; ++k) \
        acc[ai][bj][m][n] = __builtin_amdgcn_mfma_f32_16x16x32_bf16(Bt[n][k], At[m][k], acc[ai][bj][m][n], 0, 0, 0); __builtin_amdgcn_s_setprio(0); } while (0)
#define PG8_WAIT_V(n) asm volatile("s_waitcnt vmcnt(" #n ")" ::: "memory")
#define PG8_WAIT_L(n) asm volatile("s_waitcnt lgkmcnt(" #n ")" ::: "memory")
#define PG8_BAR __builtin_amdgcn_s_barrier()
#define PG8_SCHED __builtin_amdgcn_sched_barrier(0)
    Unit cur, nxt; int ui = 0;
    if (!S.next(0, cur)) return;
    f32x4 acc[2][2][4][2];
#pragma unroll
    for (int a = 0; a < 2; ++a)
#pragma unroll
        for (int b = 0; b < 2; ++b)
#pragma unroll
            for (int m = 0; m < 4; ++m)
#pragma unroll
                for (int n = 0; n < 2; ++n) acc[a][b][m][n] = (f32x4){0.f, 0.f, 0.f, 0.f};
    bf16x8 At[4][2], B0[2][2], B1[2][2];
#define PG8_APTR(u) ((const char*)g.A + (size_t)(u).pm * tstep + (size_t)((u).pn / nNr) * K * 2)
#define PG8_BPTR(u) ((const char*)g.Bt + (size_t)((u).pn % nNr) * tstep + (size_t)((u).pn / nNr) * K * 2)
    const char* cA = PG8_APTR(cur); const char* cB = PG8_BPTR(cur);
    S.a_ready(cur);
    if constexpr (SP2) {
        PG8_STAGE(PG8_SB(0, 0), cB, voffB); PG8_STAGE(PG8_SB(0, 1), cB + hstep, voffB); PG8_STAGE(PG8_SA(0, 0), cA, voffA); PG8_STAGE(PG8_SA(0, 1), cA + hstep, voffA);
        if (wr == 1) PG8_BAR;
        PG8_WAIT_V(2); PG8_BAR;
        PG8_STAGE(PG8_SB(1, 0), cB + kstep, voffB); PG8_STAGE(PG8_SA(1, 0), cA + kstep, voffA); PG8_STAGE(PG8_SB(1, 1), cB + hstep + kstep, voffB);
        PG8_WAIT_V(6); PG8_BAR;
    } else {
        PG8_STAGE(PG8_SB(0, 0), cB, voffB); PG8_STAGE(PG8_SA(0, 0), cA, voffA); PG8_STAGE(PG8_SB(0, 1), cB + hstep, voffB); PG8_STAGE(PG8_SA(0, 1), cA + hstep, voffA);
        if (wr == 1) PG8_BAR;
        PG8_WAIT_V(4); PG8_BAR;
        PG8_STAGE(PG8_SB(1, 0), cB + kstep, voffB); PG8_STAGE(PG8_SA(1, 0), cA + kstep, voffA); PG8_STAGE(PG8_SB(1, 1), cB + hstep + kstep, voffB);
        PG8_WAIT_V(6); PG8_BAR;
    }
    for (;;) {
        const bool has_next = S.next(ui + 1, nxt);
        const char* nA = has_next ? PG8_APTR(nxt) : cA; const char* nB = has_next ? PG8_BPTR(nxt) : cB;
        for (int t = 0; t < nt; t += 2) {
            const bool last = (t == nt - 2);
            const char* a1 = cA + (size_t)(t + 1) * kstep;
            const char* a2 = last ? nA : cA + (size_t)(t + 2) * kstep; const char* b2 = last ? nB : cB + (size_t)(t + 2) * kstep;
            const char* a3 = a2 + kstep; const char* b3 = b2 + kstep;
            if (last && has_next) S.a_ready(nxt);
            if constexpr (SP2) {
            PG8_LDB(B0, 0, 0); PG8_LDB(B1, 0, 1); PG8_SCHED; PG8_LDA(At, 0, 0); PG8_STAGE(PG8_SA(1, 1), a1 + hstep, voffA);
            PG8_WAIT_V(8); PG8_WAIT_L(0); PG8_BAR; PG8_MMA(0, 0, At, B0); PG8_MMA(0, 1, At, B1); PG8_BAR; PG8_SCHED;
            PG8_LDA(At, 0, 1); PG8_STAGE(PG8_SB(0, 0), b2, voffB); PG8_STAGE(PG8_SB(0, 1), b2 + hstep, voffB); PG8_STAGE(PG8_SA(0, 0), a2, voffA);
            PG8_WAIT_V(8); PG8_WAIT_L(0); PG8_BAR; PG8_MMA(1, 0, At, B0); PG8_MMA(1, 1, At, B1); PG8_BAR; PG8_SCHED;
            PG8_LDB(B0, 1, 0); PG8_LDB(B1, 1, 1); PG8_SCHED; PG8_LDA(At, 1, 0); PG8_STAGE(PG8_SA(0, 1), a2 + hstep, voffA);
            PG8_WAIT_V(8); PG8_WAIT_L(0); PG8_BAR; PG8_MMA(0, 0, At, B0); PG8_MMA(0, 1, At, B1); PG8_BAR; PG8_SCHED;
            PG8_LDA(At, 1, 1); PG8_STAGE(PG8_SB(1, 0), b3, voffB); PG8_STAGE(PG8_SB(1, 1), b3 + hstep, voffB); PG8_STAGE(PG8_SA(1, 0), a3, voffA);
            PG8_WAIT_V(8); PG8_WAIT_L(0); PG8_BAR; PG8_MMA(1, 0, At, B0); PG8_MMA(1, 1, At, B1); PG8_BAR; PG8_SCHED;
            } else {
            PG8_LDB(B0, 0, 0); PG8_SCHED; PG8_LDA(At, 0, 0); PG8_STAGE(PG8_SA(1, 1), a1 + hstep, voffA);
            PG8_WAIT_L(8); PG8_BAR; PG8_WAIT_L(0); PG8_MMA(0, 0, At, B0); PG8_BAR; PG8_SCHED;
            PG8_LDB(B1, 0, 1); PG8_STAGE(PG8_SB(0, 0), b2, voffB);
            PG8_BAR; PG8_WAIT_L(0); PG8_MMA(0, 1, At, B1); PG8_BAR;
            PG8_LDA(At, 0, 1); PG8_STAGE(PG8_SA(0, 0), a2, voffA);
            PG8_BAR; PG8_WAIT_L(0); PG8_MMA(1, 0, At, B0); PG8_BAR; PG8_SCHED;
            PG8_STAGE(PG8_SB(0, 1), b2 + hstep, voffB);
            PG8_WAIT_V(6); PG8_BAR; PG8_MMA(1, 1, At, B1); PG8_BAR;
            PG8_LDB(B0, 1, 0); PG8_SCHED; PG8_LDA(At, 1, 0); PG8_STAGE(PG8_SA(0, 1), a2 + hstep, voffA);
            PG8_WAIT_L(8); PG8_BAR; PG8_WAIT_L(0); PG8_MMA(0, 0, At, B0); PG8_BAR; PG8_SCHED;
            PG8_LDB(B1, 1, 1); PG8_STAGE(PG8_SB(1, 0), b3, voffB);
            PG8_BAR; PG8_WAIT_L(0); PG8_MMA(0, 1, At, B1); PG8_BAR;
            PG8_LDA(At, 1, 1); PG8_STAGE(PG8_SA(1, 0), a3, voffA);
            PG8_BAR; PG8_WAIT_L(0); PG8_MMA(1, 0, At, B0); PG8_BAR; PG8_SCHED;
            PG8_STAGE(PG8_SB(1, 1), b3 + hstep, voffB);
            PG8_WAIT_V(6); PG8_BAR; PG8_MMA(1, 1, At, B1); PG8_BAR;
            }
        }
        if constexpr (ALIGN_EPI) { if (wr == 0) PG8_BAR; }
        if constexpr (!Epi::AFTER_DRAIN) { E(acc, cur, wr, wc, fr, fq); S.done(cur); }
        if (!has_next) break;
#pragma unroll
        for (int a = 0; a < 2; ++a)
#pragma unroll
            for (int b = 0; b < 2; ++b)
#pragma unroll
                for (int m = 0; m < 4; ++m)
#pragma unroll
                    for (int n = 0; n < 2; ++n) acc[a][b][m][n] = (f32x4){0.f, 0.f, 0.f, 0.f};
        cur = nxt; cA = nA; cB = nB; ++ui;
        if constexpr (ALIGN_EPI) { if (wr == 1) PG8_BAR; }
    }
    PG8_WAIT_V(0);
    if constexpr (!ALIGN_EPI) { if (wr == 0) PG8_BAR; }
    PG8_BAR;
    if constexpr (Epi::AFTER_DRAIN) { E.fused(acc, cur, wr, wc, fr, fq, lds, wid, lane); S.done(cur); }
#undef PG8_APTR
#undef PG8_BPTR
#undef PG8_SA
#undef PG8_SB
#undef PG8_STAGE
#undef PG8_LDA
#undef PG8_LDB
#undef PG8_MMA
#undef PG8_WAIT_V
#undef PG8_WAIT_L
#undef PG8_BAR
#undef PG8_SCHED
}
}

constexpr int DM = 2048, NTOK = 6144, NCTX = 4096, DEPTH = 4;
constexpr int CW = 1024, SW = 1024, INC = 4096, DFF = 5632, UPN = 2 * DFF;
constexpr float EPS = 1e-6f;
constexpr int NWAVES = 8;

constexpr size_t MiB = 1u << 20;
constexpr size_t WS_CTL = 0, CTL_ZERO_BYTES = 1 * MiB;
constexpr size_t WS_MOD = 1 * MiB;
constexpr size_t WS_WIN = 2 * MiB, WS_WGLU = 66 * MiB, WS_WOUT = 74 * MiB, WS_WUP = 106 * MiB, WS_WDN = 282 * MiB;
constexpr size_t WS_H = 370 * MiB;
constexpr size_t WS_GB = 394 * MiB, WS_V = 406 * MiB, WS_U = 418 * MiB;
constexpr size_t WS_Z = 430 * MiB, WS_O = 442 * MiB;
constexpr size_t WS_MIXIN = 454 * MiB, WS_MIXED = 478 * MiB;
constexpr size_t WS_UP = 502 * MiB;
constexpr size_t WS_ACT = 634 * MiB;
constexpr size_t WS_FF = 700 * MiB;
constexpr size_t WS_END = 724 * MiB;
constexpr int CW_SUB = 12288;
constexpr size_t WS_FFP = WS_UP;
constexpr int CW_BAR = 4096;

constexpr int RING_BYTES = 131072;
constexpr int LDS_BYTES = 147456;
constexpr int LDSCTL_OFF = LDS_BYTES - 512, MISC_OFF = LDSCTL_OFF;

#define GAS __attribute__((address_space(1)))
#define LAS __attribute__((address_space(3)))
typedef unsigned short bf16;
typedef unsigned v4u __attribute__((ext_vector_type(4)));
typedef unsigned v2u __attribute__((ext_vector_type(2)));
typedef float f32x4 __attribute__((ext_vector_type(4)));
typedef float f32x2 __attribute__((ext_vector_type(2)));
typedef float f32x16 __attribute__((ext_vector_type(16)));
typedef short bf16x8 __attribute__((ext_vector_type(8)));
typedef GAS unsigned gu32;
#define LDS_WAIT() asm volatile("s_waitcnt lgkmcnt(0)" ::: "memory")

__device__ __forceinline__ unsigned f2bf(float f) { unsigned u = __builtin_bit_cast(unsigned, f); return (u + 0x7fffu + ((u >> 16) & 1u)) >> 16; }
__device__ __forceinline__ unsigned pk2(float lo, float hi) { unsigned r; asm("v_cvt_pk_bf16_f32 %0, %1, %2" : "=v"(r) : "v"(lo), "v"(hi)); return r; }
__device__ __forceinline__ float bflo(unsigned w) { return __uint_as_float(w << 16); }
__device__ __forceinline__ float bfhi(unsigned w) { return __uint_as_float(w & 0xffff0000u); }
__device__ __forceinline__ void unpack8(const v4u w, float (&f)[8]) { f[0] = bflo(w.x); f[1] = bfhi(w.x); f[2] = bflo(w.y); f[3] = bfhi(w.y); f[4] = bflo(w.z); f[5] = bfhi(w.z); f[6] = bflo(w.w); f[7] = bfhi(w.w); }
__device__ __forceinline__ v4u pack8(const float (&f)[8]) { v4u w; w.x = pk2(f[0], f[1]); w.y = pk2(f[2], f[3]); w.z = pk2(f[4], f[5]); w.w = pk2(f[6], f[7]); return w; }
__device__ __forceinline__ float wave_sum(float v) {
#pragma unroll
    for (int o = 1; o < 64; o <<= 1) v += __shfl_xor(v, o);
    return v;
}
__device__ __forceinline__ float sigmoidf_(float x) { return 1.0f / (1.0f + __expf(-x)); }
__device__ __forceinline__ float gelu_tanh(float y) { const float v = 0.7978845608028654f * (y + 0.044715f * y * y * y); const float t = 1.0f - 2.0f / (__expf(2.0f * v) + 1.0f); return 0.5f * y * (1.0f + t); }
__device__ __forceinline__ void sincos_cw(float x, float& s, float& c) {
    const float k = rintf(x * 0.6366197723675814f);
    float r = fmaf(k, -1.5707963705062866f, x);
    r = fmaf(k, 4.371138828673793e-08f, r);
    r = fmaf(k, 1.7763568394002505e-15f, r);
    const float r2 = r * r;
    const float sp = r + r * r2 * fmaf(r2, fmaf(r2, -1.9515295891e-4f, 8.3321608736e-3f), -1.6666654611e-1f);
    const float cp = fmaf(r2 * r2, fmaf(r2, fmaf(r2, 2.443315711809948e-5f, -1.388731625493765e-3f), 4.166664568298827e-2f), fmaf(r2, -0.5f, 1.0f));
    const int q = ((int)k) & 3;
    const float ss = (q & 1) ? cp : sp, cc = (q & 1) ? sp : cp;
    s = (q & 2) ? -ss : ss;
    c = ((q + 1) & 2) ? -cc : cc;
}

__device__ __forceinline__ int fresh_v(int x) { asm volatile("" : "+v"(x)); return x; }
__device__ __forceinline__ int fresh_s(int x) { asm volatile("" : "+s"(x)); return x; }
struct Args { const float* in[30]; float* out; unsigned char* ws; };
struct KImg { unsigned long long in[30]; unsigned long long out; unsigned long long ws; };
struct DArgs { const float* in[30]; float* out; unsigned char* ws; };
__device__ __forceinline__ DArgs load_args() {
    const __attribute__((address_space(4))) KImg* p = (const __attribute__((address_space(4))) KImg*)__builtin_amdgcn_kernarg_segment_ptr();
    asm volatile("" : "+s"(p));
    DArgs a;
#pragma unroll
    for (int i = 0; i < 30; ++i) a.in[i] = (const float*)(GAS const float*)p->in[i];
    a.out = (float*)(GAS float*)p->out; a.ws = (unsigned char*)(GAS unsigned char*)p->ws;
    return a;
}
enum { I_XP = 0, I_XS, I_SRE, I_SIM, I_C, I_CCTX, I_WADA, I_BADA, I_GPRE1, I_WIN, I_CONVW, I_ARE, I_AIM, I_LOGDT, I_BRE, I_BIM, I_CRE, I_CIM, I_SSMD, I_WGLU, I_BGLU,
       I_GCONV, I_GSSM, I_WOUT, I_GPOST1, I_GPRE2, I_WUP, I_FFNW, I_WDOWN, I_GPOST2 };

namespace pg8 {
struct EpiIn {
    static constexpr bool PERM = true, AFTER_DRAIN = false;
    bf16_t *GB, *V, *U;
    __device__ __forceinline__ void operator()(const f32x4 (&acc)[2][2][4][2], const Unit& u, int wr, int wc, int fr, int fq) const {
        const int row0 = u.pm * BM + wr * 64 + fr;
        if (u.pn < 8) {
            const int col0 = u.pn * 128 + wc * 32 + 8 * fq;
#pragma unroll
            for (int ai = 0; ai < 2; ++ai)
#pragma unroll
                for (int m = 0; m < 4; ++m) { bf16_t* rowp = V + (size_t)(row0 + ai * HALF + m * 16) * 1024 + col0;
                    const f32x4 v0 = acc[ai][0][m][0] * acc[ai][1][m][0], v1 = acc[ai][0][m][1] * acc[ai][1][m][1];
                    u32x4 w; w.x = cvt_pk_bf16(v0[0], v0[1]); w.y = cvt_pk_bf16(v0[2], v0[3]); w.z = cvt_pk_bf16(v1[0], v1[1]); w.w = cvt_pk_bf16(v1[2], v1[3]);
                    *(u32x4*)rowp = w; }
        } else {
            const int col0 = (u.pn - 8) * 128 + wc * 32 + 8 * fq;
#pragma unroll
            for (int ai = 0; ai < 2; ++ai)
#pragma unroll
                for (int m = 0; m < 4; ++m) { const size_t off = (size_t)(row0 + ai * HALF + m * 16) * 1024 + col0;
#pragma unroll
                    for (int bj = 0; bj < 2; ++bj) { const f32x4 v0 = acc[ai][bj][m][0], v1 = acc[ai][bj][m][1];
                        u32x4 w; w.x = cvt_pk_bf16(v0[0], v0[1]); w.y = cvt_pk_bf16(v0[2], v0[3]); w.z = cvt_pk_bf16(v1[0], v1[1]); w.w = cvt_pk_bf16(v1[2], v1[3]);
                        *(u32x4*)((bj ? U : GB) + off) = w; } }
        }
    }
};
struct EpiGlu {
    static constexpr bool PERM = true, AFTER_DRAIN = false;
    const bf16_t* Z; bf16_t* O; const float* bias;
    __device__ __forceinline__ void operator()(const f32x4 (&acc)[2][2][4][2], const Unit& u, int wr, int wc, int fr, int fq) const {
        const int row0 = u.pm * BM + wr * 64 + fr, col0 = u.pn * BM + wc * 32 + 8 * fq;
        f32x4 bv[2][2];
#pragma unroll
        for (int bj = 0; bj < 2; ++bj)
#pragma unroll
            for (int n = 0; n < 2; ++n) bv[bj][n] = *(const f32x4*)(bias + col0 + bj * HALF + 4 * n);
#pragma unroll
        for (int ai = 0; ai < 2; ++ai)
#pragma unroll
            for (int m = 0; m < 4; ++m) { const size_t off = (size_t)(row0 + ai * HALF + m * 16) * 1024 + col0;
#pragma unroll
                for (int bj = 0; bj < 2; ++bj) { const u32x4 zw = *(const u32x4*)(Z + off + bj * HALF);
                    const f32x4 g0 = acc[ai][bj][m][0] + bv[bj][0], g1 = acc[ai][bj][m][1] + bv[bj][1];
                    float z[8]; z[0] = __uint_as_float(zw.x << 16); z[1] = __uint_as_float(zw.x & 0xffff0000u); z[2] = __uint_as_float(zw.y << 16); z[3] = __uint_as_float(zw.y & 0xffff0000u);
                    z[4] = __uint_as_float(zw.z << 16); z[5] = __uint_as_float(zw.z & 0xffff0000u); z[6] = __uint_as_float(zw.w << 16); z[7] = __uint_as_float(zw.w & 0xffff0000u);
                    float o[8];
#pragma unroll
                    for (int j = 0; j < 4; ++j) { o[j] = z[j] / (1.0f + __expf(-g0[j])); o[4 + j] = z[4 + j] / (1.0f + __expf(-g1[j])); }
                    u32x4 w; w.x = cvt_pk_bf16(o[0], o[1]); w.y = cvt_pk_bf16(o[2], o[3]); w.z = cvt_pk_bf16(o[4], o[5]); w.w = cvt_pk_bf16(o[6], o[7]);
                    *(u32x4*)(O + off + bj * HALF) = w; } }
    }
};
typedef unsigned u32x2 __attribute__((ext_vector_type(2)));
struct EpiFfn {
    static constexpr bool PERM = true, AFTER_DRAIN = false;
    bf16_t* ACT; const float* fw; PG8_LAS float* xch;
    static __device__ __forceinline__ float ror8(float v) { return __builtin_bit_cast(float, __builtin_amdgcn_mov_dpp(__builtin_bit_cast(int, v), 0x128  , 0xf, 0xf, true)); }
    static __device__ __forceinline__ f32x4 shx8(const f32x4 v) { f32x4 r; r[0] = ror8(v[0]); r[1] = ror8(v[1]); r[2] = ror8(v[2]); r[3] = ror8(v[3]); return r; }
    static __device__ __forceinline__ f32x4 shl(const f32x4 v, int src) { f32x4 r; r[0] = __shfl(v[0], src); r[1] = __shfl(v[1], src); r[2] = __shfl(v[2], src); r[3] = __shfl(v[3], src); return r; }
    static __device__ __forceinline__ f32x4 sel(bool c, const f32x4 a, const f32x4 b) { f32x4 r; r[0] = c ? a[0] : b[0]; r[1] = c ? a[1] : b[1]; r[2] = c ? a[2] : b[2]; r[3] = c ? a[3] : b[3]; return r; }
    __device__ __forceinline__ void operator()(const f32x4 (&acc)[2][2][4][2], const Unit& u, int wr, int wc, int fr, int fq) const {
        const bool ctx = u.pm < 16, h = (fr >> 3) != 0;
        const int c7 = fr & 7, lane = fq * 16 + fr, ch0 = u.pn * 128 + wc * 32 + 8 * fq;
        const f32x4 zero = {0.f, 0.f, 0.f, 0.f};
        f32x4 wa[2][3], wg[2][3];
#pragma unroll
        for (int k = 0; k < 3; ++k) { wa[0][k] = *(const f32x4*)(fw + k * (2 * 5632) + ch0); wg[0][k] = *(const f32x4*)(fw + k * (2 * 5632) + 5632 + ch0); }
        if (ctx) {
            if (wr == 0 && fr == 15) { PG8_LAS f32x4* p = (PG8_LAS f32x4*)(xch + ((wc * 2 + 0) * 4 + fq) * 16); p[0] = acc[1][0][3][0]; p[1] = acc[1][0][3][1]; p[2] = acc[1][1][3][0]; p[3] = acc[1][1][3][1]; }
            if (wr == 1 && fr == 0)  { PG8_LAS f32x4* p = (PG8_LAS f32x4*)(xch + ((wc * 2 + 1) * 4 + fq) * 16); p[0] = acc[0][0][0][0]; p[1] = acc[0][0][0][1]; p[2] = acc[0][1][0][0]; p[3] = acc[0][1][0][1]; }
            asm volatile("s_waitcnt lgkmcnt(0)" ::: "memory"); __builtin_amdgcn_s_barrier(); asm volatile("" ::: "memory");
        }
        const int srcp = (lane + 7) & 63, srcn = (lane - 7) & 63;
        u32x2 keep[8];
#pragma unroll
        for (int n = 0; n < 2; ++n) {
            f32x4 bpa = shl(acc[1][0][3][n], srcp), bpg = shl(acc[1][1][3][n], srcp), bna = shl(acc[0][0][0][n], srcn), bng = shl(acc[0][1][0][n], srcn);
            if (ctx) {
                const PG8_LAS f32x4* p0 = (const PG8_LAS f32x4*)(xch + ((wc * 2 + 0) * 4 + fq) * 16); const PG8_LAS f32x4* p1 = (const PG8_LAS f32x4*)(xch + ((wc * 2 + 1) * 4 + fq) * 16);
                const f32x4 xpa = p0[n], xpg = p0[2 + n], xna = p1[n], xng = p1[2 + n];
                bpa = sel(c7 >= 1, bpa, sel(wr == 1, xpa, zero)); bpg = sel(c7 >= 1, bpg, sel(wr == 1, xpg, zero));
                bna = sel(c7 <= 6, bna, sel(wr == 0, xna, zero)); bng = sel(c7 <= 6, bng, sel(wr == 0, xng, zero));
            } else { bpa = zero; bpg = zero; bna = zero; bng = zero; }
            if (n == 0) {
#pragma unroll
                for (int k = 0; k < 3; ++k) { wa[1][k] = *(const f32x4*)(fw + k * (2 * 5632) + ch0 + 4); wg[1][k] = *(const f32x4*)(fw + k * (2 * 5632) + 5632 + ch0 + 4); }
            }
            f32x4 ea0 = shx8(acc[0][0][0][n]), eg0 = shx8(acc[0][1][0][n]);
            f32x4 pa = sel(h, ea0, bpa), pg = sel(h, eg0, bpg);
#pragma unroll
            for (int s = 0; s < 8; ++s) { const int ai = s >> 2, m = s & 3;
                const f32x4 eap = s < 7 ? shx8(acc[(s + 1) >> 2][0][(s + 1) & 3][n]) : bna, egp = s < 7 ? shx8(acc[(s + 1) >> 2][1][(s + 1) & 3][n]) : bng;
                const f32x4 xa = acc[ai][0][m][n], xg = acc[ai][1][m][n];
                const f32x4 na = sel(h, eap, ea0), ng = sel(h, egp, eg0);
                const f32x4 ca = wa[n][0] * pa + wa[n][1] * xa + wa[n][2] * na, cg = wg[n][0] * pg + wg[n][1] * xg + wg[n][2] * ng;
                const f32x4 t = cg * ca, ex = cg * (-1.442695041f);
                f32x4 den; den[0] = __builtin_amdgcn_exp2f(ex[0]); den[1] = __builtin_amdgcn_exp2f(ex[1]); den[2] = __builtin_amdgcn_exp2f(ex[2]); den[3] = __builtin_amdgcn_exp2f(ex[3]);
                den = den + 1.0f;
                f32x4 rc; rc[0] = __builtin_amdgcn_rcpf(den[0]); rc[1] = __builtin_amdgcn_rcpf(den[1]); rc[2] = __builtin_amdgcn_rcpf(den[2]); rc[3] = __builtin_amdgcn_rcpf(den[3]);
                const f32x4 o = t * rc;
                u32x2 w; w.x = cvt_pk_bf16(o[0], o[1]); w.y = cvt_pk_bf16(o[2], o[3]);
                if (n == 0) keep[s] = w;
                else { u32x4 w4; w4.x = keep[s].x; w4.y = keep[s].y; w4.z = w.x; w4.w = w.y; *(u32x4*)(ACT + (size_t)(u.pm * BM + ai * HALF + wr * 64 + m * 16 + fr) * 5632 + ch0) = w4; }
                pa = na; pg = ng; ea0 = eap; eg0 = egp;
            }
        }
    }
};
struct G4Order {
    int lo, hi, G, c; bool plain;
    __device__ __forceinline__ bool next(int i, Unit& u) const {
        const int L = lo + i * G + c; if (L >= hi) return false;
        StaticOrder so; so.init(24 * BM, 44 * BM, 1, 0);
        if (plain) return so.next(L, u);
        if (L >= 1024) { u.pm = 23; u.pn = 12 + (L - 1024); return true; }
        so.next(L, u); if (u.pm == 23 && u.pn >= 12) so.next(1024 + u.pn - 12, u);
        return true;
    }
    __device__ __forceinline__ void a_ready(const Unit&) const {}
    __device__ __forceinline__ void done(const Unit&) const {}
};
struct G5Order {
    bool st; StaticOrder so; Unit u0;
    __device__ __forceinline__ bool next(int i, Unit& u) const { if (st) return so.next(i, u); if (i != 0 || u0.pm < 0) return false; u = u0; return true; }
    __device__ __forceinline__ void a_ready(const Unit&) const {}
    __device__ __forceinline__ void done(const Unit&) const {}
};
}

__device__ __forceinline__ void cvt_load(const float* __restrict__ W, int N, int k0, int n0, int tid, f32x4 (&r0)[4], f32x4 (&r1)[4]) {
    const int n4 = tid & 31, kp = tid >> 5;
#pragma unroll
    for (int i = 0; i < 4; ++i) { const float* p = W + (size_t)(k0 + 2 * kp + 32 * i) * N + n0 + 4 * n4; r0[i] = __builtin_nontemporal_load((const f32x4*)p); r1[i] = __builtin_nontemporal_load((const f32x4*)(p + N)); }
}
__device__ __forceinline__ void cvt_put(LAS unsigned* T, int tid, const f32x4 (&r0)[4], const f32x4 (&r1)[4]) {
    const int n4 = tid & 31, kp = tid >> 5;
#pragma unroll
    for (int i = 0; i < 4; ++i)
#pragma unroll
        for (int e = 0; e < 4; ++e) T[(4 * n4 + e) * 65 + kp + 16 * i] = pk2(r0[i][e], r1[i][e]);
}
__device__ __forceinline__ void cvt_store(const LAS unsigned* T, bf16* __restrict__ Bt, int K, int k0, int j0, int tid) {
    const int n = tid >> 2, kc = tid & 3;
    unsigned w[16];
#pragma unroll
    for (int i = 0; i < 16; ++i) w[i] = T[n * 65 + 16 * kc + i];
    v4u* dst = (v4u*)(Bt + (size_t)(j0 + n) * K + k0 + 32 * kc);
#pragma unroll
    for (int q = 0; q < 4; ++q) { v4u o; o.x = w[4 * q]; o.y = w[4 * q + 1]; o.z = w[4 * q + 2]; o.w = w[4 * q + 3]; dst[q] = o; }
}
constexpr int CVT_PER_LAYER = 512 + 64 + 256 + 1408 + 704;
struct CvtD { const float* W; bf16* Bt; int N, K, k0, n0, j0; };
__device__ __forceinline__ CvtD cvt_desc(const DArgs& a, int it) {
    const int l = it / CVT_PER_LAYER; int r = it % CVT_PER_LAYER;
    const float* W; bf16* Bt; int N, K, jb, kb, n0;
    if (r < 512) { N = INC; K = DM; W = a.in[I_WIN] + (size_t)l * K * N; Bt = (bf16*)(a.ws + WS_WIN) + (size_t)l * N * K; kb = r >> 5; jb = r & 31;
        const int pn = jb >> 1, bj = jb & 1; n0 = pn < 8 ? ((bj ? 2048 : 1024) + 128 * pn) : ((bj ? 3072 : 0) + 128 * (pn - 8)); }
    else if (r < 576) { r -= 512; N = SW; K = SW; W = a.in[I_WGLU] + (size_t)l * K * N; Bt = (bf16*)(a.ws + WS_WGLU) + (size_t)l * N * K; kb = r >> 3; jb = r & 7; n0 = 128 * jb; }
    else if (r < 832) { r -= 576; N = DM; K = DM; W = a.in[I_WOUT] + (size_t)l * K * N; Bt = (bf16*)(a.ws + WS_WOUT) + (size_t)l * N * K; kb = r >> 4; jb = r & 15; n0 = 128 * jb; }
    else if (r < 2240) { r -= 832; N = UPN; K = DM; W = a.in[I_WUP] + (size_t)l * K * N; Bt = (bf16*)(a.ws + WS_WUP) + (size_t)l * N * K; kb = r / 88; jb = r % 88; n0 = ((jb & 1) ? DFF : 0) + 128 * (jb >> 1); }
    else { r -= 2240; N = DM; K = DFF; W = a.in[I_WDOWN] + (size_t)l * K * N; Bt = (bf16*)(a.ws + WS_WDN) + (size_t)l * N * K; kb = r >> 4; jb = r & 15; n0 = 128 * jb; }
    CvtD d; d.W = W; d.Bt = Bt; d.N = N; d.K = K; d.k0 = 128 * kb; d.n0 = n0; d.j0 = 128 * jb; return d;
}

constexpr int CW_CVT = 8192;
#define CVT_LDS_BAR() asm volatile("s_waitcnt lgkmcnt(0)\n\ts_barrier" ::: "memory")
constexpr int CVT_S0 = 2240;
__device__ __forceinline__ int cvt_fill(LAS unsigned char* lds, int tid_, int ln, int budget  , int stream = 0) {
    const int tid = fresh_v(tid_);
    volatile LAS unsigned* tk = (volatile LAS unsigned*)(lds + MISC_OFF) + 16;
    LAS unsigned* T0 = (LAS unsigned*)lds; LAS unsigned* T1 = T0 + 128 * 65;
    const int npairs = budget < 0 ? 0x7fffffff : (budget + 1) / 2;
    if (npairs <= 0) return 0;
    const int base = stream ? CVT_S0 : 0, count = stream ? CVT_PER_LAYER - CVT_S0 : CVT_S0, cw = CW_CVT + 64 * (stream ? 5 + ln : ln);
    if (tid == 0) { const DArgs a = load_args(); tk[0] = __hip_atomic_fetch_add((unsigned*)(a.ws + WS_CTL) + cw, 1u, __ATOMIC_RELAXED, __HIP_MEMORY_SCOPE_AGENT); }
    __syncthreads();
    int n = 0;
    for (; n < npairs; ++n) {
        const unsigned t = tk[n & 1];
        if (2u * t >= (unsigned)count) break;
        const DArgs a = load_args();
        unsigned nx = 0xffffffffu;
        if (tid == 0 && n + 1 < npairs) nx = __hip_atomic_fetch_add((unsigned*)(a.ws + WS_CTL) + cw, 1u, __ATOMIC_RELAXED, __HIP_MEMORY_SCOPE_AGENT);
        const CvtD d0 = cvt_desc(a, ln * CVT_PER_LAYER + base + 2 * (int)t), d1 = cvt_desc(a, ln * CVT_PER_LAYER + base + 2 * (int)t + 1);
        f32x4 a0[4], a1[4], b0[4], b1[4];
        cvt_load(d0.W, d0.N, d0.k0, d0.n0, tid, a0, a1); cvt_load(d1.W, d1.N, d1.k0, d1.n0, tid, b0, b1);
        cvt_put(T0, tid, a0, a1); cvt_put(T1, tid, b0, b1);
        if (tid == 0) tk[(n + 1) & 1] = nx;
        CVT_LDS_BAR();
        cvt_store(T0, d0.Bt, d0.K, d0.k0, d0.j0, tid); cvt_store(T1, d1.Bt, d1.K, d1.k0, d1.j0, tid);
        CVT_LDS_BAR();
    }
    __syncthreads();
    return 2 * n;
}
__device__ __forceinline__ void cvt_slot(LAS unsigned char* lds, int tid, int l, bool has_next, int budget) {
    const int done = cvt_fill(lds, tid, l, budget, 1);
    if (has_next && done < budget) cvt_fill(lds, tid, l + 1, budget - done, 0);
}
__device__ __forceinline__ void mod_task(LAS unsigned char* lds, int tid_, int lane_, int wave_, int task) {
    const DArgs a = load_args(); const int tid = fresh_v(tid_), lane = fresh_v(lane_), wave = fresh_s(wave_);
    LAS float* SC = (LAS float*)(lds + 36864);
    LAS float* RED = (LAS float*)(lds + 36864 + 24576);
    const int l = task / 48, j0 = (task % 48) * 256;
    for (int i = tid; i < 3 * DM; i += 512) { const int v = i >> 11, k = i & 2047; const float x = v == 0 ? a.in[I_CCTX][k] : a.in[I_C][(v - 1) * DM + k]; SC[i] = x / (1.0f + __expf(-x)); }
    __syncthreads();
    const float* W = a.in[I_WADA] + (size_t)l * DM * 12288 + j0 + 4 * lane;
    f32x4 a0 = {0.f, 0.f, 0.f, 0.f}, a1 = a0, a2 = a0;
    const int kbeg = wave * 256;
    for (int k = kbeg; k < kbeg + 256; k += 8) {
        f32x4 w[8];
#pragma unroll
        for (int u = 0; u < 8; ++u) w[u] = __builtin_nontemporal_load((const f32x4*)(W + (size_t)(k + u) * 12288));
#pragma unroll
        for (int u = 0; u < 8; ++u) { const float s0 = SC[k + u], s1 = SC[2048 + k + u], s2 = SC[4096 + k + u]; a0 += w[u] * s0; a1 += w[u] * s1; a2 += w[u] * s2; }
    }
    *(LAS f32x4*)(RED + (wave * 3 + 0) * 256 + 4 * lane) = a0;
    *(LAS f32x4*)(RED + (wave * 3 + 1) * 256 + 4 * lane) = a1;
    *(LAS f32x4*)(RED + (wave * 3 + 2) * 256 + 4 * lane) = a2;
    __syncthreads();
    float* MOD = (float*)(a.ws + WS_MOD);
    for (int i = tid; i < 768; i += 512) { const int v = i >> 8, jj = i & 255; float s = a.in[I_BADA][l * 12288 + j0 + jj];
#pragma unroll
        for (int w8 = 0; w8 < 8; ++w8) s += RED[(w8 * 3 + v) * 256 + jj];
        const int ch = (j0 + jj) >> 11, e = (j0 + jj) & 2047;
        if (ch == 1) s = (1.0f + s) * a.in[I_GPRE1][l * DM + e]; else if (ch == 2) s *= a.in[I_GPOST1][l * DM + e];
        else if (ch == 4) s = (1.0f + s) * a.in[I_GPRE2][l * DM + e]; else if (ch == 5) s *= a.in[I_GPOST2][l * DM + e];
        MOD[(size_t)(l * 3 + v) * 12288 + j0 + jj] = s; }
    __syncthreads();
}

__device__ __forceinline__ void mod_task64(LAS unsigned char* lds, int tid_, int lane_, int wave_, int l, int task) {
    const DArgs a = load_args(); const int tid = fresh_v(tid_), lane = fresh_v(lane_), wave = fresh_s(wave_);
    LAS float* SC = (LAS float*)(lds + 36864);
    LAS float* RED = (LAS float*)(lds + 36864 + 24576);
    const int j0 = task * 64, c4 = lane & 15, rsub = lane >> 4;
    for (int i = tid; i < 3 * DM; i += 512) { const int v = i >> 11, k = i & 2047; const float x = v == 0 ? a.in[I_CCTX][k] : a.in[I_C][(v - 1) * DM + k]; SC[i] = x / (1.0f + __expf(-x)); }
    __syncthreads();
    const float* W = a.in[I_WADA] + (size_t)l * DM * 12288 + j0 + 4 * c4;
    f32x4 a0 = {0.f, 0.f, 0.f, 0.f}, a1 = a0, a2 = a0;
    const int kbeg = wave * 256;
    for (int k = kbeg; k < kbeg + 256; k += 32) {
        f32x4 w[8];
#pragma unroll
        for (int u = 0; u < 8; ++u) w[u] = __builtin_nontemporal_load((const f32x4*)(W + (size_t)(k + 4 * u + rsub) * 12288));
#pragma unroll
        for (int u = 0; u < 8; ++u) { const int kk = k + 4 * u + rsub; const float s0 = SC[kk], s1 = SC[2048 + kk], s2 = SC[4096 + kk]; a0 += w[u] * s0; a1 += w[u] * s1; a2 += w[u] * s2; }
    }
#pragma unroll
    for (int i = 0; i < 4; ++i) { a0[i] += __shfl_xor(a0[i], 16); a0[i] += __shfl_xor(a0[i], 32); a1[i] += __shfl_xor(a1[i], 16); a1[i] += __shfl_xor(a1[i], 32); a2[i] += __shfl_xor(a2[i], 16); a2[i] += __shfl_xor(a2[i], 32); }
    if (rsub == 0) { *(LAS f32x4*)(RED + (wave * 3 + 0) * 64 + 4 * c4) = a0; *(LAS f32x4*)(RED + (wave * 3 + 1) * 64 + 4 * c4) = a1; *(LAS f32x4*)(RED + (wave * 3 + 2) * 64 + 4 * c4) = a2; }
    __syncthreads();
    float* MOD = (float*)(a.ws + WS_MOD);
    if (tid < 192) { const int v = tid >> 6, jj = tid & 63; float s = a.in[I_BADA][l * 12288 + j0 + jj];
#pragma unroll
        for (int w8 = 0; w8 < 8; ++w8) s += RED[(w8 * 3 + v) * 64 + jj];
        const int ch = (j0 + jj) >> 11, e = (j0 + jj) & 2047;
        if (ch == 1) s = (1.0f + s) * a.in[I_GPRE1][l * DM + e]; else if (ch == 2) s *= a.in[I_GPOST1][l * DM + e];
        else if (ch == 4) s = (1.0f + s) * a.in[I_GPRE2][l * DM + e]; else if (ch == 5) s *= a.in[I_GPOST2][l * DM + e];
        MOD[(size_t)(l * 3 + v) * 12288 + j0 + jj] = s; }
    __syncthreads();
}

__device__ __forceinline__ int mod_vec(int row) { return row < NCTX ? 0 : 1 + ((row - NCTX) >> 10); }
__device__ __forceinline__ int perm_row(int row) {
    int gr, cc, base;
    if (row < NCTX) { const int t = row & 255; gr = t & 15; cc = t >> 4; base = row & ~255; }
    else { const int q = row - NCTX, p = q & 1023; gr = p >> 6; cc = p & 15; base = NCTX + ((q >> 10) * 4 + ((p >> 4) & 3)) * 256; }
    return base + 128 * (gr >> 3) + 64 * (cc >> 3) + 16 * ((gr >> 1) & 3) + 8 * (gr & 1) + (cc & 7);
}
constexpr size_t WS_XH = WS_UP + 8 * MiB, WS_XL = WS_UP + 40 * MiB;
__device__ __forceinline__ void x24_load(const unsigned char* ws, int row, int e0, float (&o)[8]) {
    const v4u h = __builtin_nontemporal_load((const v4u*)((const unsigned short*)(ws + WS_XH) + (size_t)row * DM + e0)); const v2u lo = __builtin_nontemporal_load((const v2u*)(ws + WS_XL + (size_t)row * DM + e0));
    const unsigned hw[4] = {h.x, h.y, h.z, h.w}, lw[2] = {lo.x, lo.y};
#pragma unroll
    for (int i = 0; i < 8; ++i) { const unsigned hi = (i & 1) ? (hw[i >> 1] & 0xffff0000u) : (hw[i >> 1] << 16); const unsigned l8 = (lw[i >> 2] >> (8 * (i & 3))) & 0xffu; o[i] = __uint_as_float(hi | (l8 << 8)); }
}
__device__ __forceinline__ void x24_store(unsigned char* ws, int row, int e0, const float (&x)[8]) {
    unsigned b[8];
#pragma unroll
    for (int i = 0; i < 8; ++i) b[i] = __float_as_uint(x[i]) + 0x80u;
    v4u h; h.x = (b[0] >> 16) | (b[1] & 0xffff0000u); h.y = (b[2] >> 16) | (b[3] & 0xffff0000u); h.z = (b[4] >> 16) | (b[5] & 0xffff0000u); h.w = (b[6] >> 16) | (b[7] & 0xffff0000u);
    v2u lo; lo.x = ((b[0] >> 8) & 0xffu) | (b[1] & 0xff00u) | ((b[2] << 8) & 0xff0000u) | ((b[3] << 16) & 0xff000000u); lo.y = ((b[4] >> 8) & 0xffu) | (b[5] & 0xff00u) | ((b[6] << 8) & 0xff0000u) | ((b[7] << 16) & 0xff000000u);
    __builtin_nontemporal_store(h, (v4u*)((unsigned short*)(ws + WS_XH) + (size_t)row * DM + e0)); __builtin_nontemporal_store(lo, (v2u*)(ws + WS_XL + (size_t)row * DM + e0));
}
template <int MODE>
__device__ __forceinline__ void row_pass(int l, int bx_, int G_, int wave_, int lane_, bool split23 = false) {
    const int bx = fresh_s(bx_), G = fresh_s(G_), wave = fresh_s(wave_), lane = fresh_v(lane_);
    constexpr bool FIRST = (MODE == 0), HAS_NEXT = (MODE != 3);
    const DArgs a = load_args();
    const float* MOD = (const float*)(a.ws + WS_MOD);
    const float* modl = MOD + (size_t)l * 3 * 12288;
    const bf16* Y = (const bf16*)(a.ws + (MODE == 1 ? WS_MIXED : WS_FF));
    const float* modg = modl + (MODE == 1 ? 2 : 5) * DM;
    const float* modn = MODE == 2 ? modl + 3 * 12288 : modl;
    const int sc_off = (MODE == 1 ? 4 : 1) * DM, sh_off = (MODE == 1 ? 3 : 0) * DM;
    bf16* Hdst = (bf16*)(a.ws + WS_H);
    const int rpw = (NTOK + G * NWAVES - 1) / (G * NWAVES), rbeg = (bx * NWAVES + wave) * rpw, rend = rbeg + rpw < NTOK ? rbeg + rpw : NTOK;
    int vprev = -1;
    f32x4 gv[8], cv[8], hv[8];
#pragma unroll
    for (int j = 0; j < 8; ++j) { gv[j] = (f32x4){0.f, 0.f, 0.f, 0.f}; cv[j] = gv[j]; hv[j] = gv[j]; }
    for (int row = rbeg; row < rend; ++row) {
        const int v = mod_vec(row);
        if (v != vprev) { vprev = v;
#pragma unroll
            for (int j = 0; j < 4; ++j) { const int e0 = 8 * lane + 512 * j;
                if (!FIRST) { const float* gate = modg + (size_t)v * 12288; gv[2 * j] = *(const f32x4*)(gate + e0); gv[2 * j + 1] = *(const f32x4*)(gate + e0 + 4); }
                if (HAS_NEXT) { const float* sc = modn + (size_t)v * 12288 + sc_off; const float* sh = modn + (size_t)v * 12288 + sh_off;
                    cv[2 * j] = *(const f32x4*)(sc + e0); cv[2 * j + 1] = *(const f32x4*)(sc + e0 + 4); hv[2 * j] = *(const f32x4*)(sh + e0); hv[2 * j + 1] = *(const f32x4*)(sh + e0 + 4); } } }
        float* xr = a.out + (size_t)row * DM;
        float x[32];
        if (FIRST) {
            const float* src = row < NCTX ? a.in[I_XP] + (size_t)row * DM : a.in[I_XS] + (size_t)(row - NCTX) * DM;
#pragma unroll
            for (int j = 0; j < 4; ++j) { const f32x4 p = __builtin_nontemporal_load((const f32x4*)(src + 8 * lane + 512 * j)), q = __builtin_nontemporal_load((const f32x4*)(src + 8 * lane + 512 * j + 4));
                x[8 * j] = p[0]; x[8 * j + 1] = p[1]; x[8 * j + 2] = p[2]; x[8 * j + 3] = p[3]; x[8 * j + 4] = q[0]; x[8 * j + 5] = q[1]; x[8 * j + 6] = q[2]; x[8 * j + 7] = q[3];
                const float t8[8] = {p[0], p[1], p[2], p[3], q[0], q[1], q[2], q[3]}; x24_store(a.ws, row, 8 * lane + 512 * j, t8); }
        } else {
            float y[32]; float ssq = 0.f;
            const int pr = MODE == 1 ? row : perm_row(row);
            const bool sp23 = MODE != 1 && split23 && pr >= 23 * 256;
            const bf16* yr = sp23 ? (const bf16*)(a.ws + WS_FFP) + (size_t)(pr - 23 * 256) * DM : Y + (size_t)pr * DM;
#pragma unroll
            for (int j = 0; j < 4; ++j) { const v4u w = __builtin_nontemporal_load((const v4u*)(yr + 8 * lane + 512 * j)); float t[8]; unpack8(w, t);
                if (sp23) {
#pragma unroll
                    for (int sp = 1; sp < 4; ++sp) { float t2[8]; unpack8(*(const v4u*)(yr + (size_t)sp * 256 * DM + 8 * lane + 512 * j), t2);
#pragma unroll
                        for (int i = 0; i < 8; ++i) t[i] += t2[i]; } }
#pragma unroll
                for (int i = 0; i < 8; ++i) { y[8 * j + i] = t[i]; ssq += t[i] * t[i]; } }
            ssq = wave_sum(ssq);
            const float rs = 1.0f / sqrtf(ssq * (1.0f / DM) + EPS);
#pragma unroll
            for (int j = 0; j < 4; ++j) { const int e0 = 8 * lane + 512 * j;
                float xo[8]; x24_load(a.ws, row, e0, xo);
                const f32x4 g0 = gv[2 * j], g1 = gv[2 * j + 1];
                f32x4 np, nq;
#pragma unroll
                for (int i = 0; i < 4; ++i) { np[i] = xo[i] + g0[i] * (y[8 * j + i] * rs); nq[i] = xo[4 + i] + g1[i] * (y[8 * j + 4 + i] * rs); x[8 * j + i] = np[i]; x[8 * j + 4 + i] = nq[i]; }
                if (MODE == 3) { __builtin_nontemporal_store(np, (f32x4*)(xr + e0)); __builtin_nontemporal_store(nq, (f32x4*)(xr + e0 + 4)); }
                else { const float t8[8] = {np[0], np[1], np[2], np[3], nq[0], nq[1], nq[2], nq[3]}; x24_store(a.ws, row, e0, t8); } }
        }
        if (HAS_NEXT) {
            float ssq = 0.f;
#pragma unroll
            for (int i = 0; i < 32; ++i) ssq += x[i] * x[i];
            ssq = wave_sum(ssq);
            const float rs = 1.0f / sqrtf(ssq * (1.0f / DM) + EPS);
            bf16* hr = Hdst + (size_t)(MODE == 1 ? perm_row(row) : row) * DM;
#pragma unroll
            for (int j = 0; j < 4; ++j) { const int e0 = 8 * lane + 512 * j;
                const f32x4 c0 = cv[2 * j], c1 = cv[2 * j + 1], h0 = hv[2 * j], h1 = hv[2 * j + 1];
                float o[8];
#pragma unroll
                for (int i = 0; i < 4; ++i) { o[i] = x[8 * j + i] * rs * c0[i] + h0[i]; o[4 + i] = x[8 * j + 4 + i] * rs * c1[i] + h1[i]; }
                *(v4u*)(hr + e0) = pack8(o); }
        }
    }
}

__device__ __forceinline__ void mix_pass(int bx_, int G_, int wave_, int lane_, int l) {
    const DArgs a = load_args(); const int bx = fresh_s(bx_), G = fresh_s(G_), wave = fresh_s(wave_), lane = fresh_v(lane_);
    const bf16* GB = (const bf16*)(a.ws + WS_GB); const bf16* V = (const bf16*)(a.ws + WS_V); const bf16* O = (const bf16*)(a.ws + WS_O); bf16* MX = (bf16*)(a.ws + WS_MIXIN);
    const float* cw = a.in[I_CONVW] + (size_t)l * 3 * CW; const float* gc = a.in[I_GCONV] + (size_t)l * CW; const float* gs = a.in[I_GSSM] + (size_t)l * SW;
    float w0r[16], w1r[16], w2r[16], gcr[16], gsr[16];
#pragma unroll
    for (int j = 0; j < 2; ++j) { const int c0 = 8 * lane + 512 * j;
#pragma unroll
        for (int hq = 0; hq < 2; ++hq) { const f32x4 t0 = *(const f32x4*)(cw + c0 + 4 * hq), t1 = *(const f32x4*)(cw + CW + c0 + 4 * hq), t2 = *(const f32x4*)(cw + 2 * CW + c0 + 4 * hq),
                                               t3 = *(const f32x4*)(gc + c0 + 4 * hq), t4 = *(const f32x4*)(gs + c0 + 4 * hq);
#pragma unroll
            for (int i = 0; i < 4; ++i) { w0r[8 * j + 4 * hq + i] = t0[i]; w1r[8 * j + 4 * hq + i] = t1[i]; w2r[8 * j + 4 * hq + i] = t2[i]; gcr[8 * j + 4 * hq + i] = t3[i]; gsr[8 * j + 4 * hq + i] = t4[i]; } } }
    const int rpw = (NTOK + G * NWAVES - 1) / (G * NWAVES), rbeg = (bx * NWAVES + wave) * rpw, rend = rbeg + rpw < NTOK ? rbeg + rpw : NTOK;
    for (int row = rbeg; row < rend; ++row) {
        bool hp, hn;
        if (row < NCTX) { const int t = row & 255; hp = t > 0; hn = t < 255; } else { const int c = (row - NCTX) & 63; hp = c > 0; hn = c < 63; }
#pragma unroll
        for (int j = 0; j < 2; ++j) { const int c0 = 8 * lane + 512 * j; const size_t off = (size_t)row * CW + c0;
            float vc[8], vp[8], vn[8], gb[8];
            unpack8(*(const v4u*)(V + off), vc); unpack8(__builtin_nontemporal_load((const v4u*)(GB + off)), gb);
            if (hp) unpack8(*(const v4u*)(V + off - CW), vp); else {
#pragma unroll
                for (int i = 0; i < 8; ++i) vp[i] = 0.f; }
            if (hn) unpack8(*(const v4u*)(V + off + CW), vn); else {
#pragma unroll
                for (int i = 0; i < 8; ++i) vn[i] = 0.f; }
            float o[8]; float ssq = 0.f;
#pragma unroll
            for (int i = 0; i < 8; ++i) { o[i] = gb[i] * (w0r[8 * j + i] * vp[i] + w1r[8 * j + i] * vc[i] + w2r[8 * j + i] * vn[i]); ssq += o[i] * o[i]; }
            ssq += __shfl_xor(ssq, 1); ssq += __shfl_xor(ssq, 2); ssq += __shfl_xor(ssq, 4);
            const float rs = 1.0f / sqrtf(ssq * (1.0f / 64.0f) + EPS);
#pragma unroll
            for (int i = 0; i < 8; ++i) o[i] = o[i] * rs * gcr[8 * j + i];
            *(v4u*)(MX + (size_t)row * DM + c0) = pack8(o); }
        float s[16]; float ssq = 0.f;
#pragma unroll
        for (int j = 0; j < 2; ++j) { float t[8]; unpack8(__builtin_nontemporal_load((const v4u*)(O + (size_t)row * SW + 8 * lane + 512 * j)), t);
#pragma unroll
            for (int i = 0; i < 8; ++i) { s[8 * j + i] = t[i]; ssq += t[i] * t[i]; } }
        ssq = wave_sum(ssq);
        const float rs = 1.0f / sqrtf(ssq * (1.0f / SW) + EPS);
#pragma unroll
        for (int j = 0; j < 2; ++j) { const int c0 = 8 * lane + 512 * j; float o[8];
#pragma unroll
            for (int i = 0; i < 8; ++i) o[i] = s[8 * j + i] * rs * gsr[8 * j + i];
            *(v4u*)(MX + (size_t)row * DM + CW + c0) = pack8(o); }
    }
}

struct S5C { bf16x8 Bf[2][4]; float ar[2][2], ai[2][2]; };
__device__ __forceinline__ void s5_setup(const DArgs& a, LAS unsigned char* lds, int lane, int wave, int l, int g, S5C& c) {
    const int n = lane & 31, hf = lane >> 5, tq = lane & 15, q = lane >> 4;
    LAS unsigned char* CFB = lds + 135168;
    LAS float* A16 = (LAS float*)(lds + 143360);
#pragma unroll
    for (int d = 0; d < 2; ++d) {
        const int pg = (l * 2 + d) * 64 + g;
        const float dt = expf(a.in[I_LOGDT][pg]);
#pragma unroll
        for (int s = 0; s < 2; ++s) { const int nn = n + 32 * s;
            const float are = a.in[I_ARE][pg * 64 + nn], aim = a.in[I_AIM][pg * 64 + nn];
            const float er = expf(are * dt); float sn, cs; sincos_cw(aim * dt, sn, cs);
            const float abr = er * cs, abi = er * sn; c.ar[d][s] = abr; c.ai[d][s] = abi;
            if (wave == 0 && hf == 0) { const float e16 = expf(16.0f * are * dt); float s16, c16; sincos_cw(16.0f * aim * dt, s16, c16); *(LAS f32x2*)(A16 + (d * 64 + nn) * 2) = (f32x2){e16 * c16, e16 * s16}; }
            const float inv = 1.0f / (are * are + aim * aim);
            const float cr = ((abr - 1.0f) * are + abi * aim) * inv, ci = (abi * are - (abr - 1.0f) * aim) * inv;
            const float* brp = a.in[I_BRE] + (unsigned)((pg * 64 + nn) * 16 + 8 * hf); const float* bip = a.in[I_BIM] + (unsigned)((pg * 64 + nn) * 16 + 8 * hf);
            const f32x4 br0 = *(const f32x4*)brp, br1 = *(const f32x4*)(brp + 4), bi0 = *(const f32x4*)bip, bi1 = *(const f32x4*)(bip + 4);
            v4u wr_, wi_;
            wr_.x = pk2(cr * br0[0] - ci * bi0[0], cr * br0[1] - ci * bi0[1]); wr_.y = pk2(cr * br0[2] - ci * bi0[2], cr * br0[3] - ci * bi0[3]);
            wr_.z = pk2(cr * br1[0] - ci * bi1[0], cr * br1[1] - ci * bi1[1]); wr_.w = pk2(cr * br1[2] - ci * bi1[2], cr * br1[3] - ci * bi1[3]);
            wi_.x = pk2(cr * bi0[0] + ci * br0[0], cr * bi0[1] + ci * br0[1]); wi_.y = pk2(cr * bi0[2] + ci * br0[2], cr * bi0[3] + ci * br0[3]);
            wi_.z = pk2(cr * bi1[0] + ci * br1[0], cr * bi1[1] + ci * br1[1]); wi_.w = pk2(cr * bi1[2] + ci * br1[2], cr * bi1[3] + ci * br1[3]);
            c.Bf[d][2 * s] = __builtin_bit_cast(bf16x8, wr_); c.Bf[d][2 * s + 1] = __builtin_bit_cast(bf16x8, wi_); }
        if (wave == 0) {
            const float* crp = a.in[I_CRE] + (unsigned)((pg * 16 + tq) * 64); const float* cip = a.in[I_CIM] + (unsigned)((pg * 16 + tq) * 64);
#pragma unroll
            for (int ks = 0; ks < 4; ++ks) { const int n0 = 8 * ks + 2 * q;
                const f32x2 cr0 = *(const f32x2*)(crp + n0), cr1 = *(const f32x2*)(crp + n0 + 32), ci0 = *(const f32x2*)(cip + n0), ci1 = *(const f32x2*)(cip + n0 + 32);
                v4u w; w.x = pk2(cr0[0], -ci0[0]); w.y = pk2(cr1[0], -ci1[0]); w.z = pk2(cr0[1], -ci0[1]); w.w = pk2(cr1[1], -ci1[1]);
                *(LAS v4u*)(CFB + ((d * 4 + ks) * 64 + lane) * 16) = w; }
        }
    }
}
__device__ __forceinline__ void s5_task(const DArgs& a, LAS unsigned char* lds, int tid, int lane, int wave, int l, int row0, int NC, int g, int bidx, bool latent, const S5C& cst, bf16x8& Afpre, int next_row0) {
#define S5_BAR() do { asm volatile("s_waitcnt lgkmcnt(0)" ::: "memory"); __builtin_amdgcn_s_barrier(); asm volatile("" ::: "memory"); } while (0)
    const int n = lane & 31, hf = lane >> 5, tq = lane & 15, q = lane >> 4;
    LAS float* EB = (LAS float*)lds;
    LAS unsigned char* SB = lds + 65536 + wave * 8704;
    const bf16* U = (const bf16*)(a.ws + WS_U); bf16* Z = (bf16*)(a.ws + WS_Z);
    LAS unsigned char* CFB = lds + 135168;
    const LAS float* A16 = (const LAS float*)(lds + 143360);
    bf16x8 Bf[2][4]; float ar[2][2], ai[2][2];
#pragma unroll
    for (int d = 0; d < 2; ++d) {
#pragma unroll
        for (int cb = 0; cb < 4; ++cb) Bf[d][cb] = cst.Bf[d][cb];
#pragma unroll
        for (int s2 = 0; s2 < 2; ++s2) { ar[d][s2] = cst.ar[d][s2]; ai[d][s2] = cst.ai[d][s2]; } }
    const f32x16 zero16 = {0.f, 0.f, 0.f, 0.f, 0.f, 0.f, 0.f, 0.f, 0.f, 0.f, 0.f, 0.f, 0.f, 0.f, 0.f, 0.f};
    const int cbit = (n >> 2) & 1, tA = (n >> 3) * 4 + (n & 3);
#define S5_PIN_BU() asm volatile("s_nop 15\n\ts_nop 15\n\ts_nop 15\n\ts_nop 15\n\ts_nop 15\n\ts_nop 15\n\ts_nop 15\n\ts_nop 15\n\ts_nop 15\n\ts_nop 15\n\ts_nop 15\n\ts_nop 15\n\ts_nop 15\n\ts_nop 15\n\ts_nop 15\n\ts_nop 15\n\ts_nop 15\n\ts_nop 15\n\ts_nop 15\n\ts_nop 15" : "+v"(acc[0]), "+v"(acc[1]), "+v"(acc[2]), "+v"(acc[3]) : "v"(Afd), "v"(Bf[d][0]), "v"(Bf[d][1]), "v"(Bf[d][2]), "v"(Bf[d][3]))
    bf16x8 Afk = {0, 0, 0, 0, 0, 0, 0, 0};
    bf16x8 Afn = Afpre;
    for (int item = wave; item < NC / 2; item += NWAVES) { const int c0 = 2 * item;
        const bf16x8 Af = Afn;
        if (item + NWAVES < NC / 2) Afn = *(const bf16x8*)(U + (unsigned)((row0 + (c0 + 2 * NWAVES + cbit) * 16 + tA) * SW + g * 16 + 8 * hf));
        Afk = Af;
#pragma unroll
        for (int d = 0; d < 2; ++d) {
            bf16x8 Afd = Af; asm volatile("" : "+v"(Afd) :: "memory");
            f32x16 acc[4];
#pragma unroll
            for (int cb = 0; cb < 4; ++cb) acc[cb] = __builtin_amdgcn_mfma_f32_32x32x16_bf16(Afd, Bf[d][cb], zero16, 0, 0, 0);
            S5_PIN_BU();
            float s0r = 0.f, s0i = 0.f, s1r = 0.f, s1i = 0.f;
#pragma unroll
            for (int ii = 0; ii < 16; ++ii) { const int i = d == 0 ? ii : 15 - ii;
                const float n0r = fmaf(ar[d][0], s0r, fmaf(-ai[d][0], s0i, acc[0][i])), n0i = fmaf(ar[d][0], s0i, fmaf(ai[d][0], s0r, acc[1][i]));
                const float n1r = fmaf(ar[d][1], s1r, fmaf(-ai[d][1], s1i, acc[2][i])), n1i = fmaf(ar[d][1], s1i, fmaf(ai[d][1], s1r, acc[3][i]));
                s0r = n0r; s0i = n0i; s1r = n1r; s1i = n1i; }
            *(LAS f32x4*)(EB + (d * 64 + c0 + hf) * 128 + 4 * n) = (f32x4){s0r, s0i, s1r, s1i};
            asm volatile("s_waitcnt lgkmcnt(0)" :: "v"(s0r), "v"(s0i), "v"(s1r), "v"(s1i) : "memory");
        }
    }
    S5_BAR();
    if (tid < 128) { const int d = tid >> 6, nn = tid & 63, pos = nn < 32 ? 4 * nn : 4 * (nn - 32) + 2;
        const f32x2 p16 = *(const LAS f32x2*)(A16 + (d * 64 + nn) * 2); const float pr = p16[0], pi = p16[1];
        const unsigned sidx = ((((unsigned)bidx * DEPTH + l) * 2 + d) * 64 + g) * 64 + nn;
        float sr = 0.f, si = 0.f;
        if (latent) { sr = a.in[I_SRE][sidx]; si = a.in[I_SIM][sidx]; }
        for (int cb8 = 0; cb8 < NC; cb8 += 8) {
            f32x2 e[8];
#pragma unroll
            for (int j = 0; j < 8; ++j) { const int c = d == 0 ? cb8 + j : NC - 1 - cb8 - j; e[j] = *(const LAS f32x2*)(EB + (d * 64 + c) * 128 + pos); }
#pragma unroll
            for (int j = 0; j < 8; ++j) { const int c = d == 0 ? cb8 + j : NC - 1 - cb8 - j; const f32x2 sv = {sr, si};
                const float nr = fmaf(pr, sr, fmaf(-pi, si, e[j][0])), ni = fmaf(pr, si, fmaf(pi, sr, e[j][1])); sr = nr; si = ni;
                *(LAS f32x2*)(EB + (d * 64 + c) * 128 + pos) = sv; }
        }
        if (!latent) { float* ns = a.out + (size_t)NTOK * DM; ns[sidx] = sr; ns[524288u + sidx] = si; }
    }
    S5_BAR();
    if (next_row0 >= 0) Afpre = *(const bf16x8*)(U + (unsigned)((next_row0 + (2 * wave + cbit) * 16 + tA) * SW + g * 16 + 8 * hf));
    if (latent) Afn = *(const bf16x8*)(U + (unsigned)((row0 + (2 * wave + cbit) * 16 + tA) * SW + g * 16 + 8 * hf));
    const f32x4 dd = *(const f32x4*)(a.in[I_SSMD] + (unsigned)(l * SW + g * 16 + 4 * q));
    for (int item = wave; item < NC / 2; item += NWAVES) { const int c0 = 2 * item;
        bf16x8 Af = Afk;
        if (latent) { Af = Afn; if (item + NWAVES < NC / 2) Afn = *(const bf16x8*)(U + (unsigned)((row0 + (c0 + 2 * NWAVES + cbit) * 16 + tA) * SW + g * 16 + 8 * hf)); }
        v2u uwv[2];
#pragma unroll
        for (int cc = 0; cc < 2; ++cc) uwv[cc] = *(const v2u*)(U + (unsigned)((row0 + (c0 + cc) * 16 + tq) * SW + g * 16 + 4 * q));
        f32x4 yacc[2] = {{0.f, 0.f, 0.f, 0.f}, {0.f, 0.f, 0.f, 0.f}};
#pragma unroll
        for (int d = 0; d < 2; ++d) {
            bf16x8 Afd = Af; asm volatile("" : "+v"(Afd) :: "memory");
            f32x16 acc[4];
#pragma unroll
            for (int cb = 0; cb < 4; ++cb) acc[cb] = __builtin_amdgcn_mfma_f32_32x32x16_bf16(Afd, Bf[d][cb], zero16, 0, 0, 0);
            S5_PIN_BU();
            const f32x4 s_in = *(const LAS f32x4*)(EB + (d * 64 + c0 + hf) * 128 + 4 * n);
            float s0r = s_in[0], s0i = s_in[1], s1r = s_in[2], s1i = s_in[3];
            v2u w[16];
#pragma unroll
            for (int ii = 0; ii < 16; ++ii) { const int i = d == 0 ? ii : 15 - ii;
                const float n0r = fmaf(ar[d][0], s0r, fmaf(-ai[d][0], s0i, acc[0][i])), n0i = fmaf(ar[d][0], s0i, fmaf(ai[d][0], s0r, acc[1][i]));
                const float n1r = fmaf(ar[d][1], s1r, fmaf(-ai[d][1], s1i, acc[2][i])), n1i = fmaf(ar[d][1], s1i, fmaf(ai[d][1], s1r, acc[3][i]));
                s0r = n0r; s0i = n0i; s1r = n1r; s1i = n1i;
                w[i].x = pk2(s0r, s0i); w[i].y = pk2(s1r, s1i); }
#pragma unroll
            for (int i = 0; i < 16; ++i) *(LAS v2u*)(SB + (hf * 16 + i) * 272 + 8 * n) = w[i];
            asm volatile("s_waitcnt lgkmcnt(0)" :: "v"(w[0]), "v"(w[1]), "v"(w[2]), "v"(w[3]), "v"(w[4]), "v"(w[5]), "v"(w[6]), "v"(w[7]), "v"(w[8]), "v"(w[9]), "v"(w[10]), "v"(w[11]), "v"(w[12]), "v"(w[13]), "v"(w[14]), "v"(w[15]) : "memory");
            {
                bf16x8 sf[2][4], cf[4];
#pragma unroll
                for (int ks = 0; ks < 4; ++ks) { cf[ks] = *(const LAS bf16x8*)(CFB + ((d * 4 + ks) * 64 + lane) * 16);
#pragma unroll
                    for (int cc = 0; cc < 2; ++cc) sf[cc][ks] = *(const LAS bf16x8*)(SB + (cc * 16 + tq) * 272 + ks * 64 + q * 16); }
                asm volatile("s_waitcnt lgkmcnt(0)" : "+v"(sf[0][0]), "+v"(sf[0][1]), "+v"(sf[0][2]), "+v"(sf[0][3]), "+v"(sf[1][0]), "+v"(sf[1][1]), "+v"(sf[1][2]), "+v"(sf[1][3]), "+v"(cf[0]), "+v"(cf[1]), "+v"(cf[2]), "+v"(cf[3]) :: "memory");
#pragma unroll
                for (int cc = 0; cc < 2; ++cc)
#pragma unroll
                    for (int ks = 0; ks < 4; ++ks) yacc[cc] = __builtin_amdgcn_mfma_f32_16x16x32_bf16(cf[ks], sf[cc][ks], yacc[cc], 0, 0, 0);
                asm volatile("s_nop 15\n\ts_nop 15\n\ts_nop 15\n\ts_nop 15\n\ts_nop 15\n\ts_nop 15\n\ts_nop 15\n\ts_nop 15\n\ts_nop 15\n\ts_nop 15\n\ts_nop 15\n\ts_nop 15\n\ts_nop 15\n\ts_nop 15\n\ts_nop 15\n\ts_nop 15" : "+v"(yacc[0]), "+v"(yacc[1]) : "v"(sf[0][0]), "v"(sf[0][1]), "v"(sf[0][2]), "v"(sf[0][3]), "v"(sf[1][0]), "v"(sf[1][1]), "v"(sf[1][2]), "v"(sf[1][3]), "v"(cf[0]), "v"(cf[1]), "v"(cf[2]), "v"(cf[3]) : "memory");
            }
        }
#pragma unroll
        for (int cc = 0; cc < 2; ++cc) { const unsigned off = (unsigned)((row0 + (c0 + cc) * 16 + tq) * SW + g * 16 + 4 * q);
            const v2u uw = uwv[cc];
            const float u0 = bflo(uw.x), u1 = bfhi(uw.x), u2 = bflo(uw.y), u3 = bfhi(uw.y);
            const float z0 = gelu_tanh(yacc[cc][0] + dd[0] * u0), z1 = gelu_tanh(yacc[cc][1] + dd[1] * u1), z2 = gelu_tanh(yacc[cc][2] + dd[2] * u2), z3 = gelu_tanh(yacc[cc][3] + dd[3] * u3);
            v2u zw; zw.x = pk2(z0, z1); zw.y = pk2(z2, z3);
            *(v2u*)(Z + off) = zw; }
    }
    S5_BAR();
}
__device__ __forceinline__ void s5_phase(LAS unsigned char* lds, int tid_, int lane_, int wave_, int bx_, int G_, int l) {
    const DArgs a = load_args(); const int tid = fresh_v(tid_), lane = fresh_v(lane_), wave = fresh_s(wave_), bx = fresh_s(bx_), G = fresh_s(G_);
    const bool bal = (G == 256);
    const int nt = bal ? (bx < 128 ? 3 : 6) : (128 + 1024 - bx + G - 1) / G;
    S5C cst; int gprev = -1; bf16x8 Afpre = {0, 0, 0, 0, 0, 0, 0, 0};
    const int lane_n = lane & 31, cbit = (lane_n >> 2) & 1, tA = (lane_n >> 3) * 4 + (lane_n & 3), hf = lane >> 5;
    const bf16* U = (const bf16*)(a.ws + WS_U);
    for (int i = 0; i < nt; ++i) {
        bool latent, latn = false; int b, g, bn = 0, gn = -1;
#define S5_TASK(ii, LAT, B, GG) do { if (bal) { if (bx < 128) { LAT = ((ii) == 0); GG = bx & 63; B = LAT ? (bx >> 6) : 2 * (bx >> 6) + ((ii) - 1); } else { const int w = bx - 128; LAT = false; GG = w >> 1; B = 4 + 6 * (w & 1) + (ii); } } \
        else { const int t = bx + (ii) * G; LAT = t < 128; const int tc = LAT ? t : t - 128; B = tc >> 6; GG = tc & 63; } } while (0)
        S5_TASK(i, latent, b, g);
        if (i + 1 < nt) S5_TASK(i + 1, latn, bn, gn);
        const int row0 = latent ? NCTX + b * 1024 : b * 256;
        const int rown = (i + 1 < nt && gn == g) ? (latn ? NCTX + bn * 1024 : bn * 256) : -1;
        if (g != gprev) { s5_setup(a, lds, lane, wave, l, g, cst); gprev = g;
            Afpre = *(const bf16x8*)(U + (unsigned)((row0 + (2 * wave + cbit) * 16 + tA) * SW + g * 16 + 8 * hf)); }
        s5_task(a, lds, tid, lane, wave, l, row0, latent ? 64 : 16, g, b, latent, cst, Afpre, rown);
#undef S5_TASK
    }
}
#define XB_TMO      128
#define XB_XCNT(j)  (256  + 64 * (j))
#define XB_XSUB(j)  (1280 + 64 * (j))
#define XB_XGEN(j)  (2304 + 64 * (j))
#define XB_TOP      3328
#define XB_TOPGEN   3392
#define XCD_BAR_WORDS 3456
#define XB_SPIN_CAP (1u << 18)

__device__ __forceinline__ unsigned xb_ld(unsigned* p)              { return __hip_atomic_load(p, __ATOMIC_RELAXED, __HIP_MEMORY_SCOPE_AGENT); }
__device__ __forceinline__ unsigned xb_add(unsigned* p, unsigned v) { return __hip_atomic_fetch_add(p, v, __ATOMIC_RELAXED, __HIP_MEMORY_SCOPE_AGENT); }
__device__ __forceinline__ unsigned xb_xcc_id() { return (unsigned)__builtin_amdgcn_s_getreg((3 << 11) | 20) & 0xFu; }
#define XB_SPIN(cond, bar) do { unsigned _sp = 0; while (cond) { __builtin_amdgcn_s_sleep(1); \
    if ((++_sp & 255u) == 0u) { if (xb_ld(&(bar)[XB_TMO])) break; if (_sp > XB_SPIN_CAP) { atomicAdd(&(bar)[XB_TMO], 1u); break; } } } } while (0)

struct XcdBarrier {
    unsigned* bar; unsigned x;
    volatile LAS unsigned* st;
};

__device__ __forceinline__ XcdBarrier xcd_barrier_post(unsigned* bar, volatile LAS unsigned* st) {
    XcdBarrier b; b.bar = bar; b.x = xb_xcc_id(); b.st = st;
    if (threadIdx.x == 0) (void)xb_add(&bar[XB_XCNT(b.x)], 1u);
    return b;
}
__device__ __forceinline__ void xcd_barrier_complete(unsigned* bar, unsigned x, unsigned& nloc, unsigned& nx) {
    const unsigned G = gridDim.x * gridDim.y * gridDim.z;
    unsigned sum, cnt, mine, sp = 0u;
    for (;;) {
        sum = 0u; cnt = 0u; mine = 0u;
#pragma unroll
        for (unsigned j = 0; j < 16; ++j) { const unsigned c = xb_ld(&bar[XB_XCNT(j)]); sum += c; cnt += (c > 0u) ? 1u : 0u; mine = (j == x) ? c : mine; }
        if (sum == G) break;
        __builtin_amdgcn_s_sleep(1);
        if ((++sp & 255u) == 0u) { if (xb_ld(&bar[XB_TMO])) break; if (sp > XB_SPIN_CAP) { atomicAdd(&bar[XB_TMO], 1u); break; } }
    }
    nloc = mine > 0u ? mine : 1u; nx = cnt > 0u ? cnt : 1u;
}

__device__ __forceinline__ void xcd_barrier(const XcdBarrier& b) {
    asm volatile("s_waitcnt vmcnt(0)" ::: "memory");
    __syncthreads();
    if (threadIdx.x == 0) {
        unsigned* bar = b.bar;
        __builtin_amdgcn_s_waitcnt(0);
        unsigned nloc = b.st[0], nx = b.st[1];
        if (nloc == 0u) { xcd_barrier_complete(bar, b.x, nloc, nx); b.st[0] = nloc; b.st[1] = nx; }
        const unsigned old = xb_add(&bar[XB_XSUB(b.x)], 1u);
        const unsigned gen = old / nloc;
        if (old + 1u == (gen + 1u) * nloc) {
            __builtin_amdgcn_fence(__ATOMIC_RELEASE, "agent");
            asm volatile("s_waitcnt vmcnt(0)" ::: "memory");
            const unsigned og = xb_add(&bar[XB_TOP], 1u);
            const unsigned tg = og / nx;
            if (og + 1u == (tg + 1u) * nx) xb_add(&bar[XB_TOPGEN], 1u);
            else XB_SPIN(xb_ld(&bar[XB_TOPGEN]) == tg, bar);
            __builtin_amdgcn_fence(__ATOMIC_ACQUIRE, "agent");
            xb_add(&bar[XB_XGEN(b.x)], 1u);
            asm volatile("s_waitcnt vmcnt(0)" ::: "memory");
        } else {
            XB_SPIN(xb_ld(&bar[XB_XGEN(b.x)]) == gen, bar);
            __builtin_amdgcn_fence(__ATOMIC_ACQUIRE, "agent");
            asm volatile("s_waitcnt vmcnt(0)" ::: "memory");
        }
    }
    __syncthreads();
}


__device__ __forceinline__ void sub_barrier(unsigned* word, unsigned n, unsigned* bar) {
    asm volatile("s_waitcnt vmcnt(0)" ::: "memory");
    __syncthreads();
    if (threadIdx.x == 0) {
        __builtin_amdgcn_s_waitcnt(0);
        __builtin_amdgcn_fence(__ATOMIC_RELEASE, "agent");
        asm volatile("s_waitcnt vmcnt(0)" ::: "memory");
        (void)xb_add(word, 1u);
        XB_SPIN(xb_ld(word) < n, bar);
        __builtin_amdgcn_fence(__ATOMIC_ACQUIRE, "agent");
        asm volatile("s_waitcnt vmcnt(0)" ::: "memory");
    }
    __syncthreads();
}

__global__ void __launch_bounds__(NWAVES * 64, 2) fwd_kernel(Args  ) {
    extern __shared__ __attribute__((aligned(16))) unsigned char lds_raw[];
    LAS unsigned char* lds = (LAS unsigned char*)lds_raw;
    const int tid = threadIdx.x, lane = tid & 63, wave = __builtin_amdgcn_readfirstlane(tid >> 6), G = gridDim.x, bx = blockIdx.x;
    volatile LAS unsigned* MISC = (volatile LAS unsigned*)(lds + MISC_OFF);
    for (int u = tid; u < (LDS_BYTES - LDSCTL_OFF) / 4; u += NWAVES * 64) ((LAS unsigned*)(lds + LDSCTL_OFF))[u] = 0u;
    __syncthreads();
    XcdBarrier bar;
    { const DArgs a = load_args(); gu32* ctl = (gu32*)(a.ws + WS_CTL); bar = xcd_barrier_post((unsigned*)(ctl + CW_BAR), MISC + 8); }
#define GRID_BAR() do { XcdBarrier b_ = bar; asm volatile("" : "+s"(b_.bar), "+s"(b_.x)); xcd_barrier(b_); } while (0)


    for (int t = bx; t < 192; t += G) mod_task64(lds, tid, lane, wave, 0, t);
    cvt_fill(lds, tid, 0, -1, 0);
    GRID_BAR();
    row_pass<0>(0, bx, G, wave, lane);
    GRID_BAR();

    const int nl = fresh_s(DEPTH);
    for (int li = 0; li < nl; ++li) {
        const int l = li;
        const bool dfl = fresh_s(G) == 256;
        { const int x = bx & 7, r = bx >> 3;
          pg8::G5Order S; S.st = !dfl; S.so.init(NTOK, INC, fresh_s(G), fresh_s(bx));
          if (r < 24) { S.u0.pm = 3 * x + r % 3; S.u0.pn = 8 + r / 3; } else if (r < 28) { S.u0.pm = 3 * x + (r - 24) % 3; S.u0.pn = (r - 24) / 3; } else { S.u0.pm = -1; S.u0.pn = 0; }
          if (S.st || S.u0.pm >= 0) {
              const DArgs a = load_args(); pg8::Gemm g{(const bf16*)(a.ws + WS_H), (const bf16*)(a.ws + WS_WIN) + (size_t)l * INC * DM, NTOK, INC, DM};
              pg8::EpiIn E{(bf16*)(a.ws + WS_GB), (bf16*)(a.ws + WS_V), (bf16*)(a.ws + WS_U)};
              pg8::gemm_phase<pg8::EpiIn, pg8::G5Order, true, true>(lds, g, S, E);
          } else cvt_slot(lds, tid, l, li + 1 < nl, 12);
        }
        GRID_BAR();
        s5_phase(lds, tid, lane, wave, bx, G, l);
        GRID_BAR();
        { const int x = bx & 7, r = bx >> 3;
          if (dfl && r < 20) {
              pg8::G5Order S; S.st = false; S.u0.pm = 3 * x + (r + 4) % 3; S.u0.pn = (r + 4) / 3;
              const DArgs a = load_args(); pg8::Gemm g{(const bf16*)(a.ws + WS_H), (const bf16*)(a.ws + WS_WIN) + (size_t)l * INC * DM, NTOK, INC, DM};
              pg8::EpiIn E{(bf16*)(a.ws + WS_GB), (bf16*)(a.ws + WS_V), (bf16*)(a.ws + WS_U)};
              pg8::gemm_phase<pg8::EpiIn, pg8::G5Order, true, true>(lds, g, S, E);
          } else {
              pg8::G5Order S; S.st = !dfl; S.so.init(NTOK, SW, fresh_s(G), fresh_s(bx)); S.u0.pm = 3 * x + (r - 20) % 3; S.u0.pn = (r - 20) / 3;
              const DArgs a = load_args(); pg8::Gemm g{(const bf16*)(a.ws + WS_Z), (const bf16*)(a.ws + WS_WGLU) + (size_t)l * SW * SW, NTOK, SW, SW};
              pg8::EpiGlu E{(const bf16*)(a.ws + WS_Z), (bf16*)(a.ws + WS_O), a.in[I_BGLU] + (size_t)l * SW};
              pg8::gemm_phase<pg8::EpiGlu, pg8::G5Order, true, true>(lds, g, S, E);
              cvt_slot(lds, tid, l, li + 1 < nl, 4);
          }
        }
        GRID_BAR();
        mix_pass(bx, G, wave, lane, l);
        GRID_BAR();
        { const DArgs a = load_args(); pg8::Gemm g{(const bf16*)(a.ws + WS_MIXIN), (const bf16*)(a.ws + WS_WOUT) + (size_t)l * DM * DM, NTOK, DM, DM}; pg8::G5Order S; S.st = !dfl; S.so.init(NTOK, DM, fresh_s(G), fresh_s(bx)); { const int x = bx & 7, r = bx >> 3; S.u0.pm = r < 24 ? 3 * x + r % 3 : -1; S.u0.pn = r / 3; }
          pg8::EpiBf16<0> E{(bf16*)(a.ws + WS_MIXED), DM, nullptr, 0, 0, 1.f};
          pg8::gemm_phase<pg8::EpiBf16<0>, pg8::G5Order, true, true>(lds, g, S, E); }
        if (li + 1 < nl && G != 256) for (int t = bx; t < 48; t += G) mod_task(lds, tid, lane, wave, 48 * (l + 1) + t);
        if (bx >= 192) cvt_slot(lds, tid, l, li + 1 < nl, 12);
        GRID_BAR();
        row_pass<1>(l, bx, G, wave, lane);
        cvt_fill(lds, tid, l, -1, 1);
        GRID_BAR();
        { const DArgs a = load_args(); pg8::Gemm g{(const bf16*)(a.ws + WS_H), (const bf16*)(a.ws + WS_WUP) + (size_t)l * UPN * DM, NTOK, UPN, DM}; pg8::G4Order S{0, dfl ? 1024 : 1056, fresh_s(G), fresh_s(bx), !dfl};
          pg8::EpiFfn E{(bf16*)(a.ws + WS_ACT), a.in[I_FFNW] + (size_t)l * 3 * UPN, (LAS float*)(lds + RING_BYTES)};
          pg8::gemm_phase<pg8::EpiFfn, pg8::G4Order, true, true>(lds, g, S, E); }
        GRID_BAR();
        if (dfl && bx < 32) {
            { const DArgs a = load_args(); pg8::Gemm g{(const bf16*)(a.ws + WS_H), (const bf16*)(a.ws + WS_WUP) + (size_t)l * UPN * DM, NTOK, UPN, DM}; pg8::G4Order S{1024, 1056, fresh_s(G), fresh_s(bx), false};
              pg8::EpiFfn E{(bf16*)(a.ws + WS_ACT), a.in[I_FFNW] + (size_t)l * 3 * UPN, (LAS float*)(lds + RING_BYTES)};
              pg8::gemm_phase<pg8::EpiFfn, pg8::G4Order, true, true>(lds, g, S, E); }
            { const DArgs a = load_args(); sub_barrier((unsigned*)(a.ws + WS_CTL) + CW_SUB + 64 * l, 32u, (unsigned*)(a.ws + WS_CTL) + CW_BAR); }
            { const DArgs a = load_args(); pg8::Gemm g{(const bf16*)(a.ws + WS_ACT) + (size_t)23 * 256 * DFF, (const bf16*)(a.ws + WS_WDN) + (size_t)l * DM * DFF, 256, 4 * DM, DFF / 4, DFF, 4};
              pg8::G5Order S; S.st = false; S.u0.pm = 0; S.u0.pn = fresh_s(bx);
              pg8::EpiBf16<0> E{(bf16*)(a.ws + WS_FFP), DM, nullptr, DM, (size_t)256 * DM, 1.f};
              pg8::gemm_phase<pg8::EpiBf16<0>, pg8::G5Order, true, true>(lds, g, S, E); }
            if (li + 1 < nl) cvt_fill(lds, tid, l + 1, 8);
        } else {
            const int x = bx & 7, r = (bx >> 3) - 4;
            pg8::G5Order S; S.st = !dfl; S.so.init(NTOK, DM, fresh_s(G), fresh_s(bx));
            if (bx < 224 && !(x == 7 && r >= 16)) { S.u0.pm = x < 7 ? 3 * x + r % 3 : 21 + (r & 1); S.u0.pn = x < 7 ? r / 3 : r >> 1; } else { S.u0.pm = -1; S.u0.pn = 0; }
            if (S.st || S.u0.pm >= 0) {
                const DArgs a = load_args(); pg8::Gemm g{(const bf16*)(a.ws + WS_ACT), (const bf16*)(a.ws + WS_WDN) + (size_t)l * DM * DFF, NTOK, DM, DFF};
                pg8::EpiBf16<0> E{(bf16*)(a.ws + WS_FF), DM, nullptr, 0, 0, 1.f};
                pg8::gemm_phase<pg8::EpiBf16<0>, pg8::G5Order, true, true>(lds, g, S, E);
            } else if (li + 1 < nl) {
                if (dfl) { const int q = bx >= 224 ? bx - 224 : 32 + (r - 16);
                    mod_task(lds, tid, lane, wave, 48 * (l + 1) + q); if (q + 40 < 48) mod_task(lds, tid, lane, wave, 48 * (l + 1) + q + 40); }
                cvt_fill(lds, tid, l + 1, dfl ? 4 : 48);
            }
        }
        GRID_BAR();
        if (li < nl - 1) {
            row_pass<2>(l, bx, G, wave, lane, fresh_s(G) == 256);
            cvt_fill(lds, tid, l + 1, -1);
            GRID_BAR();
        } else {
            row_pass<3>(l, bx, G, wave, lane, fresh_s(G) == 256);
        }
    }

#undef GRID_BAR
}

extern "C" void kernel_launch(void* const* d_in, const int* in_sizes, int n_in, void* d_out, int out_size, void* d_ws, size_t ws_size, hipStream_t stream) {
    static int grid = 0;
    if (grid == 0) {
        if (n_in != 30 || out_size != NTOK * DM + 2 * 524288 || ws_size < WS_END) { fprintf(stderr, "kernel_launch: unexpected shapes (n_in %d, out %d, ws %zu); nothing launched\n", n_in, out_size, ws_size); grid = -1; return; }
        int dev = 0, cus = 0, per_cu = 0;
        if (hipGetDevice(&dev) != hipSuccess || hipDeviceGetAttribute(&cus, hipDeviceAttributeMultiprocessorCount, dev) != hipSuccess) { grid = -1; return; }
        if (hipFuncSetAttribute((const void*)fwd_kernel, hipFuncAttributeMaxDynamicSharedMemorySize, LDS_BYTES) != hipSuccess) { fprintf(stderr, "kernel_launch: hipFuncSetAttribute failed\n"); grid = -1; return; }
        if (hipOccupancyMaxActiveBlocksPerMultiprocessor(&per_cu, (const void*)fwd_kernel, NWAVES * 64, LDS_BYTES) != hipSuccess || per_cu < 1)
            fprintf(stderr, "kernel_launch: note: occupancy query reports %d workgroups per CU\n", per_cu);
        (void)hipGetLastError();
        grid = cus;
    }
    if (grid < 0) return;
    if (hipMemsetAsync((char*)d_ws + WS_CTL, 0, CTL_ZERO_BYTES, stream) != hipSuccess) return;
    Args a{};
    for (int i = 0; i < 30; ++i) a.in[i] = (const float*)d_in[i];
    a.out = (float*)d_out; a.ws = (unsigned char*)d_ws;
    hipLaunchKernelGGL(fwd_kernel, dim3(grid), dim3(NWAVES * 64), LDS_BYTES, stream, a);
}
```
